# Optimizing an MI355X kernel written in HIP

```python
import math, functools
import jax, jax.numpy as jnp
from jax import lax
import numpy as np

D_MODEL = 1024
BATCH = 2
SEQ = 8192
DEPTH = 1
DEC_BATCH = 128
DEC_SEQ = 8
PAST_LEN = 16384
PAGE_SIZE = 128

M_HEADS = 4
M_DK = 64
M_DV = 128
M_CHUNK = 64
M_QK_W = M_HEADS * M_DK
M_V_W = M_HEADS * M_DV
FORGET_BIAS_MEAN = 3.0
A_HEADS = 8
A_KV_HEADS = 2
A_HEAD_DIM = 64
A_GROUPS = A_HEADS // A_KV_HEADS
A_Q_W = A_HEADS * A_HEAD_DIM
A_KV_W = A_KV_HEADS * A_HEAD_DIM
WINDOW = 128
D_FF = -(-8 * D_MODEL // (3 * 256)) * 256
EPS = 1e-6
IN_SIZES = (M_QK_W, M_QK_W, M_V_W, M_V_W, M_HEADS, M_HEADS, A_Q_W, A_KV_W, A_KV_W, D_MODEL, D_MODEL)
D_IN = sum(IN_SIZES)

kernel_name = "hybrid_mlstm_swa_sink_decoder_step"


def rms_norm(x, w):
    xf = x.astype(jnp.float32)
    y = xf * lax.rsqrt(jnp.mean(xf * xf, axis=-1, keepdims=True) + EPS)
    return (y * w.astype(jnp.float32)).astype(x.dtype)


def mlstm_chunkwise(q, k, v, i_pre, f_pre, C0, n0, m0):
    f32 = jnp.float32
    B, T = q.shape[0], q.shape[1]
    L = math.gcd(T, M_CHUNK)
    nc = T // L

    def chunks(a):
        a = a.astype(f32).reshape((B, nc, L) + a.shape[2:])
        return jnp.moveaxis(jnp.moveaxis(a, 1, 0), 3, 2)

    qc = chunks(q)
    kc = chunks(k) * (M_DK ** -0.5)
    vc = chunks(v)
    ic = chunks(i_pre)
    bc = jnp.cumsum(jax.nn.log_sigmoid(chunks(f_pre)), axis=-1)
    causal = jnp.tril(jnp.ones((L, L), dtype=bool))

    def step(carry, xs):
        C, n, m = carry
        q_, k_, v_, i_, b_ = xs
        logw = jnp.where(causal, b_[..., :, None] - b_[..., None, :] + i_[..., None, :], -jnp.inf)
        inter = b_ + m[..., None]
        m_t = jnp.maximum(inter, logw.max(axis=-1))
        w_inter = jnp.exp(inter - m_t)
        w = jnp.exp(logw - m_t[..., None])
        s = jnp.einsum('bhtd,bhsd->bhts', q_, k_) * w
        num = w_inter[..., None] * jnp.einsum('bhtd,bhde->bhte', q_, C) + jnp.einsum('bhts,bhse->bhte', s, v_)
        den = w_inter * jnp.einsum('bhtd,bhd->bht', q_, n) + s.sum(axis=-1)
        h = num / jnp.maximum(jnp.abs(den), jnp.exp(-m_t))[..., None]
        w_last = w[..., -1, :]
        g = w_inter[..., -1]
        C = g[..., None, None] * C + jnp.einsum('bhs,bhsd,bhse->bhde', w_last, k_, v_)
        n = g[..., None] * n + jnp.einsum('bhs,bhsd->bhd', w_last, k_)
        return (C, n, m_t[..., -1]), h

    (C, n, m), h = lax.scan(step, (C0.astype(f32), n0.astype(f32), m0.astype(f32)), (qc, kc, vc, ic, bc))
    h = jnp.moveaxis(jnp.moveaxis(h, 2, 3), 0, 1).reshape(B, T, M_HEADS, M_DV)
    return h, C, n, m


def sink_softmax(scores, mask, sinks):
    s = jnp.where(mask, scores, -jnp.inf)
    sk = sinks.astype(jnp.float32).reshape(A_KV_HEADS, A_GROUPS)[:, :, None, None]
    mx = jnp.maximum(s.max(axis=-1, keepdims=True), sk)
    p = jnp.exp(s - mx)
    return p / (p.sum(axis=-1, keepdims=True) + jnp.exp(sk - mx))


def swa_prompt(q, k, v, sinks):
    f32 = jnp.float32
    B, T = q.shape[0], q.shape[1]
    nb = T // WINDOW
    qb = q.astype(f32).reshape(B, nb, WINDOW, A_KV_HEADS, A_GROUPS, A_HEAD_DIM)
    kb = k.astype(f32).reshape(B, nb, WINDOW, A_KV_HEADS, A_HEAD_DIM)
    vb = v.astype(f32).reshape(B, nb, WINDOW, A_KV_HEADS, A_HEAD_DIM)

    def with_prev(a):
        prev = jnp.pad(a, ((0, 0), (1, 0), (0, 0), (0, 0), (0, 0)))[:, :-1]
        return jnp.concatenate([prev, a], axis=2)

    kk, vv = with_prev(kb), with_prev(vb)
    scores = jnp.einsum('bnqkgd,bnskd->bnkgqs', qb, kk) * (A_HEAD_DIM ** -0.5)
    dist = jnp.arange(WINDOW)[:, None] + WINDOW - jnp.arange(2 * WINDOW)[None, :]
    local = (dist >= 0) & (dist < WINDOW)
    valid = (jnp.arange(nb)[:, None, None] > 0) | (jnp.arange(2 * WINDOW)[None, None, :] >= WINDOW)
    mask = local[None] & valid
    p = sink_softmax(scores, mask[None, :, None, None], sinks)
    out = jnp.einsum('bnkgqs,bnskd->bnqkgd', p, vv).reshape(B, T, A_Q_W)
    wb = min(WINDOW, T)
    return out.astype(q.dtype), k[:, T - wb:], v[:, T - wb:]


def swa_sample(q, k, v, sinks, k_buf, v_buf):
    f32 = jnp.float32
    B, T = q.shape[0], q.shape[1]
    wb = k_buf.shape[1]
    kc = jnp.concatenate([k_buf.astype(k.dtype), k], axis=1)
    vc = jnp.concatenate([v_buf.astype(v.dtype), v], axis=1)
    qg = q.astype(f32).reshape(B, T, A_KV_HEADS, A_GROUPS, A_HEAD_DIM)
    scores = jnp.einsum('btkgd,bskd->bkgts', qg, kc.astype(f32)) * (A_HEAD_DIM ** -0.5)
    dist = jnp.arange(T)[:, None] + wb - jnp.arange(wb + T)[None, :]
    mask = (dist >= 0) & (dist < WINDOW)
    p = sink_softmax(scores, mask, sinks)
    out = jnp.einsum('bkgts,bskd->btkgd', p, vc.astype(f32)).reshape(B, T, A_Q_W)
    return out.astype(q.dtype), kc[:, T:], vc[:, T:]


def layer(x, C0, n0, m0, attn, norm_mix_w, w_in, i_bias, f_bias, m_norm_w, q_norm_w, k_norm_w, sinks,
          w_branch_a, w_branch_b, w_out, norm_ffn_w, w_gate, w_up, w_down):
    B, T = x.shape[0], x.shape[1]
    hn = rms_norm(x, norm_mix_w)
    proj = hn @ w_in
    idx = np.cumsum(IN_SIZES)[:-1].tolist()
    q_m, k_m, v_m, o_m, i_m, f_m, q_a, k_a, v_a, g_a, g_b = jnp.split(proj, idx, axis=-1)

    def heads(a, h):
        return a.reshape(B, T, h, -1)

    h_m, C, n, m = mlstm_chunkwise(heads(q_m, M_HEADS), heads(k_m, M_HEADS), heads(v_m, M_HEADS),
                                   i_m + i_bias, f_m + f_bias, C0, n0, m0)
    h_m = rms_norm(h_m, m_norm_w).reshape(B, T, M_V_W)
    h_m = (h_m * jax.nn.sigmoid(o_m.astype(jnp.float32))).astype(x.dtype)
    qa = rms_norm(heads(q_a, A_HEADS), q_norm_w)
    ka = rms_norm(heads(k_a, A_KV_HEADS), k_norm_w)
    h_a, k_win, v_win = attn(qa, ka, heads(v_a, A_KV_HEADS), sinks)
    mix = jax.nn.sigmoid(g_a) * (h_m @ w_branch_a) + jax.nn.sigmoid(g_b) * (h_a @ w_branch_b)
    x = x + mix @ w_out
    hf = rms_norm(x, norm_ffn_w)
    x = x + (jax.nn.silu(hf @ w_gate) * (hf @ w_up)) @ w_down
    return x, C, n, m, k_win, v_win


def setup_inputs(seed: int = 0) -> dict:
    key = jax.random.key(seed)
    ks = jax.random.split(key, 24)
    f32 = jnp.float32
    wb = min(WINDOW, PAST_LEN)
    nrm = lambda k, shape, scale: jax.random.normal(k, shape, f32) * scale
    return {
        'x_prompt': nrm(ks[0], (BATCH, SEQ, D_MODEL), 1.0),
        'x_sample': nrm(ks[1], (DEC_BATCH, DEC_SEQ, D_MODEL), 1.0),
        'state_mlstm_C': nrm(ks[2], (DEPTH, DEC_BATCH, M_HEADS, M_DK, M_DV), 0.5),
        'state_mlstm_n': nrm(ks[3], (DEPTH, DEC_BATCH, M_HEADS, M_DK), 0.5),
        'state_mlstm_m': nrm(ks[4], (DEPTH, DEC_BATCH, M_HEADS), 1.0),
        'cache_swa_k': nrm(ks[5], (DEPTH, DEC_BATCH, wb, A_KV_HEADS, A_HEAD_DIM), 1.0),
        'cache_swa_v': nrm(ks[6], (DEPTH, DEC_BATCH, wb, A_KV_HEADS, A_HEAD_DIM), 1.0),
        'norm_mix_w': 1.0 + nrm(ks[7], (DEPTH, D_MODEL), 0.02),
        'w_in': nrm(ks[8], (DEPTH, D_MODEL, D_IN), D_MODEL ** -0.5),
        'mlstm_i_bias': nrm(ks[9], (DEPTH, M_HEADS), 0.1),
        'mlstm_f_bias': FORGET_BIAS_MEAN + nrm(ks[10], (DEPTH, M_HEADS), 0.5),
        'mlstm_norm_w': 1.0 + nrm(ks[11], (DEPTH, M_HEADS, M_DV), 0.02),
        'q_norm_w': 1.0 + nrm(ks[12], (DEPTH, A_HEAD_DIM), 0.02),
        'k_norm_w': 1.0 + nrm(ks[13], (DEPTH, A_HEAD_DIM), 0.02),
        'attn_sinks': nrm(ks[14], (DEPTH, A_HEADS), 0.5),
        'w_branch_a': nrm(ks[15], (DEPTH, M_V_W, D_MODEL), M_V_W ** -0.5),
        'w_branch_b': nrm(ks[16], (DEPTH, A_Q_W, D_MODEL), A_Q_W ** -0.5),
        'w_out': nrm(ks[17], (DEPTH, D_MODEL, D_MODEL), D_MODEL ** -0.5),
        'norm_ffn_w': 1.0 + nrm(ks[18], (DEPTH, D_MODEL), 0.02),
        'w_gate': nrm(ks[19], (DEPTH, D_MODEL, D_FF), D_MODEL ** -0.5),
        'w_up': nrm(ks[20], (DEPTH, D_MODEL, D_FF), D_MODEL ** -0.5),
        'w_down': nrm(ks[21], (DEPTH, D_FF, D_MODEL), D_FF ** -0.5),
    }


def reference(x_prompt, x_sample, state_mlstm_C, state_mlstm_n, state_mlstm_m, cache_swa_k, cache_swa_v,
              norm_mix_w, w_in, mlstm_i_bias, mlstm_f_bias, mlstm_norm_w, q_norm_w, k_norm_w, attn_sinks,
              w_branch_a, w_branch_b, w_out, norm_ffn_w, w_gate, w_up, w_down):
    f32 = jnp.float32
    bp = x_prompt.shape[0]
    yp, ys = x_prompt, x_sample
    Cp_l, np_l, mp_l, kp_l, vp_l = [], [], [], [], []
    Cs_l, ns_l, ms_l, ks_l, vs_l = [], [], [], [], []
    for l in range(DEPTH):
        w = (norm_mix_w[l], w_in[l], mlstm_i_bias[l], mlstm_f_bias[l], mlstm_norm_w[l], q_norm_w[l],
             k_norm_w[l], attn_sinks[l], w_branch_a[l], w_branch_b[l], w_out[l], norm_ffn_w[l],
             w_gate[l], w_up[l], w_down[l])
        C0 = jnp.zeros((bp, M_HEADS, M_DK, M_DV), f32)
        n0 = jnp.zeros((bp, M_HEADS, M_DK), f32)
        m0 = jnp.zeros((bp, M_HEADS), f32)
        yp, Cp, np_, mp, kp, vp = layer(yp, C0, n0, m0, swa_prompt, *w)
        attn_s = functools.partial(swa_sample, k_buf=cache_swa_k[l], v_buf=cache_swa_v[l])
        ys, Cs, ns, ms, kS, vS = layer(ys, state_mlstm_C[l], state_mlstm_n[l], state_mlstm_m[l], attn_s, *w)
        Cp_l.append(Cp); np_l.append(np_); mp_l.append(mp); kp_l.append(kp); vp_l.append(vp)
        Cs_l.append(Cs); ns_l.append(ns); ms_l.append(ms); ks_l.append(kS); vs_l.append(vS)
    return (yp, ys,
            jnp.stack(Cp_l), jnp.stack(np_l), jnp.stack(mp_l), jnp.stack(kp_l), jnp.stack(vp_l),
            jnp.stack(Cs_l), jnp.stack(ns_l), jnp.stack(ms_l), jnp.stack(ks_l), jnp.stack(vs_l))
```

```cpp
#include <hip/hip_runtime.h>
#include <hip/hip_cooperative_groups.h>
#include <cstdio>
#include <cstdint>
namespace cg = cooperative_groups;

#ifndef N_LAUNCHES
#define N_LAUNCHES 1
#endif

namespace pg8 {
#define PG8_LAS __attribute__((address_space(3)))
typedef unsigned short bf16_t;
typedef short bf16x8 __attribute__((ext_vector_type(8)));
typedef float f32x4 __attribute__((ext_vector_type(4)));
typedef unsigned u32x4 __attribute__((ext_vector_type(4)));
constexpr int BM = 256, BK = 64, HALF = 128, HTB = HALF * BK * 2  , STAGE_BYTES = 8 * HTB, NXCD = 8, WGM = 8;

__host__ __device__ __forceinline__ int lds_byte(int r, int c) { const int st = (r >> 4) * 2 + (c >> 5), rr = r & 15, cc = c & 31, ob = rr * 64 + cc * 2; return st * 1024 + (ob ^ (((ob >> 9) & 1) << 5)); }
__host__ __device__ __forceinline__ void stage_rc(int b, int& R, int& C) { const int st = b / 1024, sb = b % 1024, swz = sb ^ (((sb >> 9) & 1) << 5); R = (st >> 1) * 16 + swz / 64; C = (st & 1) * 32 + (swz % 64) / 2; }
__host__ __device__ __forceinline__ int perm32(int rho) { const int n = rho >> 4, i = rho & 15; return 8 * (i >> 2) + 4 * n + (i & 3); }

struct Unit { int pm, pn; };
struct Gemm { const bf16_t* A; const bf16_t* Bt; int M, N, K; };

struct StaticOrder {
    int nM, nN, nwg, G, c;
    __host__ __device__ void init(int M, int N, int G_, int c_) { nM = M / BM; nN = N / BM; nwg = nM * nN; G = G_; c = c_; }
    __host__ __device__ bool next(int i, Unit& u) const {
        const long L = (long)i * G + c; if (L >= nwg) return false;
        int wgid = (int)L; { const int q = nwg / NXCD, r = nwg % NXCD, xcd = wgid % NXCD, off = wgid / NXCD; wgid = (xcd < r ? xcd * (q + 1) : r * (q + 1) + (xcd - r) * q) + off; }
        const int nig = WGM * nN, gid = wgid / nig, fm = gid * WGM, gsz = (nM - fm) < WGM ? (nM - fm) : WGM;
        u.pm = fm + ((wgid % nig) % gsz); u.pn = (wgid % nig) / gsz; return true;
    }
    __device__ __forceinline__ void a_ready(const Unit&) const {}
    __device__ __forceinline__ void done(const Unit&) const {}
};

__device__ __forceinline__ unsigned cvt_pk_bf16(float lo, float hi) { unsigned r; asm volatile("v_cvt_pk_bf16_f32 %0, %1, %2" : "=v"(r) : "v"(lo), "v"(hi)); return r; }
__device__ __forceinline__ float bflo(unsigned w) { return __builtin_bit_cast(float, w << 16); }
__device__ __forceinline__ float bfhi(unsigned w) { return __builtin_bit_cast(float, w & 0xffff0000u); }
__device__ __forceinline__ float sigm(float x) { return 1.0f / (1.0f + __expf(-x)); }

struct EpiProj {
    static constexpr bool PERM = true, AFTER_DRAIN = false, HAS_MID = false;
    bf16_t* mixin; bf16_t* gates;
    __device__ __forceinline__ void operator()(const f32x4 (&acc)[2][2][4][2], const Unit& u, int wr, int wc, int fr, int fq) const {
        const bool isg = u.pn >= 9; const bool sg = isg || u.pn == 4 || u.pn == 5;
        bf16_t* base = isg ? gates : mixin; const int ldc = isg ? 2048 : 2304;
        const int col0 = (isg ? (u.pn - 9) : u.pn) * 256 + wc * 32 + 8 * fq, row0 = u.pm * BM + wr * 64 + fr;
#pragma unroll
        for (int ai = 0; ai < 2; ++ai)
#pragma unroll
            for (int m = 0; m < 4; ++m) { bf16_t* rowp = base + (size_t)(row0 + ai * HALF + m * 16) * ldc + col0;
#pragma unroll
                for (int bj = 0; bj < 2; ++bj) { f32x4 v0 = acc[ai][bj][m][0], v1 = acc[ai][bj][m][1];
                    if (sg) {
#pragma unroll
                        for (int i = 0; i < 4; ++i) { v0[i] = sigm(v0[i]); v1[i] = sigm(v1[i]); } }
                    u32x4 w; w.x = cvt_pk_bf16(v0[0], v0[1]); w.y = cvt_pk_bf16(v0[2], v0[3]); w.z = cvt_pk_bf16(v1[0], v1[1]); w.w = cvt_pk_bf16(v1[2], v1[3]);
                    *(u32x4*)(rowp + bj * HALF) = w; } }
    }
};

struct EpiMix {
    static constexpr bool PERM = true, AFTER_DRAIN = false, HAS_MID = true;
    const bf16_t* gates; bf16_t* mix;
    __device__ __forceinline__ void mid(f32x4 (&acc)[2][2][4][2], const Unit& u, int wr, int wc, int fr, int fq) const {
        unsigned rb = (unsigned)(u.pm * BM + wr * 64 + fr) * 2048u + (unsigned)(u.pn * BM + wc * 32 + 8 * fq);
        asm volatile("" : "+v"(rb));
#pragma unroll
        for (int ai = 0; ai < 2; ++ai)
#pragma unroll
            for (int m = 0; m < 4; ++m) { const bf16_t* rowp = gates + (rb + (unsigned)((ai * HALF + m * 16) * 2048));
#pragma unroll
                for (int bj = 0; bj < 2; ++bj) { const u32x4 a = *(const u32x4*)(rowp + bj * HALF), b = *(const u32x4*)(rowp + 1024 + bj * HALF);
                    const float tiny = 8.673617379884035e-19f;
                    f32x4 r0, r1;
                    r0[0] = bflo(a.x) * __builtin_amdgcn_rcpf(fmaxf(bflo(b.x), tiny)); r0[1] = bfhi(a.x) * __builtin_amdgcn_rcpf(fmaxf(bfhi(b.x), tiny)); r0[2] = bflo(a.y) * __builtin_amdgcn_rcpf(fmaxf(bflo(b.y), tiny)); r0[3] = bfhi(a.y) * __builtin_amdgcn_rcpf(fmaxf(bfhi(b.y), tiny));
                    r1[0] = bflo(a.z) * __builtin_amdgcn_rcpf(fmaxf(bflo(b.z), tiny)); r1[1] = bfhi(a.z) * __builtin_amdgcn_rcpf(fmaxf(bfhi(b.z), tiny)); r1[2] = bflo(a.w) * __builtin_amdgcn_rcpf(fmaxf(bflo(b.w), tiny)); r1[3] = bfhi(a.w) * __builtin_amdgcn_rcpf(fmaxf(bfhi(b.w), tiny));
                    acc[ai][bj][m][0] = acc[ai][bj][m][0] * r0; acc[ai][bj][m][1] = acc[ai][bj][m][1] * r1; }
                if (m == 3) __builtin_amdgcn_sched_barrier(0); }
    }
    __device__ __forceinline__ void operator()(const f32x4 (&acc)[2][2][4][2], const Unit& u, int wr, int wc, int fr, int fq) const {
        const int col0 = u.pn * BM + wc * 32 + 8 * fq, row0 = u.pm * BM + wr * 64 + fr;
#pragma unroll
        for (int ai = 0; ai < 2; ++ai)
#pragma unroll
            for (int m = 0; m < 4; ++m) { const size_t row = (size_t)(row0 + ai * HALF + m * 16);
#pragma unroll
                for (int bj = 0; bj < 2; ++bj) { const u32x4 b = *(const u32x4*)(gates + row * 2048 + 1024 + col0 + bj * HALF);
                    const float tiny = 8.673617379884035e-19f;
                    f32x4 s0, s1;
                    s0[0] = fmaxf(bflo(b.x), tiny); s0[1] = fmaxf(bfhi(b.x), tiny); s0[2] = fmaxf(bflo(b.y), tiny); s0[3] = fmaxf(bfhi(b.y), tiny);
                    s1[0] = fmaxf(bflo(b.z), tiny); s1[1] = fmaxf(bfhi(b.z), tiny); s1[2] = fmaxf(bflo(b.w), tiny); s1[3] = fmaxf(bfhi(b.w), tiny);
                    const f32x4 v0 = acc[ai][bj][m][0] * s0, v1 = acc[ai][bj][m][1] * s1;
                    u32x4 w; w.x = cvt_pk_bf16(v0[0], v0[1]); w.y = cvt_pk_bf16(v0[2], v0[3]); w.z = cvt_pk_bf16(v1[0], v1[1]); w.w = cvt_pk_bf16(v1[2], v1[3]);
                    *(u32x4*)(mix + row * 1024 + col0 + bj * HALF) = w; } }
    }
};

struct EpiOut {
    static constexpr bool PERM = true, AFTER_DRAIN = false, HAS_MID = false;
    const float* xp; const float* xs; float* out; bf16_t* hfw; const float* nfw; float* rowss;
    __device__ __forceinline__ void operator()(const f32x4 (&acc)[2][2][4][2], const Unit& u, int wr, int wc, int fr, int fq) const {
        const int col0 = u.pn * BM + wc * 32 + 8 * fq, row0 = u.pm * BM + wr * 64 + fr;
#pragma unroll
        for (int ai = 0; ai < 2; ++ai)
#pragma unroll
            for (int m = 0; m < 4; ++m) { const int row = row0 + ai * HALF + m * 16;
                const float* xrow = row < 16384 ? xp + (size_t)row * 1024 : xs + (size_t)(row - 16384) * 1024;
                float ss = 0.f;
#pragma unroll
                for (int bj = 0; bj < 2; ++bj) { const int c = col0 + bj * HALF;
                    const f32x4 y0 = *(const f32x4*)(xrow + c) + acc[ai][bj][m][0], y1 = *(const f32x4*)(xrow + c + 4) + acc[ai][bj][m][1];
                    *(f32x4*)(out + (size_t)row * 1024 + c) = y0; *(f32x4*)(out + (size_t)row * 1024 + c + 4) = y1;
                    ss += (y0[0] * y0[0] + y0[1] * y0[1]) + (y0[2] * y0[2] + y0[3] * y0[3]) + (y1[0] * y1[0] + y1[1] * y1[1]) + (y1[2] * y1[2] + y1[3] * y1[3]);
                    const f32x4 w0 = *(const f32x4*)(nfw + c), w1 = *(const f32x4*)(nfw + c + 4);
                    const f32x4 z0 = y0 * w0, z1 = y1 * w1;
                    u32x4 w; w.x = cvt_pk_bf16(z0[0], z0[1]); w.y = cvt_pk_bf16(z0[2], z0[3]); w.z = cvt_pk_bf16(z1[0], z1[1]); w.w = cvt_pk_bf16(z1[2], z1[3]);
                    *(u32x4*)(hfw + (size_t)row * 1024 + c) = w; }
                ss += __shfl_xor(ss, 16); ss += __shfl_xor(ss, 32);
                if (fq == 0) unsafeAtomicAdd(rowss + row, ss); }
    }
};

struct EpiGU {
    static constexpr bool PERM = true, AFTER_DRAIN = false, HAS_MID = false;
    bf16_t* act; const float* rowss;
    __device__ __forceinline__ void operator()(const f32x4 (&acc)[2][2][4][2], const Unit& u, int wr, int wc, int fr, int fq) const {
        const int col0 = u.pn * HALF + wc * 32 + 8 * fq, row0 = u.pm * BM + wr * 64 + fr;
#pragma unroll
        for (int ai = 0; ai < 2; ++ai)
#pragma unroll
            for (int m = 0; m < 4; ++m) { const int row = row0 + ai * HALF + m * 16;
                const float rstd = __builtin_amdgcn_rsqf(rowss[row] * (1.0f / 1024.0f) + 1e-6f);
                float o[8];
#pragma unroll
                for (int n = 0; n < 2; ++n)
#pragma unroll
                    for (int j = 0; j < 4; ++j) { const float g = acc[ai][0][m][n][j] * rstd, up = acc[ai][1][m][n][j] * rstd; o[n * 4 + j] = g * sigm(g) * up; }
                u32x4 w; w.x = cvt_pk_bf16(o[0], o[1]); w.y = cvt_pk_bf16(o[2], o[3]); w.z = cvt_pk_bf16(o[4], o[5]); w.w = cvt_pk_bf16(o[6], o[7]);
                *(u32x4*)(act + (size_t)row * 2816 + col0) = w; }
    }
};

struct EpiDown {
    static constexpr bool PERM = true, AFTER_DRAIN = false, HAS_MID = false;
    float* out;
    __device__ __forceinline__ void operator()(const f32x4 (&acc)[2][2][4][2], const Unit& u, int wr, int wc, int fr, int fq) const {
        const int col0 = u.pn * BM + wc * 32 + 8 * fq, row0 = u.pm * BM + wr * 64 + fr;
#pragma unroll
        for (int ai = 0; ai < 2; ++ai)
#pragma unroll
            for (int m = 0; m < 4; ++m) { float* rowp = out + (size_t)(row0 + ai * HALF + m * 16) * 1024 + col0;
#pragma unroll
                for (int bj = 0; bj < 2; ++bj) { const f32x4 y0 = *(const f32x4*)(rowp + bj * HALF) + acc[ai][bj][m][0], y1 = *(const f32x4*)(rowp + bj * HALF + 4) + acc[ai][bj][m][1];
                    *(f32x4*)(rowp + bj * HALF) = y0; *(f32x4*)(rowp + bj * HALF + 4) = y1; } }
    }
};

template <class Epi, class Sched, bool ALIGN_EPI = false, bool SP2 = false>
__device__ __forceinline__ void gemm_phase(PG8_LAS unsigned char* lds, const Gemm g, const Sched& S, const Epi& E) {
    const int tid = threadIdx.x, wid = __builtin_amdgcn_readfirstlane(tid >> 6), lane = tid & 63, wr = wid >> 2, wc = wid & 3, fr = lane & 15, fq = lane >> 4;
    const int K = g.K, nt = K / BK;
    unsigned voffA[2], voffB[2];
#pragma unroll
    for (int i = 0; i < 2; ++i) { int R, C; stage_rc(tid * 16 + i * 8192, R, C); const int Rb = Epi::PERM ? ((R & ~31) + perm32(R & 31)) : R;
        voffA[i] = (unsigned)(R * K + C) * 2u; voffB[i] = (unsigned)(Rb * K + C) * 2u; }
    const size_t kstep = (size_t)(BK * 2);
    const size_t hstep = (size_t)HALF * K * 2;
    const size_t tstep = 2 * hstep;
    const unsigned ldsw = (unsigned)wid * 1024u;
    const int aoff = lds_byte(wr * 64 + fr, fq * 8), boff = lds_byte(wc * 32 + fr, fq * 8);
#define PG8_SA(b, h) (((b) * 2 + (h)) * HTB)
#define PG8_SB(b, h) ((4 + (b) * 2 + (h)) * HTB)
#define PG8_STAGE(bufoff, gbase, voff) do { _Pragma("unroll") for (int _i = 0; _i < 2; ++_i) \
        __builtin_amdgcn_global_load_lds((const unsigned*)((const char*)(gbase) + (voff)[_i]), (PG8_LAS unsigned*)(lds + (bufoff) + ldsw + _i * 8192), 16, 0, 0); } while (0)
#define PG8_LDA(dst, b, h) do { _Pragma("unroll") for (int m = 0; m < 4; ++m) _Pragma("unroll") for (int k = 0; k < 2; ++k) dst[m][k] = *(const PG8_LAS bf16x8*)(lds + PG8_SA(b, h) + aoff + m * 2048 + k * 1024); } while (0)
#define PG8_LDB(dst, b, h) do { _Pragma("unroll") for (int n = 0; n < 2; ++n) _Pragma("unroll") for (int k = 0; k < 2; ++k) dst[n][k] = *(const PG8_LAS bf16x8*)(lds + PG8_SB(b, h) + boff + n * 2048 + k * 1024); } while (0)
#define PG8_MMA(ai, bj, At, Bt) do { __builtin_amdgcn_s_setprio(1); _Pragma("unroll") for (int m = 0; m < 4; ++m) _Pragma("unroll") for (int n = 0; n < 2; ++n) _Pragma("unroll") for (int k = 0; k < 2; ++k) \
        acc[ai][bj][m][n] = __builtin_amdgcn_mfma_f32_16x16x32_bf16(Bt[n][k], At[m][k], acc[ai][bj][m][n], 0, 0, 0); __builtin_amdgcn_s_setprio(0); } while (0)
#define PG8_WAIT_V(n) asm volatile("s_waitcnt vmcnt(" #n ")" ::: "memory")
#define PG8_WAIT_L(n) asm volatile("s_waitcnt lgkmcnt(" #n ")" ::: "memory")
#define PG8_BAR __builtin_amdgcn_s_barrier()
#define PG8_SCHED __builtin_amdgcn_sched_barrier(0)
    Unit cur, nxt; int ui = 0;
    if (!S.next(0, cur)) return;
    f32x4 acc[2][2][4][2];
#pragma unroll
    for (int a = 0; a < 2; ++a)
#pragma unroll
        for (int b = 0; b < 2; ++b)
#pragma unroll
            for (int m = 0; m < 4; ++m)
#pragma unroll
                for (int n = 0; n < 2; ++n) acc[a][b][m][n] = (f32x4){0.f, 0.f, 0.f, 0.f};
    bf16x8 At[4][2], B0[2][2], B1[2][2];
    const char* cA = (const char*)g.A + (size_t)cur.pm * tstep; const char* cB = (const char*)g.Bt + (size_t)cur.pn * tstep;
    S.a_ready(cur);
    if constexpr (SP2) {
        PG8_STAGE(PG8_SB(0, 0), cB, voffB); PG8_STAGE(PG8_SB(0, 1), cB + hstep, voffB); PG8_STAGE(PG8_SA(0, 0), cA, voffA); PG8_STAGE(PG8_SA(0, 1), cA + hstep, voffA);
        if (wr == 1) PG8_BAR;
        PG8_WAIT_V(2); PG8_BAR;
        PG8_STAGE(PG8_SB(1, 0), cB + kstep, voffB); PG8_STAGE(PG8_SA(1, 0), cA + kstep, voffA); PG8_STAGE(PG8_SB(1, 1), cB + hstep + kstep, voffB);
        PG8_WAIT_V(6); PG8_BAR;
    } else {
        PG8_STAGE(PG8_SB(0, 0), cB, voffB); PG8_STAGE(PG8_SA(0, 0), cA, voffA); PG8_STAGE(PG8_SB(0, 1), cB + hstep, voffB); PG8_STAGE(PG8_SA(0, 1), cA + hstep, voffA);
        if (wr == 1) PG8_BAR;
        PG8_WAIT_V(4); PG8_BAR;
        PG8_STAGE(PG8_SB(1, 0), cB + kstep, voffB); PG8_STAGE(PG8_SA(1, 0), cA + kstep, voffA); PG8_STAGE(PG8_SB(1, 1), cB + hstep + kstep, voffB);
        PG8_WAIT_V(6); PG8_BAR;
    }
    for (;;) {
        const bool has_next = S.next(ui + 1, nxt);
        const char* nA = has_next ? (const char*)g.A + (size_t)nxt.pm * tstep : cA; const char* nB = has_next ? (const char*)g.Bt + (size_t)nxt.pn * tstep : cB;
        for (int t = 0; t < nt; t += 2) {
            if constexpr (Epi::HAS_MID) { if (t == (nt >> 1)) E.mid(acc, cur, wr, wc, fr, fq); }
            const bool last = (t == nt - 2);
            const char* a1 = cA + (size_t)(t + 1) * kstep;
            const char* a2 = last ? nA : cA + (size_t)(t + 2) * kstep; const char* b2 = last ? nB : cB + (size_t)(t + 2) * kstep;
            const char* a3 = a2 + kstep; const char* b3 = b2 + kstep;
            if (last && has_next) S.a_ready(nxt);
            if constexpr (SP2) {
            PG8_LDB(B0, 0, 0); PG8_LDB(B1, 0, 1); PG8_SCHED; PG8_LDA(At, 0, 0); PG8_STAGE(PG8_SA(1, 1), a1 + hstep, voffA);
            PG8_WAIT_V(8); PG8_WAIT_L(0); PG8_BAR; PG8_MMA(0, 0, At, B0); PG8_MMA(0, 1, At, B1); PG8_BAR; PG8_SCHED;
            PG8_LDA(At, 0, 1); PG8_STAGE(PG8_SB(0, 0), b2, voffB); PG8_STAGE(PG8_SB(0, 1), b2 + hstep, voffB); PG8_STAGE(PG8_SA(0, 0), a2, voffA);
            PG8_WAIT_V(8); PG8_WAIT_L(0); PG8_BAR; PG8_MMA(1, 0, At, B0); PG8_MMA(1, 1, At, B1); PG8_BAR; PG8_SCHED;
            PG8_LDB(B0, 1, 0); PG8_LDB(B1, 1, 1); PG8_SCHED; PG8_LDA(At, 1, 0); PG8_STAGE(PG8_SA(0, 1), a2 + hstep, voffA);
            PG8_WAIT_V(8); PG8_WAIT_L(0); PG8_BAR; PG8_MMA(0, 0, At, B0); PG8_MMA(0, 1, At, B1); PG8_BAR; PG8_SCHED;
            PG8_LDA(At, 1, 1); PG8_STAGE(PG8_SB(1, 0), b3, voffB); PG8_STAGE(PG8_SB(1, 1), b3 + hstep, voffB); PG8_STAGE(PG8_SA(1, 0), a3, voffA);
            PG8_WAIT_V(8); PG8_WAIT_L(0); PG8_BAR; PG8_MMA(1, 0, At, B0); PG8_MMA(1, 1, At, B1); PG8_BAR; PG8_SCHED;
            } else {
            PG8_LDB(B0, 0, 0); PG8_SCHED; PG8_LDA(At, 0, 0); PG8_STAGE(PG8_SA(1, 1), a1 + hstep, voffA);
            PG8_WAIT_L(8); PG8_BAR; PG8_WAIT_L(0); PG8_MMA(0, 0, At, B0); PG8_BAR; PG8_SCHED;
            PG8_LDB(B1, 0, 1); PG8_STAGE(PG8_SB(0, 0), b2, voffB);
            PG8_BAR; PG8_WAIT_L(0); PG8_MMA(0, 1, At, B1); PG8_BAR;
            PG8_LDA(At, 0, 1); PG8_STAGE(PG8_SA(0, 0), a2, voffA);
            PG8_BAR; PG8_WAIT_L(0); PG8_MMA(1, 0, At, B0); PG8_BAR; PG8_SCHED;
            PG8_STAGE(PG8_SB(0, 1), b2 + hstep, voffB);
            PG8_WAIT_V(6); PG8_BAR; PG8_MMA(1, 1, At, B1); PG8_BAR;
            PG8_LDB(B0, 1, 0); PG8_SCHED; PG8_LDA(At, 1, 0); PG8_STAGE(PG8_SA(0, 1), a2 + hstep, voffA);
            PG8_WAIT_L(8); PG8_BAR; PG8_WAIT_L(0); PG8_MMA(0, 0, At, B0); PG8_BAR; PG8_SCHED;
            PG8_LDB(B1, 1, 1); PG8_STAGE(PG8_SB(1, 0), b3, voffB);
            PG8_BAR; PG8_WAIT_L(0); PG8_MMA(0, 1, At, B1); PG8_BAR;
            PG8_LDA(At, 1, 1); PG8_STAGE(PG8_SA(1, 0), a3, voffA);
            PG8_BAR; PG8_WAIT_L(0); PG8_MMA(1, 0, At, B0); PG8_BAR; PG8_SCHED;
            PG8_STAGE(PG8_SB(1, 1), b3 + hstep, voffB);
            PG8_WAIT_V(6); PG8_BAR; PG8_MMA(1, 1, At, B1); PG8_BAR;
            }
        }
        if constexpr (ALIGN_EPI) { if (wr == 0) PG8_BAR; }
        if constexpr (!Epi::AFTER_DRAIN) { E(acc, cur, wr, wc, fr, fq); S.done(cur); }
        if (!has_next) break;
#pragma unroll
        for (int a = 0; a < 2; ++a)
#pragma unroll
            for (int b = 0; b < 2; ++b)
#pragma unroll
                for (int m = 0; m < 4; ++m)
#pragma unroll
                    for (int n = 0; n < 2; ++n) acc[a][b][m][n] = (f32x4){0.f, 0.f, 0.f, 0.f};
        cur = nxt; cA = nA; cB = nB; ++ui;
        if constexpr (ALIGN_EPI) { if (wr == 1) PG8_BAR; }
    }
    PG8_WAIT_V(0);
    if constexpr (!ALIGN_EPI) { if (wr == 0) PG8_BAR; }
    PG8_BAR;
    if constexpr (Epi::AFTER_DRAIN) { E.fused(acc, cur, wr, wc, fr, fq, lds, wid, lane); S.done(cur); }
#undef PG8_SA
#undef PG8_SB
#undef PG8_STAGE
#undef PG8_LDA
#undef PG8_LDB
#undef PG8_MMA
#undef PG8_WAIT_V
#undef PG8_WAIT_L
#undef PG8_BAR
#undef PG8_SCHED
}
}
using pg8::bf16_t; using pg8::bf16x8; using pg8::f32x4; using pg8::u32x4; using pg8::cvt_pk_bf16; using pg8::bflo; using pg8::bfhi; using pg8::sigm;
typedef unsigned u32x2 __attribute__((ext_vector_type(2)));
constexpr int MP = 16384, MS = 1024, MT = MP + MS;
constexpr int DIN = 4360, NPROJ = 4352, NMIX = 2304, NGATE = 2048, DFF = 2816;
constexpr float EPS = 1e-6f, LOG2E = 1.4426950408889634f;
constexpr size_t MiB = 1u << 20;
constexpr size_t WS_ROWSS = 0;
constexpr size_t WS_SUMA = 128 * 1024, WS_SUMM = WS_SUMA + 4096, WS_MCH = WS_SUMM + 4096;
constexpr size_t WS_GI = 256 * 1024, WS_GB = WS_GI + 320 * 1024;
constexpr size_t WS_DN = 1 * MiB, WS_NPREV = WS_DN + 256 * 1024;
constexpr size_t WS_WIN = 2 * MiB;
constexpr size_t WS_WAB = WS_WIN + 17 * MiB / 2;
constexpr size_t WS_WOUT = WS_WAB + 2 * MiB;
constexpr size_t WS_WGU = WS_WOUT + 2 * MiB;
constexpr size_t WS_WD = WS_WGU + 11 * MiB;
constexpr size_t WS_HN = WS_WD + 11 * MiB / 2;
constexpr size_t OB_DCT = 34 * MiB, OB_CPT = 50 * MiB;
constexpr size_t WS_MIXIN = WS_HN + 34 * MiB;
constexpr size_t WS_GATES = WS_MIXIN + 153 * MiB / 2;
constexpr size_t WS_HCAT = WS_GATES + 68 * MiB;
constexpr size_t WS_END = WS_HCAT + 34 * MiB;
static_assert(WS_END <= 256 * MiB, "workspace map");
constexpr size_t O_Y = 0, O_CP = (size_t)MT * 1024, O_NP = O_CP + 65536, O_MP = O_NP + 512, O_KWP = O_MP + 8, O_VWP = O_KWP + 32768,
                 O_CS = O_VWP + 32768, O_NS = O_CS + 4194304, O_MS = O_NS + 32768, O_KWS = O_MS + 512, O_VWS = O_KWS + 2097152, O_END = O_VWS + 2097152;
constexpr int LDS_BYTES = 131072;

struct Params { const float* in[22]; float* out; unsigned char* ws; int ph_lo, ph_hi; };

__device__ __forceinline__ float bf2f(bf16_t h) { return __builtin_bit_cast(float, (unsigned)h << 16); }
__device__ __forceinline__ bf16_t f2bf(float f) { return (bf16_t)(cvt_pk_bf16(f, 0.f) & 0xffffu); }
__device__ __forceinline__ float wave_sum(float v) {
#pragma unroll
    for (int o = 1; o < 64; o <<= 1) v += __shfl_xor(v, o);
    return v; }
__device__ __forceinline__ float wave_max(float v) {
#pragma unroll
    for (int o = 1; o < 64; o <<= 1) v = fmaxf(v, __shfl_xor(v, o));
    return v; }
__device__ __forceinline__ f32x4 mfma16(bf16x8 a, bf16x8 b, f32x4 c) { f32x4 d = __builtin_amdgcn_mfma_f32_16x16x32_bf16(a, b, c, 0, 0, 0); asm volatile("" : "+v"(d) : "v"(a), "v"(b)); return d; }
__device__ __forceinline__ bf16x8 pack8(const f32x4& a, const f32x4& b) { u32x4 t; t.x = cvt_pk_bf16(a[0], a[1]); t.y = cvt_pk_bf16(a[2], a[3]); t.z = cvt_pk_bf16(b[0], b[1]); t.w = cvt_pk_bf16(b[2], b[3]); return __builtin_bit_cast(bf16x8, t); }
__device__ __forceinline__ void unpack8(const u32x4& r, float* f) { f[0] = bflo(r.x); f[1] = bfhi(r.x); f[2] = bflo(r.y); f[3] = bfhi(r.y); f[4] = bflo(r.z); f[5] = bfhi(r.z); f[6] = bflo(r.w); f[7] = bfhi(r.w); }

__device__ __forceinline__ void p0_tokens(const Params& P, int u, unsigned char* lds, int tid) {
    const float* wg = (const float*)lds; float* graw = (float*)(lds + 32768);
    const float* nw = P.in[7];
    bf16_t* HN = (bf16_t*)(P.ws + WS_HN);
    const int lane = tid & 63, w = tid >> 6;
#pragma unroll 1
    for (int tt = 0; tt < 8; ++tt) {
        const int r = u * 64 + w * 8 + tt;
        const float* xrow = r < MP ? P.in[0] + (size_t)r * 1024 : P.in[1] + (size_t)(r - MP) * 1024;
        f32x4 xv[4]; float ss = 0.f;
#pragma unroll
        for (int j = 0; j < 4; ++j) { xv[j] = ((const f32x4*)xrow)[lane + 64 * j]; ss += (xv[j][0] * xv[j][0] + xv[j][1] * xv[j][1]) + (xv[j][2] * xv[j][2] + xv[j][3] * xv[j][3]); }
        ss = wave_sum(ss);
        const float rstd = 1.0f / sqrtf(ss * (1.0f / 1024.0f) + EPS);
        float g[8];
#pragma unroll
        for (int q = 0; q < 8; ++q) g[q] = 0.f;
#pragma unroll
        for (int j = 0; j < 4; ++j) { const int k0 = 4 * (lane + 64 * j);
            const f32x4 nv = *(const f32x4*)(nw + k0); const f32x4 hv = xv[j] * rstd * nv;
            u32x2 pk; pk.x = cvt_pk_bf16(hv[0], hv[1]); pk.y = cvt_pk_bf16(hv[2], hv[3]);
            *(u32x2*)(HN + (size_t)r * 1024 + k0) = pk;
#pragma unroll
            for (int q = 0; q < 8; ++q) { const f32x4 wv = *(const f32x4*)(wg + q * 1024 + k0); g[q] += (xv[j][0] * wv[0] + xv[j][1] * wv[1]) + (xv[j][2] * wv[2] + xv[j][3] * wv[3]); } }
#pragma unroll
        for (int q = 0; q < 8; ++q) g[q] = wave_sum(g[q]);
        if (lane == 0) {
#pragma unroll
            for (int q = 0; q < 8; ++q) graw[(w * 8 + tt) * 8 + q] = g[q] * rstd; }
    }
    __syncthreads();
    if (w == 0) {
        const bool prompt = u < 256; const int r = u * 64 + lane; const int pos = prompt ? lane : (lane & 7);
        float* gi = (float*)(P.ws + WS_GI); float* gb = (float*)(P.ws + WS_GB);
#pragma unroll
        for (int h = 0; h < 4; ++h) {
            const float iv = graw[lane * 8 + h] + P.in[9][h], fv = graw[lane * 8 + 4 + h] + P.in[10][h];
            float b = fminf(fv, 0.f) - log1pf(expf(-fabsf(fv)));
#pragma unroll
            for (int o = 1; o < 64; o <<= 1) { const float nb = __shfl_up(b, o); if (pos >= o) b += nb; }
            gi[r * 4 + h] = iv; gb[r * 4 + h] = b;
            if (prompt) { const float A = __shfl(b, 63); const float Mv = wave_max(A - b + iv);
                if (lane == 0) { const int idx = ((u >> 7) * 4 + h) * 128 + (u & 127); ((float*)(P.ws + WS_SUMA))[idx] = A; ((float*)(P.ws + WS_SUMM))[idx] = Mv; } }
        }
    }
    __syncthreads();
}
__device__ __forceinline__ void p0_wtile(const float* src, int ldsrc, int k0, int c0, bf16_t* dst, int lddst, int n0, int k0d, unsigned char* lds, int tid) {
    float* tile = (float*)(lds + 40960);
#pragma unroll
    for (int p = 0; p < 2; ++p) { const int i = (tid >> 4) + 32 * p, j4 = (tid & 15) * 4;
        const f32x4 v = *(const f32x4*)(src + (size_t)(k0 + i) * ldsrc + c0 + j4);
        tile[i * 65 + j4] = v[0]; tile[i * 65 + j4 + 1] = v[1]; tile[i * 65 + j4 + 2] = v[2]; tile[i * 65 + j4 + 3] = v[3]; }
    __syncthreads();
    { const int n = tid >> 3, kc = (tid & 7) * 8; const float* s = tile + kc * 65 + n;
        u32x4 o; o.x = cvt_pk_bf16(s[0], s[65]); o.y = cvt_pk_bf16(s[2 * 65], s[3 * 65]); o.z = cvt_pk_bf16(s[4 * 65], s[5 * 65]); o.w = cvt_pk_bf16(s[6 * 65], s[7 * 65]);
        *(u32x4*)(dst + (size_t)(n0 + n) * lddst + k0d + kc) = o; }
    __syncthreads();
}
__device__ __forceinline__ void p0_prep(const Params& P, unsigned char* lds, int tid, int G) {
    float* rowss = (float*)(P.ws + WS_ROWSS);
    for (int i = blockIdx.x * 512 + tid; i < MT; i += G * 512) rowss[i] = 0.f;
    { float* wg = (float*)lds; const float* w_in = P.in[8]; const float* nw = P.in[7];
        for (int idx = tid; idx < 8192; idx += 512) { const int k = idx >> 3, q = idx & 7; wg[q * 1024 + k] = w_in[(size_t)k * DIN + 1536 + q] * nw[k]; } }
    __syncthreads();
    for (int u = blockIdx.x; u < MT / 64; u += G) p0_tokens(P, u, lds, tid);
    constexpr int NT_IN = 68 * 16, NT_AB = 256, NT_OUT = 256, NT_GU = 1408, NT_D = 704, NT_ALL = NT_IN + NT_AB + NT_OUT + NT_GU + NT_D;
    for (int it = (G - 1 - (int)blockIdx.x); it < NT_ALL; it += G) {
        int r = it;
        if (r < NT_IN) { const int nt = r >> 4, kt = r & 15, c0 = nt * 64; p0_wtile(P.in[8], DIN, kt * 64, c0 < 1536 ? c0 : c0 + 8, (bf16_t*)(P.ws + WS_WIN), 1024, c0, kt * 64, lds, tid); continue; } r -= NT_IN;
        if (r < NT_AB) { const int which = r >> 7, rr = r & 127, nt = rr >> 3, kt = rr & 7; p0_wtile(which ? P.in[16] : P.in[15], 1024, kt * 64, nt * 64, (bf16_t*)(P.ws + WS_WAB), 1024, nt * 64, which * 512 + kt * 64, lds, tid); continue; } r -= NT_AB;
        if (r < NT_OUT) { const int nt = r >> 4, kt = r & 15; p0_wtile(P.in[17], 1024, kt * 64, nt * 64, (bf16_t*)(P.ws + WS_WOUT), 1024, nt * 64, kt * 64, lds, tid); continue; } r -= NT_OUT;
        if (r < NT_GU) { const int which = r / 704, rr = r % 704, jt = rr >> 4, kt = rr & 15, j0 = jt * 64;
            p0_wtile(which ? P.in[20] : P.in[19], DFF, kt * 64, j0, (bf16_t*)(P.ws + WS_WGU), 1024, 256 * (j0 >> 7) + (j0 & 127) + which * 128, kt * 64, lds, tid); continue; } r -= NT_GU;
        { const int nt = r / 44, kt = r % 44; p0_wtile(P.in[21], 1024, kt * 64, nt * 64, (bf16_t*)(P.ws + WS_WD), DFF, nt * 64, kt * 64, lds, tid); }
    }
}

template <int NQT>
__device__ __forceinline__ void attn_core(const unsigned char* lds, const bf16x8 (&qf)[NQT][2], int kt_lo, int kt_hi, int qbase, int jmin, float sink2, f32x4 (&o)[4][NQT], float (&l)[NQT]) {
    const bf16_t* Ks = (const bf16_t*)lds; const bf16_t* Vt = (const bf16_t*)(lds + 36864);
    const int lane = threadIdx.x & 63, fr = lane & 15, g = lane >> 4;
    float mrun[NQT];
#pragma unroll
    for (int qt = 0; qt < NQT; ++qt) { mrun[qt] = sink2; l[qt] = (g == 0) ? 1.f : 0.f;
#pragma unroll
        for (int dt = 0; dt < 4; ++dt) o[dt][qt] = (f32x4){0.f, 0.f, 0.f, 0.f}; }
#pragma unroll 1
    for (int kt = kt_lo; kt <= kt_hi; ++kt) {
        f32x4 s[4][NQT];
#pragma unroll
        for (int ks = 0; ks < 4; ++ks)
#pragma unroll
            for (int qt = 0; qt < NQT; ++qt) s[ks][qt] = (f32x4){0.f, 0.f, 0.f, 0.f};
#pragma unroll
        for (int ks = 0; ks < 4; ++ks)
#pragma unroll
            for (int kk = 0; kk < 2; ++kk) { const bf16x8 kf = *(const bf16x8*)(Ks + (kt * 64 + ks * 16 + fr) * 72 + g * 8 + kk * 32);
#pragma unroll
                for (int qt = 0; qt < NQT; ++qt) s[ks][qt] = mfma16(kf, qf[qt][kk], s[ks][qt]); }
#pragma unroll
        for (int qt = 0; qt < NQT; ++qt) { const int qi = qbase + 16 * qt + fr; float mx = -1e30f;
#pragma unroll
            for (int ks = 0; ks < 4; ++ks)
#pragma unroll
                for (int r = 0; r < 4; ++r) { const int j = kt * 64 + ks * 16 + g * 4 + r; const bool ok = (j > qi) && (j <= qi + 128) && (j >= jmin);
                    const float v = ok ? s[ks][qt][r] : -1e30f; s[ks][qt][r] = v; mx = fmaxf(mx, v); }
            mx = fmaxf(mx, __shfl_xor(mx, 16)); mx = fmaxf(mx, __shfl_xor(mx, 32));
            const float mnew = fmaxf(mrun[qt], mx), alpha = __builtin_amdgcn_exp2f(mrun[qt] - mnew); mrun[qt] = mnew;
            float ps = 0.f;
#pragma unroll
            for (int ks = 0; ks < 4; ++ks)
#pragma unroll
                for (int r = 0; r < 4; ++r) { const float p = __builtin_amdgcn_exp2f(s[ks][qt][r] - mnew); s[ks][qt][r] = p; ps += p; }
            l[qt] = l[qt] * alpha + ps;
#pragma unroll
            for (int dt = 0; dt < 4; ++dt) o[dt][qt] = o[dt][qt] * alpha; }
#pragma unroll
        for (int c = 0; c < 2; ++c) { bf16x8 pf[NQT];
#pragma unroll
            for (int qt = 0; qt < NQT; ++qt) pf[qt] = pack8(s[2 * c][qt], s[2 * c + 1][qt]);
#pragma unroll
            for (int dt = 0; dt < 4; ++dt) { const bf16_t* vp = Vt + (dt * 16 + fr) * 264 + kt * 64 + c * 32 + g * 4;
                const u32x2 v0 = *(const u32x2*)vp, v1 = *(const u32x2*)(vp + 16);
                const bf16x8 vf = __builtin_bit_cast(bf16x8, (u32x4){v0.x, v0.y, v1.x, v1.y});
#pragma unroll
                for (int qt = 0; qt < NQT; ++qt) o[dt][qt] = mfma16(vf, pf[qt], o[dt][qt]); } }
    }
}
__device__ __forceinline__ void attn_put(unsigned char* lds, int slot, int hh, const float* kf, const float* vf) {
    bf16_t* Ks = (bf16_t*)lds; bf16_t* Vt = (bf16_t*)(lds + 36864);
#pragma unroll
    for (int i = 0; i < 4; ++i) { u32x4 w; w.x = cvt_pk_bf16(kf[8 * i], kf[8 * i + 1]); w.y = cvt_pk_bf16(kf[8 * i + 2], kf[8 * i + 3]); w.z = cvt_pk_bf16(kf[8 * i + 4], kf[8 * i + 5]); w.w = cvt_pk_bf16(kf[8 * i + 6], kf[8 * i + 7]);
        *(u32x4*)(Ks + slot * 72 + hh * 32 + 8 * i) = w; }
#pragma unroll
    for (int i = 0; i < 32; ++i) Vt[(hh * 32 + i) * 264 + slot] = f2bf(vf[i]);
}
__device__ __forceinline__ void attn_prompt_item(const Params& P, int item, unsigned char* lds, int tid) {
    const int kvh = item & 1, n = (item >> 1) & 63, b = item >> 7;
    const bf16_t* mixin = (const bf16_t*)(P.ws + WS_MIXIN);
    { const int slot = tid >> 1, hh = tid & 1, tokb = n * 128 - 128 + slot;
        float kf[32], vf[32];
        if (tokb >= 0) { const bf16_t* rowp = mixin + (size_t)(b * 8192 + tokb) * NMIX + 2048 + kvh * 64 + hh * 32;
#pragma unroll
            for (int i = 0; i < 4; ++i) { const u32x4 kr = *(const u32x4*)(rowp + 8 * i), vr = *(const u32x4*)(rowp + 128 + 8 * i); unpack8(kr, kf + 8 * i); unpack8(vr, vf + 8 * i); } }
        else {
#pragma unroll
            for (int i = 0; i < 32; ++i) { kf[i] = 0.f; vf[i] = 0.f; } }
        float ss = 0.f;
#pragma unroll
        for (int i = 0; i < 32; ++i) ss += kf[i] * kf[i];
        ss += __shfl_xor(ss, 1);
        const float rstd = 1.0f / sqrtf(ss * (1.0f / 64.0f) + EPS);
#pragma unroll
        for (int i = 0; i < 32; ++i) kf[i] = kf[i] * rstd * P.in[13][hh * 32 + i];
        attn_put(lds, slot, hh, kf, vf);
        if (n == 63 && slot >= 128) { float* kw = P.out + O_KWP + ((size_t)(b * 128 + slot - 128) * 2 + kvh) * 64 + hh * 32; float* vw = P.out + O_VWP + ((size_t)(b * 128 + slot - 128) * 2 + kvh) * 64 + hh * 32;
#pragma unroll
            for (int i = 0; i < 8; ++i) { *(f32x4*)(kw + 4 * i) = (f32x4){kf[4 * i], kf[4 * i + 1], kf[4 * i + 2], kf[4 * i + 3]}; *(f32x4*)(vw + 4 * i) = (f32x4){vf[4 * i], vf[4 * i + 1], vf[4 * i + 2], vf[4 * i + 3]}; } }
    }
    __syncthreads();
    const int w = tid >> 6, lane = tid & 63, fr = lane & 15, g = lane >> 4, gq = w >> 1, half = w & 1, head = kvh * 4 + gq;
    bf16_t* hcat = (bf16_t*)(P.ws + WS_HCAT);
#pragma unroll 1
    for (int qh = 0; qh < 2; ++qh) {
    bf16x8 qf[2][2];
#pragma unroll
    for (int qt = 0; qt < 2; ++qt) { const int tok = b * 8192 + n * 128 + half * 64 + qh * 32 + qt * 16 + fr; const bf16_t* qp = mixin + (size_t)tok * NMIX + 1536 + head * 64 + g * 8;
        float f0[8], f1[8]; unpack8(*(const u32x4*)qp, f0); unpack8(*(const u32x4*)(qp + 32), f1);
        float ss = 0.f;
#pragma unroll
        for (int i = 0; i < 8; ++i) ss += f0[i] * f0[i] + f1[i] * f1[i];
        ss += __shfl_xor(ss, 16); ss += __shfl_xor(ss, 32);
        const float sc = (0.125f * LOG2E) / sqrtf(ss * (1.0f / 64.0f) + EPS);
#pragma unroll
        for (int i = 0; i < 8; ++i) { f0[i] = f0[i] * sc * P.in[12][g * 8 + i]; f1[i] = f1[i] * sc * P.in[12][32 + g * 8 + i]; }
        qf[qt][0] = pack8((f32x4){f0[0], f0[1], f0[2], f0[3]}, (f32x4){f0[4], f0[5], f0[6], f0[7]}); qf[qt][1] = pack8((f32x4){f1[0], f1[1], f1[2], f1[3]}, (f32x4){f1[4], f1[5], f1[6], f1[7]}); }
    f32x4 o[4][2]; float l[2];
    attn_core<2>(lds, qf, half, half + 2, half * 64 + qh * 32, n == 0 ? 128 : 0, P.in[14][head] * LOG2E, o, l);
#pragma unroll
    for (int qt = 0; qt < 2; ++qt) { float lt = l[qt]; lt += __shfl_xor(lt, 16); lt += __shfl_xor(lt, 32); const float inv = 1.0f / lt;
        const int tok = b * 8192 + n * 128 + half * 64 + qh * 32 + qt * 16 + fr;
#pragma unroll
        for (int dt = 0; dt < 4; ++dt) { const f32x4 v = o[dt][qt] * inv; u32x2 pk; pk.x = cvt_pk_bf16(v[0], v[1]); pk.y = cvt_pk_bf16(v[2], v[3]);
            *(u32x2*)(hcat + (size_t)tok * 1024 + 512 + head * 64 + dt * 16 + g * 4) = pk; } }
    }
    __syncthreads();
}
__device__ __forceinline__ void attn_sample_item(const Params& P, int item, unsigned char* lds, int tid) {
    const int kvh = item & 1, b = item >> 1;
    const bf16_t* mixin = (const bf16_t*)(P.ws + WS_MIXIN);
    { const int slot = tid >> 1, hh = tid & 1;
        if (slot < 192) { float kf[32], vf[32];
            if (slot < 128) { const size_t off = ((size_t)(b * 128 + slot) * 2 + kvh) * 64 + hh * 32; const float* kp = P.in[5] + off; const float* vp = P.in[6] + off;
#pragma unroll
                for (int i = 0; i < 8; ++i) { const f32x4 a = *(const f32x4*)(kp + 4 * i), c = *(const f32x4*)(vp + 4 * i);
                    kf[4 * i] = a[0]; kf[4 * i + 1] = a[1]; kf[4 * i + 2] = a[2]; kf[4 * i + 3] = a[3]; vf[4 * i] = c[0]; vf[4 * i + 1] = c[1]; vf[4 * i + 2] = c[2]; vf[4 * i + 3] = c[3]; } }
            else if (slot < 136) { const bf16_t* rowp = mixin + (size_t)(MP + b * 8 + slot - 128) * NMIX + 2048 + kvh * 64 + hh * 32;
#pragma unroll
                for (int i = 0; i < 4; ++i) { const u32x4 kr = *(const u32x4*)(rowp + 8 * i), vr = *(const u32x4*)(rowp + 128 + 8 * i); unpack8(kr, kf + 8 * i); unpack8(vr, vf + 8 * i); }
                float ss = 0.f;
#pragma unroll
                for (int i = 0; i < 32; ++i) ss += kf[i] * kf[i];
                ss += __shfl_xor(ss, 1);
                const float rstd = 1.0f / sqrtf(ss * (1.0f / 64.0f) + EPS);
#pragma unroll
                for (int i = 0; i < 32; ++i) kf[i] = kf[i] * rstd * P.in[13][hh * 32 + i]; }
            else {
#pragma unroll
                for (int i = 0; i < 32; ++i) { kf[i] = 0.f; vf[i] = 0.f; } }
            attn_put(lds, slot, hh, kf, vf);
            if (slot >= 8 && slot < 136) { const size_t off = ((size_t)(b * 128 + slot - 8) * 2 + kvh) * 64 + hh * 32; float* kw = P.out + O_KWS + off; float* vw = P.out + O_VWS + off;
#pragma unroll
                for (int i = 0; i < 8; ++i) { *(f32x4*)(kw + 4 * i) = (f32x4){kf[4 * i], kf[4 * i + 1], kf[4 * i + 2], kf[4 * i + 3]}; *(f32x4*)(vw + 4 * i) = (f32x4){vf[4 * i], vf[4 * i + 1], vf[4 * i + 2], vf[4 * i + 3]}; } }
        }
    }
    __syncthreads();
    const int w = tid >> 6, lane = tid & 63, fr = lane & 15, g = lane >> 4;
    if (w < 4) { const int head = kvh * 4 + w; const int tok = MP + b * 8 + (fr & 7);
        bf16x8 qf[1][2];
        { const bf16_t* qp = mixin + (size_t)tok * NMIX + 1536 + head * 64 + g * 8;
            float f0[8], f1[8]; unpack8(*(const u32x4*)qp, f0); unpack8(*(const u32x4*)(qp + 32), f1);
            float ss = 0.f;
#pragma unroll
            for (int i = 0; i < 8; ++i) ss += f0[i] * f0[i] + f1[i] * f1[i];
            ss += __shfl_xor(ss, 16); ss += __shfl_xor(ss, 32);
            const float sc = (0.125f * LOG2E) / sqrtf(ss * (1.0f / 64.0f) + EPS);
#pragma unroll
            for (int i = 0; i < 8; ++i) { f0[i] = f0[i] * sc * P.in[12][g * 8 + i]; f1[i] = f1[i] * sc * P.in[12][32 + g * 8 + i]; }
            qf[0][0] = pack8((f32x4){f0[0], f0[1], f0[2], f0[3]}, (f32x4){f0[4], f0[5], f0[6], f0[7]}); qf[0][1] = pack8((f32x4){f1[0], f1[1], f1[2], f1[3]}, (f32x4){f1[4], f1[5], f1[6], f1[7]}); }
        f32x4 o[4][1]; float l[1];
        attn_core<1>(lds, qf, 0, 2, 0, 0, P.in[14][head] * LOG2E, o, l);
        float lt = l[0]; lt += __shfl_xor(lt, 16); lt += __shfl_xor(lt, 32); const float inv = 1.0f / lt;
        bf16_t* hcat = (bf16_t*)(P.ws + WS_HCAT);
        if (fr < 8) {
#pragma unroll
            for (int dt = 0; dt < 4; ++dt) { const f32x4 v = o[dt][0] * inv; u32x2 pk; pk.x = cvt_pk_bf16(v[0], v[1]); pk.y = cvt_pk_bf16(v[2], v[3]);
                *(u32x2*)(hcat + (size_t)tok * 1024 + 512 + head * 64 + dt * 16 + g * 4) = pk; } }
    }
    __syncthreads();
}
__device__ __forceinline__ void mlstm_b_item(const Params& P, int item, unsigned char* lds, int tid) {
    const int c = item & 127, h = (item >> 7) & 3, b = item >> 9, r0 = b * 8192 + c * 64;
    float* wl = (float*)lds; bf16_t* Kt = (bf16_t*)(lds + 256); bf16_t* Vt = (bf16_t*)(lds + 256 + 9216);
    const bf16_t* mixin = (const bf16_t*)(P.ws + WS_MIXIN);
    if (tid < 64) { const float iv = ((const float*)(P.ws + WS_GI))[(r0 + tid) * 4 + h], bb = ((const float*)(P.ws + WS_GB))[(r0 + tid) * 4 + h];
        const float A = __shfl(bb, 63), v = A - bb + iv, M = wave_max(v); wl[tid] = __expf(v - M) * 0.125f; }
    __syncthreads();
    { const int s = tid >> 3, ch = tid & 7; const bf16_t* rowp = mixin + (size_t)(r0 + s) * NMIX; const float ws_ = wl[s];
        float kf[8]; unpack8(*(const u32x4*)(rowp + 256 + h * 64 + ch * 8), kf);
#pragma unroll
        for (int i = 0; i < 8; ++i) Kt[(ch * 8 + i) * 72 + s] = f2bf(kf[i] * ws_);
        const u32x4 v0 = *(const u32x4*)(rowp + 512 + h * 128 + ch * 16), v1 = *(const u32x4*)(rowp + 512 + h * 128 + ch * 16 + 8);
        const unsigned vv[8] = {v0.x, v0.y, v0.z, v0.w, v1.x, v1.y, v1.z, v1.w};
#pragma unroll
        for (int i = 0; i < 8; ++i) { Vt[(ch * 16 + 2 * i) * 72 + s] = (bf16_t)(vv[i] & 0xffffu); Vt[(ch * 16 + 2 * i + 1) * 72 + s] = (bf16_t)(vv[i] >> 16); } }
    __syncthreads();
    { const int w = tid >> 6, lane = tid & 63, fr = lane & 15, g = lane >> 4, e0 = 16 * w;
        f32x4 acc[4];
#pragma unroll
        for (int dt = 0; dt < 4; ++dt) acc[dt] = (f32x4){0.f, 0.f, 0.f, 0.f};
#pragma unroll
        for (int kk = 0; kk < 2; ++kk) { const bf16x8 vf = *(const bf16x8*)(Vt + (e0 + fr) * 72 + g * 8 + kk * 32);
#pragma unroll
            for (int dt = 0; dt < 4; ++dt) { const bf16x8 kf = *(const bf16x8*)(Kt + (dt * 16 + fr) * 72 + g * 8 + kk * 32); acc[dt] = mfma16(kf, vf, acc[dt]); } }
        bf16_t* dct = (bf16_t*)((unsigned char*)P.out + OB_DCT) + ((size_t)item * 128 + e0 + fr) * 64;
#pragma unroll
        for (int dt = 0; dt < 4; ++dt) { u32x2 pk; pk.x = cvt_pk_bf16(acc[dt][0], acc[dt][1]); pk.y = cvt_pk_bf16(acc[dt][2], acc[dt][3]); *(u32x2*)(dct + dt * 16 + g * 4) = pk; } }
    if (tid < 64) { float sum = 0.f;
#pragma unroll 8
        for (int s = 0; s < 64; ++s) sum += bf2f(Kt[tid * 72 + s]);
        ((float*)(P.ws + WS_DN))[item * 64 + tid] = sum; }
    __syncthreads();
}
__device__ __forceinline__ void mlstm_scan(const Params& P, unsigned char* lds, int tid) {
    const int pair = blockIdx.x >> 3, sub = blockIdx.x & 7;
    float* ga = (float*)lds; float* ea = ga + 128; float* marr = ea + 128;
    if (tid == 0) { float m = 0.f; const float* sA = (const float*)(P.ws + WS_SUMA) + pair * 128; const float* sM = (const float*)(P.ws + WS_SUMM) + pair * 128;
        for (int c = 0; c < 128; ++c) { const float A = sA[c], Mv = sM[c], mn = fmaxf(A + m, Mv); ga[c] = __expf(A + m - mn); ea[c] = __expf(Mv - mn); m = mn; marr[c] = mn; } }
    __syncthreads();
    if (sub == 0) { if (tid < 128) ((float*)(P.ws + WS_MCH))[pair * 128 + tid] = marr[tid]; if (tid == 0) P.out[O_MP + pair] = marr[127]; }
#ifndef P3_SCANMASK
#define P3_SCANMASK 3
#endif
    if (P3_SCANMASK & 1) { const int idx2 = sub * 512 + tid; float C0 = 0.f, C1 = 0.f;
        const unsigned* src = (const unsigned*)((unsigned char*)P.out + OB_DCT) + (size_t)pair * 128 * 4096 + idx2; unsigned* dst = (unsigned*)((unsigned char*)P.out + OB_CPT) + (size_t)pair * 128 * 4096 + idx2;
#pragma unroll 1
        for (int c = 0; c < 128; c += 8) { unsigned v[8];
#pragma unroll
            for (int j = 0; j < 8; ++j) v[j] = src[(size_t)(c + j) * 4096];
#pragma unroll
            for (int j = 0; j < 8; ++j) { dst[(size_t)(c + j) * 4096] = cvt_pk_bf16(C0, C1); const float gg = ga[c + j], ee = ea[c + j]; C0 = gg * C0 + ee * bflo(v[j]); C1 = gg * C1 + ee * bfhi(v[j]); } }
        const int i0 = 2 * idx2, e = i0 >> 6, d = i0 & 63;
        P.out[O_CP + ((size_t)pair * 64 + d) * 128 + e] = C0; P.out[O_CP + ((size_t)pair * 64 + d + 1) * 128 + e] = C1; }
    if ((P3_SCANMASK & 2) && sub == 0 && tid < 64) { float nn = 0.f; const float* dn = (const float*)(P.ws + WS_DN) + (size_t)pair * 128 * 64 + tid; float* np = (float*)(P.ws + WS_NPREV) + (size_t)pair * 128 * 64 + tid;
        for (int c = 0; c < 128; ++c) { np[c * 64] = nn; nn = ga[c] * nn + ea[c] * dn[c * 64]; }
        P.out[O_NP + pair * 64 + tid] = nn; }
    __syncthreads();
}
__device__ __forceinline__ void mlstm_sample_item(const Params& P, int item, unsigned char* lds, int tid) {
    const int h = item & 3, b = item >> 2, r0 = MP + b * 8;
    float* q = (float*)lds; float* k = q + 512; float* v = k + 512; float* sw = v + 1024; float* sc = sw + 64; float* n0s = sc + 64; float* part = n0s + 64; float* red = part + 4096;
    const bf16_t* mixin = (const bf16_t*)(P.ws + WS_MIXIN);
    for (int idx = tid; idx < 2048; idx += 512) {
        if (idx < 512) { const int t = idx >> 6, d = idx & 63; q[idx] = bf2f(mixin[(size_t)(r0 + t) * NMIX + h * 64 + d]); }
        else if (idx < 1024) { const int i2 = idx - 512, t = i2 >> 6, d = i2 & 63; k[i2] = bf2f(mixin[(size_t)(r0 + t) * NMIX + 256 + h * 64 + d]) * 0.125f; }
        else { const int i3 = idx - 1024, t = i3 >> 7, e = i3 & 127; v[i3] = bf2f(mixin[(size_t)(r0 + t) * NMIX + 512 + h * 128 + e]); } }
    if (tid < 64) n0s[tid] = P.in[3][(b * 4 + h) * 64 + tid];
    if (tid < 8) { const float bb = ((const float*)(P.ws + WS_GB))[(r0 + tid) * 4 + h]; sc[tid] = bb; sc[8 + tid] = ((const float*)(P.ws + WS_GI))[(r0 + tid) * 4 + h] - bb; }
    __syncthreads();
    const float mprev = P.in[4][b * 4 + h];
    if (tid < 8) { float cm = mprev; for (int s = 0; s <= tid; ++s) cm = fmaxf(cm, sc[8 + s]); const float mt = sc[tid] + cm; sc[16 + tid] = mt; sc[24 + tid] = __expf(sc[tid] + mprev - mt); }
    __syncthreads();
    if (tid < 8) { const float b7 = sc[7], m7 = sc[23]; sc[32 + tid] = __expf(b7 + sc[8 + tid] - m7); if (tid == 0) { sc[48] = __expf(b7 + mprev - m7); P.out[O_MS + b * 4 + h] = m7; } }
    if (tid >= 64 && tid < 128) { const int i = tid - 64, t = i >> 3, s = i & 7; float dot = 0.f;
        for (int d = 0; d < 64; ++d) dot += q[t * 64 + d] * k[s * 64 + d];
        sw[i] = (s <= t) ? dot * __expf(sc[t] + sc[8 + s] - sc[16 + t]) : 0.f; }
    if (tid >= 128 && tid < 136) { const int t = tid - 128; float qn = 0.f; for (int d = 0; d < 64; ++d) qn += q[t * 64 + d] * n0s[d]; sc[40 + t] = qn; }
    __syncthreads();
    { const int e = tid & 127, dq = tid >> 7; const float gd = sc[48]; float num[8];
#pragma unroll
        for (int t = 0; t < 8; ++t) num[t] = 0.f;
#pragma unroll 4
        for (int dd = 0; dd < 16; ++dd) { const int d = dq * 16 + dd; const size_t ic = ((size_t)(b * 4 + h) * 64 + d) * 128 + e; const float c0 = P.in[2][ic];
            float upd = 0.f;
#pragma unroll
            for (int s = 0; s < 8; ++s) upd += sc[32 + s] * k[s * 64 + d] * v[s * 128 + e];
            P.out[O_CS + ic] = gd * c0 + upd;
#pragma unroll
            for (int t = 0; t < 8; ++t) num[t] += q[t * 64 + d] * c0; }
#pragma unroll
        for (int t = 0; t < 8; ++t) part[(dq * 8 + t) * 128 + e] = num[t]; }
    if (tid < 64) { float nn = sc[48] * n0s[tid];
#pragma unroll
        for (int s = 0; s < 8; ++s) nn += sc[32 + s] * k[s * 64 + tid];
        P.out[O_NS + (b * 4 + h) * 64 + tid] = nn; }
    __syncthreads();
    { const int e = tid & 127, tq = tid >> 7, w = tid >> 6, lane = tid & 63; float hv[2];
#pragma unroll
        for (int u = 0; u < 2; ++u) { const int t = tq * 2 + u; float inter = 0.f, intra = 0.f, rs = 0.f;
#pragma unroll
            for (int dq = 0; dq < 4; ++dq) inter += part[(dq * 8 + t) * 128 + e];
#pragma unroll
            for (int s = 0; s < 8; ++s) { intra += sw[t * 8 + s] * v[s * 128 + e]; rs += sw[t * 8 + s]; }
            const float wi = sc[24 + t], den = wi * sc[40 + t] + rs; hv[u] = (wi * inter + intra) / fmaxf(fabsf(den), __expf(-sc[16 + t])); }
        const float s0 = wave_sum(hv[0] * hv[0]), s1 = wave_sum(hv[1] * hv[1]);
        if (lane == 0) { red[w * 2] = s0; red[w * 2 + 1] = s1; }
        __syncthreads();
        bf16_t* hcat = (bf16_t*)(P.ws + WS_HCAT);
#pragma unroll
        for (int u = 0; u < 2; ++u) { const int t = tq * 2 + u; const float tot = red[(w & ~1) * 2 + u] + red[(w | 1) * 2 + u]; const float rstd = 1.0f / sqrtf(tot * (1.0f / 128.0f) + EPS);
            const float so = bf2f(mixin[(size_t)(r0 + t) * NMIX + 1024 + h * 128 + e]);
            hcat[(size_t)(r0 + t) * 1024 + h * 128 + e] = f2bf(hv[u] * rstd * P.in[11][h * 128 + e] * so); } }
    __syncthreads();
}
__device__ __forceinline__ void mlstm_d_item(const Params& P, int item, unsigned char* lds, int tid) {
    const int c = item & 127, h = (item >> 7) & 3, b = item >> 9, r0 = b * 8192 + c * 64, pair = item >> 7;
    float* lb = (float*)lds; float* lu = lb + 64; float* lm = lb + 128; float* misc = lb + 192; float* npv = lb + 256; float* red = lb + 320;
    bf16_t* Kn = (bf16_t*)(lds + 2048); bf16_t* Vt = (bf16_t*)(lds + 11264); bf16_t* Cs = (bf16_t*)(lds + 29696);
    const bf16_t* mixin = (const bf16_t*)(P.ws + WS_MIXIN);
    if (tid < 64) { const float iv = ((const float*)(P.ws + WS_GI))[(r0 + tid) * 4 + h], bb = ((const float*)(P.ws + WS_GB))[(r0 + tid) * 4 + h];
        const float mprev = c ? ((const float*)(P.ws + WS_MCH))[pair * 128 + c - 1] : 0.f;
        const float u = iv - bb; float cm = u;
#pragma unroll
        for (int o = 1; o < 64; o <<= 1) { const float nb = __shfl_up(cm, o); if (tid >= o) cm = fmaxf(cm, nb); }
        lb[tid] = bb; lu[tid] = u; lm[tid] = bb + fmaxf(mprev, cm); if (tid == 0) misc[0] = mprev;
        npv[tid] = ((const float*)(P.ws + WS_NPREV))[(size_t)item * 64 + tid]; }
    { const int s = tid >> 3, ch = tid & 7; const bf16_t* rowp = mixin + (size_t)(r0 + s) * NMIX;
        *(u32x4*)(Kn + s * 72 + ch * 8) = *(const u32x4*)(rowp + 256 + h * 64 + ch * 8);
        const u32x4 v0 = *(const u32x4*)(rowp + 512 + h * 128 + ch * 16), v1 = *(const u32x4*)(rowp + 512 + h * 128 + ch * 16 + 8);
        const unsigned vv[8] = {v0.x, v0.y, v0.z, v0.w, v1.x, v1.y, v1.z, v1.w};
#pragma unroll
        for (int i = 0; i < 8; ++i) { Vt[(ch * 16 + 2 * i) * 72 + s] = (bf16_t)(vv[i] & 0xffffu); Vt[(ch * 16 + 2 * i + 1) * 72 + s] = (bf16_t)(vv[i] >> 16); }
        const bf16_t* cp = (const bf16_t*)((unsigned char*)P.out + OB_CPT) + (size_t)item * 8192;
#pragma unroll
        for (int j = 0; j < 2; ++j) { const int idx = tid + 512 * j, e = idx >> 3, dch = idx & 7; *(u32x4*)(Cs + e * 72 + dch * 8) = *(const u32x4*)(cp + e * 64 + dch * 8); } }
    __syncthreads();
    const int w = tid >> 6, lane = tid & 63, fr = lane & 15, g = lane >> 4, tt = w & 3, eh = w >> 2, t = tt * 16 + fr, tok = r0 + t;
    bf16x8 qf[2]; float qv0[8], qv1[8];
    { const bf16_t* qp = mixin + (size_t)tok * NMIX + h * 64 + g * 8; const u32x4 a = *(const u32x4*)qp, bq = *(const u32x4*)(qp + 32);
        qf[0] = __builtin_bit_cast(bf16x8, a); qf[1] = __builtin_bit_cast(bf16x8, bq); unpack8(a, qv0); unpack8(bq, qv1); }
    f32x4 s[4];
#pragma unroll
    for (int st = 0; st < 4; ++st) { s[st] = (f32x4){0.f, 0.f, 0.f, 0.f};
#pragma unroll
        for (int kk = 0; kk < 2; ++kk) { const bf16x8 kf = *(const bf16x8*)(Kn + (st * 16 + fr) * 72 + g * 8 + kk * 32); s[st] = mfma16(kf, qf[kk], s[st]); } }
    const float bt = lb[t], mt = lm[t], mprev = misc[0];
    float rs = 0.f;
#pragma unroll
    for (int st = 0; st < 4; ++st)
#pragma unroll
        for (int r = 0; r < 4; ++r) { const int si = st * 16 + g * 4 + r; const float wv = (si <= t) ? __expf(bt + lu[si] - mt) : 0.f; const float val = s[st][r] * 0.125f * wv; s[st][r] = val; rs += val; }
    rs += __shfl_xor(rs, 16); rs += __shfl_xor(rs, 32);
    float qn = 0.f;
#pragma unroll
    for (int i = 0; i < 8; ++i) qn += qv0[i] * npv[g * 8 + i] + qv1[i] * npv[32 + g * 8 + i];
    qn += __shfl_xor(qn, 16); qn += __shfl_xor(qn, 32);
    const float wi = __expf(bt + mprev - mt), den = wi * qn + rs, inv = 1.0f / fmaxf(fabsf(den), __expf(-mt));
    bf16x8 pf[2]; pf[0] = pack8(s[0], s[1]); pf[1] = pack8(s[2], s[3]);
    f32x4 h1[4], h2[4];
#pragma unroll
    for (int et = 0; et < 4; ++et) { const int e = eh * 64 + et * 16 + fr; h1[et] = (f32x4){0.f, 0.f, 0.f, 0.f}; h2[et] = (f32x4){0.f, 0.f, 0.f, 0.f};
#pragma unroll
        for (int cc = 0; cc < 2; ++cc) { const bf16_t* vp = Vt + e * 72 + cc * 32 + g * 4; const u32x2 v0 = *(const u32x2*)vp, v1 = *(const u32x2*)(vp + 16);
            h2[et] = mfma16(__builtin_bit_cast(bf16x8, (u32x4){v0.x, v0.y, v1.x, v1.y}), pf[cc], h2[et]); }
#pragma unroll
        for (int kk = 0; kk < 2; ++kk) { const bf16x8 cf = *(const bf16x8*)(Cs + e * 72 + g * 8 + kk * 32); h1[et] = mfma16(cf, qf[kk], h1[et]); } }
    float ss = 0.f;
#pragma unroll
    for (int et = 0; et < 4; ++et)
#pragma unroll
        for (int r = 0; r < 4; ++r) { const float hv = (wi * h1[et][r] + h2[et][r]) * inv; h2[et][r] = hv; ss += hv * hv; }
    ss += __shfl_xor(ss, 16); ss += __shfl_xor(ss, 32);
    if (g == 0) red[w * 16 + fr] = ss;
    __syncthreads();
    { const float tot = red[w * 16 + fr] + red[(w ^ 4) * 16 + fr]; const float rstd = 1.0f / sqrtf(tot * (1.0f / 128.0f) + EPS);
        bf16_t* hcat = (bf16_t*)(P.ws + WS_HCAT);
#pragma unroll
        for (int et = 0; et < 4; ++et) { const int e0 = eh * 64 + et * 16 + g * 4; const u32x2 so = *(const u32x2*)(mixin + (size_t)tok * NMIX + 1024 + h * 128 + e0); const f32x4 mw = *(const f32x4*)(P.in[11] + h * 128 + e0);
            const float o0 = h2[et][0] * rstd * mw[0] * bflo(so.x), o1 = h2[et][1] * rstd * mw[1] * bfhi(so.x), o2 = h2[et][2] * rstd * mw[2] * bflo(so.y), o3 = h2[et][3] * rstd * mw[3] * bfhi(so.y);
            u32x2 pk; pk.x = cvt_pk_bf16(o0, o1); pk.y = cvt_pk_bf16(o2, o3); *(u32x2*)(hcat + (size_t)tok * 1024 + h * 128 + e0) = pk; } }
    __syncthreads();
}

__global__ void __launch_bounds__(512, 2) fwd_kernel(Params P) {
    extern __shared__ __attribute__((aligned(16))) unsigned char lds[];
    cg::grid_group grid = cg::this_grid();
    const int tid = threadIdx.x, G = gridDim.x;
    const int lo = P.ph_lo, hi = P.ph_hi;
#ifndef PHASE_MASK
#define PHASE_MASK 0x1ff
#endif
#define IN(k) (((PHASE_MASK >> (k)) & 1) && lo <= (k) && (k) < hi)
#define GSYNC() do { asm volatile("s_waitcnt vmcnt(0)" ::: "memory"); __syncthreads(); grid.sync(); __builtin_amdgcn_fence(__ATOMIC_ACQUIRE, "agent"); asm volatile("s_waitcnt vmcnt(0)" ::: "memory"); __syncthreads(); } while (0)
#define SEAM(k) do { if (IN(k) && IN((k) + 1)) GSYNC(); } while (0)
    bf16_t* HN = (bf16_t*)(P.ws + WS_HN); bf16_t* MIXIN = (bf16_t*)(P.ws + WS_MIXIN); bf16_t* GATES = (bf16_t*)(P.ws + WS_GATES); bf16_t* HCAT = (bf16_t*)(P.ws + WS_HCAT);
    PG8_LAS unsigned char* ldsa = (PG8_LAS unsigned char*)lds;
    if (IN(0)) p0_prep(P, lds, tid, G);
    SEAM(0);
    if (IN(1)) { pg8::Gemm g{HN, (const bf16_t*)(P.ws + WS_WIN), MT, NPROJ, 1024}; pg8::StaticOrder S; S.init(MT, NPROJ, G, (int)blockIdx.x);
        pg8::EpiProj E{MIXIN, GATES}; pg8::gemm_phase<pg8::EpiProj, pg8::StaticOrder, true, true>(ldsa, g, S, E); }
    SEAM(1);
    if (IN(2)) {
        for (int it = blockIdx.x; it < 256 + 256 + 1024; it += G) {
            if (it < 256) attn_prompt_item(P, it, lds, tid);
            else if (it < 512) attn_sample_item(P, it - 256, lds, tid);
            else mlstm_b_item(P, it - 512, lds, tid);
        } }
    SEAM(2);
    if (IN(3)) {
        const int nscan = (G > 64) ? 64 : 0;
#ifndef P3_VARIANT
#define P3_VARIANT 3
#endif
        if (nscan) { if ((int)blockIdx.x < 64) { if (P3_VARIANT & 1) mlstm_scan(P, lds, tid); } else if (P3_VARIANT & 2) for (int it = blockIdx.x - 64; it < 512; it += G - 64) mlstm_sample_item(P, it, lds, tid); }
        else { for (int it = blockIdx.x; it < 512; it += G) mlstm_sample_item(P, it, lds, tid); }
    }
    SEAM(3);
    if (IN(4)) { for (int it = blockIdx.x; it < 1024; it += G) mlstm_d_item(P, it, lds, tid); }
    SEAM(4);
    if (IN(5)) { pg8::Gemm g{HCAT, (const bf16_t*)(P.ws + WS_WAB), MT, 1024, 1024}; pg8::StaticOrder S; S.init(MT, 1024, G, (int)blockIdx.x);
        pg8::EpiMix E{GATES, MIXIN}; pg8::gemm_phase<pg8::EpiMix, pg8::StaticOrder, true, true>(ldsa, g, S, E); }
    SEAM(5);
    if (IN(6)) { pg8::Gemm g{MIXIN, (const bf16_t*)(P.ws + WS_WOUT), MT, 1024, 1024}; pg8::StaticOrder S; S.init(MT, 1024, G, (int)blockIdx.x);
        pg8::EpiOut E{P.in[0], P.in[1], P.out, HN, P.in[18], (float*)(P.ws + WS_ROWSS)}; pg8::gemm_phase<pg8::EpiOut, pg8::StaticOrder, true, true>(ldsa, g, S, E); }
    SEAM(6);
    if (IN(7)) { pg8::Gemm g{HN, (const bf16_t*)(P.ws + WS_WGU), MT, 2 * DFF, 1024}; pg8::StaticOrder S; S.init(MT, 2 * DFF, G, (int)blockIdx.x);
        pg8::EpiGU E{MIXIN, (const float*)(P.ws + WS_ROWSS)}; pg8::gemm_phase<pg8::EpiGU, pg8::StaticOrder, true, true>(ldsa, g, S, E); }
    SEAM(7);
    if (IN(8)) { pg8::Gemm g{MIXIN, (const bf16_t*)(P.ws + WS_WD), MT, 1024, DFF}; pg8::StaticOrder S; S.init(MT, 1024, G, (int)blockIdx.x);
        pg8::EpiDown E{P.out}; pg8::gemm_phase<pg8::EpiDown, pg8::StaticOrder, true, true>(ldsa, g, S, E); }
#ifdef DBG_DUMP
    GSYNC();
    if (DBG_DUMP == 1) { for (size_t i = (size_t)blockIdx.x * 512 + tid; i < (size_t)MT * 1024; i += (size_t)G * 512) { const size_t r = i >> 10, c = i & 1023; P.out[i] = bf2f(MIXIN[r * NMIX + c]); } }
    if (DBG_DUMP == 2) { const bf16_t* d = (const bf16_t*)((unsigned char*)P.out + OB_DCT); for (size_t i = (size_t)blockIdx.x * 512 + tid; i < (size_t)1024 * 8192; i += (size_t)G * 512) P.out[i] = bf2f(d[i]); }
    if (DBG_DUMP == 4) { unsigned* d = (unsigned*)((unsigned char*)P.out + OB_DCT); for (size_t i = (size_t)blockIdx.x * 512 + tid; i < (size_t)1024 * 4096; i += (size_t)G * 512) { const unsigned w = __hip_atomic_load(d + i, __ATOMIC_RELAXED, __HIP_MEMORY_SCOPE_AGENT); P.out[2 * i] = bflo(w); P.out[2 * i + 1] = bfhi(w); } }
    if (DBG_DUMP == 5) { const float* a = (const float*)(P.ws + WS_GI); const float* bq = (const float*)(P.ws + WS_GB); for (int i = blockIdx.x * 512 + tid; i < MT * 4; i += G * 512) { P.out[i] = a[i]; P.out[MT * 4 + i] = bq[i]; } }
    if (DBG_DUMP == 6) { const float* a = (const float*)(P.ws + WS_DN); for (int i = blockIdx.x * 512 + tid; i < 65536; i += G * 512) P.out[i] = a[i]; }
    if (DBG_DUMP == 3) { for (size_t i = (size_t)blockIdx.x * 512 + tid; i < (size_t)MT * 1024; i += (size_t)G * 512) P.out[i] = bf2f(HN[i]); }
#endif
#undef IN
#undef SEAM
}

extern "C" void kernel_launch(void* const* d_in, const int* in_sizes, int n_in, void* d_out, int out_size, void* d_ws, size_t ws_size, hipStream_t stream) {
    static int grid = 0;
    if (grid == 0) {
        if (n_in != 22 || (size_t)out_size != O_END || ws_size < WS_END) { fprintf(stderr, "kernel_launch: unexpected shapes (n_in %d, out %d, ws %zu)\n", n_in, out_size, ws_size); grid = -1; return; }
        int dev = 0, cus = 0, per_cu = 0;
        (void)hipGetDevice(&dev); (void)hipDeviceGetAttribute(&cus, hipDeviceAttributeMultiprocessorCount, dev);
        if (hipFuncSetAttribute((const void*)fwd_kernel, hipFuncAttributeMaxDynamicSharedMemorySize, LDS_BYTES) != hipSuccess) { fprintf(stderr, "kernel_launch: hipFuncSetAttribute failed\n"); grid = -1; return; }
        if (hipOccupancyMaxActiveBlocksPerMultiprocessor(&per_cu, (const void*)fwd_kernel, 512, LDS_BYTES) != hipSuccess || per_cu < 1) { fprintf(stderr, "kernel_launch: occupancy query failed (%d)\n", per_cu); (void)hipGetLastError(); per_cu = 1; }
        grid = cus * 1;
        if (grid < 65) { fprintf(stderr, "kernel_launch: needs more than 64 CUs\n"); grid = -1; return; }
    }
    if (grid < 0) return;
    Params p{};
    for (int i = 0; i < 22; ++i) p.in[i] = (const float*)d_in[i];
    p.out = (float*)d_out; p.ws = (unsigned char*)d_ws;
    constexpr int NPH = 9;
    for (int li = 0; li < N_LAUNCHES; ++li) {
        p.ph_lo = (N_LAUNCHES == 1) ? 0 : li; p.ph_hi = (N_LAUNCHES == 1) ? NPH : li + 1;
        void* args[] = {&p};
        const hipError_t e = hipLaunchCooperativeKernel((const void*)fwd_kernel, dim3(grid), dim3(512), args, LDS_BYTES, stream);
        if (e != hipSuccess) { fprintf(stderr, "kernel_launch: cooperative launch %d failed: %s (grid %d)\n", li, hipGetErrorString(e), grid); break; }
    }
}
```

```cpp
#include <hip/hip_runtime.h>
#include <hip/hip_cooperative_groups.h>
#include <cstdio>
#include <cstdint>
namespace cg = cooperative_groups;

#ifndef N_LAUNCHES
#define N_LAUNCHES 1
#endif

namespace pg8 {
#define PG8_LAS __attribute__((address_space(3)))
typedef unsigned short bf16_t;
typedef short bf16x8 __attribute__((ext_vector_type(8)));
typedef float f32x4 __attribute__((ext_vector_type(4)));
typedef unsigned u32x4 __attribute__((ext_vector_type(4)));
constexpr int BM = 256, BK = 64, HALF = 128, HTB = HALF * BK * 2  , STAGE_BYTES = 8 * HTB, NXCD = 8, WGM = 8;

__host__ __device__ __forceinline__ int lds_byte(int r, int c) { const int st = (r >> 4) * 2 + (c >> 5), rr = r & 15, cc = c & 31, ob = rr * 64 + cc * 2; return st * 1024 + (ob ^ (((ob >> 9) & 1) << 5)); }
__host__ __device__ __forceinline__ void stage_rc(int b, int& R, int& C) { const int st = b / 1024, sb = b % 1024, swz = sb ^ (((sb >> 9) & 1) << 5); R = (st >> 1) * 16 + swz / 64; C = (st & 1) * 32 + (swz % 64) / 2; }
__host__ __device__ __forceinline__ int perm32(int rho) { const int n = rho >> 4, i = rho & 15; return 8 * (i >> 2) + 4 * n + (i & 3); }

struct Unit { int pm, pn; };
struct Gemm { const bf16_t* A; const bf16_t* Bt; int M, N, K; };

struct StaticOrder {
    int nM, nN, nwg, G, c;
    __host__ __device__ void init(int M, int N, int G_, int c_) { nM = M / BM; nN = N / BM; nwg = nM * nN; G = G_; c = c_; }
    __host__ __device__ bool next(int i, Unit& u) const {
        const long L = (long)i * G + c; if (L >= nwg) return false;
        int wgid = (int)L; { const int q = nwg / NXCD, r = nwg % NXCD, xcd = wgid % NXCD, off = wgid / NXCD; wgid = (xcd < r ? xcd * (q + 1) : r * (q + 1) + (xcd - r) * q) + off; }
        const int nig = WGM * nN, gid = wgid / nig, fm = gid * WGM, gsz = (nM - fm) < WGM ? (nM - fm) : WGM;
        u.pm = fm + ((wgid % nig) % gsz); u.pn = (wgid % nig) / gsz; return true;
    }
    __device__ __forceinline__ void a_ready(const Unit&) const {}
    __device__ __forceinline__ void done(const Unit&) const {}
};

__device__ __forceinline__ unsigned cvt_pk_bf16(float lo, float hi) { unsigned r; asm volatile("v_cvt_pk_bf16_f32 %0, %1, %2" : "=v"(r) : "v"(lo), "v"(hi)); return r; }
__device__ __forceinline__ float bflo(unsigned w) { return __builtin_bit_cast(float, w << 16); }
__device__ __forceinline__ float bfhi(unsigned w) { return __builtin_bit_cast(float, w & 0xffff0000u); }
__device__ __forceinline__ float sigm(float x) { return 1.0f / (1.0f + __expf(-x)); }

struct EpiProj {
    static constexpr bool PERM = true, AFTER_DRAIN = false, HAS_MID = false;
    bf16_t* mixin; bf16_t* gates;
    __device__ __forceinline__ void operator()(const f32x4 (&acc)[2][2][4][2], const Unit& u, int wr, int wc, int fr, int fq) const {
        const bool isg = u.pn >= 9; const bool sg = isg || u.pn == 4 || u.pn == 5;
        bf16_t* base = isg ? gates : mixin; const int ldc = isg ? 2048 : 2304;
        const int col0 = (isg ? (u.pn - 9) : u.pn) * 256 + wc * 32 + 8 * fq, row0 = u.pm * BM + wr * 64 + fr;
#pragma unroll
        for (int ai = 0; ai < 2; ++ai)
#pragma unroll
            for (int m = 0; m < 4; ++m) { bf16_t* rowp = base + (size_t)(row0 + ai * HALF + m * 16) * ldc + col0;
#pragma unroll
                for (int bj = 0; bj < 2; ++bj) { f32x4 v0 = acc[ai][bj][m][0], v1 = acc[ai][bj][m][1];
                    if (sg) {
#pragma unroll
                        for (int i = 0; i < 4; ++i) { v0[i] = sigm(v0[i]); v1[i] = sigm(v1[i]); } }
                    u32x4 w; w.x = cvt_pk_bf16(v0[0], v0[1]); w.y = cvt_pk_bf16(v0[2], v0[3]); w.z = cvt_pk_bf16(v1[0], v1[1]); w.w = cvt_pk_bf16(v1[2], v1[3]);
                    *(u32x4*)(rowp + bj * HALF) = w; } }
    }
};

struct EpiMix {
    static constexpr bool PERM = true, AFTER_DRAIN = false, HAS_MID = true;
    const bf16_t* gates; bf16_t* mix;
    __device__ __forceinline__ void mid(f32x4 (&acc)[2][2][4][2], const Unit& u, int wr, int wc, int fr, int fq) const {
        unsigned rb = (unsigned)(u.pm * BM + wr * 64 + fr) * 2048u + (unsigned)(u.pn * BM + wc * 32 + 8 * fq);
        asm volatile("" : "+v"(rb));
#pragma unroll
        for (int ai = 0; ai < 2; ++ai)
#pragma unroll
            for (int m = 0; m < 4; ++m) { const bf16_t* rowp = gates + (rb + (unsigned)((ai * HALF + m * 16) * 2048));
#pragma unroll
                for (int bj = 0; bj < 2; ++bj) { const u32x4 a = *(const u32x4*)(rowp + bj * HALF), b = *(const u32x4*)(rowp + 1024 + bj * HALF);
                    const float tiny = 8.673617379884035e-19f;
                    f32x4 r0, r1;
                    r0[0] = bflo(a.x) * __builtin_amdgcn_rcpf(fmaxf(bflo(b.x), tiny)); r0[1] = bfhi(a.x) * __builtin_amdgcn_rcpf(fmaxf(bfhi(b.x), tiny)); r0[2] = bflo(a.y) * __builtin_amdgcn_rcpf(fmaxf(bflo(b.y), tiny)); r0[3] = bfhi(a.y) * __builtin_amdgcn_rcpf(fmaxf(bfhi(b.y), tiny));
                    r1[0] = bflo(a.z) * __builtin_amdgcn_rcpf(fmaxf(bflo(b.z), tiny)); r1[1] = bfhi(a.z) * __builtin_amdgcn_rcpf(fmaxf(bfhi(b.z), tiny)); r1[2] = bflo(a.w) * __builtin_amdgcn_rcpf(fmaxf(bflo(b.w), tiny)); r1[3] = bfhi(a.w) * __builtin_amdgcn_rcpf(fmaxf(bfhi(b.w), tiny));
                    acc[ai][bj][m][0] = acc[ai][bj][m][0] * r0; acc[ai][bj][m][1] = acc[ai][bj][m][1] * r1; }
                if (m == 3) __builtin_amdgcn_sched_barrier(0); }
    }
    __device__ __forceinline__ void operator()(const f32x4 (&acc)[2][2][4][2], const Unit& u, int wr, int wc, int fr, int fq) const {
        const int col0 = u.pn * BM + wc * 32 + 8 * fq, row0 = u.pm * BM + wr * 64 + fr;
#pragma unroll
        for (int ai = 0; ai < 2; ++ai)
#pragma unroll
            for (int m = 0; m < 4; ++m) { const size_t row = (size_t)(row0 + ai * HALF + m * 16);
#pragma unroll
                for (int bj = 0; bj < 2; ++bj) { const u32x4 b = *(const u32x4*)(gates + row * 2048 + 1024 + col0 + bj * HALF);
                    const float tiny = 8.673617379884035e-19f;
                    f32x4 s0, s1;
                    s0[0] = fmaxf(bflo(b.x), tiny); s0[1] = fmaxf(bfhi(b.x), tiny); s0[2] = fmaxf(bflo(b.y), tiny); s0[3] = fmaxf(bfhi(b.y), tiny);
                    s1[0] = fmaxf(bflo(b.z), tiny); s1[1] = fmaxf(bfhi(b.z), tiny); s1[2] = fmaxf(bflo(b.w), tiny); s1[3] = fmaxf(bfhi(b.w), tiny);
                    const f32x4 v0 = acc[ai][bj][m][0] * s0, v1 = acc[ai][bj][m][1] * s1;
                    u32x4 w; w.x = cvt_pk_bf16(v0[0], v0[1]); w.y = cvt_pk_bf16(v0[2], v0[3]); w.z = cvt_pk_bf16(v1[0], v1[1]); w.w = cvt_pk_bf16(v1[2], v1[3]);
                    *(u32x4*)(mix + row * 1024 + col0 + bj * HALF) = w; } }
    }
};

struct EpiOut {
    static constexpr bool PERM = true, AFTER_DRAIN = false, HAS_MID = false;
    const float* xp; const float* xs; float* out; bf16_t* hfw; const float* nfw; float* rowss;
    __device__ __forceinline__ void operator()(const f32x4 (&acc)[2][2][4][2], const Unit& u, int wr, int wc, int fr, int fq) const {
        const int col0 = u.pn * BM + wc * 32 + 8 * fq, row0 = u.pm * BM + wr * 64 + fr;
#pragma unroll
        for (int ai = 0; ai < 2; ++ai)
#pragma unroll
            for (int m = 0; m < 4; ++m) { const int row = row0 + ai * HALF + m * 16;
                const float* xrow = row < 16384 ? xp + (size_t)row * 1024 : xs + (size_t)(row - 16384) * 1024;
                float ss = 0.f;
#pragma unroll
                for (int bj = 0; bj < 2; ++bj) { const int c = col0 + bj * HALF;
                    const f32x4 y0 = *(const f32x4*)(xrow + c) + acc[ai][bj][m][0], y1 = *(const f32x4*)(xrow + c + 4) + acc[ai][bj][m][1];
                    *(f32x4*)(out + (size_t)row * 1024 + c) = y0; *(f32x4*)(out + (size_t)row * 1024 + c + 4) = y1;
                    ss += (y0[0] * y0[0] + y0[1] * y0[1]) + (y0[2] * y0[2] + y0[3] * y0[3]) + (y1[0] * y1[0] + y1[1] * y1[1]) + (y1[2] * y1[2] + y1[3] * y1[3]);
                    const f32x4 w0 = *(const f32x4*)(nfw + c), w1 = *(const f32x4*)(nfw + c + 4);
                    const f32x4 z0 = y0 * w0, z1 = y1 * w1;
                    u32x4 w; w.x = cvt_pk_bf16(z0[0], z0[1]); w.y = cvt_pk_bf16(z0[2], z0[3]); w.z = cvt_pk_bf16(z1[0], z1[1]); w.w = cvt_pk_bf16(z1[2], z1[3]);
                    *(u32x4*)(hfw + (size_t)row * 1024 + c) = w; }
                ss += __shfl_xor(ss, 16); ss += __shfl_xor(ss, 32);
                if (fq == 0) unsafeAtomicAdd(rowss + row, ss); }
    }
};

struct EpiGU {
    static constexpr bool PERM = true, AFTER_DRAIN = false, HAS_MID = false;
    bf16_t* act; const float* rowss;
    __device__ __forceinline__ void operator()(const f32x4 (&acc)[2][2][4][2], const Unit& u, int wr, int wc, int fr, int fq) const {
        const int col0 = u.pn * HALF + wc * 32 + 8 * fq, row0 = u.pm * BM + wr * 64 + fr;
#pragma unroll
        for (int ai = 0; ai < 2; ++ai)
#pragma unroll
            for (int m = 0; m < 4; ++m) { const int row = row0 + ai * HALF + m * 16;
                const float rstd = __builtin_amdgcn_rsqf(rowss[row] * (1.0f / 1024.0f) + 1e-6f);
                float o[8];
#pragma unroll
                for (int n = 0; n < 2; ++n)
#pragma unroll
                    for (int j = 0; j < 4; ++j) { const float g = acc[ai][0][m][n][j] * rstd, up = acc[ai][1][m][n][j] * rstd; o[n * 4 + j] = g * sigm(g) * up; }
                u32x4 w; w.x = cvt_pk_bf16(o[0], o[1]); w.y = cvt_pk_bf16(o[2], o[3]); w.z = cvt_pk_bf16(o[4], o[5]); w.w = cvt_pk_bf16(o[6], o[7]);
                *(u32x4*)(act + (size_t)row * 2816 + col0) = w; }
    }
};

struct EpiDown {
    static constexpr bool PERM = true, AFTER_DRAIN = false, HAS_MID = false;
    float* out;
    __device__ __forceinline__ void operator()(const f32x4 (&acc)[2][2][4][2], const Unit& u, int wr, int wc, int fr, int fq) const {
        const int col0 = u.pn * BM + wc * 32 + 8 * fq, row0 = u.pm * BM + wr * 64 + fr;
#pragma unroll
        for (int ai = 0; ai < 2; ++ai)
#pragma unroll
            for (int m = 0; m < 4; ++m) { float* rowp = out + (size_t)(row0 + ai * HALF + m * 16) * 1024 + col0;
#pragma unroll
                for (int bj = 0; bj < 2; ++bj) { const f32x4 y0 = *(const f32x4*)(rowp + bj * HALF) + acc[ai][bj][m][0], y1 = *(const f32x4*)(rowp + bj * HALF + 4) + acc[ai][bj][m][1];
                    *(f32x4*)(rowp + bj * HALF) = y0; *(f32x4*)(rowp + bj * HALF + 4) = y1; } }
    }
};

template <class Epi, class Sched, bool ALIGN_EPI = false, bool SP2 = false>
__device__ __forceinline__ void gemm_phase(PG8_LAS unsigned char* lds, const Gemm g, const Sched& S, const Epi& E) {
    const int tid = threadIdx.x, wid = __builtin_amdgcn_readfirstlane(tid >> 6), lane = tid & 63, wr = wid >> 2, wc = wid & 3, fr = lane & 15, fq = lane >> 4;
    const int K = g.K, nt = K / BK;
    unsigned voffA[2], voffB[2];
#pragma unroll
    for (int i = 0; i < 2; ++i) { int R, C; stage_rc(tid * 16 + i * 8192, R, C); const int Rb = Epi::PERM ? ((R & ~31) + perm32(R & 31)) : R;
        voffA[i] = (unsigned)(R * K + C) * 2u; voffB[i] = (unsigned)(Rb * K + C) * 2u; }
    const size_t kstep = (size_t)(BK * 2);
    const size_t hstep = (size_t)HALF * K * 2;
    const size_t tstep = 2 * hstep;
    const unsigned ldsw = (unsigned)wid * 1024u;
    const int aoff = lds_byte(wr * 64 + fr, fq * 8), boff = lds_byte(wc * 32 + fr, fq * 8);
#define PG8_SA(b, h) (((b) * 2 + (h)) * HTB)
#define PG8_SB(b, h) ((4 + (b) * 2 + (h)) * HTB)
#define PG8_STAGE(bufoff, gbase, voff) do { _Pragma("unroll") for (int _i = 0; _i < 2; ++_i) \
        __builtin_amdgcn_global_load_lds((const unsigned*)((const char*)(gbase) + (voff)[_i]), (PG8_LAS unsigned*)(lds + (bufoff) + ldsw + _i * 8192), 16, 0, 0); } while (0)
#define PG8_LDA(dst, b, h) do { _Pragma("unroll") for (int m = 0; m < 4; ++m) _Pragma("unroll") for (int k = 0; k < 2; ++k) dst[m][k] = *(const PG8_LAS bf16x8*)(lds + PG8_SA(b, h) + aoff + m * 2048 + k * 1024); } while (0)
#define PG8_LDB(dst, b, h) do { _Pragma("unroll") for (int n = 0; n < 2; ++n) _Pragma("unroll") for (int k = 0; k < 2; ++k) dst[n][k] = *(const PG8_LAS bf16x8*)(lds + PG8_SB(b, h) + boff + n * 2048 + k * 1024); } while (0)
#define PG8_MMA(ai, bj, At, Bt) do { __builtin_amdgcn_s_setprio(1); _Pragma("unroll") for (int m = 0; m < 4; ++m) _Pragma("unroll") for (int n = 0; n < 2; ++n) _Pragma("unroll") for (int k = 0; k < 2; ++k) \
        acc[ai][bj][m][n] = __builtin_amdgcn_mfma_f32_16x16x32_bf16(Bt[n][k], At[m][k], acc[ai][bj][m][n], 0, 0, 0); __builtin_amdgcn_s_setprio(0); } while (0)
#define PG8_WAIT_V(n) asm volatile("s_waitcnt vmcnt(" #n ")" ::: "memory")
#define PG8_WAIT_L(n) asm volatile("s_waitcnt lgkmcnt(" #n ")" ::: "memory")
#define PG8_BAR __builtin_amdgcn_s_barrier()
#define PG8_SCHED __builtin_amdgcn_sched_barrier(0)
    Unit cur, nxt; int ui = 0;
    if (!S.next(0, cur)) return;
    f32x4 acc[2][2][4][2];
#pragma unroll
    for (int a = 0; a < 2; ++a)
#pragma unroll
        for (int b = 0; b < 2; ++b)
#pragma unroll
            for (int m = 0; m < 4; ++m)
#pragma unroll
                for (int n = 0; n < 2; ++n) acc[a][b][m][n] = (f32x4){0.f, 0.f, 0.f, 0.f};
    bf16x8 At[4][2], B0[2][2], B1[2][2];
    const char* cA = (const char*)g.A + (size_t)cur.pm * tstep; const char* cB = (const char*)g.Bt + (size_t)cur.pn * tstep;
    S.a_ready(cur);
    if constexpr (SP2) {
        PG8_STAGE(PG8_SB(0, 0), cB, voffB); PG8_STAGE(PG8_SB(0, 1), cB + hstep, voffB); PG8_STAGE(PG8_SA(0, 0), cA, voffA); PG8_STAGE(PG8_SA(0, 1), cA + hstep, voffA);
        if (wr == 1) PG8_BAR;
        PG8_WAIT_V(2); PG8_BAR;
        PG8_STAGE(PG8_SB(1, 0), cB + kstep, voffB); PG8_STAGE(PG8_SA(1, 0), cA + kstep, voffA); PG8_STAGE(PG8_SB(1, 1), cB + hstep + kstep, voffB);
        PG8_WAIT_V(6); PG8_BAR;
    } else {
        PG8_STAGE(PG8_SB(0, 0), cB, voffB); PG8_STAGE(PG8_SA(0, 0), cA, voffA); PG8_STAGE(PG8_SB(0, 1), cB + hstep, voffB); PG8_STAGE(PG8_SA(0, 1), cA + hstep, voffA);
        if (wr == 1) PG8_BAR;
        PG8_WAIT_V(4); PG8_BAR;
        PG8_STAGE(PG8_SB(1, 0), cB + kstep, voffB); PG8_STAGE(PG8_SA(1, 0), cA + kstep, voffA); PG8_STAGE(PG8_SB(1, 1), cB + hstep + kstep, voffB);
        PG8_WAIT_V(6); PG8_BAR;
    }
    for (;;) {
        const bool has_next = S.next(ui + 1, nxt);
        const char* nA = has_next ? (const char*)g.A + (size_t)nxt.pm * tstep : cA; const char* nB = has_next ? (const char*)g.Bt + (size_t)nxt.pn * tstep : cB;
        for (int t = 0; t < nt; t += 2) {
            if constexpr (Epi::HAS_MID) { if (t == (nt >> 1)) E.mid(acc, cur, wr, wc, fr, fq); }
            const bool last = (t == nt - 2);
            const char* a1 = cA + (size_t)(t + 1) * kstep;
            const char* a2 = last ? nA : cA + (size_t)(t + 2) * kstep; const char* b2 = last ? nB : cB + (size_t)(t + 2) * kstep;
            const char* a3 = a2 + kstep; const char* b3 = b2 + kstep;
            if (last && has_next) S.a_ready(nxt);
            if constexpr (SP2) {
            PG8_LDB(B0, 0, 0); PG8_LDB(B1, 0, 1); PG8_SCHED; PG8_LDA(At, 0, 0); PG8_STAGE(PG8_SA(1, 1), a1 + hstep, voffA);
            PG8_WAIT_V(8); PG8_WAIT_L(0); PG8_BAR; PG8_MMA(0, 0, At, B0); PG8_MMA(0, 1, At, B1); PG8_BAR; PG8_SCHED;
            PG8_LDA(At, 0, 1); PG8_STAGE(PG8_SB(0, 0), b2, voffB); PG8_STAGE(PG8_SB(0, 1), b2 + hstep, voffB); PG8_STAGE(PG8_SA(0, 0), a2, voffA);
            PG8_WAIT_V(8); PG8_WAIT_L(0); PG8_BAR; PG8_MMA(1, 0, At, B0); PG8_MMA(1, 1, At, B1); PG8_BAR; PG8_SCHED;
            PG8_LDB(B0, 1, 0); PG8_LDB(B1, 1, 1); PG8_SCHED; PG8_LDA(At, 1, 0); PG8_STAGE(PG8_SA(0, 1), a2 + hstep, voffA);
            PG8_WAIT_V(8); PG8_WAIT_L(0); PG8_BAR; PG8_MMA(0, 0, At, B0); PG8_MMA(0, 1, At, B1); PG8_BAR; PG8_SCHED;
            PG8_LDA(At, 1, 1); PG8_STAGE(PG8_SB(1, 0), b3, voffB); PG8_STAGE(PG8_SB(1, 1), b3 + hstep, voffB); PG8_STAGE(PG8_SA(1, 0), a3, voffA);
            PG8_WAIT_V(8); PG8_WAIT_L(0); PG8_BAR; PG8_MMA(1, 0, At, B0); PG8_MMA(1, 1, At, B1); PG8_BAR; PG8_SCHED;
            } else {
            PG8_LDB(B0, 0, 0); PG8_SCHED; PG8_LDA(At, 0, 0); PG8_STAGE(PG8_SA(1, 1), a1 + hstep, voffA);
            PG8_WAIT_L(8); PG8_BAR; PG8_WAIT_L(0); PG8_MMA(0, 0, At, B0); PG8_BAR; PG8_SCHED;
            PG8_LDB(B1, 0, 1); PG8_STAGE(PG8_SB(0, 0), b2, voffB);
            PG8_BAR; PG8_WAIT_L(0); PG8_MMA(0, 1, At, B1); PG8_BAR;
            PG8_LDA(At, 0, 1); PG8_STAGE(PG8_SA(0, 0), a2, voffA);
            PG8_BAR; PG8_WAIT_L(0); PG8_MMA(1, 0, At, B0); PG8_BAR; PG8_SCHED;
            PG8_STAGE(PG8_SB(0, 1), b2 + hstep, voffB);
            PG8_WAIT_V(6); PG8_BAR; PG8_MMA(1, 1, At, B1); PG8_BAR;
            PG8_LDB(B0, 1, 0); PG8_SCHED; PG8_LDA(At, 1, 0); PG8_STAGE(PG8_SA(0, 1), a2 + hstep, voffA);
            PG8_WAIT_L(8); PG8_BAR; PG8_WAIT_L(0); PG8_MMA(0, 0, At, B0); PG8_BAR; PG8_SCHED;
            PG8_LDB(B1, 1, 1); PG8_STAGE(PG8_SB(1, 0), b3, voffB);
            PG8_BAR; PG8_WAIT_L(0); PG8_MMA(0, 1, At, B1); PG8_BAR;
            PG8_LDA(At, 1, 1); PG8_STAGE(PG8_SA(1, 0), a3, voffA);
            PG8_BAR; PG8_WAIT_L(0); PG8_MMA(1, 0, At, B0); PG8_BAR; PG8_SCHED;
            PG8_STAGE(PG8_SB(1, 1), b3 + hstep, voffB);
            PG8_WAIT_V(6); PG8_BAR; PG8_MMA(1, 1, At, B1); PG8_BAR;
            }
        }
        if constexpr (ALIGN_EPI) { if (wr == 0) PG8_BAR; }
        if constexpr (!Epi::AFTER_DRAIN) { E(acc, cur, wr, wc, fr, fq); S.done(cur); }
        if (!has_next) break;
#pragma unroll
        for (int a = 0; a < 2; ++a)
#pragma unroll
            for (int b = 0; b < 2; ++b)
#pragma unroll
                for (int m = 0; m < 4; ++m)
#pragma unroll
                    for (int n = 0; n < 2; ++n) acc[a][b][m][n] = (f32x4){0.f, 0.f, 0.f, 0.f};
        cur = nxt; cA = nA; cB = nB; ++ui;
        if constexpr (ALIGN_EPI) { if (wr == 1) PG8_BAR; }
    }
    PG8_WAIT_V(0);
    if constexpr (!ALIGN_EPI) { if (wr == 0) PG8_BAR; }
    PG8_BAR;
    if constexpr (Epi::AFTER_DRAIN) { E.fused(acc, cur, wr, wc, fr, fq, lds, wid, lane); S.done(cur); }
#undef PG8_SA
#undef PG8_SB
#undef PG8_STAGE
#undef PG8_LDA
#undef PG8_LDB
#undef PG8_MMA
#undef PG8_WAIT_V
#undef PG8_WAIT_L
#undef PG8_BAR
#undef PG8_SCHED
}
}
using pg8::bf16_t; using pg8::bf16x8; using pg8::f32x4; using pg8::u32x4; using pg8::cvt_pk_bf16; using pg8::bflo; using pg8::bfhi; using pg8::sigm;
typedef unsigned u32x2 __attribute__((ext_vector_type(2)));
constexpr int MP = 16384, MS = 1024, MT = MP + MS;
constexpr int DIN = 4360, NPROJ = 4352, NMIX = 2304, NGATE = 2048, DFF = 2816;
constexpr float EPS = 1e-6f, LOG2E = 1.4426950408889634f;
constexpr size_t MiB = 1u << 20;
constexpr size_t WS_ROWSS = 0;
constexpr size_t WS_SUMA = 128 * 1024, WS_SUMM = WS_SUMA + 4096, WS_MCH = WS_SUMM + 4096;
constexpr size_t WS_GI = 256 * 1024, WS_GB = WS_GI + 320 * 1024;
constexpr size_t WS_DN = 1 * MiB, WS_NPREV = WS_DN + 256 * 1024;
constexpr size_t WS_WIN = 2 * MiB;
constexpr size_t WS_WAB = WS_WIN + 17 * MiB / 2;
constexpr size_t WS_WOUT = WS_WAB + 2 * MiB;
constexpr size_t WS_WGU = WS_WOUT + 2 * MiB;
constexpr size_t WS_WD = WS_WGU + 11 * MiB;
constexpr size_t WS_HN = WS_WD + 11 * MiB / 2;
constexpr size_t OB_DCT = 34 * MiB, OB_CPT = 50 * MiB;
constexpr size_t WS_MIXIN = WS_HN + 34 * MiB;
constexpr size_t WS_GATES = WS_MIXIN + 153 * MiB / 2;
constexpr size_t WS_HCAT = WS_GATES + 68 * MiB;
constexpr size_t WS_END = WS_HCAT + 34 * MiB;
static_assert(WS_END <= 256 * MiB, "workspace map");
constexpr size_t O_Y = 0, O_CP = (size_t)MT * 1024, O_NP = O_CP + 65536, O_MP = O_NP + 512, O_KWP = O_MP + 8, O_VWP = O_KWP + 32768,
                 O_CS = O_VWP + 32768, O_NS = O_CS + 4194304, O_MS = O_NS + 32768, O_KWS = O_MS + 512, O_VWS = O_KWS + 2097152, O_END = O_VWS + 2097152;
constexpr size_t WS_BAR = 1536 * 1024;
constexpr int LDS_BYTES = 131072 + 256;

struct Params { const float* in[22]; float* out; unsigned char* ws; int ph_lo, ph_hi; };

__device__ __forceinline__ float bf2f(bf16_t h) { return __builtin_bit_cast(float, (unsigned)h << 16); }
__device__ __forceinline__ bf16_t f2bf(float f) { return (bf16_t)(cvt_pk_bf16(f, 0.f) & 0xffffu); }
__device__ __forceinline__ float wave_sum(float v) {
#pragma unroll
    for (int o = 1; o < 64; o <<= 1) v += __shfl_xor(v, o);
    return v; }
__device__ __forceinline__ float wave_max(float v) {
#pragma unroll
    for (int o = 1; o < 64; o <<= 1) v = fmaxf(v, __shfl_xor(v, o));
    return v; }
__device__ __forceinline__ f32x4 mfma16(bf16x8 a, bf16x8 b, f32x4 c) { f32x4 d = __builtin_amdgcn_mfma_f32_16x16x32_bf16(a, b, c, 0, 0, 0); asm volatile("" : "+v"(d) : "v"(a), "v"(b)); return d; }
__device__ __forceinline__ bf16x8 pack8(const f32x4& a, const f32x4& b) { u32x4 t; t.x = cvt_pk_bf16(a[0], a[1]); t.y = cvt_pk_bf16(a[2], a[3]); t.z = cvt_pk_bf16(b[0], b[1]); t.w = cvt_pk_bf16(b[2], b[3]); return __builtin_bit_cast(bf16x8, t); }
__device__ __forceinline__ void unpack8(const u32x4& r, float* f) { f[0] = bflo(r.x); f[1] = bfhi(r.x); f[2] = bflo(r.y); f[3] = bfhi(r.y); f[4] = bflo(r.z); f[5] = bfhi(r.z); f[6] = bflo(r.w); f[7] = bfhi(r.w); }

__device__ __forceinline__ void p0_tokens(const Params& P, int u, unsigned char* lds, int tid) {
    const float* wg = (const float*)lds; float* graw = (float*)(lds + 32768);
    const float* nw = P.in[7];
    bf16_t* HN = (bf16_t*)(P.ws + WS_HN);
    const int lane = tid & 63, w = tid >> 6;
#pragma unroll 1
    for (int tt = 0; tt < 8; ++tt) {
        const int r = u * 64 + w * 8 + tt;
        const float* xrow = r < MP ? P.in[0] + (size_t)r * 1024 : P.in[1] + (size_t)(r - MP) * 1024;
        f32x4 xv[4]; float ss = 0.f;
#pragma unroll
        for (int j = 0; j < 4; ++j) { xv[j] = ((const f32x4*)xrow)[lane + 64 * j]; ss += (xv[j][0] * xv[j][0] + xv[j][1] * xv[j][1]) + (xv[j][2] * xv[j][2] + xv[j][3] * xv[j][3]); }
        ss = wave_sum(ss);
        const float rstd = 1.0f / sqrtf(ss * (1.0f / 1024.0f) + EPS);
        float g[8];
#pragma unroll
        for (int q = 0; q < 8; ++q) g[q] = 0.f;
#pragma unroll
        for (int j = 0; j < 4; ++j) { const int k0 = 4 * (lane + 64 * j);
            const f32x4 nv = *(const f32x4*)(nw + k0); const f32x4 hv = xv[j] * rstd * nv;
            u32x2 pk; pk.x = cvt_pk_bf16(hv[0], hv[1]); pk.y = cvt_pk_bf16(hv[2], hv[3]);
            *(u32x2*)(HN + (size_t)r * 1024 + k0) = pk;
#pragma unroll
            for (int q = 0; q < 8; ++q) { const f32x4 wv = *(const f32x4*)(wg + q * 1024 + k0); g[q] += (xv[j][0] * wv[0] + xv[j][1] * wv[1]) + (xv[j][2] * wv[2] + xv[j][3] * wv[3]); } }
#pragma unroll
        for (int q = 0; q < 8; ++q) g[q] = wave_sum(g[q]);
        if (lane == 0) {
#pragma unroll
            for (int q = 0; q < 8; ++q) graw[(w * 8 + tt) * 8 + q] = g[q] * rstd; }
    }
    __syncthreads();
    if (w == 0) {
        const bool prompt = u < 256; const int r = u * 64 + lane; const int pos = prompt ? lane : (lane & 7);
        float* gi = (float*)(P.ws + WS_GI); float* gb = (float*)(P.ws + WS_GB);
#pragma unroll
        for (int h = 0; h < 4; ++h) {
            const float iv = graw[lane * 8 + h] + P.in[9][h], fv = graw[lane * 8 + 4 + h] + P.in[10][h];
            float b = fminf(fv, 0.f) - log1pf(expf(-fabsf(fv)));
#pragma unroll
            for (int o = 1; o < 64; o <<= 1) { const float nb = __shfl_up(b, o); if (pos >= o) b += nb; }
            gi[r * 4 + h] = iv; gb[r * 4 + h] = b;
            if (prompt) { const float A = __shfl(b, 63); const float Mv = wave_max(A - b + iv);
                if (lane == 0) { const int idx = ((u >> 7) * 4 + h) * 128 + (u & 127); ((float*)(P.ws + WS_SUMA))[idx] = A; ((float*)(P.ws + WS_SUMM))[idx] = Mv; } }
        }
    }
    __syncthreads();
}
__device__ __forceinline__ void p0_wtile(const float* src, int ldsrc, int k0, int c0, bf16_t* dst, int lddst, int n0, int k0d, unsigned char* lds, int tid) {
    float* tile = (float*)(lds + 40960);
#pragma unroll
    for (int p = 0; p < 2; ++p) { const int i = (tid >> 4) + 32 * p, j4 = (tid & 15) * 4;
        const f32x4 v = *(const f32x4*)(src + (size_t)(k0 + i) * ldsrc + c0 + j4);
        tile[i * 65 + j4] = v[0]; tile[i * 65 + j4 + 1] = v[1]; tile[i * 65 + j4 + 2] = v[2]; tile[i * 65 + j4 + 3] = v[3]; }
    __syncthreads();
    { const int n = tid >> 3, kc = (tid & 7) * 8; const float* s = tile + kc * 65 + n;
        u32x4 o; o.x = cvt_pk_bf16(s[0], s[65]); o.y = cvt_pk_bf16(s[2 * 65], s[3 * 65]); o.z = cvt_pk_bf16(s[4 * 65], s[5 * 65]); o.w = cvt_pk_bf16(s[6 * 65], s[7 * 65]);
        *(u32x4*)(dst + (size_t)(n0 + n) * lddst + k0d + kc) = o; }
    __syncthreads();
}
__device__ __forceinline__ void p0_prep(const Params& P, unsigned char* lds, int tid, int G) {
    float* rowss = (float*)(P.ws + WS_ROWSS);
    for (int i = blockIdx.x * 512 + tid; i < MT; i += G * 512) rowss[i] = 0.f;
    { float* wg = (float*)lds; const float* w_in = P.in[8]; const float* nw = P.in[7];
        for (int idx = tid; idx < 8192; idx += 512) { const int k = idx >> 3, q = idx & 7; wg[q * 1024 + k] = w_in[(size_t)k * DIN + 1536 + q] * nw[k]; } }
    __syncthreads();
    for (int u = blockIdx.x; u < MT / 64; u += G) p0_tokens(P, u, lds, tid);
    constexpr int NT_IN = 68 * 16, NT_AB = 256, NT_OUT = 256, NT_GU = 1408, NT_D = 704, NT_ALL = NT_IN + NT_AB + NT_OUT + NT_GU + NT_D;
    for (int it = (G - 1 - (int)blockIdx.x); it < NT_ALL; it += G) {
        int r = it;
        if (r < NT_IN) { const int nt = r >> 4, kt = r & 15, c0 = nt * 64; p0_wtile(P.in[8], DIN, kt * 64, c0 < 1536 ? c0 : c0 + 8, (bf16_t*)(P.ws + WS_WIN), 1024, c0, kt * 64, lds, tid); continue; } r -= NT_IN;
        if (r < NT_AB) { const int which = r >> 7, rr = r & 127, nt = rr >> 3, kt = rr & 7; p0_wtile(which ? P.in[16] : P.in[15], 1024, kt * 64, nt * 64, (bf16_t*)(P.ws + WS_WAB), 1024, nt * 64, which * 512 + kt * 64, lds, tid); continue; } r -= NT_AB;
        if (r < NT_OUT) { const int nt = r >> 4, kt = r & 15; p0_wtile(P.in[17], 1024, kt * 64, nt * 64, (bf16_t*)(P.ws + WS_WOUT), 1024, nt * 64, kt * 64, lds, tid); continue; } r -= NT_OUT;
        if (r < NT_GU) { const int which = r / 704, rr = r % 704, jt = rr >> 4, kt = rr & 15, j0 = jt * 64;
            p0_wtile(which ? P.in[20] : P.in[19], DFF, kt * 64, j0, (bf16_t*)(P.ws + WS_WGU), 1024, 256 * (j0 >> 7) + (j0 & 127) + which * 128, kt * 64, lds, tid); continue; } r -= NT_GU;
        { const int nt = r / 44, kt = r % 44; p0_wtile(P.in[21], 1024, kt * 64, nt * 64, (bf16_t*)(P.ws + WS_WD), DFF, nt * 64, kt * 64, lds, tid); }
    }
}

template <int NQT>
__device__ __forceinline__ void attn_core(const unsigned char* lds, const bf16x8 (&qf)[NQT][2], int kt_lo, int kt_hi, int qbase, int jmin, float sink2, f32x4 (&o)[4][NQT], float (&l)[NQT]) {
    const bf16_t* Ks = (const bf16_t*)lds; const bf16_t* Vt = (const bf16_t*)(lds + 36864);
    const int lane = threadIdx.x & 63, fr = lane & 15, g = lane >> 4;
    float mrun[NQT];
#pragma unroll
    for (int qt = 0; qt < NQT; ++qt) { mrun[qt] = sink2; l[qt] = (g == 0) ? 1.f : 0.f;
#pragma unroll
        for (int dt = 0; dt < 4; ++dt) o[dt][qt] = (f32x4){0.f, 0.f, 0.f, 0.f}; }
#pragma unroll 1
    for (int kt = kt_lo; kt <= kt_hi; ++kt) {
        f32x4 s[4][NQT];
#pragma unroll
        for (int ks = 0; ks < 4; ++ks)
#pragma unroll
            for (int qt = 0; qt < NQT; ++qt) s[ks][qt] = (f32x4){0.f, 0.f, 0.f, 0.f};
#pragma unroll
        for (int ks = 0; ks < 4; ++ks)
#pragma unroll
            for (int kk = 0; kk < 2; ++kk) { const bf16x8 kf = *(const bf16x8*)(Ks + (kt * 64 + ks * 16 + fr) * 72 + g * 8 + kk * 32);
#pragma unroll
                for (int qt = 0; qt < NQT; ++qt) s[ks][qt] = mfma16(kf, qf[qt][kk], s[ks][qt]); }
#pragma unroll
        for (int qt = 0; qt < NQT; ++qt) { const int qi = qbase + 16 * qt + fr; float mx = -1e30f;
#pragma unroll
            for (int ks = 0; ks < 4; ++ks)
#pragma unroll
                for (int r = 0; r < 4; ++r) { const int j = kt * 64 + ks * 16 + g * 4 + r; const bool ok = (j > qi) && (j <= qi + 128) && (j >= jmin);
                    const float v = ok ? s[ks][qt][r] : -1e30f; s[ks][qt][r] = v; mx = fmaxf(mx, v); }
            mx = fmaxf(mx, __shfl_xor(mx, 16)); mx = fmaxf(mx, __shfl_xor(mx, 32));
            const float mnew = fmaxf(mrun[qt], mx), alpha = __builtin_amdgcn_exp2f(mrun[qt] - mnew); mrun[qt] = mnew;
            float ps = 0.f;
#pragma unroll
            for (int ks = 0; ks < 4; ++ks)
#pragma unroll
                for (int r = 0; r < 4; ++r) { const float p = __builtin_amdgcn_exp2f(s[ks][qt][r] - mnew); s[ks][qt][r] = p; ps += p; }
            l[qt] = l[qt] * alpha + ps;
#pragma unroll
            for (int dt = 0; dt < 4; ++dt) o[dt][qt] = o[dt][qt] * alpha; }
#pragma unroll
        for (int c = 0; c < 2; ++c) { bf16x8 pf[NQT];
#pragma unroll
            for (int qt = 0; qt < NQT; ++qt) pf[qt] = pack8(s[2 * c][qt], s[2 * c + 1][qt]);
#pragma unroll
            for (int dt = 0; dt < 4; ++dt) { const bf16_t* vp = Vt + (dt * 16 + fr) * 264 + kt * 64 + c * 32 + g * 4;
                const u32x2 v0 = *(const u32x2*)vp, v1 = *(const u32x2*)(vp + 16);
                const bf16x8 vf = __builtin_bit_cast(bf16x8, (u32x4){v0.x, v0.y, v1.x, v1.y});
#pragma unroll
                for (int qt = 0; qt < NQT; ++qt) o[dt][qt] = mfma16(vf, pf[qt], o[dt][qt]); } }
    }
}
__device__ __forceinline__ void attn_put(unsigned char* lds, int slot, int hh, const float* kf, const float* vf) {
    bf16_t* Ks = (bf16_t*)lds; bf16_t* Vt = (bf16_t*)(lds + 36864);
#pragma unroll
    for (int i = 0; i < 4; ++i) { u32x4 w; w.x = cvt_pk_bf16(kf[8 * i], kf[8 * i + 1]); w.y = cvt_pk_bf16(kf[8 * i + 2], kf[8 * i + 3]); w.z = cvt_pk_bf16(kf[8 * i + 4], kf[8 * i + 5]); w.w = cvt_pk_bf16(kf[8 * i + 6], kf[8 * i + 7]);
        *(u32x4*)(Ks + slot * 72 + hh * 32 + 8 * i) = w; }
#pragma unroll
    for (int i = 0; i < 32; ++i) Vt[(hh * 32 + i) * 264 + slot] = f2bf(vf[i]);
}
__device__ __forceinline__ void attn_prompt_item(const Params& P, int item, unsigned char* lds, int tid) {
    const int kvh = item & 1, n = (item >> 1) & 63, b = item >> 7;
    const bf16_t* mixin = (const bf16_t*)(P.ws + WS_MIXIN);
    { const int slot = tid >> 1, hh = tid & 1, tokb = n * 128 - 128 + slot;
        float kf[32], vf[32];
        if (tokb >= 0) { const bf16_t* rowp = mixin + (size_t)(b * 8192 + tokb) * NMIX + 2048 + kvh * 64 + hh * 32;
#pragma unroll
            for (int i = 0; i < 4; ++i) { const u32x4 kr = *(const u32x4*)(rowp + 8 * i), vr = *(const u32x4*)(rowp + 128 + 8 * i); unpack8(kr, kf + 8 * i); unpack8(vr, vf + 8 * i); } }
        else {
#pragma unroll
            for (int i = 0; i < 32; ++i) { kf[i] = 0.f; vf[i] = 0.f; } }
        float ss = 0.f;
#pragma unroll
        for (int i = 0; i < 32; ++i) ss += kf[i] * kf[i];
        ss += __shfl_xor(ss, 1);
        const float rstd = 1.0f / sqrtf(ss * (1.0f / 64.0f) + EPS);
#pragma unroll
        for (int i = 0; i < 32; ++i) kf[i] = kf[i] * rstd * P.in[13][hh * 32 + i];
        attn_put(lds, slot, hh, kf, vf);
        if (n == 63 && slot >= 128) { float* kw = P.out + O_KWP + ((size_t)(b * 128 + slot - 128) * 2 + kvh) * 64 + hh * 32; float* vw = P.out + O_VWP + ((size_t)(b * 128 + slot - 128) * 2 + kvh) * 64 + hh * 32;
#pragma unroll
            for (int i = 0; i < 8; ++i) { *(f32x4*)(kw + 4 * i) = (f32x4){kf[4 * i], kf[4 * i + 1], kf[4 * i + 2], kf[4 * i + 3]}; *(f32x4*)(vw + 4 * i) = (f32x4){vf[4 * i], vf[4 * i + 1], vf[4 * i + 2], vf[4 * i + 3]}; } }
    }
    __syncthreads();
    const int w = tid >> 6, lane = tid & 63, fr = lane & 15, g = lane >> 4, gq = w >> 1, half = w & 1, head = kvh * 4 + gq;
    bf16_t* hcat = (bf16_t*)(P.ws + WS_HCAT);
#pragma unroll 1
    for (int qh = 0; qh < 2; ++qh) {
    bf16x8 qf[2][2];
#pragma unroll
    for (int qt = 0; qt < 2; ++qt) { const int tok = b * 8192 + n * 128 + half * 64 + qh * 32 + qt * 16 + fr; const bf16_t* qp = mixin + (size_t)tok * NMIX + 1536 + head * 64 + g * 8;
        float f0[8], f1[8]; unpack8(*(const u32x4*)qp, f0); unpack8(*(const u32x4*)(qp + 32), f1);
        float ss = 0.f;
#pragma unroll
        for (int i = 0; i < 8; ++i) ss += f0[i] * f0[i] + f1[i] * f1[i];
        ss += __shfl_xor(ss, 16); ss += __shfl_xor(ss, 32);
        const float sc = (0.125f * LOG2E) / sqrtf(ss * (1.0f / 64.0f) + EPS);
#pragma unroll
        for (int i = 0; i < 8; ++i) { f0[i] = f0[i] * sc * P.in[12][g * 8 + i]; f1[i] = f1[i] * sc * P.in[12][32 + g * 8 + i]; }
        qf[qt][0] = pack8((f32x4){f0[0], f0[1], f0[2], f0[3]}, (f32x4){f0[4], f0[5], f0[6], f0[7]}); qf[qt][1] = pack8((f32x4){f1[0], f1[1], f1[2], f1[3]}, (f32x4){f1[4], f1[5], f1[6], f1[7]}); }
    f32x4 o[4][2]; float l[2];
    attn_core<2>(lds, qf, half, half + 2, half * 64 + qh * 32, n == 0 ? 128 : 0, P.in[14][head] * LOG2E, o, l);
#pragma unroll
    for (int qt = 0; qt < 2; ++qt) { float lt = l[qt]; lt += __shfl_xor(lt, 16); lt += __shfl_xor(lt, 32); const float inv = 1.0f / lt;
        const int tok = b * 8192 + n * 128 + half * 64 + qh * 32 + qt * 16 + fr;
#pragma unroll
        for (int dt = 0; dt < 4; ++dt) { const f32x4 v = o[dt][qt] * inv; u32x2 pk; pk.x = cvt_pk_bf16(v[0], v[1]); pk.y = cvt_pk_bf16(v[2], v[3]);
            *(u32x2*)(hcat + (size_t)tok * 1024 + 512 + head * 64 + dt * 16 + g * 4) = pk; } }
    }
    __syncthreads();
}
__device__ __forceinline__ void attn_sample_item(const Params& P, int item, unsigned char* lds, int tid) {
    const int kvh = item & 1, b = item >> 1;
    const bf16_t* mixin = (const bf16_t*)(P.ws + WS_MIXIN);
    { const int slot = tid >> 1, hh = tid & 1;
        if (slot < 192) { float kf[32], vf[32];
            if (slot < 128) { const size_t off = ((size_t)(b * 128 + slot) * 2 + kvh) * 64 + hh * 32; const float* kp = P.in[5] + off; const float* vp = P.in[6] + off;
#pragma unroll
                for (int i = 0; i < 8; ++i) { const f32x4 a = *(const f32x4*)(kp + 4 * i), c = *(const f32x4*)(vp + 4 * i);
                    kf[4 * i] = a[0]; kf[4 * i + 1] = a[1]; kf[4 * i + 2] = a[2]; kf[4 * i + 3] = a[3]; vf[4 * i] = c[0]; vf[4 * i + 1] = c[1]; vf[4 * i + 2] = c[2]; vf[4 * i + 3] = c[3]; } }
            else if (slot < 136) { const bf16_t* rowp = mixin + (size_t)(MP + b * 8 + slot - 128) * NMIX + 2048 + kvh * 64 + hh * 32;
#pragma unroll
                for (int i = 0; i < 4; ++i) { const u32x4 kr = *(const u32x4*)(rowp + 8 * i), vr = *(const u32x4*)(rowp + 128 + 8 * i); unpack8(kr, kf + 8 * i); unpack8(vr, vf + 8 * i); }
                float ss = 0.f;
#pragma unroll
                for (int i = 0; i < 32; ++i) ss += kf[i] * kf[i];
                ss += __shfl_xor(ss, 1);
                const float rstd = 1.0f / sqrtf(ss * (1.0f / 64.0f) + EPS);
#pragma unroll
                for (int i = 0; i < 32; ++i) kf[i] = kf[i] * rstd * P.in[13][hh * 32 + i]; }
            else {
#pragma unroll
                for (int i = 0; i < 32; ++i) { kf[i] = 0.f; vf[i] = 0.f; } }
            attn_put(lds, slot, hh, kf, vf);
            if (slot >= 8 && slot < 136) { const size_t off = ((size_t)(b * 128 + slot - 8) * 2 + kvh) * 64 + hh * 32; float* kw = P.out + O_KWS + off; float* vw = P.out + O_VWS + off;
#pragma unroll
                for (int i = 0; i < 8; ++i) { *(f32x4*)(kw + 4 * i) = (f32x4){kf[4 * i], kf[4 * i + 1], kf[4 * i + 2], kf[4 * i + 3]}; *(f32x4*)(vw + 4 * i) = (f32x4){vf[4 * i], vf[4 * i + 1], vf[4 * i + 2], vf[4 * i + 3]}; } }
        }
    }
    __syncthreads();
    const int w = tid >> 6, lane = tid & 63, fr = lane & 15, g = lane >> 4;
    if (w < 4) { const int head = kvh * 4 + w; const int tok = MP + b * 8 + (fr & 7);
        bf16x8 qf[1][2];
        { const bf16_t* qp = mixin + (size_t)tok * NMIX + 1536 + head * 64 + g * 8;
            float f0[8], f1[8]; unpack8(*(const u32x4*)qp, f0); unpack8(*(const u32x4*)(qp + 32), f1);
            float ss = 0.f;
#pragma unroll
            for (int i = 0; i < 8; ++i) ss += f0[i] * f0[i] + f1[i] * f1[i];
            ss += __shfl_xor(ss, 16); ss += __shfl_xor(ss, 32);
            const float sc = (0.125f * LOG2E) / sqrtf(ss * (1.0f / 64.0f) + EPS);
#pragma unroll
            for (int i = 0; i < 8; ++i) { f0[i] = f0[i] * sc * P.in[12][g * 8 + i]; f1[i] = f1[i] * sc * P.in[12][32 + g * 8 + i]; }
            qf[0][0] = pack8((f32x4){f0[0], f0[1], f0[2], f0[3]}, (f32x4){f0[4], f0[5], f0[6], f0[7]}); qf[0][1] = pack8((f32x4){f1[0], f1[1], f1[2], f1[3]}, (f32x4){f1[4], f1[5], f1[6], f1[7]}); }
        f32x4 o[4][1]; float l[1];
        attn_core<1>(lds, qf, 0, 2, 0, 0, P.in[14][head] * LOG2E, o, l);
        float lt = l[0]; lt += __shfl_xor(lt, 16); lt += __shfl_xor(lt, 32); const float inv = 1.0f / lt;
        bf16_t* hcat = (bf16_t*)(P.ws + WS_HCAT);
        if (fr < 8) {
#pragma unroll
            for (int dt = 0; dt < 4; ++dt) { const f32x4 v = o[dt][0] * inv; u32x2 pk; pk.x = cvt_pk_bf16(v[0], v[1]); pk.y = cvt_pk_bf16(v[2], v[3]);
                *(u32x2*)(hcat + (size_t)tok * 1024 + 512 + head * 64 + dt * 16 + g * 4) = pk; } }
    }
    __syncthreads();
}
#define LAS __attribute__((address_space(3)))
#define XB_TMO      128
#define XB_XCNT(j)  (256  + 64 * (j))
#define XB_XSUB(j)  (1280 + 64 * (j))
#define XB_XGEN(j)  (2304 + 64 * (j))
#define XB_TOP      3328
#define XB_TOPGEN   3392
#define XCD_BAR_WORDS 3456
#define XB_SPIN_CAP (1u << 18)

__device__ __forceinline__ unsigned xb_ld(unsigned* p)              { return __hip_atomic_load(p, __ATOMIC_RELAXED, __HIP_MEMORY_SCOPE_AGENT); }
__device__ __forceinline__ unsigned xb_add(unsigned* p, unsigned v) { return __hip_atomic_fetch_add(p, v, __ATOMIC_RELAXED, __HIP_MEMORY_SCOPE_AGENT); }
__device__ __forceinline__ unsigned xb_xcc_id() { return (unsigned)__builtin_amdgcn_s_getreg((3 << 11) | 20) & 0xFu; }
#define XB_SPIN(cond, bar) do { unsigned _sp = 0; while (cond) { __builtin_amdgcn_s_sleep(1); \
    if ((++_sp & 255u) == 0u) { if (xb_ld(&(bar)[XB_TMO])) break; if (_sp > XB_SPIN_CAP) { atomicAdd(&(bar)[XB_TMO], 1u); break; } } } } while (0)

struct XcdBarrier {
    unsigned* bar; unsigned x;
    volatile LAS unsigned* st;
};

__device__ __forceinline__ XcdBarrier xcd_barrier_post(unsigned* bar, volatile LAS unsigned* st) {
    XcdBarrier b; b.bar = bar; b.x = xb_xcc_id(); b.st = st;
    if (threadIdx.x == 0) (void)xb_add(&bar[XB_XCNT(b.x)], 1u);
    return b;
}
__device__ __forceinline__ void xcd_barrier_complete(unsigned* bar, unsigned x, unsigned& nloc, unsigned& nx) {
    const unsigned G = gridDim.x * gridDim.y * gridDim.z;
    unsigned sum, cnt, mine, sp = 0u;
    for (;;) {
        sum = 0u; cnt = 0u; mine = 0u;
#pragma unroll
        for (unsigned j = 0; j < 16; ++j) { const unsigned c = xb_ld(&bar[XB_XCNT(j)]); sum += c; cnt += (c > 0u) ? 1u : 0u; mine = (j == x) ? c : mine; }
        if (sum == G) break;
        __builtin_amdgcn_s_sleep(1);
        if ((++sp & 255u) == 0u) { if (xb_ld(&bar[XB_TMO])) break; if (sp > XB_SPIN_CAP) { atomicAdd(&bar[XB_TMO], 1u); break; } }
    }
    nloc = mine > 0u ? mine : 1u; nx = cnt > 0u ? cnt : 1u;
}

__device__ __forceinline__ void xcd_barrier(const XcdBarrier& b) {
    asm volatile("s_waitcnt vmcnt(0)" ::: "memory");
    __syncthreads();
    if (threadIdx.x == 0) {
        unsigned* bar = b.bar;
        __builtin_amdgcn_s_waitcnt(0);
        unsigned nloc = b.st[0], nx = b.st[1];
        if (nloc == 0u) { xcd_barrier_complete(bar, b.x, nloc, nx); b.st[0] = nloc; b.st[1] = nx; }
        const unsigned old = xb_add(&bar[XB_XSUB(b.x)], 1u);
        const unsigned gen = old / nloc;
        if (old + 1u == (gen + 1u) * nloc) {
            __builtin_amdgcn_fence(__ATOMIC_RELEASE, "agent");
            asm volatile("s_waitcnt vmcnt(0)" ::: "memory");
            const unsigned og = xb_add(&bar[XB_TOP], 1u);
            const unsigned tg = og / nx;
            if (og + 1u == (tg + 1u) * nx) xb_add(&bar[XB_TOPGEN], 1u);
            else XB_SPIN(xb_ld(&bar[XB_TOPGEN]) == tg, bar);
            __builtin_amdgcn_fence(__ATOMIC_ACQUIRE, "agent");
            xb_add(&bar[XB_XGEN(b.x)], 1u);
            asm volatile("s_waitcnt vmcnt(0)" ::: "memory");
        } else {
            XB_SPIN(xb_ld(&bar[XB_XGEN(b.x)]) == gen, bar);
            __builtin_amdgcn_fence(__ATOMIC_ACQUIRE, "agent");
            asm volatile("s_waitcnt vmcnt(0)" ::: "memory");
        }
    }
    __syncthreads();
}
__device__ __forceinline__ void mlstm_b_item(const Params& P, int item, unsigned char* lds, int tid) {
    const int c = item & 127, h = (item >> 7) & 3, b = item >> 9, r0 = b * 8192 + c * 64;
    float* wl = (float*)lds; bf16_t* Kt = (bf16_t*)(lds + 256); bf16_t* Vt = (bf16_t*)(lds + 256 + 9216);
    const bf16_t* mixin = (const bf16_t*)(P.ws + WS_MIXIN);
    if (tid < 64) { const float iv = ((const float*)(P.ws + WS_GI))[(r0 + tid) * 4 + h], bb = ((const float*)(P.ws + WS_GB))[(r0 + tid) * 4 + h];
        const float A = __shfl(bb, 63), v = A - bb + iv, M = wave_max(v); wl[tid] = __expf(v - M) * 0.125f; }
    __syncthreads();
    { const int s = tid >> 3, ch = tid & 7; const bf16_t* rowp = mixin + (size_t)(r0 + s) * NMIX; const float ws_ = wl[s];
        float kf[8]; unpack8(*(const u32x4*)(rowp + 256 + h * 64 + ch * 8), kf);
#pragma unroll
        for (int i = 0; i < 8; ++i) Kt[(ch * 8 + i) * 72 + s] = f2bf(kf[i] * ws_);
        const u32x4 v0 = *(const u32x4*)(rowp + 512 + h * 128 + ch * 16), v1 = *(const u32x4*)(rowp + 512 + h * 128 + ch * 16 + 8);
        const unsigned vv[8] = {v0.x, v0.y, v0.z, v0.w, v1.x, v1.y, v1.z, v1.w};
#pragma unroll
        for (int i = 0; i < 8; ++i) { Vt[(ch * 16 + 2 * i) * 72 + s] = (bf16_t)(vv[i] & 0xffffu); Vt[(ch * 16 + 2 * i + 1) * 72 + s] = (bf16_t)(vv[i] >> 16); } }
    __syncthreads();
    { const int w = tid >> 6, lane = tid & 63, fr = lane & 15, g = lane >> 4, e0 = 16 * w;
        f32x4 acc[4];
#pragma unroll
        for (int dt = 0; dt < 4; ++dt) acc[dt] = (f32x4){0.f, 0.f, 0.f, 0.f};
#pragma unroll
        for (int kk = 0; kk < 2; ++kk) { const bf16x8 vf = *(const bf16x8*)(Vt + (e0 + fr) * 72 + g * 8 + kk * 32);
#pragma unroll
            for (int dt = 0; dt < 4; ++dt) { const bf16x8 kf = *(const bf16x8*)(Kt + (dt * 16 + fr) * 72 + g * 8 + kk * 32); acc[dt] = mfma16(kf, vf, acc[dt]); } }
        bf16_t* dct = (bf16_t*)((unsigned char*)P.out + OB_DCT) + ((size_t)item * 128 + e0 + fr) * 64;
#pragma unroll
        for (int dt = 0; dt < 4; ++dt) { u32x2 pk; pk.x = cvt_pk_bf16(acc[dt][0], acc[dt][1]); pk.y = cvt_pk_bf16(acc[dt][2], acc[dt][3]); *(u32x2*)(dct + dt * 16 + g * 4) = pk; } }
    if (tid < 64) { float sum = 0.f;
#pragma unroll 8
        for (int s = 0; s < 64; ++s) sum += bf2f(Kt[tid * 72 + s]);
        ((float*)(P.ws + WS_DN))[item * 64 + tid] = sum; }
    __syncthreads();
}
__device__ __forceinline__ void mlstm_scan(const Params& P, unsigned char* lds, int tid) {
    const int pair = blockIdx.x >> 3, sub = blockIdx.x & 7;
    float* ga = (float*)lds; float* ea = ga + 128; float* marr = ea + 128;
    if (tid == 0) { float m = 0.f; const float* sA = (const float*)(P.ws + WS_SUMA) + pair * 128; const float* sM = (const float*)(P.ws + WS_SUMM) + pair * 128;
        for (int c = 0; c < 128; ++c) { const float A = sA[c], Mv = sM[c], mn = fmaxf(A + m, Mv); ga[c] = __expf(A + m - mn); ea[c] = __expf(Mv - mn); m = mn; marr[c] = mn; } }
    __syncthreads();
    if (sub == 0) { if (tid < 128) ((float*)(P.ws + WS_MCH))[pair * 128 + tid] = marr[tid]; if (tid == 0) P.out[O_MP + pair] = marr[127]; }
#ifndef P3_SCANMASK
#define P3_SCANMASK 3
#endif
    if (P3_SCANMASK & 1) { const int idx2 = sub * 512 + tid; float C0 = 0.f, C1 = 0.f;
        const unsigned* src = (const unsigned*)((unsigned char*)P.out + OB_DCT) + (size_t)pair * 128 * 4096 + idx2; unsigned* dst = (unsigned*)((unsigned char*)P.out + OB_CPT) + (size_t)pair * 128 * 4096 + idx2;
#pragma unroll 1
        for (int c = 0; c < 128; c += 8) { unsigned v[8];
#pragma unroll
            for (int j = 0; j < 8; ++j) v[j] = src[(size_t)(c + j) * 4096];
#pragma unroll
            for (int j = 0; j < 8; ++j) { dst[(size_t)(c + j) * 4096] = cvt_pk_bf16(C0, C1); const float gg = ga[c + j], ee = ea[c + j]; C0 = gg * C0 + ee * bflo(v[j]); C1 = gg * C1 + ee * bfhi(v[j]); } }
        const int i0 = 2 * idx2, e = i0 >> 6, d = i0 & 63;
        P.out[O_CP + ((size_t)pair * 64 + d) * 128 + e] = C0; P.out[O_CP + ((size_t)pair * 64 + d + 1) * 128 + e] = C1; }
    if ((P3_SCANMASK & 2) && sub == 0 && tid < 64) { float nn = 0.f; const float* dn = (const float*)(P.ws + WS_DN) + (size_t)pair * 128 * 64 + tid; float* np = (float*)(P.ws + WS_NPREV) + (size_t)pair * 128 * 64 + tid;
        for (int c = 0; c < 128; ++c) { np[c * 64] = nn; nn = ga[c] * nn + ea[c] * dn[c * 64]; }
        P.out[O_NP + pair * 64 + tid] = nn; }
    __syncthreads();
}
__device__ __forceinline__ void mlstm_sample_item(const Params& P, int item, unsigned char* lds, int tid) {
    const int h = item & 3, b = item >> 2, r0 = MP + b * 8;
    float* q = (float*)lds; float* k = q + 512; float* v = k + 512; float* sw = v + 1024; float* sc = sw + 64; float* n0s = sc + 64; float* part = n0s + 64; float* red = part + 4096;
    const bf16_t* mixin = (const bf16_t*)(P.ws + WS_MIXIN);
    for (int idx = tid; idx < 2048; idx += 512) {
        if (idx < 512) { const int t = idx >> 6, d = idx & 63; q[idx] = bf2f(mixin[(size_t)(r0 + t) * NMIX + h * 64 + d]); }
        else if (idx < 1024) { const int i2 = idx - 512, t = i2 >> 6, d = i2 & 63; k[i2] = bf2f(mixin[(size_t)(r0 + t) * NMIX + 256 + h * 64 + d]) * 0.125f; }
        else { const int i3 = idx - 1024, t = i3 >> 7, e = i3 & 127; v[i3] = bf2f(mixin[(size_t)(r0 + t) * NMIX + 512 + h * 128 + e]); } }
    if (tid < 64) n0s[tid] = P.in[3][(b * 4 + h) * 64 + tid];
    if (tid < 8) { const float bb = ((const float*)(P.ws + WS_GB))[(r0 + tid) * 4 + h]; sc[tid] = bb; sc[8 + tid] = ((const float*)(P.ws + WS_GI))[(r0 + tid) * 4 + h] - bb; }
    __syncthreads();
    const float mprev = P.in[4][b * 4 + h];
    if (tid < 8) { float cm = mprev; for (int s = 0; s <= tid; ++s) cm = fmaxf(cm, sc[8 + s]); const float mt = sc[tid] + cm; sc[16 + tid] = mt; sc[24 + tid] = __expf(sc[tid] + mprev - mt); }
    __syncthreads();
    if (tid < 8) { const float b7 = sc[7], m7 = sc[23]; sc[32 + tid] = __expf(b7 + sc[8 + tid] - m7); if (tid == 0) { sc[48] = __expf(b7 + mprev - m7); P.out[O_MS + b * 4 + h] = m7; } }
    if (tid >= 64 && tid < 128) { const int i = tid - 64, t = i >> 3, s = i & 7; float dot = 0.f;
        for (int d = 0; d < 64; ++d) dot += q[t * 64 + d] * k[s * 64 + d];
        sw[i] = (s <= t) ? dot * __expf(sc[t] + sc[8 + s] - sc[16 + t]) : 0.f; }
    if (tid >= 128 && tid < 136) { const int t = tid - 128; float qn = 0.f; for (int d = 0; d < 64; ++d) qn += q[t * 64 + d] * n0s[d]; sc[40 + t] = qn; }
    __syncthreads();
    { const int e = tid & 127, dq = tid >> 7; const float gd = sc[48]; float num[8];
#pragma unroll
        for (int t = 0; t < 8; ++t) num[t] = 0.f;
#pragma unroll 4
        for (int dd = 0; dd < 16; ++dd) { const int d = dq * 16 + dd; const size_t ic = ((size_t)(b * 4 + h) * 64 + d) * 128 + e; const float c0 = P.in[2][ic];
            float upd = 0.f;
#pragma unroll
            for (int s = 0; s < 8; ++s) upd += sc[32 + s] * k[s * 64 + d] * v[s * 128 + e];
            P.out[O_CS + ic] = gd * c0 + upd;
#pragma unroll
            for (int t = 0; t < 8; ++t) num[t] += q[t * 64 + d] * c0; }
#pragma unroll
        for (int t = 0; t < 8; ++t) part[(dq * 8 + t) * 128 + e] = num[t]; }
    if (tid < 64) { float nn = sc[48] * n0s[tid];
#pragma unroll
        for (int s = 0; s < 8; ++s) nn += sc[32 + s] * k[s * 64 + tid];
        P.out[O_NS + (b * 4 + h) * 64 + tid] = nn; }
    __syncthreads();
    { const int e = tid & 127, tq = tid >> 7, w = tid >> 6, lane = tid & 63; float hv[2];
#pragma unroll
        for (int u = 0; u < 2; ++u) { const int t = tq * 2 + u; float inter = 0.f, intra = 0.f, rs = 0.f;
#pragma unroll
            for (int dq = 0; dq < 4; ++dq) inter += part[(dq * 8 + t) * 128 + e];
#pragma unroll
            for (int s = 0; s < 8; ++s) { intra += sw[t * 8 + s] * v[s * 128 + e]; rs += sw[t * 8 + s]; }
            const float wi = sc[24 + t], den = wi * sc[40 + t] + rs; hv[u] = (wi * inter + intra) / fmaxf(fabsf(den), __expf(-sc[16 + t])); }
        const float s0 = wave_sum(hv[0] * hv[0]), s1 = wave_sum(hv[1] * hv[1]);
        if (lane == 0) { red[w * 2] = s0; red[w * 2 + 1] = s1; }
        __syncthreads();
        bf16_t* hcat = (bf16_t*)(P.ws + WS_HCAT);
#pragma unroll
        for (int u = 0; u < 2; ++u) { const int t = tq * 2 + u; const float tot = red[(w & ~1) * 2 + u] + red[(w | 1) * 2 + u]; const float rstd = 1.0f / sqrtf(tot * (1.0f / 128.0f) + EPS);
            const float so = bf2f(mixin[(size_t)(r0 + t) * NMIX + 1024 + h * 128 + e]);
            hcat[(size_t)(r0 + t) * 1024 + h * 128 + e] = f2bf(hv[u] * rstd * P.in[11][h * 128 + e] * so); } }
    __syncthreads();
}
__device__ __forceinline__ void mlstm_d_item(const Params& P, int item, unsigned char* lds, int tid) {
    const int c = item & 127, h = (item >> 7) & 3, b = item >> 9, r0 = b * 8192 + c * 64, pair = item >> 7;
    float* lb = (float*)lds; float* lu = lb + 64; float* lm = lb + 128; float* misc = lb + 192; float* npv = lb + 256; float* red = lb + 320;
    bf16_t* Kn = (bf16_t*)(lds + 2048); bf16_t* Vt = (bf16_t*)(lds + 11264); bf16_t* Cs = (bf16_t*)(lds + 29696);
    const bf16_t* mixin = (const bf16_t*)(P.ws + WS_MIXIN);
    if (tid < 64) { const float iv = ((const float*)(P.ws + WS_GI))[(r0 + tid) * 4 + h], bb = ((const float*)(P.ws + WS_GB))[(r0 + tid) * 4 + h];
        const float mprev = c ? ((const float*)(P.ws + WS_MCH))[pair * 128 + c - 1] : 0.f;
        const float u = iv - bb; float cm = u;
#pragma unroll
        for (int o = 1; o < 64; o <<= 1) { const float nb = __shfl_up(cm, o); if (tid >= o) cm = fmaxf(cm, nb); }
        lb[tid] = bb; lu[tid] = u; lm[tid] = bb + fmaxf(mprev, cm); if (tid == 0) misc[0] = mprev;
        npv[tid] = ((const float*)(P.ws + WS_NPREV))[(size_t)item * 64 + tid]; }
    { const int s = tid >> 3, ch = tid & 7; const bf16_t* rowp = mixin + (size_t)(r0 + s) * NMIX;
        *(u32x4*)(Kn + s * 72 + ch * 8) = *(const u32x4*)(rowp + 256 + h * 64 + ch * 8);
        const u32x4 v0 = *(const u32x4*)(rowp + 512 + h * 128 + ch * 16), v1 = *(const u32x4*)(rowp + 512 + h * 128 + ch * 16 + 8);
        const unsigned vv[8] = {v0.x, v0.y, v0.z, v0.w, v1.x, v1.y, v1.z, v1.w};
#pragma unroll
        for (int i = 0; i < 8; ++i) { Vt[(ch * 16 + 2 * i) * 72 + s] = (bf16_t)(vv[i] & 0xffffu); Vt[(ch * 16 + 2 * i + 1) * 72 + s] = (bf16_t)(vv[i] >> 16); }
        const bf16_t* cp = (const bf16_t*)((unsigned char*)P.out + OB_CPT) + (size_t)item * 8192;
#pragma unroll
        for (int j = 0; j < 2; ++j) { const int idx = tid + 512 * j, e = idx >> 3, dch = idx & 7; *(u32x4*)(Cs + e * 72 + dch * 8) = *(const u32x4*)(cp + e * 64 + dch * 8); } }
    __syncthreads();
    const int w = tid >> 6, lane = tid & 63, fr = lane & 15, g = lane >> 4, tt = w & 3, eh = w >> 2, t = tt * 16 + fr, tok = r0 + t;
    bf16x8 qf[2]; float qv0[8], qv1[8];
    { const bf16_t* qp = mixin + (size_t)tok * NMIX + h * 64 + g * 8; const u32x4 a = *(const u32x4*)qp, bq = *(const u32x4*)(qp + 32);
        qf[0] = __builtin_bit_cast(bf16x8, a); qf[1] = __builtin_bit_cast(bf16x8, bq); unpack8(a, qv0); unpack8(bq, qv1); }
    f32x4 s[4];
#pragma unroll
    for (int st = 0; st < 4; ++st) { s[st] = (f32x4){0.f, 0.f, 0.f, 0.f};
#pragma unroll
        for (int kk = 0; kk < 2; ++kk) { const bf16x8 kf = *(const bf16x8*)(Kn + (st * 16 + fr) * 72 + g * 8 + kk * 32); s[st] = mfma16(kf, qf[kk], s[st]); } }
    const float bt = lb[t], mt = lm[t], mprev = misc[0];
    float rs = 0.f;
#pragma unroll
    for (int st = 0; st < 4; ++st)
#pragma unroll
        for (int r = 0; r < 4; ++r) { const int si = st * 16 + g * 4 + r; const float wv = (si <= t) ? __expf(bt + lu[si] - mt) : 0.f; const float val = s[st][r] * 0.125f * wv; s[st][r] = val; rs += val; }
    rs += __shfl_xor(rs, 16); rs += __shfl_xor(rs, 32);
    float qn = 0.f;
#pragma unroll
    for (int i = 0; i < 8; ++i) qn += qv0[i] * npv[g * 8 + i] + qv1[i] * npv[32 + g * 8 + i];
    qn += __shfl_xor(qn, 16); qn += __shfl_xor(qn, 32);
    const float wi = __expf(bt + mprev - mt), den = wi * qn + rs, inv = 1.0f / fmaxf(fabsf(den), __expf(-mt));
    bf16x8 pf[2]; pf[0] = pack8(s[0], s[1]); pf[1] = pack8(s[2], s[3]);
    f32x4 h1[4], h2[4];
#pragma unroll
    for (int et = 0; et < 4; ++et) { const int e = eh * 64 + et * 16 + fr; h1[et] = (f32x4){0.f, 0.f, 0.f, 0.f}; h2[et] = (f32x4){0.f, 0.f, 0.f, 0.f};
#pragma unroll
        for (int cc = 0; cc < 2; ++cc) { const bf16_t* vp = Vt + e * 72 + cc * 32 + g * 4; const u32x2 v0 = *(const u32x2*)vp, v1 = *(const u32x2*)(vp + 16);
            h2[et] = mfma16(__builtin_bit_cast(bf16x8, (u32x4){v0.x, v0.y, v1.x, v1.y}), pf[cc], h2[et]); }
#pragma unroll
        for (int kk = 0; kk < 2; ++kk) { const bf16x8 cf = *(const bf16x8*)(Cs + e * 72 + g * 8 + kk * 32); h1[et] = mfma16(cf, qf[kk], h1[et]); } }
    float ss = 0.f;
#pragma unroll
    for (int et = 0; et < 4; ++et)
#pragma unroll
        for (int r = 0; r < 4; ++r) { const float hv = (wi * h1[et][r] + h2[et][r]) * inv; h2[et][r] = hv; ss += hv * hv; }
    ss += __shfl_xor(ss, 16); ss += __shfl_xor(ss, 32);
    if (g == 0) red[w * 16 + fr] = ss;
    __syncthreads();
    { const float tot = red[w * 16 + fr] + red[(w ^ 4) * 16 + fr]; const float rstd = 1.0f / sqrtf(tot * (1.0f / 128.0f) + EPS);
        bf16_t* hcat = (bf16_t*)(P.ws + WS_HCAT);
#pragma unroll
        for (int et = 0; et < 4; ++et) { const int e0 = eh * 64 + et * 16 + g * 4; const u32x2 so = *(const u32x2*)(mixin + (size_t)tok * NMIX + 1024 + h * 128 + e0); const f32x4 mw = *(const f32x4*)(P.in[11] + h * 128 + e0);
            const float o0 = h2[et][0] * rstd * mw[0] * bflo(so.x), o1 = h2[et][1] * rstd * mw[1] * bfhi(so.x), o2 = h2[et][2] * rstd * mw[2] * bflo(so.y), o3 = h2[et][3] * rstd * mw[3] * bfhi(so.y);
            u32x2 pk; pk.x = cvt_pk_bf16(o0, o1); pk.y = cvt_pk_bf16(o2, o3); *(u32x2*)(hcat + (size_t)tok * 1024 + h * 128 + e0) = pk; } }
    __syncthreads();
}

#define GSYNC_F(grid) xcd_barrier(xbar)
__global__ void __launch_bounds__(512, 2) fwd_kernel(Params P) {
    extern __shared__ __attribute__((aligned(16))) unsigned char lds[];
    cg::grid_group grid = cg::this_grid();
    const int tid = threadIdx.x, G = gridDim.x;
    const int lo = P.ph_lo, hi = P.ph_hi;
    volatile LAS unsigned* xst = (volatile LAS unsigned*)((LAS unsigned char*)lds + 131072);
    if (tid < 4) xst[tid] = 0u;
    __syncthreads();
    XcdBarrier xbar = xcd_barrier_post((unsigned*)(P.ws + WS_BAR), xst);
#ifndef PHASE_MASK
#define PHASE_MASK 0x1ff
#endif
#define IN(k) (((PHASE_MASK >> (k)) & 1) && lo <= (k) && (k) < hi)
#define GSYNC() xcd_barrier(xbar)
#define SEAM(k) do { if (IN(k) && IN((k) + 1)) GSYNC(); } while (0)
#ifndef DUP_MASK
#define DUP_MASK 0
#endif
#ifndef EXTRA_SYNCS
#define EXTRA_SYNCS 0
#endif
#define REP(k) for (int rep_ = 0; rep_ <= ((DUP_MASK >> (k)) & 1); ++rep_) if (rep_ == 0 || (GSYNC_F(grid), true))
    bf16_t* HN = (bf16_t*)(P.ws + WS_HN); bf16_t* MIXIN = (bf16_t*)(P.ws + WS_MIXIN); bf16_t* GATES = (bf16_t*)(P.ws + WS_GATES); bf16_t* HCAT = (bf16_t*)(P.ws + WS_HCAT);
    PG8_LAS unsigned char* ldsa = (PG8_LAS unsigned char*)lds;
    if (IN(0)) REP(0) p0_prep(P, lds, tid, G);
    if (lo < 0) grid.sync();
    SEAM(0);
    for (int xs_ = 0; xs_ < EXTRA_SYNCS; ++xs_) GSYNC();
    if (IN(1)) REP(1) { pg8::Gemm g{HN, (const bf16_t*)(P.ws + WS_WIN), MT, NPROJ, 1024}; pg8::StaticOrder S; S.init(MT, NPROJ, G, (int)blockIdx.x);
        pg8::EpiProj E{MIXIN, GATES}; pg8::gemm_phase<pg8::EpiProj, pg8::StaticOrder, true, true>(ldsa, g, S, E); }
    SEAM(1);
    if (IN(2)) REP(2) {
        for (int it = blockIdx.x; it < 256 + 256 + 1024; it += G) {
            if (it < 256) attn_prompt_item(P, it, lds, tid);
            else if (it < 512) attn_sample_item(P, it - 256, lds, tid);
            else mlstm_b_item(P, it - 512, lds, tid);
        } }
    SEAM(2);
    if (IN(3)) REP(3) {
        const int nscan = (G > 64) ? 64 : 0;
#ifndef P3_VARIANT
#define P3_VARIANT 3
#endif
        if (nscan) { if ((int)blockIdx.x < 64) { if (P3_VARIANT & 1) mlstm_scan(P, lds, tid); } else if (P3_VARIANT & 2) for (int it = blockIdx.x - 64; it < 512; it += G - 64) mlstm_sample_item(P, it, lds, tid); }
        else { for (int it = blockIdx.x; it < 512; it += G) mlstm_sample_item(P, it, lds, tid); }
    }
    SEAM(3);
    if (IN(4)) REP(4) { for (int it = blockIdx.x; it < 1024; it += G) mlstm_d_item(P, it, lds, tid); }
    SEAM(4);
    if (IN(5)) REP(5) { pg8::Gemm g{HCAT, (const bf16_t*)(P.ws + WS_WAB), MT, 1024, 1024}; pg8::StaticOrder S; S.init(MT, 1024, G, (int)blockIdx.x);
        pg8::EpiMix E{GATES, MIXIN}; pg8::gemm_phase<pg8::EpiMix, pg8::StaticOrder, true, true>(ldsa, g, S, E); }
    SEAM(5);
    if (IN(6)) REP(6) { pg8::Gemm g{MIXIN, (const bf16_t*)(P.ws + WS_WOUT), MT, 1024, 1024}; pg8::StaticOrder S; S.init(MT, 1024, G, (int)blockIdx.x);
        pg8::EpiOut E{P.in[0], P.in[1], P.out, HN, P.in[18], (float*)(P.ws + WS_ROWSS)}; pg8::gemm_phase<pg8::EpiOut, pg8::StaticOrder, true, true>(ldsa, g, S, E); }
    SEAM(6);
    if (IN(7)) REP(7) { pg8::Gemm g{HN, (const bf16_t*)(P.ws + WS_WGU), MT, 2 * DFF, 1024}; pg8::StaticOrder S; S.init(MT, 2 * DFF, G, (int)blockIdx.x);
        pg8::EpiGU E{MIXIN, (const float*)(P.ws + WS_ROWSS)}; pg8::gemm_phase<pg8::EpiGU, pg8::StaticOrder, true, true>(ldsa, g, S, E); }
    SEAM(7);
    if (IN(8)) REP(8) { pg8::Gemm g{MIXIN, (const bf16_t*)(P.ws + WS_WD), MT, 1024, DFF}; pg8::StaticOrder S; S.init(MT, 1024, G, (int)blockIdx.x);
        pg8::EpiDown E{P.out}; pg8::gemm_phase<pg8::EpiDown, pg8::StaticOrder, true, true>(ldsa, g, S, E); }
#ifdef DBG_DUMP
    GSYNC();
    if (DBG_DUMP == 1) { for (size_t i = (size_t)blockIdx.x * 512 + tid; i < (size_t)MT * 1024; i += (size_t)G * 512) { const size_t r = i >> 10, c = i & 1023; P.out[i] = bf2f(MIXIN[r * NMIX + c]); } }
    if (DBG_DUMP == 2) { const bf16_t* d = (const bf16_t*)((unsigned char*)P.out + OB_DCT); for (size_t i = (size_t)blockIdx.x * 512 + tid; i < (size_t)1024 * 8192; i += (size_t)G * 512) P.out[i] = bf2f(d[i]); }
    if (DBG_DUMP == 4) { unsigned* d = (unsigned*)((unsigned char*)P.out + OB_DCT); for (size_t i = (size_t)blockIdx.x * 512 + tid; i < (size_t)1024 * 4096; i += (size_t)G * 512) { const unsigned w = __hip_atomic_load(d + i, __ATOMIC_RELAXED, __HIP_MEMORY_SCOPE_AGENT); P.out[2 * i] = bflo(w); P.out[2 * i + 1] = bfhi(w); } }
    if (DBG_DUMP == 5) { const float* a = (const float*)(P.ws + WS_GI); const float* bq = (const float*)(P.ws + WS_GB); for (int i = blockIdx.x * 512 + tid; i < MT * 4; i += G * 512) { P.out[i] = a[i]; P.out[MT * 4 + i] = bq[i]; } }
    if (DBG_DUMP == 6) { const float* a = (const float*)(P.ws + WS_DN); for (int i = blockIdx.x * 512 + tid; i < 65536; i += G * 512) P.out[i] = a[i]; }
    if (DBG_DUMP == 3) { for (size_t i = (size_t)blockIdx.x * 512 + tid; i < (size_t)MT * 1024; i += (size_t)G * 512) P.out[i] = bf2f(HN[i]); }
#endif
#undef IN
#undef SEAM
}

extern "C" void kernel_launch(void* const* d_in, const int* in_sizes, int n_in, void* d_out, int out_size, void* d_ws, size_t ws_size, hipStream_t stream) {
    static int grid = 0;
    if (grid == 0) {
        if (n_in != 22 || (size_t)out_size != O_END || ws_size < WS_END) { fprintf(stderr, "kernel_launch: unexpected shapes (n_in %d, out %d, ws %zu)\n", n_in, out_size, ws_size); grid = -1; return; }
        int dev = 0, cus = 0, per_cu = 0;
        (void)hipGetDevice(&dev); (void)hipDeviceGetAttribute(&cus, hipDeviceAttributeMultiprocessorCount, dev);
        if (hipFuncSetAttribute((const void*)fwd_kernel, hipFuncAttributeMaxDynamicSharedMemorySize, LDS_BYTES) != hipSuccess) { fprintf(stderr, "kernel_launch: hipFuncSetAttribute failed\n"); grid = -1; return; }
        if (hipOccupancyMaxActiveBlocksPerMultiprocessor(&per_cu, (const void*)fwd_kernel, 512, LDS_BYTES) != hipSuccess || per_cu < 1) { fprintf(stderr, "kernel_launch: occupancy query failed (%d)\n", per_cu); (void)hipGetLastError(); per_cu = 1; }
        grid = cus * 1;
        if (grid < 65) { fprintf(stderr, "kernel_launch: needs more than 64 CUs\n"); grid = -1; return; }
    }
    if (grid < 0) return;
    if (hipMemsetAsync((char*)d_ws + WS_BAR, 0, XCD_BAR_WORDS * 4, stream) != hipSuccess) { fprintf(stderr, "kernel_launch: memset failed\n"); return; }
    Params p{};
    for (int i = 0; i < 22; ++i) p.in[i] = (const float*)d_in[i];
    p.out = (float*)d_out; p.ws = (unsigned char*)d_ws;
    constexpr int NPH = 9;
    for (int li = 0; li < N_LAUNCHES; ++li) {
        p.ph_lo = (N_LAUNCHES == 1) ? 0 : li; p.ph_hi = (N_LAUNCHES == 1) ? NPH : li + 1;
        void* args[] = {&p};
        const hipError_t e = hipLaunchCooperativeKernel((const void*)fwd_kernel, dim3(grid), dim3(512), args, LDS_BYTES, stream);
        if (e != hipSuccess) { fprintf(stderr, "kernel_launch: cooperative launch %d failed: %s (grid %d)\n", li, hipGetErrorString(e), grid); break; }
    }
}
```

```cpp
#include <hip/hip_runtime.h>
#include <hip/hip_cooperative_groups.h>
#include <cstdio>
#include <cstdint>
namespace cg = cooperative_groups;

#ifndef N_LAUNCHES
#define N_LAUNCHES 1
#endif

namespace pg8 {
#define PG8_LAS __attribute__((address_space(3)))
typedef unsigned short bf16_t;
typedef short bf16x8 __attribute__((ext_vector_type(8)));
typedef float f32x4 __attribute__((ext_vector_type(4)));
typedef unsigned u32x4 __attribute__((ext_vector_type(4)));
constexpr int BM = 256, BK = 64, HALF = 128, HTB = HALF * BK * 2  , STAGE_BYTES = 8 * HTB, NXCD = 8, WGM = 8;

__host__ __device__ __forceinline__ int lds_byte(int r, int c) { const int st = (r >> 4) * 2 + (c >> 5), rr = r & 15, cc = c & 31, ob = rr * 64 + cc * 2; return st * 1024 + (ob ^ (((ob >> 9) & 1) << 5)); }
__host__ __device__ __forceinline__ void stage_rc(int b, int& R, int& C) { const int st = b / 1024, sb = b % 1024, swz = sb ^ (((sb >> 9) & 1) << 5); R = (st >> 1) * 16 + swz / 64; C = (st & 1) * 32 + (swz % 64) / 2; }
__host__ __device__ __forceinline__ int perm32(int rho) { const int n = rho >> 4, i = rho & 15; return 8 * (i >> 2) + 4 * n + (i & 3); }

struct Unit { int pm, pn; };
struct Gemm { const bf16_t* A; const bf16_t* Bt; int M, N, K; };

struct StaticOrder {
    int nM, nN, nwg, G, c;
    __host__ __device__ void init(int M, int N, int G_, int c_) { nM = M / BM; nN = N / BM; nwg = nM * nN; G = G_; c = c_; }
    __host__ __device__ bool next(int i, Unit& u) const {
        const long L = (long)i * G + c; if (L >= nwg) return false;
        int wgid = (int)L; { const int q = nwg / NXCD, r = nwg % NXCD, xcd = wgid % NXCD, off = wgid / NXCD; wgid = (xcd < r ? xcd * (q + 1) : r * (q + 1) + (xcd - r) * q) + off; }
        const int nig = WGM * nN, gid = wgid / nig, fm = gid * WGM, gsz = (nM - fm) < WGM ? (nM - fm) : WGM;
        u.pm = fm + ((wgid % nig) % gsz); u.pn = (wgid % nig) / gsz; return true;
    }
    __device__ __forceinline__ void a_ready(const Unit&) const {}
    __device__ __forceinline__ void done(const Unit&) const {}
};

__device__ __forceinline__ unsigned cvt_pk_bf16(float lo, float hi) { unsigned r; asm volatile("v_cvt_pk_bf16_f32 %0, %1, %2" : "=v"(r) : "v"(lo), "v"(hi)); return r; }
__device__ __forceinline__ float bflo(unsigned w) { return __builtin_bit_cast(float, w << 16); }
__device__ __forceinline__ float bfhi(unsigned w) { return __builtin_bit_cast(float, w & 0xffff0000u); }
__device__ __forceinline__ float sigm(float x) { return 1.0f / (1.0f + __expf(-x)); }

struct EpiProj {
    static constexpr bool PERM = true, AFTER_DRAIN = false, HAS_MID = false;
    bf16_t* mixin; bf16_t* gates;
    __device__ __forceinline__ void operator()(const f32x4 (&acc)[2][2][4][2], const Unit& u, int wr, int wc, int fr, int fq) const {
        const bool isg = u.pn >= 9; const bool sg = isg || u.pn == 4 || u.pn == 5;
        bf16_t* base = isg ? gates : mixin; const int ldc = isg ? 2048 : 2304;
        const int col0 = (isg ? (u.pn - 9) : u.pn) * 256 + wc * 32 + 8 * fq, row0 = u.pm * BM + wr * 64 + fr;
#pragma unroll
        for (int ai = 0; ai < 2; ++ai)
#pragma unroll
            for (int m = 0; m < 4; ++m) { bf16_t* rowp = base + (size_t)(row0 + ai * HALF + m * 16) * ldc + col0;
#pragma unroll
                for (int bj = 0; bj < 2; ++bj) { f32x4 v0 = acc[ai][bj][m][0], v1 = acc[ai][bj][m][1];
                    if (sg) {
#pragma unroll
                        for (int i = 0; i < 4; ++i) { v0[i] = sigm(v0[i]); v1[i] = sigm(v1[i]); } }
                    u32x4 w; w.x = cvt_pk_bf16(v0[0], v0[1]); w.y = cvt_pk_bf16(v0[2], v0[3]); w.z = cvt_pk_bf16(v1[0], v1[1]); w.w = cvt_pk_bf16(v1[2], v1[3]);
                    *(u32x4*)(rowp + bj * HALF) = w; } }
    }
};

struct EpiMix {
    static constexpr bool PERM = true, AFTER_DRAIN = false, HAS_MID = true;
    const bf16_t* gates; bf16_t* mix;
    __device__ __forceinline__ void mid(f32x4 (&acc)[2][2][4][2], const Unit& u, int wr, int wc, int fr, int fq) const {
        unsigned rb = (unsigned)(u.pm * BM + wr * 64 + fr) * 2048u + (unsigned)(u.pn * BM + wc * 32 + 8 * fq);
        asm volatile("" : "+v"(rb));
#pragma unroll
        for (int ai = 0; ai < 2; ++ai)
#pragma unroll
            for (int m = 0; m < 4; ++m) { const bf16_t* rowp = gates + (rb + (unsigned)((ai * HALF + m * 16) * 2048));
#pragma unroll
                for (int bj = 0; bj < 2; ++bj) { const u32x4 a = *(const u32x4*)(rowp + bj * HALF), b = *(const u32x4*)(rowp + 1024 + bj * HALF);
                    const float tiny = 8.673617379884035e-19f;
                    f32x4 r0, r1;
                    r0[0] = bflo(a.x) * __builtin_amdgcn_rcpf(fmaxf(bflo(b.x), tiny)); r0[1] = bfhi(a.x) * __builtin_amdgcn_rcpf(fmaxf(bfhi(b.x), tiny)); r0[2] = bflo(a.y) * __builtin_amdgcn_rcpf(fmaxf(bflo(b.y), tiny)); r0[3] = bfhi(a.y) * __builtin_amdgcn_rcpf(fmaxf(bfhi(b.y), tiny));
                    r1[0] = bflo(a.z) * __builtin_amdgcn_rcpf(fmaxf(bflo(b.z), tiny)); r1[1] = bfhi(a.z) * __builtin_amdgcn_rcpf(fmaxf(bfhi(b.z), tiny)); r1[2] = bflo(a.w) * __builtin_amdgcn_rcpf(fmaxf(bflo(b.w), tiny)); r1[3] = bfhi(a.w) * __builtin_amdgcn_rcpf(fmaxf(bfhi(b.w), tiny));
                    acc[ai][bj][m][0] = acc[ai][bj][m][0] * r0; acc[ai][bj][m][1] = acc[ai][bj][m][1] * r1; }
                if (m == 3) __builtin_amdgcn_sched_barrier(0); }
    }
    __device__ __forceinline__ void operator()(const f32x4 (&acc)[2][2][4][2], const Unit& u, int wr, int wc, int fr, int fq) const {
        const int col0 = u.pn * BM + wc * 32 + 8 * fq, row0 = u.pm * BM + wr * 64 + fr;
#pragma unroll
        for (int ai = 0; ai < 2; ++ai)
#pragma unroll
            for (int m = 0; m < 4; ++m) { const size_t row = (size_t)(row0 + ai * HALF + m * 16);
#pragma unroll
                for (int bj = 0; bj < 2; ++bj) { const u32x4 b = *(const u32x4*)(gates + row * 2048 + 1024 + col0 + bj * HALF);
                    const float tiny = 8.673617379884035e-19f;
                    f32x4 s0, s1;
                    s0[0] = fmaxf(bflo(b.x), tiny); s0[1] = fmaxf(bfhi(b.x), tiny); s0[2] = fmaxf(bflo(b.y), tiny); s0[3] = fmaxf(bfhi(b.y), tiny);
                    s1[0] = fmaxf(bflo(b.z), tiny); s1[1] = fmaxf(bfhi(b.z), tiny); s1[2] = fmaxf(bflo(b.w), tiny); s1[3] = fmaxf(bfhi(b.w), tiny);
                    const f32x4 v0 = acc[ai][bj][m][0] * s0, v1 = acc[ai][bj][m][1] * s1;
                    u32x4 w; w.x = cvt_pk_bf16(v0[0], v0[1]); w.y = cvt_pk_bf16(v0[2], v0[3]); w.z = cvt_pk_bf16(v1[0], v1[1]); w.w = cvt_pk_bf16(v1[2], v1[3]);
                    *(u32x4*)(mix + row * 1024 + col0 + bj * HALF) = w; } }
    }
};

struct EpiOut {
    static constexpr bool PERM = true, AFTER_DRAIN = false, HAS_MID = false;
    const float* xp; const float* xs; float* out; bf16_t* hfw; const float* nfw; float* rowss;
    __device__ __forceinline__ void operator()(const f32x4 (&acc)[2][2][4][2], const Unit& u, int wr, int wc, int fr, int fq) const {
        const int col0 = u.pn * BM + wc * 32 + 8 * fq, row0 = u.pm * BM + wr * 64 + fr;
#pragma unroll
        for (int ai = 0; ai < 2; ++ai)
#pragma unroll
            for (int m = 0; m < 4; ++m) { const int row = row0 + ai * HALF + m * 16;
                const float* xrow = row < 16384 ? xp + (size_t)row * 1024 : xs + (size_t)(row - 16384) * 1024;
                float ss = 0.f;
#pragma unroll
                for (int bj = 0; bj < 2; ++bj) { const int c = col0 + bj * HALF;
                    const f32x4 y0 = *(const f32x4*)(xrow + c) + acc[ai][bj][m][0], y1 = *(const f32x4*)(xrow + c + 4) + acc[ai][bj][m][1];
                    *(f32x4*)(out + (size_t)row * 1024 + c) = y0; *(f32x4*)(out + (size_t)row * 1024 + c + 4) = y1;
                    ss += (y0[0] * y0[0] + y0[1] * y0[1]) + (y0[2] * y0[2] + y0[3] * y0[3]) + (y1[0] * y1[0] + y1[1] * y1[1]) + (y1[2] * y1[2] + y1[3] * y1[3]);
                    const f32x4 w0 = *(const f32x4*)(nfw + c), w1 = *(const f32x4*)(nfw + c + 4);
                    const f32x4 z0 = y0 * w0, z1 = y1 * w1;
                    u32x4 w; w.x = cvt_pk_bf16(z0[0], z0[1]); w.y = cvt_pk_bf16(z0[2], z0[3]); w.z = cvt_pk_bf16(z1[0], z1[1]); w.w = cvt_pk_bf16(z1[2], z1[3]);
                    *(u32x4*)(hfw + (size_t)row * 1024 + c) = w; }
                ss += __shfl_xor(ss, 16); ss += __shfl_xor(ss, 32);
                if (fq == 0) unsafeAtomicAdd(rowss + row, ss); }
    }
};

struct EpiGU {
    static constexpr bool PERM = true, AFTER_DRAIN = false, HAS_MID = false;
    bf16_t* act; const float* rowss;
    __device__ __forceinline__ void operator()(const f32x4 (&acc)[2][2][4][2], const Unit& u, int wr, int wc, int fr, int fq) const {
        const int col0 = u.pn * HALF + wc * 32 + 8 * fq, row0 = u.pm * BM + wr * 64 + fr;
#pragma unroll
        for (int ai = 0; ai < 2; ++ai)
#pragma unroll
            for (int m = 0; m < 4; ++m) { const int row = row0 + ai * HALF + m * 16;
                const float rstd = __builtin_amdgcn_rsqf(rowss[row] * (1.0f / 1024.0f) + 1e-6f);
                float o[8];
#pragma unroll
                for (int n = 0; n < 2; ++n)
#pragma unroll
                    for (int j = 0; j < 4; ++j) { const float g = acc[ai][0][m][n][j] * rstd, up = acc[ai][1][m][n][j] * rstd; o[n * 4 + j] = g * sigm(g) * up; }
                u32x4 w; w.x = cvt_pk_bf16(o[0], o[1]); w.y = cvt_pk_bf16(o[2], o[3]); w.z = cvt_pk_bf16(o[4], o[5]); w.w = cvt_pk_bf16(o[6], o[7]);
                *(u32x4*)(act + (size_t)row * 2816 + col0) = w; }
    }
};

struct EpiDown {
    static constexpr bool PERM = true, AFTER_DRAIN = false, HAS_MID = false;
    float* out;
    __device__ __forceinline__ void operator()(const f32x4 (&acc)[2][2][4][2], const Unit& u, int wr, int wc, int fr, int fq) const {
        const int col0 = u.pn * BM + wc * 32 + 8 * fq, row0 = u.pm * BM + wr * 64 + fr;
#pragma unroll
        for (int ai = 0; ai < 2; ++ai)
#pragma unroll
            for (int m = 0; m < 4; ++m) { float* rowp = out + (size_t)(row0 + ai * HALF + m * 16) * 1024 + col0;
#pragma unroll
                for (int bj = 0; bj < 2; ++bj) { const f32x4 y0 = *(const f32x4*)(rowp + bj * HALF) + acc[ai][bj][m][0], y1 = *(const f32x4*)(rowp + bj * HALF + 4) + acc[ai][bj][m][1];
                    *(f32x4*)(rowp + bj * HALF) = y0; *(f32x4*)(rowp + bj * HALF + 4) = y1; } }
    }
};

template <class Epi, class Sched, bool ALIGN_EPI = false, bool SP2 = false>
__device__ __forceinline__ void gemm_phase(PG8_LAS unsigned char* lds, const Gemm g, const Sched& S, const Epi& E) {
    const int tid = threadIdx.x, wid = __builtin_amdgcn_readfirstlane(tid >> 6), lane = tid & 63, wr = wid >> 2, wc = wid & 3, fr = lane & 15, fq = lane >> 4;
    const int K = g.K, nt = K / BK;
    unsigned voffA[2], voffB[2];
#pragma unroll
    for (int i = 0; i < 2; ++i) { int R, C; stage_rc(tid * 16 + i * 8192, R, C); const int Rb = Epi::PERM ? ((R & ~31) + perm32(R & 31)) : R;
        voffA[i] = (unsigned)(R * K + C) * 2u; voffB[i] = (unsigned)(Rb * K + C) * 2u; }
    const size_t kstep = (size_t)(BK * 2);
    const size_t hstep = (size_t)HALF * K * 2;
    const size_t tstep = 2 * hstep;
    const unsigned ldsw = (unsigned)wid * 1024u;
    const int aoff = lds_byte(wr * 64 + fr, fq * 8), boff = lds_byte(wc * 32 + fr, fq * 8);
#define PG8_SA(b, h) (((b) * 2 + (h)) * HTB)
#define PG8_SB(b, h) ((4 + (b) * 2 + (h)) * HTB)
#define PG8_STAGE(bufoff, gbase, voff) do { _Pragma("unroll") for (int _i = 0; _i < 2; ++_i) \
        __builtin_amdgcn_global_load_lds((const unsigned*)((const char*)(gbase) + (voff)[_i]), (PG8_LAS unsigned*)(lds + (bufoff) + ldsw + _i * 8192), 16, 0, 0); } while (0)
#define PG8_LDA(dst, b, h) do { _Pragma("unroll") for (int m = 0; m < 4; ++m) _Pragma("unroll") for (int k = 0; k < 2; ++k) dst[m][k] = *(const PG8_LAS bf16x8*)(lds + PG8_SA(b, h) + aoff + m * 2048 + k * 1024); } while (0)
#define PG8_LDB(dst, b, h) do { _Pragma("unroll") for (int n = 0; n < 2; ++n) _Pragma("unroll") for (int k = 0; k < 2; ++k) dst[n][k] = *(const PG8_LAS bf16x8*)(lds + PG8_SB(b, h) + boff + n * 2048 + k * 1024); } while (0)
#define PG8_MMA(ai, bj, At, Bt) do { __builtin_amdgcn_s_setprio(1); _Pragma("unroll") for (int m = 0; m < 4; ++m) _Pragma("unroll") for (int n = 0; n < 2; ++n) _Pragma("unroll") for (int k = 0; k < 2; ++k) \
        acc[ai][bj][m][n] = __builtin_amdgcn_mfma_f32_16x16x32_bf16(Bt[n][k], At[m][k], acc[ai][bj][m][n], 0, 0, 0); __builtin_amdgcn_s_setprio(0); } while (0)
#define PG8_WAIT_V(n) asm volatile("s_waitcnt vmcnt(" #n ")" ::: "memory")
#define PG8_WAIT_L(n) asm volatile("s_waitcnt lgkmcnt(" #n ")" ::: "memory")
#define PG8_BAR __builtin_amdgcn_s_barrier()
#define PG8_SCHED __builtin_amdgcn_sched_barrier(0)
    Unit cur, nxt; int ui = 0;
    if (!S.next(0, cur)) return;
    f32x4 acc[2][2][4][2];
#pragma unroll
    for (int a = 0; a < 2; ++a)
#pragma unroll
        for (int b = 0; b < 2; ++b)
#pragma unroll
            for (int m = 0; m < 4; ++m)
#pragma unroll
                for (int n = 0; n < 2; ++n) acc[a][b][m][n] = (f32x4){0.f, 0.f, 0.f, 0.f};
    bf16x8 At[4][2], B0[2][2], B1[2][2];
    const char* cA = (const char*)g.A + (size_t)cur.pm * tstep; const char* cB = (const char*)g.Bt + (size_t)cur.pn * tstep;
    S.a_ready(cur);
    if constexpr (SP2) {
        PG8_STAGE(PG8_SB(0, 0), cB, voffB); PG8_STAGE(PG8_SB(0, 1), cB + hstep, voffB); PG8_STAGE(PG8_SA(0, 0), cA, voffA); PG8_STAGE(PG8_SA(0, 1), cA + hstep, voffA);
        if (wr == 1) PG8_BAR;
        PG8_WAIT_V(2); PG8_BAR;
        PG8_STAGE(PG8_SB(1, 0), cB + kstep, voffB); PG8_STAGE(PG8_SA(1, 0), cA + kstep, voffA); PG8_STAGE(PG8_SB(1, 1), cB + hstep + kstep, voffB);
        PG8_WAIT_V(6); PG8_BAR;
    } else {
        PG8_STAGE(PG8_SB(0, 0), cB, voffB); PG8_STAGE(PG8_SA(0, 0), cA, voffA); PG8_STAGE(PG8_SB(0, 1), cB + hstep, voffB); PG8_STAGE(PG8_SA(0, 1), cA + hstep, voffA);
        if (wr == 1) PG8_BAR;
        PG8_WAIT_V(4); PG8_BAR;
        PG8_STAGE(PG8_SB(1, 0), cB + kstep, voffB); PG8_STAGE(PG8_SA(1, 0), cA + kstep, voffA); PG8_STAGE(PG8_SB(1, 1), cB + hstep + kstep, voffB);
        PG8_WAIT_V(6); PG8_BAR;
    }
    for (;;) {
        const bool has_next = S.next(ui + 1, nxt);
        const char* nA = has_next ? (const char*)g.A + (size_t)nxt.pm * tstep : cA; const char* nB = has_next ? (const char*)g.Bt + (size_t)nxt.pn * tstep : cB;
        for (int t = 0; t < nt; t += 2) {
            if constexpr (Epi::HAS_MID) { if (t == (nt >> 1)) E.mid(acc, cur, wr, wc, fr, fq); }
            const bool last = (t == nt - 2);
            const char* a1 = cA + (size_t)(t + 1) * kstep;
            const char* a2 = last ? nA : cA + (size_t)(t + 2) * kstep; const char* b2 = last ? nB : cB + (size_t)(t + 2) * kstep;
            const char* a3 = a2 + kstep; const char* b3 = b2 + kstep;
            if (last && has_next) S.a_ready(nxt);
            if constexpr (SP2) {
            PG8_LDB(B0, 0, 0); PG8_LDB(B1, 0, 1); PG8_SCHED; PG8_LDA(At, 0, 0); PG8_STAGE(PG8_SA(1, 1), a1 + hstep, voffA);
            PG8_WAIT_V(8); PG8_WAIT_L(0); PG8_BAR; PG8_MMA(0, 0, At, B0); PG8_MMA(0, 1, At, B1); PG8_BAR; PG8_SCHED;
            PG8_LDA(At, 0, 1); PG8_STAGE(PG8_SB(0, 0), b2, voffB); PG8_STAGE(PG8_SB(0, 1), b2 + hstep, voffB); PG8_STAGE(PG8_SA(0, 0), a2, voffA);
            PG8_WAIT_V(8); PG8_WAIT_L(0); PG8_BAR; PG8_MMA(1, 0, At, B0); PG8_MMA(1, 1, At, B1); PG8_BAR; PG8_SCHED;
            PG8_LDB(B0, 1, 0); PG8_LDB(B1, 1, 1); PG8_SCHED; PG8_LDA(At, 1, 0); PG8_STAGE(PG8_SA(0, 1), a2 + hstep, voffA);
            PG8_WAIT_V(8); PG8_WAIT_L(0); PG8_BAR; PG8_MMA(0, 0, At, B0); PG8_MMA(0, 1, At, B1); PG8_BAR; PG8_SCHED;
            PG8_LDA(At, 1, 1); PG8_STAGE(PG8_SB(1, 0), b3, voffB); PG8_STAGE(PG8_SB(1, 1), b3 + hstep, voffB); PG8_STAGE(PG8_SA(1, 0), a3, voffA);
            PG8_WAIT_V(8); PG8_WAIT_L(0); PG8_BAR; PG8_MMA(1, 0, At, B0); PG8_MMA(1, 1, At, B1); PG8_BAR; PG8_SCHED;
            } else {
            PG8_LDB(B0, 0, 0); PG8_SCHED; PG8_LDA(At, 0, 0); PG8_STAGE(PG8_SA(1, 1), a1 + hstep, voffA);
            PG8_WAIT_L(8); PG8_BAR; PG8_WAIT_L(0); PG8_MMA(0, 0, At, B0); PG8_BAR; PG8_SCHED;
            PG8_LDB(B1, 0, 1); PG8_STAGE(PG8_SB(0, 0), b2, voffB);
            PG8_BAR; PG8_WAIT_L(0); PG8_MMA(0, 1, At, B1); PG8_BAR;
            PG8_LDA(At, 0, 1); PG8_STAGE(PG8_SA(0, 0), a2, voffA);
            PG8_BAR; PG8_WAIT_L(0); PG8_MMA(1, 0, At, B0); PG8_BAR; PG8_SCHED;
            PG8_STAGE(PG8_SB(0, 1), b2 + hstep, voffB);
            PG8_WAIT_V(6); PG8_BAR; PG8_MMA(1, 1, At, B1); PG8_BAR;
            PG8_LDB(B0, 1, 0); PG8_SCHED; PG8_LDA(At, 1, 0); PG8_STAGE(PG8_SA(0, 1), a2 + hstep, voffA);
            PG8_WAIT_L(8); PG8_BAR; PG8_WAIT_L(0); PG8_MMA(0, 0, At, B0); PG8_BAR; PG8_SCHED;
            PG8_LDB(B1, 1, 1); PG8_STAGE(PG8_SB(1, 0), b3, voffB);
            PG8_BAR; PG8_WAIT_L(0); PG8_MMA(0, 1, At, B1); PG8_BAR;
            PG8_LDA(At, 1, 1); PG8_STAGE(PG8_SA(1, 0), a3, voffA);
            PG8_BAR; PG8_WAIT_L(0); PG8_MMA(1, 0, At, B0); PG8_BAR; PG8_SCHED;
            PG8_STAGE(PG8_SB(1, 1), b3 + hstep, voffB);
            PG8_WAIT_V(6); PG8_BAR; PG8_MMA(1, 1, At, B1); PG8_BAR;
            }
        }
        if constexpr (ALIGN_EPI) { if (wr == 0) PG8_BAR; }
        if constexpr (!Epi::AFTER_DRAIN) { E(acc, cur, wr, wc, fr, fq); S.done(cur); }
        if (!has_next) break;
#pragma unroll
        for (int a = 0; a < 2; ++a)
#pragma unroll
            for (int b = 0; b < 2; ++b)
#pragma unroll
                for (int m = 0; m < 4; ++m)
#pragma unroll
                    for (int n = 0; n < 2; ++n) acc[a][b][m][n] = (f32x4){0.f, 0.f, 0.f, 0.f};
        cur = nxt; cA = nA; cB = nB; ++ui;
        if constexpr (ALIGN_EPI) { if (wr == 1) PG8_BAR; }
    }
    PG8_WAIT_V(0);
    if constexpr (!ALIGN_EPI) { if (wr == 0) PG8_BAR; }
    PG8_BAR;
    if constexpr (Epi::AFTER_DRAIN) { E.fused(acc, cur, wr, wc, fr, fq, lds, wid, lane); S.done(cur); }
#undef PG8_SA
#undef PG8_SB
#undef PG8_STAGE
#undef PG8_LDA
#undef PG8_LDB
#undef PG8_MMA
#undef PG8_WAIT_V
#undef PG8_WAIT_L
#undef PG8_BAR
#undef PG8_SCHED
}
}
using pg8::bf16_t; using pg8::bf16x8; using pg8::f32x4; using pg8::u32x4; using pg8::cvt_pk_bf16; using pg8::bflo; using pg8::bfhi; using pg8::sigm;
typedef unsigned u32x2 __attribute__((ext_vector_type(2)));
constexpr int MP = 16384, MS = 1024, MT = MP + MS;
constexpr int DIN = 4360, NPROJ = 4352, NMIX = 2304, NGATE = 2048, DFF = 2816;
constexpr float EPS = 1e-6f, LOG2E = 1.4426950408889634f;
constexpr size_t MiB = 1u << 20;
constexpr size_t WS_ROWSS = 0;
constexpr size_t WS_SUMA = 128 * 1024, WS_SUMM = WS_SUMA + 4096, WS_MCH = WS_SUMM + 4096;
constexpr size_t WS_GI = 256 * 1024, WS_GB = WS_GI + 320 * 1024;
constexpr size_t WS_DN = 1 * MiB, WS_NPREV = WS_DN + 256 * 1024;
constexpr size_t WS_WIN = 2 * MiB;
constexpr size_t WS_WAB = WS_WIN + 17 * MiB / 2;
constexpr size_t WS_WOUT = WS_WAB + 2 * MiB;
constexpr size_t WS_WGU = WS_WOUT + 2 * MiB;
constexpr size_t WS_WD = WS_WGU + 11 * MiB;
constexpr size_t WS_HN = WS_WD + 11 * MiB / 2;
constexpr size_t OB_DCT = 34 * MiB, OB_CPT = 50 * MiB;
constexpr size_t WS_MIXIN = WS_HN + 34 * MiB;
constexpr size_t WS_GATES = WS_MIXIN + 153 * MiB / 2;
constexpr size_t WS_HCAT = WS_GATES + 68 * MiB;
constexpr size_t WS_END = WS_HCAT + 34 * MiB;
static_assert(WS_END <= 256 * MiB, "workspace map");
constexpr size_t O_Y = 0, O_CP = (size_t)MT * 1024, O_NP = O_CP + 65536, O_MP = O_NP + 512, O_KWP = O_MP + 8, O_VWP = O_KWP + 32768,
                 O_CS = O_VWP + 32768, O_NS = O_CS + 4194304, O_MS = O_NS + 32768, O_KWS = O_MS + 512, O_VWS = O_KWS + 2097152, O_END = O_VWS + 2097152;
constexpr size_t WS_BAR = 1536 * 1024;
constexpr int LDS_BYTES = 131072 + 256;

struct Params { const float* in[22]; float* out; unsigned char* ws; int ph_lo, ph_hi; };

__device__ __forceinline__ float bf2f(bf16_t h) { return __builtin_bit_cast(float, (unsigned)h << 16); }
__device__ __forceinline__ bf16_t f2bf(float f) { return (bf16_t)(cvt_pk_bf16(f, 0.f) & 0xffffu); }
__device__ __forceinline__ float wave_sum(float v) {
#pragma unroll
    for (int o = 1; o < 64; o <<= 1) v += __shfl_xor(v, o);
    return v; }
__device__ __forceinline__ float wave_max(float v) {
#pragma unroll
    for (int o = 1; o < 64; o <<= 1) v = fmaxf(v, __shfl_xor(v, o));
    return v; }
__device__ __forceinline__ f32x4 mfma16(bf16x8 a, bf16x8 b, f32x4 c) { f32x4 d = __builtin_amdgcn_mfma_f32_16x16x32_bf16(a, b, c, 0, 0, 0); asm volatile("" : "+v"(d) : "v"(a), "v"(b)); return d; }
__device__ __forceinline__ bf16x8 pack8(const f32x4& a, const f32x4& b) { u32x4 t; t.x = cvt_pk_bf16(a[0], a[1]); t.y = cvt_pk_bf16(a[2], a[3]); t.z = cvt_pk_bf16(b[0], b[1]); t.w = cvt_pk_bf16(b[2], b[3]); return __builtin_bit_cast(bf16x8, t); }
__device__ __forceinline__ void unpack8(const u32x4& r, float* f) { f[0] = bflo(r.x); f[1] = bfhi(r.x); f[2] = bflo(r.y); f[3] = bfhi(r.y); f[4] = bflo(r.z); f[5] = bfhi(r.z); f[6] = bflo(r.w); f[7] = bfhi(r.w); }

__device__ __forceinline__ void p0_tokens(const Params& P, int u, unsigned char* lds, int tid) {
    const float* wg = (const float*)lds; float* graw = (float*)(lds + 32768);
    const float* nw = P.in[7];
    bf16_t* HN = (bf16_t*)(P.ws + WS_HN);
    const int lane = tid & 63, w = tid >> 6;
#pragma unroll 1
    for (int tt = 0; tt < 8; ++tt) {
        const int r = u * 64 + w * 8 + tt;
        const float* xrow = r < MP ? P.in[0] + (size_t)r * 1024 : P.in[1] + (size_t)(r - MP) * 1024;
        f32x4 xv[4]; float ss = 0.f;
#pragma unroll
        for (int j = 0; j < 4; ++j) { xv[j] = ((const f32x4*)xrow)[lane + 64 * j]; ss += (xv[j][0] * xv[j][0] + xv[j][1] * xv[j][1]) + (xv[j][2] * xv[j][2] + xv[j][3] * xv[j][3]); }
        ss = wave_sum(ss);
        const float rstd = 1.0f / sqrtf(ss * (1.0f / 1024.0f) + EPS);
        float g[8];
#pragma unroll
        for (int q = 0; q < 8; ++q) g[q] = 0.f;
#pragma unroll
        for (int j = 0; j < 4; ++j) { const int k0 = 4 * (lane + 64 * j);
            const f32x4 nv = *(const f32x4*)(nw + k0); const f32x4 hv = xv[j] * rstd * nv;
            u32x2 pk; pk.x = cvt_pk_bf16(hv[0], hv[1]); pk.y = cvt_pk_bf16(hv[2], hv[3]);
            *(u32x2*)(HN + (size_t)r * 1024 + k0) = pk;
#pragma unroll
            for (int q = 0; q < 8; ++q) { const f32x4 wv = *(const f32x4*)(wg + q * 1024 + k0); g[q] += (xv[j][0] * wv[0] + xv[j][1] * wv[1]) + (xv[j][2] * wv[2] + xv[j][3] * wv[3]); } }
#pragma unroll
        for (int q = 0; q < 8; ++q) g[q] = wave_sum(g[q]);
        if (lane == 0) {
#pragma unroll
            for (int q = 0; q < 8; ++q) graw[(w * 8 + tt) * 8 + q] = g[q] * rstd; }
    }
    __syncthreads();
    if (w == 0) {
        const bool prompt = u < 256; const int r = u * 64 + lane; const int pos = prompt ? lane : (lane & 7);
        float* gi = (float*)(P.ws + WS_GI); float* gb = (float*)(P.ws + WS_GB);
#pragma unroll
        for (int h = 0; h < 4; ++h) {
            const float iv = graw[lane * 8 + h] + P.in[9][h], fv = graw[lane * 8 + 4 + h] + P.in[10][h];
            float b = fminf(fv, 0.f) - log1pf(expf(-fabsf(fv)));
#pragma unroll
            for (int o = 1; o < 64; o <<= 1) { const float nb = __shfl_up(b, o); if (pos >= o) b += nb; }
            gi[r * 4 + h] = iv; gb[r * 4 + h] = b;
            if (prompt) { const float A = __shfl(b, 63); const float Mv = wave_max(A - b + iv);
                if (lane == 0) { const int idx = ((u >> 7) * 4 + h) * 128 + (u & 127); ((float*)(P.ws + WS_SUMA))[idx] = A; ((float*)(P.ws + WS_SUMM))[idx] = Mv; } }
        }
    }
    __syncthreads();
}
__device__ __forceinline__ void p0_wtile(const float* src, int ldsrc, int k0, int c0, bf16_t* dst, int lddst, int n0, int k0d, unsigned char* lds, int tid) {
    float* tile = (float*)(lds + 40960);
#pragma unroll
    for (int p = 0; p < 2; ++p) { const int i = (tid >> 4) + 32 * p, j4 = (tid & 15) * 4;
        const f32x4 v = *(const f32x4*)(src + (size_t)(k0 + i) * ldsrc + c0 + j4);
        tile[i * 65 + j4] = v[0]; tile[i * 65 + j4 + 1] = v[1]; tile[i * 65 + j4 + 2] = v[2]; tile[i * 65 + j4 + 3] = v[3]; }
    __syncthreads();
    { const int n = tid >> 3, kc = (tid & 7) * 8; const float* s = tile + kc * 65 + n;
        u32x4 o; o.x = cvt_pk_bf16(s[0], s[65]); o.y = cvt_pk_bf16(s[2 * 65], s[3 * 65]); o.z = cvt_pk_bf16(s[4 * 65], s[5 * 65]); o.w = cvt_pk_bf16(s[6 * 65], s[7 * 65]);
        *(u32x4*)(dst + (size_t)(n0 + n) * lddst + k0d + kc) = o; }
    __syncthreads();
}
__device__ __forceinline__ void p0_prep(const Params& P, unsigned char* lds, int tid, int G) {
    float* rowss = (float*)(P.ws + WS_ROWSS);
    for (int i = blockIdx.x * 512 + tid; i < MT; i += G * 512) rowss[i] = 0.f;
    { float* wg = (float*)lds; const float* w_in = P.in[8]; const float* nw = P.in[7];
        for (int idx = tid; idx < 8192; idx += 512) { const int k = idx >> 3, q = idx & 7; wg[q * 1024 + k] = w_in[(size_t)k * DIN + 1536 + q] * nw[k]; } }
    __syncthreads();
    for (int u = blockIdx.x; u < MT / 64; u += G) p0_tokens(P, u, lds, tid);
    constexpr int NT_IN = 68 * 16, NT_AB = 256, NT_OUT = 256, NT_GU = 1408, NT_D = 704, NT_ALL = NT_IN + NT_AB + NT_OUT + NT_GU + NT_D;
    for (int it = (G - 1 - (int)blockIdx.x); it < NT_ALL; it += G) {
        int r = it;
        if (r < NT_IN) { const int nt = r >> 4, kt = r & 15, c0 = nt * 64; p0_wtile(P.in[8], DIN, kt * 64, c0 < 1536 ? c0 : c0 + 8, (bf16_t*)(P.ws + WS_WIN), 1024, c0, kt * 64, lds, tid); continue; } r -= NT_IN;
        if (r < NT_AB) { const int which = r >> 7, rr = r & 127, nt = rr >> 3, kt = rr & 7; p0_wtile(which ? P.in[16] : P.in[15], 1024, kt * 64, nt * 64, (bf16_t*)(P.ws + WS_WAB), 1024, nt * 64, which * 512 + kt * 64, lds, tid); continue; } r -= NT_AB;
        if (r < NT_OUT) { const int nt = r >> 4, kt = r & 15; p0_wtile(P.in[17], 1024, kt * 64, nt * 64, (bf16_t*)(P.ws + WS_WOUT), 1024, nt * 64, kt * 64, lds, tid); continue; } r -= NT_OUT;
        if (r < NT_GU) { const int which = r / 704, rr = r % 704, jt = rr >> 4, kt = rr & 15, j0 = jt * 64;
            p0_wtile(which ? P.in[20] : P.in[19], DFF, kt * 64, j0, (bf16_t*)(P.ws + WS_WGU), 1024, 256 * (j0 >> 7) + (j0 & 127) + which * 128, kt * 64, lds, tid); continue; } r -= NT_GU;
        { const int nt = r / 44, kt = r % 44; p0_wtile(P.in[21], 1024, kt * 64, nt * 64, (bf16_t*)(P.ws + WS_WD), DFF, nt * 64, kt * 64, lds, tid); }
    }
}

template <int NQT>
__device__ __forceinline__ void attn_core(const unsigned char* lds, const bf16x8 (&qf)[NQT][2], int kt_lo, int kt_hi, int qbase, int jmin, float sink2, f32x4 (&o)[4][NQT], float (&l)[NQT]) {
    const bf16_t* Ks = (const bf16_t*)lds; const bf16_t* Vt = (const bf16_t*)(lds + 36864);
    const int lane = threadIdx.x & 63, fr = lane & 15, g = lane >> 4;
    float mrun[NQT];
#pragma unroll
    for (int qt = 0; qt < NQT; ++qt) { mrun[qt] = sink2; l[qt] = (g == 0) ? 1.f : 0.f;
#pragma unroll
        for (int dt = 0; dt < 4; ++dt) o[dt][qt] = (f32x4){0.f, 0.f, 0.f, 0.f}; }
#pragma unroll 1
    for (int kt = kt_lo; kt <= kt_hi; ++kt) {
        f32x4 s[4][NQT];
#pragma unroll
        for (int ks = 0; ks < 4; ++ks)
#pragma unroll
            for (int qt = 0; qt < NQT; ++qt) s[ks][qt] = (f32x4){0.f, 0.f, 0.f, 0.f};
#pragma unroll
        for (int ks = 0; ks < 4; ++ks)
#pragma unroll
            for (int kk = 0; kk < 2; ++kk) { const bf16x8 kf = *(const bf16x8*)(Ks + (kt * 64 + ks * 16 + fr) * 72 + g * 8 + kk * 32);
#pragma unroll
                for (int qt = 0; qt < NQT; ++qt) s[ks][qt] = mfma16(kf, qf[qt][kk], s[ks][qt]); }
#pragma unroll
        for (int qt = 0; qt < NQT; ++qt) { const int qi = qbase + 16 * qt + fr; float mx = -1e30f;
#pragma unroll
            for (int ks = 0; ks < 4; ++ks)
#pragma unroll
                for (int r = 0; r < 4; ++r) { const int j = kt * 64 + ks * 16 + g * 4 + r; const bool ok = (j > qi) && (j <= qi + 128) && (j >= jmin);
                    const float v = ok ? s[ks][qt][r] : -1e30f; s[ks][qt][r] = v; mx = fmaxf(mx, v); }
            mx = fmaxf(mx, __shfl_xor(mx, 16)); mx = fmaxf(mx, __shfl_xor(mx, 32));
            const float mnew = fmaxf(mrun[qt], mx), alpha = __builtin_amdgcn_exp2f(mrun[qt] - mnew); mrun[qt] = mnew;
            float ps = 0.f;
#pragma unroll
            for (int ks = 0; ks < 4; ++ks)
#pragma unroll
                for (int r = 0; r < 4; ++r) { const float p = __builtin_amdgcn_exp2f(s[ks][qt][r] - mnew); s[ks][qt][r] = p; ps += p; }
            l[qt] = l[qt] * alpha + ps;
#pragma unroll
            for (int dt = 0; dt < 4; ++dt) o[dt][qt] = o[dt][qt] * alpha; }
#pragma unroll
        for (int c = 0; c < 2; ++c) { bf16x8 pf[NQT];
#pragma unroll
            for (int qt = 0; qt < NQT; ++qt) pf[qt] = pack8(s[2 * c][qt], s[2 * c + 1][qt]);
#pragma unroll
            for (int dt = 0; dt < 4; ++dt) { const bf16_t* vp = Vt + (dt * 16 + fr) * 264 + kt * 64 + c * 32 + g * 4;
                const u32x2 v0 = *(const u32x2*)vp, v1 = *(const u32x2*)(vp + 16);
                const bf16x8 vf = __builtin_bit_cast(bf16x8, (u32x4){v0.x, v0.y, v1.x, v1.y});
#pragma unroll
                for (int qt = 0; qt < NQT; ++qt) o[dt][qt] = mfma16(vf, pf[qt], o[dt][qt]); } }
    }
}
__device__ __forceinline__ void attn_put(unsigned char* lds, int slot, int hh, const float* kf, const float* vf) {
    bf16_t* Ks = (bf16_t*)lds; bf16_t* Vt = (bf16_t*)(lds + 36864);
#pragma unroll
    for (int i = 0; i < 4; ++i) { u32x4 w; w.x = cvt_pk_bf16(kf[8 * i], kf[8 * i + 1]); w.y = cvt_pk_bf16(kf[8 * i + 2], kf[8 * i + 3]); w.z = cvt_pk_bf16(kf[8 * i + 4], kf[8 * i + 5]); w.w = cvt_pk_bf16(kf[8 * i + 6], kf[8 * i + 7]);
        *(u32x4*)(Ks + slot * 72 + hh * 32 + 8 * i) = w; }
#pragma unroll
    for (int i = 0; i < 32; ++i) Vt[(hh * 32 + i) * 264 + slot] = f2bf(vf[i]);
}
__device__ __forceinline__ void attn_prompt_item(const Params& P, int item, unsigned char* lds, int tid) {
    const int kvh = item & 1, n = (item >> 1) & 63, b = item >> 7;
    const bf16_t* mixin = (const bf16_t*)(P.ws + WS_MIXIN);
    { const int slot = tid >> 1, hh = tid & 1, tokb = n * 128 - 128 + slot;
        float kf[32], vf[32];
        if (tokb >= 0) { const bf16_t* rowp = mixin + (size_t)(b * 8192 + tokb) * NMIX + 2048 + kvh * 64 + hh * 32;
#pragma unroll
            for (int i = 0; i < 4; ++i) { const u32x4 kr = *(const u32x4*)(rowp + 8 * i), vr = *(const u32x4*)(rowp + 128 + 8 * i); unpack8(kr, kf + 8 * i); unpack8(vr, vf + 8 * i); } }
        else {
#pragma unroll
            for (int i = 0; i < 32; ++i) { kf[i] = 0.f; vf[i] = 0.f; } }
        float ss = 0.f;
#pragma unroll
        for (int i = 0; i < 32; ++i) ss += kf[i] * kf[i];
        ss += __shfl_xor(ss, 1);
        const float rstd = 1.0f / sqrtf(ss * (1.0f / 64.0f) + EPS);
#pragma unroll
        for (int i = 0; i < 32; ++i) kf[i] = kf[i] * rstd * P.in[13][hh * 32 + i];
        attn_put(lds, slot, hh, kf, vf);
        if (n == 63 && slot >= 128) { float* kw = P.out + O_KWP + ((size_t)(b * 128 + slot - 128) * 2 + kvh) * 64 + hh * 32; float* vw = P.out + O_VWP + ((size_t)(b * 128 + slot - 128) * 2 + kvh) * 64 + hh * 32;
#pragma unroll
            for (int i = 0; i < 8; ++i) { *(f32x4*)(kw + 4 * i) = (f32x4){kf[4 * i], kf[4 * i + 1], kf[4 * i + 2], kf[4 * i + 3]}; *(f32x4*)(vw + 4 * i) = (f32x4){vf[4 * i], vf[4 * i + 1], vf[4 * i + 2], vf[4 * i + 3]}; } }
    }
    __syncthreads();
    const int w = tid >> 6, lane = tid & 63, fr = lane & 15, g = lane >> 4, gq = w >> 1, half = w & 1, head = kvh * 4 + gq;
    bf16_t* hcat = (bf16_t*)(P.ws + WS_HCAT);
#pragma unroll 1
    for (int qh = 0; qh < 2; ++qh) {
    bf16x8 qf[2][2];
#pragma unroll
    for (int qt = 0; qt < 2; ++qt) { const int tok = b * 8192 + n * 128 + half * 64 + qh * 32 + qt * 16 + fr; const bf16_t* qp = mixin + (size_t)tok * NMIX + 1536 + head * 64 + g * 8;
        float f0[8], f1[8]; unpack8(*(const u32x4*)qp, f0); unpack8(*(const u32x4*)(qp + 32), f1);
        float ss = 0.f;
#pragma unroll
        for (int i = 0; i < 8; ++i) ss += f0[i] * f0[i] + f1[i] * f1[i];
        ss += __shfl_xor(ss, 16); ss += __shfl_xor(ss, 32);
        const float sc = (0.125f * LOG2E) / sqrtf(ss * (1.0f / 64.0f) + EPS);
#pragma unroll
        for (int i = 0; i < 8; ++i) { f0[i] = f0[i] * sc * P.in[12][g * 8 + i]; f1[i] = f1[i] * sc * P.in[12][32 + g * 8 + i]; }
        qf[qt][0] = pack8((f32x4){f0[0], f0[1], f0[2], f0[3]}, (f32x4){f0[4], f0[5], f0[6], f0[7]}); qf[qt][1] = pack8((f32x4){f1[0], f1[1], f1[2], f1[3]}, (f32x4){f1[4], f1[5], f1[6], f1[7]}); }
    f32x4 o[4][2]; float l[2];
    attn_core<2>(lds, qf, half, half + 2, half * 64 + qh * 32, n == 0 ? 128 : 0, P.in[14][head] * LOG2E, o, l);
#pragma unroll
    for (int qt = 0; qt < 2; ++qt) { float lt = l[qt]; lt += __shfl_xor(lt, 16); lt += __shfl_xor(lt, 32); const float inv = 1.0f / lt;
        const int tok = b * 8192 + n * 128 + half * 64 + qh * 32 + qt * 16 + fr;
#pragma unroll
        for (int dt = 0; dt < 4; ++dt) { const f32x4 v = o[dt][qt] * inv; u32x2 pk; pk.x = cvt_pk_bf16(v[0], v[1]); pk.y = cvt_pk_bf16(v[2], v[3]);
            *(u32x2*)(hcat + (size_t)tok * 1024 + 512 + head * 64 + dt * 16 + g * 4) = pk; } }
    }
    __syncthreads();
}
__device__ __forceinline__ void attn_sample_item(const Params& P, int item, unsigned char* lds, int tid) {
    const int kvh = item & 1, b = item >> 1;
    const bf16_t* mixin = (const bf16_t*)(P.ws + WS_MIXIN);
    { const int slot = tid >> 1, hh = tid & 1;
        if (slot < 192) { float kf[32], vf[32];
            if (slot < 128) { const size_t off = ((size_t)(b * 128 + slot) * 2 + kvh) * 64 + hh * 32; const float* kp = P.in[5] + off; const float* vp = P.in[6] + off;
#pragma unroll
                for (int i = 0; i < 8; ++i) { const f32x4 a = *(const f32x4*)(kp + 4 * i), c = *(const f32x4*)(vp + 4 * i);
                    kf[4 * i] = a[0]; kf[4 * i + 1] = a[1]; kf[4 * i + 2] = a[2]; kf[4 * i + 3] = a[3]; vf[4 * i] = c[0]; vf[4 * i + 1] = c[1]; vf[4 * i + 2] = c[2]; vf[4 * i + 3] = c[3]; } }
            else if (slot < 136) { const bf16_t* rowp = mixin + (size_t)(MP + b * 8 + slot - 128) * NMIX + 2048 + kvh * 64 + hh * 32;
#pragma unroll
                for (int i = 0; i < 4; ++i) { const u32x4 kr = *(const u32x4*)(rowp + 8 * i), vr = *(const u32x4*)(rowp + 128 + 8 * i); unpack8(kr, kf + 8 * i); unpack8(vr, vf + 8 * i); }
                float ss = 0.f;
#pragma unroll
                for (int i = 0; i < 32; ++i) ss += kf[i] * kf[i];
                ss += __shfl_xor(ss, 1);
                const float rstd = 1.0f / sqrtf(ss * (1.0f / 64.0f) + EPS);
#pragma unroll
                for (int i = 0; i < 32; ++i) kf[i] = kf[i] * rstd * P.in[13][hh * 32 + i]; }
            else {
#pragma unroll
                for (int i = 0; i < 32; ++i) { kf[i] = 0.f; vf[i] = 0.f; } }
            attn_put(lds, slot, hh, kf, vf);
            if (slot >= 8 && slot < 136) { const size_t off = ((size_t)(b * 128 + slot - 8) * 2 + kvh) * 64 + hh * 32; float* kw = P.out + O_KWS + off; float* vw = P.out + O_VWS + off;
#pragma unroll
                for (int i = 0; i < 8; ++i) { *(f32x4*)(kw + 4 * i) = (f32x4){kf[4 * i], kf[4 * i + 1], kf[4 * i + 2], kf[4 * i + 3]}; *(f32x4*)(vw + 4 * i) = (f32x4){vf[4 * i], vf[4 * i + 1], vf[4 * i + 2], vf[4 * i + 3]}; } }
        }
    }
    __syncthreads();
    const int w = tid >> 6, lane = tid & 63, fr = lane & 15, g = lane >> 4;
    if (w < 4) { const int head = kvh * 4 + w; const int tok = MP + b * 8 + (fr & 7);
        bf16x8 qf[1][2];
        { const bf16_t* qp = mixin + (size_t)tok * NMIX + 1536 + head * 64 + g * 8;
            float f0[8], f1[8]; unpack8(*(const u32x4*)qp, f0); unpack8(*(const u32x4*)(qp + 32), f1);
            float ss = 0.f;
#pragma unroll
            for (int i = 0; i < 8; ++i) ss += f0[i] * f0[i] + f1[i] * f1[i];
            ss += __shfl_xor(ss, 16); ss += __shfl_xor(ss, 32);
            const float sc = (0.125f * LOG2E) / sqrtf(ss * (1.0f / 64.0f) + EPS);
#pragma unroll
            for (int i = 0; i < 8; ++i) { f0[i] = f0[i] * sc * P.in[12][g * 8 + i]; f1[i] = f1[i] * sc * P.in[12][32 + g * 8 + i]; }
            qf[0][0] = pack8((f32x4){f0[0], f0[1], f0[2], f0[3]}, (f32x4){f0[4], f0[5], f0[6], f0[7]}); qf[0][1] = pack8((f32x4){f1[0], f1[1], f1[2], f1[3]}, (f32x4){f1[4], f1[5], f1[6], f1[7]}); }
        f32x4 o[4][1]; float l[1];
        attn_core<1>(lds, qf, 0, 2, 0, 0, P.in[14][head] * LOG2E, o, l);
        float lt = l[0]; lt += __shfl_xor(lt, 16); lt += __shfl_xor(lt, 32); const float inv = 1.0f / lt;
        bf16_t* hcat = (bf16_t*)(P.ws + WS_HCAT);
        if (fr < 8) {
#pragma unroll
            for (int dt = 0; dt < 4; ++dt) { const f32x4 v = o[dt][0] * inv; u32x2 pk; pk.x = cvt_pk_bf16(v[0], v[1]); pk.y = cvt_pk_bf16(v[2], v[3]);
                *(u32x2*)(hcat + (size_t)tok * 1024 + 512 + head * 64 + dt * 16 + g * 4) = pk; } }
    }
    __syncthreads();
}
#define LAS __attribute__((address_space(3)))
#define XB_TMO      128
#define XB_XCNT(j)  (256  + 64 * (j))
#define XB_XSUB(j)  (1280 + 64 * (j))
#define XB_XGEN(j)  (2304 + 64 * (j))
#define XB_TOP      3328
#define XB_TOPGEN   3392
#define XCD_BAR_WORDS 3456
#define XB_SPIN_CAP (1u << 18)

__device__ __forceinline__ unsigned xb_ld(unsigned* p)              { return __hip_atomic_load(p, __ATOMIC_RELAXED, __HIP_MEMORY_SCOPE_AGENT); }
__device__ __forceinline__ unsigned xb_add(unsigned* p, unsigned v) { return __hip_atomic_fetch_add(p, v, __ATOMIC_RELAXED, __HIP_MEMORY_SCOPE_AGENT); }
__device__ __forceinline__ unsigned xb_xcc_id() { return (unsigned)__builtin_amdgcn_s_getreg((3 << 11) | 20) & 0xFu; }
#define XB_SPIN(cond, bar) do { unsigned _sp = 0; while (cond) { __builtin_amdgcn_s_sleep(1); \
    if ((++_sp & 255u) == 0u) { if (xb_ld(&(bar)[XB_TMO])) break; if (_sp > XB_SPIN_CAP) { atomicAdd(&(bar)[XB_TMO], 1u); break; } } } } while (0)

struct XcdBarrier {
    unsigned* bar; unsigned x;
    volatile LAS unsigned* st;
};

__device__ __forceinline__ XcdBarrier xcd_barrier_post(unsigned* bar, volatile LAS unsigned* st) {
    XcdBarrier b; b.bar = bar; b.x = xb_xcc_id(); b.st = st;
    if (threadIdx.x == 0) (void)xb_add(&bar[XB_XCNT(b.x)], 1u);
    return b;
}
__device__ __forceinline__ void xcd_barrier_complete(unsigned* bar, unsigned x, unsigned& nloc, unsigned& nx) {
    const unsigned G = gridDim.x * gridDim.y * gridDim.z;
    unsigned sum, cnt, mine, sp = 0u;
    for (;;) {
        sum = 0u; cnt = 0u; mine = 0u;
#pragma unroll
        for (unsigned j = 0; j < 16; ++j) { const unsigned c = xb_ld(&bar[XB_XCNT(j)]); sum += c; cnt += (c > 0u) ? 1u : 0u; mine = (j == x) ? c : mine; }
        if (sum == G) break;
        __builtin_amdgcn_s_sleep(1);
        if ((++sp & 255u) == 0u) { if (xb_ld(&bar[XB_TMO])) break; if (sp > XB_SPIN_CAP) { atomicAdd(&bar[XB_TMO], 1u); break; } }
    }
    nloc = mine > 0u ? mine : 1u; nx = cnt > 0u ? cnt : 1u;
}

__device__ __forceinline__ void xcd_barrier(const XcdBarrier& b) {
    asm volatile("s_waitcnt vmcnt(0)" ::: "memory");
    __syncthreads();
    if (threadIdx.x == 0) {
        unsigned* bar = b.bar;
        __builtin_amdgcn_s_waitcnt(0);
        unsigned nloc = b.st[0], nx = b.st[1];
        if (nloc == 0u) { xcd_barrier_complete(bar, b.x, nloc, nx); b.st[0] = nloc; b.st[1] = nx; }
        const unsigned old = xb_add(&bar[XB_XSUB(b.x)], 1u);
        const unsigned gen = old / nloc;
        if (old + 1u == (gen + 1u) * nloc) {
            __builtin_amdgcn_fence(__ATOMIC_RELEASE, "agent");
            asm volatile("s_waitcnt vmcnt(0)" ::: "memory");
            const unsigned og = xb_add(&bar[XB_TOP], 1u);
            const unsigned tg = og / nx;
            if (og + 1u == (tg + 1u) * nx) xb_add(&bar[XB_TOPGEN], 1u);
            else XB_SPIN(xb_ld(&bar[XB_TOPGEN]) == tg, bar);
            __builtin_amdgcn_fence(__ATOMIC_ACQUIRE, "agent");
            xb_add(&bar[XB_XGEN(b.x)], 1u);
            asm volatile("s_waitcnt vmcnt(0)" ::: "memory");
        } else {
            XB_SPIN(xb_ld(&bar[XB_XGEN(b.x)]) == gen, bar);
            __builtin_amdgcn_fence(__ATOMIC_ACQUIRE, "agent");
            asm volatile("s_waitcnt vmcnt(0)" ::: "memory");
        }
    }
    __syncthreads();
}
__device__ __forceinline__ void mlstm_b_item(const Params& P, int item, unsigned char* lds, int tid) {
    const int c = item & 127, h = (item >> 7) & 3, b = item >> 9, r0 = b * 8192 + c * 64;
    float* wl = (float*)lds; bf16_t* Kt = (bf16_t*)(lds + 256); bf16_t* Vt = (bf16_t*)(lds + 256 + 9216);
    const bf16_t* mixin = (const bf16_t*)(P.ws + WS_MIXIN);
    if (tid < 64) { const float iv = ((const float*)(P.ws + WS_GI))[(r0 + tid) * 4 + h], bb = ((const float*)(P.ws + WS_GB))[(r0 + tid) * 4 + h];
        const float A = __shfl(bb, 63), v = A - bb + iv, M = wave_max(v); wl[tid] = __expf(v - M) * 0.125f; }
    __syncthreads();
    { const int s = tid >> 3, ch = tid & 7; const bf16_t* rowp = mixin + (size_t)(r0 + s) * NMIX; const float ws_ = wl[s];
        float kf[8]; unpack8(*(const u32x4*)(rowp + 256 + h * 64 + ch * 8), kf);
#pragma unroll
        for (int i = 0; i < 8; ++i) Kt[(ch * 8 + i) * 72 + s] = f2bf(kf[i] * ws_);
        const u32x4 v0 = *(const u32x4*)(rowp + 512 + h * 128 + ch * 16), v1 = *(const u32x4*)(rowp + 512 + h * 128 + ch * 16 + 8);
        const unsigned vv[8] = {v0.x, v0.y, v0.z, v0.w, v1.x, v1.y, v1.z, v1.w};
#pragma unroll
        for (int i = 0; i < 8; ++i) { Vt[(ch * 16 + 2 * i) * 72 + s] = (bf16_t)(vv[i] & 0xffffu); Vt[(ch * 16 + 2 * i + 1) * 72 + s] = (bf16_t)(vv[i] >> 16); } }
    __syncthreads();
    { const int w = tid >> 6, lane = tid & 63, fr = lane & 15, g = lane >> 4, e0 = 16 * w;
        f32x4 acc[4];
#pragma unroll
        for (int dt = 0; dt < 4; ++dt) acc[dt] = (f32x4){0.f, 0.f, 0.f, 0.f};
#pragma unroll
        for (int kk = 0; kk < 2; ++kk) { const bf16x8 vf = *(const bf16x8*)(Vt + (e0 + fr) * 72 + g * 8 + kk * 32);
#pragma unroll
            for (int dt = 0; dt < 4; ++dt) { const bf16x8 kf = *(const bf16x8*)(Kt + (dt * 16 + fr) * 72 + g * 8 + kk * 32); acc[dt] = mfma16(kf, vf, acc[dt]); } }
        bf16_t* dct = (bf16_t*)((unsigned char*)P.out + OB_DCT) + ((size_t)item * 128 + e0 + fr) * 64;
#pragma unroll
        for (int dt = 0; dt < 4; ++dt) { u32x2 pk; pk.x = cvt_pk_bf16(acc[dt][0], acc[dt][1]); pk.y = cvt_pk_bf16(acc[dt][2], acc[dt][3]); *(u32x2*)(dct + dt * 16 + g * 4) = pk; } }
    if (tid < 64) { float sum = 0.f;
#pragma unroll 8
        for (int s = 0; s < 64; ++s) sum += bf2f(Kt[tid * 72 + s]);
        ((float*)(P.ws + WS_DN))[item * 64 + tid] = sum; }
    __syncthreads();
}
__device__ __forceinline__ void mlstm_scan(const Params& P, unsigned char* lds, int tid) {
    const int pair = blockIdx.x >> 3, sub = blockIdx.x & 7;
    float* ga = (float*)lds; float* ea = ga + 128; float* marr = ea + 128;
    if (tid == 0) { float m = 0.f; const float* sA = (const float*)(P.ws + WS_SUMA) + pair * 128; const float* sM = (const float*)(P.ws + WS_SUMM) + pair * 128;
        for (int c = 0; c < 128; ++c) { const float A = sA[c], Mv = sM[c], mn = fmaxf(A + m, Mv); ga[c] = __expf(A + m - mn); ea[c] = __expf(Mv - mn); m = mn; marr[c] = mn; } }
    __syncthreads();
    if (sub == 0) { if (tid < 128) ((float*)(P.ws + WS_MCH))[pair * 128 + tid] = marr[tid]; if (tid == 0) P.out[O_MP + pair] = marr[127]; }
#ifndef P3_SCANMASK
#define P3_SCANMASK 3
#endif
    if (P3_SCANMASK & 1) { const int idx2 = sub * 512 + tid; float C0 = 0.f, C1 = 0.f;
        const unsigned* src = (const unsigned*)((unsigned char*)P.out + OB_DCT) + (size_t)pair * 128 * 4096 + idx2; unsigned* dst = (unsigned*)((unsigned char*)P.out + OB_CPT) + (size_t)pair * 128 * 4096 + idx2;
#pragma unroll 1
        for (int c = 0; c < 128; c += 8) { unsigned v[8];
#pragma unroll
            for (int j = 0; j < 8; ++j) v[j] = src[(size_t)(c + j) * 4096];
#pragma unroll
            for (int j = 0; j < 8; ++j) { dst[(size_t)(c + j) * 4096] = cvt_pk_bf16(C0, C1); const float gg = ga[c + j], ee = ea[c + j]; C0 = gg * C0 + ee * bflo(v[j]); C1 = gg * C1 + ee * bfhi(v[j]); } }
        const int i0 = 2 * idx2, e = i0 >> 6, d = i0 & 63;
        P.out[O_CP + ((size_t)pair * 64 + d) * 128 + e] = C0; P.out[O_CP + ((size_t)pair * 64 + d + 1) * 128 + e] = C1; }
    if ((P3_SCANMASK & 2) && sub == 0 && tid < 64) { float nn = 0.f; const float* dn = (const float*)(P.ws + WS_DN) + (size_t)pair * 128 * 64 + tid; float* np = (float*)(P.ws + WS_NPREV) + (size_t)pair * 128 * 64 + tid;
        for (int c = 0; c < 128; ++c) { np[c * 64] = nn; nn = ga[c] * nn + ea[c] * dn[c * 64]; }
        P.out[O_NP + pair * 64 + tid] = nn; }
    __syncthreads();
}
__device__ __forceinline__ void mlstm_sample_item(const Params& P, int item, unsigned char* lds, int tid) {
    const int h = item & 3, b = item >> 2, r0 = MP + b * 8;
    float* q = (float*)lds; float* k = q + 512; float* v = k + 512; float* sw = v + 1024; float* sc = sw + 64; float* n0s = sc + 64; float* part = n0s + 64; float* red = part + 4096;
    const bf16_t* mixin = (const bf16_t*)(P.ws + WS_MIXIN);
    for (int idx = tid; idx < 2048; idx += 512) {
        if (idx < 512) { const int t = idx >> 6, d = idx & 63; q[idx] = bf2f(mixin[(size_t)(r0 + t) * NMIX + h * 64 + d]); }
        else if (idx < 1024) { const int i2 = idx - 512, t = i2 >> 6, d = i2 & 63; k[i2] = bf2f(mixin[(size_t)(r0 + t) * NMIX + 256 + h * 64 + d]) * 0.125f; }
        else { const int i3 = idx - 1024, t = i3 >> 7, e = i3 & 127; v[i3] = bf2f(mixin[(size_t)(r0 + t) * NMIX + 512 + h * 128 + e]); } }
    if (tid < 64) n0s[tid] = P.in[3][(b * 4 + h) * 64 + tid];
    if (tid < 8) { const float bb = ((const float*)(P.ws + WS_GB))[(r0 + tid) * 4 + h]; sc[tid] = bb; sc[8 + tid] = ((const float*)(P.ws + WS_GI))[(r0 + tid) * 4 + h] - bb; }
    __syncthreads();
    const float mprev = P.in[4][b * 4 + h];
    if (tid < 8) { float cm = mprev; for (int s = 0; s <= tid; ++s) cm = fmaxf(cm, sc[8 + s]); const float mt = sc[tid] + cm; sc[16 + tid] = mt; sc[24 + tid] = __expf(sc[tid] + mprev - mt); }
    __syncthreads();
    if (tid < 8) { const float b7 = sc[7], m7 = sc[23]; sc[32 + tid] = __expf(b7 + sc[8 + tid] - m7); if (tid == 0) { sc[48] = __expf(b7 + mprev - m7); P.out[O_MS + b * 4 + h] = m7; } }
    if (tid >= 64 && tid < 128) { const int i = tid - 64, t = i >> 3, s = i & 7; float dot = 0.f;
        for (int d = 0; d < 64; ++d) dot += q[t * 64 + d] * k[s * 64 + d];
        sw[i] = (s <= t) ? dot * __expf(sc[t] + sc[8 + s] - sc[16 + t]) : 0.f; }
    if (tid >= 128 && tid < 136) { const int t = tid - 128; float qn = 0.f; for (int d = 0; d < 64; ++d) qn += q[t * 64 + d] * n0s[d]; sc[40 + t] = qn; }
    __syncthreads();
    { const int e = tid & 127, dq = tid >> 7; const float gd = sc[48]; float num[8];
#pragma unroll
        for (int t = 0; t < 8; ++t) num[t] = 0.f;
#pragma unroll 4
        for (int dd = 0; dd < 16; ++dd) { const int d = dq * 16 + dd; const size_t ic = ((size_t)(b * 4 + h) * 64 + d) * 128 + e; const float c0 = P.in[2][ic];
            float upd = 0.f;
#pragma unroll
            for (int s = 0; s < 8; ++s) upd += sc[32 + s] * k[s * 64 + d] * v[s * 128 + e];
            P.out[O_CS + ic] = gd * c0 + upd;
#pragma unroll
            for (int t = 0; t < 8; ++t) num[t] += q[t * 64 + d] * c0; }
#pragma unroll
        for (int t = 0; t < 8; ++t) part[(dq * 8 + t) * 128 + e] = num[t]; }
    if (tid < 64) { float nn = sc[48] * n0s[tid];
#pragma unroll
        for (int s = 0; s < 8; ++s) nn += sc[32 + s] * k[s * 64 + tid];
        P.out[O_NS + (b * 4 + h) * 64 + tid] = nn; }
    __syncthreads();
    { const int e = tid & 127, tq = tid >> 7, w = tid >> 6, lane = tid & 63; float hv[2];
#pragma unroll
        for (int u = 0; u < 2; ++u) { const int t = tq * 2 + u; float inter = 0.f, intra = 0.f, rs = 0.f;
#pragma unroll
            for (int dq = 0; dq < 4; ++dq) inter += part[(dq * 8 + t) * 128 + e];
#pragma unroll
            for (int s = 0; s < 8; ++s) { intra += sw[t * 8 + s] * v[s * 128 + e]; rs += sw[t * 8 + s]; }
            const float wi = sc[24 + t], den = wi * sc[40 + t] + rs; hv[u] = (wi * inter + intra) / fmaxf(fabsf(den), __expf(-sc[16 + t])); }
        const float s0 = wave_sum(hv[0] * hv[0]), s1 = wave_sum(hv[1] * hv[1]);
        if (lane == 0) { red[w * 2] = s0; red[w * 2 + 1] = s1; }
        __syncthreads();
        bf16_t* hcat = (bf16_t*)(P.ws + WS_HCAT);
#pragma unroll
        for (int u = 0; u < 2; ++u) { const int t = tq * 2 + u; const float tot = red[(w & ~1) * 2 + u] + red[(w | 1) * 2 + u]; const float rstd = 1.0f / sqrtf(tot * (1.0f / 128.0f) + EPS);
            const float so = bf2f(mixin[(size_t)(r0 + t) * NMIX + 1024 + h * 128 + e]);
            hcat[(size_t)(r0 + t) * 1024 + h * 128 + e] = f2bf(hv[u] * rstd * P.in[11][h * 128 + e] * so); } }
    __syncthreads();
}
__device__ __forceinline__ void mlstm_d_item(const Params& P, int item, unsigned char* lds, int tid) {
    const int c = item & 127, h = (item >> 7) & 3, b = item >> 9, r0 = b * 8192 + c * 64, pair = item >> 7;
    float* lb = (float*)lds; float* lu = lb + 64; float* lm = lb + 128; float* misc = lb + 192; float* npv = lb + 256; float* red = lb + 320;
    bf16_t* Kn = (bf16_t*)(lds + 2048); bf16_t* Vt = (bf16_t*)(lds + 11264); bf16_t* Cs = (bf16_t*)(lds + 29696);
    const bf16_t* mixin = (const bf16_t*)(P.ws + WS_MIXIN);
    if (tid < 64) { const float iv = ((const float*)(P.ws + WS_GI))[(r0 + tid) * 4 + h], bb = ((const float*)(P.ws + WS_GB))[(r0 + tid) * 4 + h];
        const float mprev = c ? ((const float*)(P.ws + WS_MCH))[pair * 128 + c - 1] : 0.f;
        const float u = iv - bb; float cm = u;
#pragma unroll
        for (int o = 1; o < 64; o <<= 1) { const float nb = __shfl_up(cm, o); if (tid >= o) cm = fmaxf(cm, nb); }
        lb[tid] = bb; lu[tid] = u; lm[tid] = bb + fmaxf(mprev, cm); if (tid == 0) misc[0] = mprev;
        npv[tid] = ((const float*)(P.ws + WS_NPREV))[(size_t)item * 64 + tid]; }
    { const int s = tid >> 3, ch = tid & 7; const bf16_t* rowp = mixin + (size_t)(r0 + s) * NMIX;
        *(u32x4*)(Kn + s * 72 + ch * 8) = *(const u32x4*)(rowp + 256 + h * 64 + ch * 8);
        const u32x4 v0 = *(const u32x4*)(rowp + 512 + h * 128 + ch * 16), v1 = *(const u32x4*)(rowp + 512 + h * 128 + ch * 16 + 8);
        const unsigned vv[8] = {v0.x, v0.y, v0.z, v0.w, v1.x, v1.y, v1.z, v1.w};
#pragma unroll
        for (int i = 0; i < 8; ++i) { Vt[(ch * 16 + 2 * i) * 72 + s] = (bf16_t)(vv[i] & 0xffffu); Vt[(ch * 16 + 2 * i + 1) * 72 + s] = (bf16_t)(vv[i] >> 16); }
        const bf16_t* cp = (const bf16_t*)((unsigned char*)P.out + OB_CPT) + (size_t)item * 8192;
#pragma unroll
        for (int j = 0; j < 2; ++j) { const int idx = tid + 512 * j, e = idx >> 3, dch = idx & 7; *(u32x4*)(Cs + e * 72 + dch * 8) = *(const u32x4*)(cp + e * 64 + dch * 8); } }
    __syncthreads();
    const int w = tid >> 6, lane = tid & 63, fr = lane & 15, g = lane >> 4, tt = w & 3, eh = w >> 2, t = tt * 16 + fr, tok = r0 + t;
    bf16x8 qf[2]; float qv0[8], qv1[8];
    { const bf16_t* qp = mixin + (size_t)tok * NMIX + h * 64 + g * 8; const u32x4 a = *(const u32x4*)qp, bq = *(const u32x4*)(qp + 32);
        qf[0] = __builtin_bit_cast(bf16x8, a); qf[1] = __builtin_bit_cast(bf16x8, bq); unpack8(a, qv0); unpack8(bq, qv1); }
    f32x4 s[4];
#pragma unroll
    for (int st = 0; st < 4; ++st) { s[st] = (f32x4){0.f, 0.f, 0.f, 0.f};
#pragma unroll
        for (int kk = 0; kk < 2; ++kk) { const bf16x8 kf = *(const bf16x8*)(Kn + (st * 16 + fr) * 72 + g * 8 + kk * 32); s[st] = mfma16(kf, qf[kk], s[st]); } }
    const float bt = lb[t], mt = lm[t], mprev = misc[0];
    float rs = 0.f;
#pragma unroll
    for (int st = 0; st < 4; ++st)
#pragma unroll
        for (int r = 0; r < 4; ++r) { const int si = st * 16 + g * 4 + r; const float wv = (si <= t) ? __expf(bt + lu[si] - mt) : 0.f; const float val = s[st][r] * 0.125f * wv; s[st][r] = val; rs += val; }
    rs += __shfl_xor(rs, 16); rs += __shfl_xor(rs, 32);
    float qn = 0.f;
#pragma unroll
    for (int i = 0; i < 8; ++i) qn += qv0[i] * npv[g * 8 + i] + qv1[i] * npv[32 + g * 8 + i];
    qn += __shfl_xor(qn, 16); qn += __shfl_xor(qn, 32);
    const float wi = __expf(bt + mprev - mt), den = wi * qn + rs, inv = 1.0f / fmaxf(fabsf(den), __expf(-mt));
    bf16x8 pf[2]; pf[0] = pack8(s[0], s[1]); pf[1] = pack8(s[2], s[3]);
    f32x4 h1[4], h2[4];
#pragma unroll
    for (int et = 0; et < 4; ++et) { const int e = eh * 64 + et * 16 + fr; h1[et] = (f32x4){0.f, 0.f, 0.f, 0.f}; h2[et] = (f32x4){0.f, 0.f, 0.f, 0.f};
#pragma unroll
        for (int cc = 0; cc < 2; ++cc) { const bf16_t* vp = Vt + e * 72 + cc * 32 + g * 4; const u32x2 v0 = *(const u32x2*)vp, v1 = *(const u32x2*)(vp + 16);
            h2[et] = mfma16(__builtin_bit_cast(bf16x8, (u32x4){v0.x, v0.y, v1.x, v1.y}), pf[cc], h2[et]); }
#pragma unroll
        for (int kk = 0; kk < 2; ++kk) { const bf16x8 cf = *(const bf16x8*)(Cs + e * 72 + g * 8 + kk * 32); h1[et] = mfma16(cf, qf[kk], h1[et]); } }
    float ss = 0.f;
#pragma unroll
    for (int et = 0; et < 4; ++et)
#pragma unroll
        for (int r = 0; r < 4; ++r) { const float hv = (wi * h1[et][r] + h2[et][r]) * inv; h2[et][r] = hv; ss += hv * hv; }
    ss += __shfl_xor(ss, 16); ss += __shfl_xor(ss, 32);
    if (g == 0) red[w * 16 + fr] = ss;
    __syncthreads();
    { const float tot = red[w * 16 + fr] + red[(w ^ 4) * 16 + fr]; const float rstd = 1.0f / sqrtf(tot * (1.0f / 128.0f) + EPS);
        bf16_t* hcat = (bf16_t*)(P.ws + WS_HCAT);
#pragma unroll
        for (int et = 0; et < 4; ++et) { const int e0 = eh * 64 + et * 16 + g * 4; const u32x2 so = *(const u32x2*)(mixin + (size_t)tok * NMIX + 1024 + h * 128 + e0); const f32x4 mw = *(const f32x4*)(P.in[11] + h * 128 + e0);
            const float o0 = h2[et][0] * rstd * mw[0] * bflo(so.x), o1 = h2[et][1] * rstd * mw[1] * bfhi(so.x), o2 = h2[et][2] * rstd * mw[2] * bflo(so.y), o3 = h2[et][3] * rstd * mw[3] * bfhi(so.y);
            u32x2 pk; pk.x = cvt_pk_bf16(o0, o1); pk.y = cvt_pk_bf16(o2, o3); *(u32x2*)(hcat + (size_t)tok * 1024 + h * 128 + e0) = pk; } }
    __syncthreads();
}


__device__ __forceinline__ void tail_mma(unsigned char* lds, const bf16_t* A, const bf16_t* Bt, int K, int r0, int c0, int nchunk, int nseg0, int tid, f32x4 (&acc)[2][2]) {
    const int w = tid >> 6, lane = tid & 63, fr = lane & 15, g = lane >> 4, wr = w & 3, wc = w >> 2;
    const bf16_t* gp[4]; unsigned lo_[4];
#pragma unroll
    for (int j = 0; j < 4; ++j) { const int idx = tid + 512 * j, mat = idx >> 10, rem = idx & 1023, row = rem >> 4, seg = rem & 15;
        gp[j] = (mat ? Bt + (size_t)(c0 + row) * K : A + (size_t)(r0 + row) * K) + seg * 8; lo_[j] = (unsigned)(mat * 17408 + row * 272 + seg * 16); }
    u32x4 st[4];
#pragma unroll
    for (int j = 0; j < 4; ++j) st[j] = *(const u32x4*)gp[j];
#pragma unroll
    for (int j = 0; j < 4; ++j) *(u32x4*)(lds + lo_[j]) = st[j];
    __syncthreads();
    const unsigned aoff = (unsigned)((16 * wr + fr) * 272 + g * 16), boff = (unsigned)(17408 + (32 * wc + fr) * 272 + g * 16);
#pragma unroll 1
    for (int ch = 0; ch < nchunk; ++ch) {
        const unsigned cur = (unsigned)(ch & 1) * 34816u, nxt = 34816u - cur;
        const bool more = ch + 1 < nchunk;
        if (more) {
#pragma unroll
            for (int j = 0; j < 4; ++j) st[j] = *(const u32x4*)(gp[j] + (size_t)(ch + 1) * 128); }
        bf16x8 fa[4], f0[4], f1[4];
#pragma unroll
        for (int kk = 0; kk < 4; ++kk) { fa[kk] = *(const bf16x8*)(lds + cur + aoff + kk * 64); f0[kk] = *(const bf16x8*)(lds + cur + boff + kk * 64); f1[kk] = *(const bf16x8*)(lds + cur + boff + 16 * 272 + kk * 64); }
        if (ch < nseg0) {
#pragma unroll
            for (int kk = 0; kk < 4; ++kk) { acc[0][0] = mfma16(f0[kk], fa[kk], acc[0][0]); acc[0][1] = mfma16(f1[kk], fa[kk], acc[0][1]); } }
        else {
#pragma unroll
            for (int kk = 0; kk < 4; ++kk) { acc[1][0] = mfma16(f0[kk], fa[kk], acc[1][0]); acc[1][1] = mfma16(f1[kk], fa[kk], acc[1][1]); } }
        if (more) {
#pragma unroll
            for (int j = 0; j < 4; ++j) *(u32x4*)(lds + nxt + lo_[j]) = st[j]; }
        __syncthreads();
    }
}
__device__ __forceinline__ void tail_mix(const Params& P, unsigned char* lds, int tb, int tid) {
    const int w = tid >> 6, lane = tid & 63, fr = lane & 15, g = lane >> 4, tok = MP + (tb >> 4) * 64 + 16 * (w & 3) + fr, col0 = (tb & 15) * 64 + 32 * (w >> 2);
    const bf16_t* hcat = (const bf16_t*)(P.ws + WS_HCAT); const bf16_t* wab = (const bf16_t*)(P.ws + WS_WAB); const bf16_t* gates = (const bf16_t*)(P.ws + WS_GATES); bf16_t* mix = (bf16_t*)(P.ws + WS_MIXIN);
    f32x4 ab[2][2]; ab[0][0] = ab[0][1] = ab[1][0] = ab[1][1] = (f32x4){0.f, 0.f, 0.f, 0.f};
    tail_mma(lds, hcat, wab, 1024, MP + (tb >> 4) * 64, (tb & 15) * 64, 8, 4, tid, ab);
    const f32x4 (&a)[2] = ab[0]; const f32x4 (&b)[2] = ab[1];
#pragma unroll
    for (int mt = 0; mt < 2; ++mt) { const int c = col0 + mt * 16 + g * 4; const u32x2 sa = *(const u32x2*)(gates + (size_t)tok * 2048 + c), sb = *(const u32x2*)(gates + (size_t)tok * 2048 + 1024 + c);
        const float v0 = bflo(sa.x) * a[mt][0] + bflo(sb.x) * b[mt][0], v1 = bfhi(sa.x) * a[mt][1] + bfhi(sb.x) * b[mt][1], v2 = bflo(sa.y) * a[mt][2] + bflo(sb.y) * b[mt][2], v3 = bfhi(sa.y) * a[mt][3] + bfhi(sb.y) * b[mt][3];
        u32x2 pk; pk.x = cvt_pk_bf16(v0, v1); pk.y = cvt_pk_bf16(v2, v3); *(u32x2*)(mix + (size_t)tok * 1024 + c) = pk; }
}
__device__ __forceinline__ void tail_out(const Params& P, unsigned char* lds, int tb, int tid) {
    const int w = tid >> 6, lane = tid & 63, fr = lane & 15, g = lane >> 4, tok = MP + (tb >> 4) * 64 + 16 * (w & 3) + fr, col0 = (tb & 15) * 64 + 32 * (w >> 2);
    f32x4 ab[2][2]; ab[0][0] = ab[0][1] = ab[1][0] = ab[1][1] = (f32x4){0.f, 0.f, 0.f, 0.f};
    tail_mma(lds, (const bf16_t*)(P.ws + WS_MIXIN), (const bf16_t*)(P.ws + WS_WOUT), 1024, MP + (tb >> 4) * 64, (tb & 15) * 64, 8, 8, tid, ab);
    const f32x4 (&acc)[2] = ab[0];
    const float* xrow = P.in[1] + (size_t)(tok - MP) * 1024; bf16_t* hfw = (bf16_t*)(P.ws + WS_HN); float ss = 0.f;
#pragma unroll
    for (int mt = 0; mt < 2; ++mt) { const int c = col0 + mt * 16 + g * 4; const f32x4 y = *(const f32x4*)(xrow + c) + acc[mt]; *(f32x4*)(P.out + (size_t)tok * 1024 + c) = y;
        ss += (y[0] * y[0] + y[1] * y[1]) + (y[2] * y[2] + y[3] * y[3]); const f32x4 z = y * *(const f32x4*)(P.in[18] + c);
        u32x2 pk; pk.x = cvt_pk_bf16(z[0], z[1]); pk.y = cvt_pk_bf16(z[2], z[3]); *(u32x2*)(hfw + (size_t)tok * 1024 + c) = pk; }
    ss += __shfl_xor(ss, 16); ss += __shfl_xor(ss, 32);
    if (g == 0) unsafeAtomicAdd((float*)(P.ws + WS_ROWSS) + tok, ss);
}
__device__ __forceinline__ void tail_down(const Params& P, unsigned char* lds, int tb, int tid) {
    const int w = tid >> 6, lane = tid & 63, fr = lane & 15, g = lane >> 4, tok = MP + (tb >> 4) * 64 + 16 * (w & 3) + fr, col0 = (tb & 15) * 64 + 32 * (w >> 2);
    f32x4 ab[2][2]; ab[0][0] = ab[0][1] = ab[1][0] = ab[1][1] = (f32x4){0.f, 0.f, 0.f, 0.f};
    tail_mma(lds, (const bf16_t*)(P.ws + WS_MIXIN), (const bf16_t*)(P.ws + WS_WD), DFF, MP + (tb >> 4) * 64, (tb & 15) * 64, 22, 22, tid, ab);
    const f32x4 (&acc)[2] = ab[0];
#pragma unroll
    for (int mt = 0; mt < 2; ++mt) { float* p = P.out + (size_t)tok * 1024 + col0 + mt * 16 + g * 4; *(f32x4*)p = *(const f32x4*)p + acc[mt]; }
}
#define GSYNC_F(grid) xcd_barrier(xbar)
__global__ void __launch_bounds__(512, 2) fwd_kernel(Params P) {
    extern __shared__ __attribute__((aligned(16))) unsigned char lds[];
    cg::grid_group grid = cg::this_grid();
    const int tid = threadIdx.x, G = gridDim.x;
    const int lo = P.ph_lo, hi = P.ph_hi;
    volatile LAS unsigned* xst = (volatile LAS unsigned*)((LAS unsigned char*)lds + 131072);
    if (tid < 4) xst[tid] = 0u;
    __syncthreads();
    XcdBarrier xbar = xcd_barrier_post((unsigned*)(P.ws + WS_BAR), xst);
#ifndef PHASE_MASK
#define PHASE_MASK 0x1ff
#endif
#define IN(k) (((PHASE_MASK >> (k)) & 1) && lo <= (k) && (k) < hi)
#define GSYNC() xcd_barrier(xbar)
#define SEAM(k) do { if (IN(k) && IN((k) + 1)) GSYNC(); } while (0)
#ifndef DUP_MASK
#define DUP_MASK 0
#endif
#ifndef EXTRA_SYNCS
#define EXTRA_SYNCS 0
#endif
#define REP(k) for (int rep_ = 0; rep_ <= ((DUP_MASK >> (k)) & 1); ++rep_) if (rep_ == 0 || (GSYNC_F(grid), true))
    bf16_t* HN = (bf16_t*)(P.ws + WS_HN); bf16_t* MIXIN = (bf16_t*)(P.ws + WS_MIXIN); bf16_t* GATES = (bf16_t*)(P.ws + WS_GATES); bf16_t* HCAT = (bf16_t*)(P.ws + WS_HCAT);
    PG8_LAS unsigned char* ldsa = (PG8_LAS unsigned char*)lds;
    if (IN(0)) REP(0) p0_prep(P, lds, tid, G);
    if (lo < 0) grid.sync();
    SEAM(0);
    for (int xs_ = 0; xs_ < EXTRA_SYNCS; ++xs_) GSYNC();
    if (IN(1)) REP(1) { pg8::Gemm g{HN, (const bf16_t*)(P.ws + WS_WIN), MT, NPROJ, 1024}; pg8::StaticOrder S; S.init(MT, NPROJ, G, (int)blockIdx.x);
        pg8::EpiProj E{MIXIN, GATES}; pg8::gemm_phase<pg8::EpiProj, pg8::StaticOrder, true, true>(ldsa, g, S, E); }
    SEAM(1);
    if (IN(2)) REP(2) {
        for (int it = blockIdx.x; it < 256 + 256 + 1024; it += G) {
            if (it < 256) attn_prompt_item(P, it, lds, tid);
            else if (it < 512) attn_sample_item(P, it - 256, lds, tid);
            else mlstm_b_item(P, it - 512, lds, tid);
        } }
    SEAM(2);
    if (IN(3)) REP(3) {
        const int nscan = (G > 64) ? 64 : 0;
#ifndef P3_VARIANT
#define P3_VARIANT 3
#endif
        if (nscan) { if ((int)blockIdx.x < 64) { if (P3_VARIANT & 1) mlstm_scan(P, lds, tid); } else if (P3_VARIANT & 2) for (int it = blockIdx.x - 64; it < 512; it += G - 64) mlstm_sample_item(P, it, lds, tid); }
        else { for (int it = blockIdx.x; it < 512; it += G) mlstm_sample_item(P, it, lds, tid); }
    }
    SEAM(3);
    if (IN(4)) REP(4) { for (int it = blockIdx.x; it < 1024; it += G) mlstm_d_item(P, it, lds, tid); }
    SEAM(4);
    if (IN(5)) REP(5) { pg8::Gemm g{HCAT, (const bf16_t*)(P.ws + WS_WAB), MP, 1024, 1024}; pg8::StaticOrder S; S.init(MP, 1024, G, (int)blockIdx.x);
        pg8::EpiMix E{GATES, MIXIN}; pg8::gemm_phase<pg8::EpiMix, pg8::StaticOrder, true, true>(ldsa, g, S, E);
        for (int tb = blockIdx.x; tb < 256; tb += G) tail_mix(P, lds, tb, tid); }
    SEAM(5);
    if (IN(6)) REP(6) { pg8::Gemm g{MIXIN, (const bf16_t*)(P.ws + WS_WOUT), MP, 1024, 1024}; pg8::StaticOrder S; S.init(MP, 1024, G, (int)blockIdx.x);
        pg8::EpiOut E{P.in[0], P.in[1], P.out, HN, P.in[18], (float*)(P.ws + WS_ROWSS)}; pg8::gemm_phase<pg8::EpiOut, pg8::StaticOrder, true, true>(ldsa, g, S, E);
        for (int tb = blockIdx.x; tb < 256; tb += G) tail_out(P, lds, tb, tid); }
    SEAM(6);
    if (IN(7)) REP(7) { pg8::Gemm g{HN, (const bf16_t*)(P.ws + WS_WGU), MT, 2 * DFF, 1024}; pg8::StaticOrder S; S.init(MT, 2 * DFF, G, (int)blockIdx.x);
        pg8::EpiGU E{MIXIN, (const float*)(P.ws + WS_ROWSS)}; pg8::gemm_phase<pg8::EpiGU, pg8::StaticOrder, true, true>(ldsa, g, S, E); }
    SEAM(7);
    if (IN(8)) REP(8) { pg8::Gemm g{MIXIN, (const bf16_t*)(P.ws + WS_WD), MP, 1024, DFF}; pg8::StaticOrder S; S.init(MP, 1024, G, (int)blockIdx.x);
        pg8::EpiDown E{P.out}; pg8::gemm_phase<pg8::EpiDown, pg8::StaticOrder, true, true>(ldsa, g, S, E);
        for (int tb = blockIdx.x; tb < 256; tb += G) tail_down(P, lds, tb, tid); }
#ifdef DBG_DUMP
    GSYNC();
    if (DBG_DUMP == 1) { for (size_t i = (size_t)blockIdx.x * 512 + tid; i < (size_t)MT * 1024; i += (size_t)G * 512) { const size_t r = i >> 10, c = i & 1023; P.out[i] = bf2f(MIXIN[r * NMIX + c]); } }
    if (DBG_DUMP == 2) { const bf16_t* d = (const bf16_t*)((unsigned char*)P.out + OB_DCT); for (size_t i = (size_t)blockIdx.x * 512 + tid; i < (size_t)1024 * 8192; i += (size_t)G * 512) P.out[i] = bf2f(d[i]); }
    if (DBG_DUMP == 4) { unsigned* d = (unsigned*)((unsigned char*)P.out + OB_DCT); for (size_t i = (size_t)blockIdx.x * 512 + tid; i < (size_t)1024 * 4096; i += (size_t)G * 512) { const unsigned w = __hip_atomic_load(d + i, __ATOMIC_RELAXED, __HIP_MEMORY_SCOPE_AGENT); P.out[2 * i] = bflo(w); P.out[2 * i + 1] = bfhi(w); } }
    if (DBG_DUMP == 5) { const float* a = (const float*)(P.ws + WS_GI); const float* bq = (const float*)(P.ws + WS_GB); for (int i = blockIdx.x * 512 + tid; i < MT * 4; i += G * 512) { P.out[i] = a[i]; P.out[MT * 4 + i] = bq[i]; } }
    if (DBG_DUMP == 6) { const float* a = (const float*)(P.ws + WS_DN); for (int i = blockIdx.x * 512 + tid; i < 65536; i += G * 512) P.out[i] = a[i]; }
    if (DBG_DUMP == 3) { for (size_t i = (size_t)blockIdx.x * 512 + tid; i < (size_t)MT * 1024; i += (size_t)G * 512) P.out[i] = bf2f(HN[i]); }
#endif
#undef IN
#undef SEAM
}

extern "C" void kernel_launch(void* const* d_in, const int* in_sizes, int n_in, void* d_out, int out_size, void* d_ws, size_t ws_size, hipStream_t stream) {
    static int grid = 0;
    if (grid == 0) {
        if (n_in != 22 || (size_t)out_size != O_END || ws_size < WS_END) { fprintf(stderr, "kernel_launch: unexpected shapes (n_in %d, out %d, ws %zu)\n", n_in, out_size, ws_size); grid = -1; return; }
        int dev = 0, cus = 0, per_cu = 0;
        (void)hipGetDevice(&dev); (void)hipDeviceGetAttribute(&cus, hipDeviceAttributeMultiprocessorCount, dev);
        if (hipFuncSetAttribute((const void*)fwd_kernel, hipFuncAttributeMaxDynamicSharedMemorySize, LDS_BYTES) != hipSuccess) { fprintf(stderr, "kernel_launch: hipFuncSetAttribute failed\n"); grid = -1; return; }
        if (hipOccupancyMaxActiveBlocksPerMultiprocessor(&per_cu, (const void*)fwd_kernel, 512, LDS_BYTES) != hipSuccess || per_cu < 1) { fprintf(stderr, "kernel_launch: occupancy query failed (%d)\n", per_cu); (void)hipGetLastError(); per_cu = 1; }
        grid = cus * 1;
        if (grid < 65) { fprintf(stderr, "kernel_launch: needs more than 64 CUs\n"); grid = -1; return; }
    }
    if (grid < 0) return;
    if (hipMemsetAsync((char*)d_ws + WS_BAR, 0, XCD_BAR_WORDS * 4, stream) != hipSuccess) { fprintf(stderr, "kernel_launch: memset failed\n"); return; }
    Params p{};
    for (int i = 0; i < 22; ++i) p.in[i] = (const float*)d_in[i];
    p.out = (float*)d_out; p.ws = (unsigned char*)d_ws;
    constexpr int NPH = 9;
    for (int li = 0; li < N_LAUNCHES; ++li) {
        p.ph_lo = (N_LAUNCHES == 1) ? 0 : li; p.ph_hi = (N_LAUNCHES == 1) ? NPH : li + 1;
        void* args[] = {&p};
        const hipError_t e = hipLaunchCooperativeKernel((const void*)fwd_kernel, dim3(grid), dim3(512), args, LDS_BYTES, stream);
        if (e != hipSuccess) { fprintf(stderr, "kernel_launch: cooperative launch %d failed: %s (grid %d)\n", li, hipGetErrorString(e), grid); break; }
    }
}
```

```cpp
#include <hip/hip_runtime.h>
#include <hip/hip_cooperative_groups.h>
#include <cstdio>
#include <cstdint>
namespace cg = cooperative_groups;

#ifndef N_LAUNCHES
#define N_LAUNCHES 1
#endif

namespace pg8 {
#define PG8_LAS __attribute__((address_space(3)))
typedef unsigned short bf16_t;
typedef short bf16x8 __attribute__((ext_vector_type(8)));
typedef float f32x4 __attribute__((ext_vector_type(4)));
typedef unsigned u32x4 __attribute__((ext_vector_type(4)));
constexpr int BM = 256, BK = 64, HALF = 128, HTB = HALF * BK * 2  , STAGE_BYTES = 8 * HTB, NXCD = 8, WGM = 8;

__host__ __device__ __forceinline__ int lds_byte(int r, int c) { const int st = (r >> 4) * 2 + (c >> 5), rr = r & 15, cc = c & 31, ob = rr * 64 + cc * 2; return st * 1024 + (ob ^ (((ob >> 9) & 1) << 5)); }
__host__ __device__ __forceinline__ void stage_rc(int b, int& R, int& C) { const int st = b / 1024, sb = b % 1024, swz = sb ^ (((sb >> 9) & 1) << 5); R = (st >> 1) * 16 + swz / 64; C = (st & 1) * 32 + (swz % 64) / 2; }
__host__ __device__ __forceinline__ int perm32(int rho) { const int n = rho >> 4, i = rho & 15; return 8 * (i >> 2) + 4 * n + (i & 3); }

struct Unit { int pm, pn; };
struct Gemm { const bf16_t* A; const bf16_t* Bt; int M, N, K; };

struct StaticOrder {
    int nM, nN, nwg, G, c;
    __host__ __device__ void init(int M, int N, int G_, int c_) { nM = M / BM; nN = N / BM; nwg = nM * nN; G = G_; c = c_; }
    __host__ __device__ bool next(int i, Unit& u) const {
        const long L = (long)i * G + c; if (L >= nwg) return false;
        int wgid = (int)L; { const int q = nwg / NXCD, r = nwg % NXCD, xcd = wgid % NXCD, off = wgid / NXCD; wgid = (xcd < r ? xcd * (q + 1) : r * (q + 1) + (xcd - r) * q) + off; }
        const int nig = WGM * nN, gid = wgid / nig, fm = gid * WGM, gsz = (nM - fm) < WGM ? (nM - fm) : WGM;
        u.pm = fm + ((wgid % nig) % gsz); u.pn = (wgid % nig) / gsz; return true;
    }
    __device__ __forceinline__ void a_ready(const Unit&) const {}
    __device__ __forceinline__ void done(const Unit&) const {}
};

__device__ __forceinline__ unsigned cvt_pk_bf16(float lo, float hi) { unsigned r; asm volatile("v_cvt_pk_bf16_f32 %0, %1, %2" : "=v"(r) : "v"(lo), "v"(hi)); return r; }
__device__ __forceinline__ float bflo(unsigned w) { return __builtin_bit_cast(float, w << 16); }
__device__ __forceinline__ float bfhi(unsigned w) { return __builtin_bit_cast(float, w & 0xffff0000u); }
__device__ __forceinline__ float sigm(float x) { return 1.0f / (1.0f + __expf(-x)); }

struct EpiProj {
    static constexpr bool PERM = true, AFTER_DRAIN = false, HAS_MID = false;
    bf16_t* mixin; bf16_t* gates;
    __device__ __forceinline__ void operator()(const f32x4 (&acc)[2][2][4][2], const Unit& u, int wr, int wc, int fr, int fq) const {
        const bool isg = u.pn >= 9; const bool sg = isg || u.pn == 4 || u.pn == 5;
        bf16_t* base = isg ? gates : mixin; const int ldc = isg ? 2048 : 2304;
        const int col0 = (isg ? (u.pn - 9) : u.pn) * 256 + wc * 32 + 8 * fq, row0 = u.pm * BM + wr * 64 + fr;
#pragma unroll
        for (int ai = 0; ai < 2; ++ai)
#pragma unroll
            for (int m = 0; m < 4; ++m) { bf16_t* rowp = base + (size_t)(row0 + ai * HALF + m * 16) * ldc + col0;
#pragma unroll
                for (int bj = 0; bj < 2; ++bj) { f32x4 v0 = acc[ai][bj][m][0], v1 = acc[ai][bj][m][1];
                    if (sg) {
#pragma unroll
                        for (int i = 0; i < 4; ++i) { v0[i] = sigm(v0[i]); v1[i] = sigm(v1[i]); } }
                    u32x4 w; w.x = cvt_pk_bf16(v0[0], v0[1]); w.y = cvt_pk_bf16(v0[2], v0[3]); w.z = cvt_pk_bf16(v1[0], v1[1]); w.w = cvt_pk_bf16(v1[2], v1[3]);
                    *(u32x4*)(rowp + bj * HALF) = w; } }
    }
};

struct EpiMix {
    static constexpr bool PERM = true, AFTER_DRAIN = false, HAS_MID = true;
    const bf16_t* gates; bf16_t* mix;
    __device__ __forceinline__ void mid(f32x4 (&acc)[2][2][4][2], const Unit& u, int wr, int wc, int fr, int fq) const {
        unsigned rb = (unsigned)(u.pm * BM + wr * 64 + fr) * 2048u + (unsigned)(u.pn * BM + wc * 32 + 8 * fq);
        asm volatile("" : "+v"(rb));
#pragma unroll
        for (int ai = 0; ai < 2; ++ai)
#pragma unroll
            for (int m = 0; m < 4; ++m) { const bf16_t* rowp = gates + (rb + (unsigned)((ai * HALF + m * 16) * 2048));
#pragma unroll
                for (int bj = 0; bj < 2; ++bj) { const u32x4 a = *(const u32x4*)(rowp + bj * HALF), b = *(const u32x4*)(rowp + 1024 + bj * HALF);
                    const float tiny = 8.673617379884035e-19f;
                    f32x4 r0, r1;
                    r0[0] = bflo(a.x) * __builtin_amdgcn_rcpf(fmaxf(bflo(b.x), tiny)); r0[1] = bfhi(a.x) * __builtin_amdgcn_rcpf(fmaxf(bfhi(b.x), tiny)); r0[2] = bflo(a.y) * __builtin_amdgcn_rcpf(fmaxf(bflo(b.y), tiny)); r0[3] = bfhi(a.y) * __builtin_amdgcn_rcpf(fmaxf(bfhi(b.y), tiny));
                    r1[0] = bflo(a.z) * __builtin_amdgcn_rcpf(fmaxf(bflo(b.z), tiny)); r1[1] = bfhi(a.z) * __builtin_amdgcn_rcpf(fmaxf(bfhi(b.z), tiny)); r1[2] = bflo(a.w) * __builtin_amdgcn_rcpf(fmaxf(bflo(b.w), tiny)); r1[3] = bfhi(a.w) * __builtin_amdgcn_rcpf(fmaxf(bfhi(b.w), tiny));
                    acc[ai][bj][m][0] = acc[ai][bj][m][0] * r0; acc[ai][bj][m][1] = acc[ai][bj][m][1] * r1; }
                if (m == 3) __builtin_amdgcn_sched_barrier(0); }
    }
    __device__ __forceinline__ void operator()(const f32x4 (&acc)[2][2][4][2], const Unit& u, int wr, int wc, int fr, int fq) const {
        const int col0 = u.pn * BM + wc * 32 + 8 * fq, row0 = u.pm * BM + wr * 64 + fr;
#pragma unroll
        for (int ai = 0; ai < 2; ++ai)
#pragma unroll
            for (int m = 0; m < 4; ++m) { const size_t row = (size_t)(row0 + ai * HALF + m * 16);
#pragma unroll
                for (int bj = 0; bj < 2; ++bj) { const u32x4 b = *(const u32x4*)(gates + row * 2048 + 1024 + col0 + bj * HALF);
                    const float tiny = 8.673617379884035e-19f;
                    f32x4 s0, s1;
                    s0[0] = fmaxf(bflo(b.x), tiny); s0[1] = fmaxf(bfhi(b.x), tiny); s0[2] = fmaxf(bflo(b.y), tiny); s0[3] = fmaxf(bfhi(b.y), tiny);
                    s1[0] = fmaxf(bflo(b.z), tiny); s1[1] = fmaxf(bfhi(b.z), tiny); s1[2] = fmaxf(bflo(b.w), tiny); s1[3] = fmaxf(bfhi(b.w), tiny);
                    const f32x4 v0 = acc[ai][bj][m][0] * s0, v1 = acc[ai][bj][m][1] * s1;
                    u32x4 w; w.x = cvt_pk_bf16(v0[0], v0[1]); w.y = cvt_pk_bf16(v0[2], v0[3]); w.z = cvt_pk_bf16(v1[0], v1[1]); w.w = cvt_pk_bf16(v1[2], v1[3]);
                    *(u32x4*)(mix + row * 1024 + col0 + bj * HALF) = w; } }
    }
};

struct EpiOut {
    static constexpr bool PERM = true, AFTER_DRAIN = false, HAS_MID = false;
    const float* xp; const float* xs; float* out; bf16_t* hfw; const float* nfw; float* rowss;
    __device__ __forceinline__ void operator()(const f32x4 (&acc)[2][2][4][2], const Unit& u, int wr, int wc, int fr, int fq) const {
        const int col0 = u.pn * BM + wc * 32 + 8 * fq, row0 = u.pm * BM + wr * 64 + fr;
#pragma unroll
        for (int ai = 0; ai < 2; ++ai)
#pragma unroll
            for (int m = 0; m < 4; ++m) { const int row = row0 + ai * HALF + m * 16;
                const float* xrow = row < 16384 ? xp + (size_t)row * 1024 : xs + (size_t)(row - 16384) * 1024;
                float ss = 0.f;
#pragma unroll
                for (int bj = 0; bj < 2; ++bj) { const int c = col0 + bj * HALF;
                    const f32x4 y0 = *(const f32x4*)(xrow + c) + acc[ai][bj][m][0], y1 = *(const f32x4*)(xrow + c + 4) + acc[ai][bj][m][1];
                    *(f32x4*)(out + (size_t)row * 1024 + c) = y0; *(f32x4*)(out + (size_t)row * 1024 + c + 4) = y1;
                    ss += (y0[0] * y0[0] + y0[1] * y0[1]) + (y0[2] * y0[2] + y0[3] * y0[3]) + (y1[0] * y1[0] + y1[1] * y1[1]) + (y1[2] * y1[2] + y1[3] * y1[3]);
                    const f32x4 w0 = *(const f32x4*)(nfw + c), w1 = *(const f32x4*)(nfw + c + 4);
                    const f32x4 z0 = y0 * w0, z1 = y1 * w1;
                    u32x4 w; w.x = cvt_pk_bf16(z0[0], z0[1]); w.y = cvt_pk_bf16(z0[2], z0[3]); w.z = cvt_pk_bf16(z1[0], z1[1]); w.w = cvt_pk_bf16(z1[2], z1[3]);
                    *(u32x4*)(hfw + (size_t)row * 1024 + c) = w; }
                ss += __shfl_xor(ss, 16); ss += __shfl_xor(ss, 32);
                if (fq == 0) unsafeAtomicAdd(rowss + row, ss); }
    }
};

struct EpiGU {
    static constexpr bool PERM = true, AFTER_DRAIN = false, HAS_MID = false;
    bf16_t* act; const float* rowss;
    __device__ __forceinline__ void operator()(const f32x4 (&acc)[2][2][4][2], const Unit& u, int wr, int wc, int fr, int fq) const {
        const int col0 = u.pn * HALF + wc * 32 + 8 * fq, row0 = u.pm * BM + wr * 64 + fr;
#pragma unroll
        for (int ai = 0; ai < 2; ++ai)
#pragma unroll
            for (int m = 0; m < 4; ++m) { const int row = row0 + ai * HALF + m * 16;
                const float rstd = __builtin_amdgcn_rsqf(rowss[row] * (1.0f / 1024.0f) + 1e-6f);
                float o[8];
#pragma unroll
                for (int n = 0; n < 2; ++n)
#pragma unroll
                    for (int j = 0; j < 4; ++j) { const float g = acc[ai][0][m][n][j] * rstd, up = acc[ai][1][m][n][j] * rstd; o[n * 4 + j] = g * sigm(g) * up; }
                u32x4 w; w.x = cvt_pk_bf16(o[0], o[1]); w.y = cvt_pk_bf16(o[2], o[3]); w.z = cvt_pk_bf16(o[4], o[5]); w.w = cvt_pk_bf16(o[6], o[7]);
                *(u32x4*)(act + (size_t)row * 2816 + col0) = w; }
    }
};

struct EpiDown {
    static constexpr bool PERM = true, AFTER_DRAIN = false, HAS_MID = false;
    float* out;
    __device__ __forceinline__ void operator()(const f32x4 (&acc)[2][2][4][2], const Unit& u, int wr, int wc, int fr, int fq) const {
        const int col0 = u.pn * BM + wc * 32 + 8 * fq, row0 = u.pm * BM + wr * 64 + fr;
#pragma unroll
        for (int ai = 0; ai < 2; ++ai)
#pragma unroll
            for (int m = 0; m < 4; ++m) { float* rowp = out + (size_t)(row0 + ai * HALF + m * 16) * 1024 + col0;
#pragma unroll
                for (int bj = 0; bj < 2; ++bj) { const f32x4 y0 = *(const f32x4*)(rowp + bj * HALF) + acc[ai][bj][m][0], y1 = *(const f32x4*)(rowp + bj * HALF + 4) + acc[ai][bj][m][1];
                    *(f32x4*)(rowp + bj * HALF) = y0; *(f32x4*)(rowp + bj * HALF + 4) = y1; } }
    }
};

template <class Epi, class Sched, bool ALIGN_EPI = false, bool SP2 = false>
__device__ __forceinline__ void gemm_phase(PG8_LAS unsigned char* lds, const Gemm g, const Sched& S, const Epi& E) {
    const int tid = threadIdx.x, wid = __builtin_amdgcn_readfirstlane(tid >> 6), lane = tid & 63, wr = wid >> 2, wc = wid & 3, fr = lane & 15, fq = lane >> 4;
    const int K = g.K, nt = K / BK;
    unsigned voffA[2], voffB[2];
#pragma unroll
    for (int i = 0; i < 2; ++i) { int R, C; stage_rc(tid * 16 + i * 8192, R, C); const int Rb = Epi::PERM ? ((R & ~31) + perm32(R & 31)) : R;
        voffA[i] = (unsigned)(R * K + C) * 2u; voffB[i] = (unsigned)(Rb * K + C) * 2u; }
    const size_t kstep = (size_t)(BK * 2);
    const size_t hstep = (size_t)HALF * K * 2;
    const size_t tstep = 2 * hstep;
    const unsigned ldsw = (unsigned)wid * 1024u;
    const int aoff = lds_byte(wr * 64 + fr, fq * 8), boff = lds_byte(wc * 32 + fr, fq * 8);
#define PG8_SA(b, h) (((b) * 2 + (h)) * HTB)
#define PG8_SB(b, h) ((4 + (b) * 2 + (h)) * HTB)
#define PG8_STAGE(bufoff, gbase, voff) do { _Pragma("unroll") for (int _i = 0; _i < 2; ++_i) \
        __builtin_amdgcn_global_load_lds((const unsigned*)((const char*)(gbase) + (voff)[_i]), (PG8_LAS unsigned*)(lds + (bufoff) + ldsw + _i * 8192), 16, 0, 0); } while (0)
#define PG8_LDA(dst, b, h) do { _Pragma("unroll") for (int m = 0; m < 4; ++m) _Pragma("unroll") for (int k = 0; k < 2; ++k) dst[m][k] = *(const PG8_LAS bf16x8*)(lds + PG8_SA(b, h) + aoff + m * 2048 + k * 1024); } while (0)
#define PG8_LDB(dst, b, h) do { _Pragma("unroll") for (int n = 0; n < 2; ++n) _Pragma("unroll") for (int k = 0; k < 2; ++k) dst[n][k] = *(const PG8_LAS bf16x8*)(lds + PG8_SB(b, h) + boff + n * 2048 + k * 1024); } while (0)
#define PG8_MMA(ai, bj, At, Bt) do { __builtin_amdgcn_s_setprio(1); _Pragma("unroll") for (int m = 0; m < 4; ++m) _Pragma("unroll") for (int n = 0; n < 2; ++n) _Pragma("unroll") for (int k = 0; k < 2; ++k) \
        acc[ai][bj][m][n] = __builtin_amdgcn_mfma_f32_16x16x32_bf16(Bt[n][k], At[m][k], acc[ai][bj][m][n], 0, 0, 0); __builtin_amdgcn_s_setprio(0); } while (0)
#define PG8_WAIT_V(n) asm volatile("s_waitcnt vmcnt(" #n ")" ::: "memory")
#define PG8_WAIT_L(n) asm volatile("s_waitcnt lgkmcnt(" #n ")" ::: "memory")
#define PG8_BAR __builtin_amdgcn_s_barrier()
#define PG8_SCHED __builtin_amdgcn_sched_barrier(0)
    Unit cur, nxt; int ui = 0;
    if (!S.next(0, cur)) return;
    f32x4 acc[2][2][4][2];
#pragma unroll
    for (int a = 0; a < 2; ++a)
#pragma unroll
        for (int b = 0; b < 2; ++b)
#pragma unroll
            for (int m = 0; m < 4; ++m)
#pragma unroll
                for (int n = 0; n < 2; ++n) acc[a][b][m][n] = (f32x4){0.f, 0.f, 0.f, 0.f};
    bf16x8 At[4][2], B0[2][2], B1[2][2];
    const char* cA = (const char*)g.A + (size_t)cur.pm * tstep; const char* cB = (const char*)g.Bt + (size_t)cur.pn * tstep;
    S.a_ready(cur);
    if constexpr (SP2) {
        PG8_STAGE(PG8_SB(0, 0), cB, voffB); PG8_STAGE(PG8_SB(0, 1), cB + hstep, voffB); PG8_STAGE(PG8_SA(0, 0), cA, voffA); PG8_STAGE(PG8_SA(0, 1), cA + hstep, voffA);
        if (wr == 1) PG8_BAR;
        PG8_WAIT_V(2); PG8_BAR;
        PG8_STAGE(PG8_SB(1, 0), cB + kstep, voffB); PG8_STAGE(PG8_SA(1, 0), cA + kstep, voffA); PG8_STAGE(PG8_SB(1, 1), cB + hstep + kstep, voffB);
        PG8_WAIT_V(6); PG8_BAR;
    } else {
        PG8_STAGE(PG8_SB(0, 0), cB, voffB); PG8_STAGE(PG8_SA(0, 0), cA, voffA); PG8_STAGE(PG8_SB(0, 1), cB + hstep, voffB); PG8_STAGE(PG8_SA(0, 1), cA + hstep, voffA);
        if (wr == 1) PG8_BAR;
        PG8_WAIT_V(4); PG8_BAR;
        PG8_STAGE(PG8_SB(1, 0), cB + kstep, voffB); PG8_STAGE(PG8_SA(1, 0), cA + kstep, voffA); PG8_STAGE(PG8_SB(1, 1), cB + hstep + kstep, voffB);
        PG8_WAIT_V(6); PG8_BAR;
    }
    for (;;) {
        const bool has_next = S.next(ui + 1, nxt);
        const char* nA = has_next ? (const char*)g.A + (size_t)nxt.pm * tstep : cA; const char* nB = has_next ? (const char*)g.Bt + (size_t)nxt.pn * tstep : cB;
        for (int t = 0; t < nt; t += 2) {
            if constexpr (Epi::HAS_MID) { if (t == (nt >> 1)) E.mid(acc, cur, wr, wc, fr, fq); }
            const bool last = (t == nt - 2);
            const char* a1 = cA + (size_t)(t + 1) * kstep;
            const char* a2 = last ? nA : cA + (size_t)(t + 2) * kstep; const char* b2 = last ? nB : cB + (size_t)(t + 2) * kstep;
            const char* a3 = a2 + kstep; const char* b3 = b2 + kstep;
            if (last && has_next) S.a_ready(nxt);
            if constexpr (SP2) {
            PG8_LDB(B0, 0, 0); PG8_LDB(B1, 0, 1); PG8_SCHED; PG8_LDA(At, 0, 0); PG8_STAGE(PG8_SA(1, 1), a1 + hstep, voffA);
            PG8_WAIT_V(8); PG8_WAIT_L(0); PG8_BAR; PG8_MMA(0, 0, At, B0); PG8_MMA(0, 1, At, B1); PG8_BAR; PG8_SCHED;
            PG8_LDA(At, 0, 1); PG8_STAGE(PG8_SB(0, 0), b2, voffB); PG8_STAGE(PG8_SB(0, 1), b2 + hstep, voffB); PG8_STAGE(PG8_SA(0, 0), a2, voffA);
            PG8_WAIT_V(8); PG8_WAIT_L(0); PG8_BAR; PG8_MMA(1, 0, At, B0); PG8_MMA(1, 1, At, B1); PG8_BAR; PG8_SCHED;
            PG8_LDB(B0, 1, 0); PG8_LDB(B1, 1, 1); PG8_SCHED; PG8_LDA(At, 1, 0); PG8_STAGE(PG8_SA(0, 1), a2 + hstep, voffA);
            PG8_WAIT_V(8); PG8_WAIT_L(0); PG8_BAR; PG8_MMA(0, 0, At, B0); PG8_MMA(0, 1, At, B1); PG8_BAR; PG8_SCHED;
            PG8_LDA(At, 1, 1); PG8_STAGE(PG8_SB(1, 0), b3, voffB); PG8_STAGE(PG8_SB(1, 1), b3 + hstep, voffB); PG8_STAGE(PG8_SA(1, 0), a3, voffA);
            PG8_WAIT_V(8); PG8_WAIT_L(0); PG8_BAR; PG8_MMA(1, 0, At, B0); PG8_MMA(1, 1, At, B1); PG8_BAR; PG8_SCHED;
            } else {
            PG8_LDB(B0, 0, 0); PG8_SCHED; PG8_LDA(At, 0, 0); PG8_STAGE(PG8_SA(1, 1), a1 + hstep, voffA);
            PG8_WAIT_L(8); PG8_BAR; PG8_WAIT_L(0); PG8_MMA(0, 0, At, B0); PG8_BAR; PG8_SCHED;
            PG8_LDB(B1, 0, 1); PG8_STAGE(PG8_SB(0, 0), b2, voffB);
            PG8_BAR; PG8_WAIT_L(0); PG8_MMA(0, 1, At, B1); PG8_BAR;
            PG8_LDA(At, 0, 1); PG8_STAGE(PG8_SA(0, 0), a2, voffA);
            PG8_BAR; PG8_WAIT_L(0); PG8_MMA(1, 0, At, B0); PG8_BAR; PG8_SCHED;
            PG8_STAGE(PG8_SB(0, 1), b2 + hstep, voffB);
            PG8_WAIT_V(6); PG8_BAR; PG8_MMA(1, 1, At, B1); PG8_BAR;
            PG8_LDB(B0, 1, 0); PG8_SCHED; PG8_LDA(At, 1, 0); PG8_STAGE(PG8_SA(0, 1), a2 + hstep, voffA);
            PG8_WAIT_L(8); PG8_BAR; PG8_WAIT_L(0); PG8_MMA(0, 0, At, B0); PG8_BAR; PG8_SCHED;
            PG8_LDB(B1, 1, 1); PG8_STAGE(PG8_SB(1, 0), b3, voffB);
            PG8_BAR; PG8_WAIT_L(0); PG8_MMA(0, 1, At, B1); PG8_BAR;
            PG8_LDA(At, 1, 1); PG8_STAGE(PG8_SA(1, 0), a3, voffA);
            PG8_BAR; PG8_WAIT_L(0); PG8_MMA(1, 0, At, B0); PG8_BAR; PG8_SCHED;
            PG8_STAGE(PG8_SB(1, 1), b3 + hstep, voffB);
            PG8_WAIT_V(6); PG8_BAR; PG8_MMA(1, 1, At, B1); PG8_BAR;
            }
        }
        if constexpr (ALIGN_EPI) { if (wr == 0) PG8_BAR; }
        if constexpr (!Epi::AFTER_DRAIN) { E(acc, cur, wr, wc, fr, fq); S.done(cur); }
        if (!has_next) break;
#pragma unroll
        for (int a = 0; a < 2; ++a)
#pragma unroll
            for (int b = 0; b < 2; ++b)
#pragma unroll
                for (int m = 0; m < 4; ++m)
#pragma unroll
                    for (int n = 0; n < 2; ++n) acc[a][b][m][n] = (f32x4){0.f, 0.f, 0.f, 0.f};
        cur = nxt; cA = nA; cB = nB; ++ui;
        if constexpr (ALIGN_EPI) { if (wr == 1) PG8_BAR; }
    }
    PG8_WAIT_V(0);
    if constexpr (!ALIGN_EPI) { if (wr == 0) PG8_BAR; }
    PG8_BAR;
    if constexpr (Epi::AFTER_DRAIN) { E.fused(acc, cur, wr, wc, fr, fq, lds, wid, lane); S.done(cur); }
#undef PG8_SA
#undef PG8_SB
#undef PG8_STAGE
#undef PG8_LDA
#undef PG8_LDB
#undef PG8_MMA
#undef PG8_WAIT_V
#undef PG8_WAIT_L
#undef PG8_BAR
#undef PG8_SCHED
}
}
using pg8::bf16_t; using pg8::bf16x8; using pg8::f32x4; using pg8::u32x4; using pg8::cvt_pk_bf16; using pg8::bflo; using pg8::bfhi; using pg8::sigm;
typedef unsigned u32x2 __attribute__((ext_vector_type(2)));
constexpr int MP = 16384, MS = 1024, MT = MP + MS;
constexpr int DIN = 4360, NPROJ = 4352, NMIX = 2304, NGATE = 2048, DFF = 2816;
constexpr float EPS = 1e-6f, LOG2E = 1.4426950408889634f;
constexpr size_t MiB = 1u << 20;
constexpr size_t WS_ROWSS = 0;
constexpr size_t WS_SUMA = 128 * 1024, WS_SUMM = WS_SUMA + 4096, WS_MCH = WS_SUMM + 4096;
constexpr size_t WS_GI = 256 * 1024, WS_GB = WS_GI + 320 * 1024;
constexpr size_t WS_DN = 1 * MiB, WS_NPREV = WS_DN + 256 * 1024;
constexpr size_t WS_WIN = 2 * MiB;
constexpr size_t WS_WAB = WS_WIN + 17 * MiB / 2;
constexpr size_t WS_WOUT = WS_WAB + 2 * MiB;
constexpr size_t WS_WGU = WS_WOUT + 2 * MiB;
constexpr size_t WS_WD = WS_WGU + 11 * MiB;
constexpr size_t WS_HN = WS_WD + 11 * MiB / 2;
constexpr size_t OB_DCT = 34 * MiB, OB_CPT = 50 * MiB;
constexpr size_t WS_MIXIN = WS_HN + 34 * MiB;
constexpr size_t WS_GATES = WS_MIXIN + 153 * MiB / 2;
constexpr size_t WS_HCAT = WS_GATES + 68 * MiB;
constexpr size_t WS_END = WS_HCAT + 34 * MiB;
static_assert(WS_END <= 256 * MiB, "workspace map");
constexpr size_t O_Y = 0, O_CP = (size_t)MT * 1024, O_NP = O_CP + 65536, O_MP = O_NP + 512, O_KWP = O_MP + 8, O_VWP = O_KWP + 32768,
                 O_CS = O_VWP + 32768, O_NS = O_CS + 4194304, O_MS = O_NS + 32768, O_KWS = O_MS + 512, O_VWS = O_KWS + 2097152, O_END = O_VWS + 2097152;
constexpr size_t WS_BAR = 1536 * 1024;
constexpr int LDS_BYTES = 131072 + 256;

struct Params { const float* in[22]; float* out; unsigned char* ws; int ph_lo, ph_hi; };

__device__ __forceinline__ float bf2f(bf16_t h) { return __builtin_bit_cast(float, (unsigned)h << 16); }
__device__ __forceinline__ bf16_t f2bf(float f) { return (bf16_t)(cvt_pk_bf16(f, 0.f) & 0xffffu); }
__device__ __forceinline__ float wave_sum(float v) {
#pragma unroll
    for (int o = 1; o < 64; o <<= 1) v += __shfl_xor(v, o);
    return v; }
__device__ __forceinline__ float wave_max(float v) {
#pragma unroll
    for (int o = 1; o < 64; o <<= 1) v = fmaxf(v, __shfl_xor(v, o));
    return v; }
__device__ __forceinline__ f32x4 mfma16(bf16x8 a, bf16x8 b, f32x4 c) { f32x4 d = __builtin_amdgcn_mfma_f32_16x16x32_bf16(a, b, c, 0, 0, 0); asm volatile("" : "+v"(d) : "v"(a), "v"(b)); return d; }
__device__ __forceinline__ bf16x8 pack8(const f32x4& a, const f32x4& b) { u32x4 t; t.x = cvt_pk_bf16(a[0], a[1]); t.y = cvt_pk_bf16(a[2], a[3]); t.z = cvt_pk_bf16(b[0], b[1]); t.w = cvt_pk_bf16(b[2], b[3]); return __builtin_bit_cast(bf16x8, t); }
__device__ __forceinline__ void unpack8(const u32x4& r, float* f) { f[0] = bflo(r.x); f[1] = bfhi(r.x); f[2] = bflo(r.y); f[3] = bfhi(r.y); f[4] = bflo(r.z); f[5] = bfhi(r.z); f[6] = bflo(r.w); f[7] = bfhi(r.w); }

__device__ __forceinline__ void p0_tokens(const Params& P, unsigned char* lds, int tid, int G) {
    const float* wg = (const float*)lds; const float* nw = P.in[7];
    bf16_t* HN = (bf16_t*)(P.ws + WS_HN); float* gi = (float*)(P.ws + WS_GI); float* gb = (float*)(P.ws + WS_GB);
    const int lane = tid & 63, w = tid >> 6;
#pragma unroll 1
    for (int r = blockIdx.x * 8 + w; r < MT; r += G * 8) {
        const float* xrow = r < MP ? P.in[0] + (size_t)r * 1024 : P.in[1] + (size_t)(r - MP) * 1024;
        f32x4 xv[4]; float ss = 0.f;
#pragma unroll
        for (int j = 0; j < 4; ++j) { xv[j] = ((const f32x4*)xrow)[lane + 64 * j]; ss += (xv[j][0] * xv[j][0] + xv[j][1] * xv[j][1]) + (xv[j][2] * xv[j][2] + xv[j][3] * xv[j][3]); }
        ss = wave_sum(ss);
        const float rstd = 1.0f / sqrtf(ss * (1.0f / 1024.0f) + EPS);
        float g[8];
#pragma unroll
        for (int q = 0; q < 8; ++q) g[q] = 0.f;
#pragma unroll
        for (int j = 0; j < 4; ++j) { const int k0 = 4 * (lane + 64 * j);
            const f32x4 nv = *(const f32x4*)(nw + k0); const f32x4 hv = xv[j] * rstd * nv;
            u32x2 pk; pk.x = cvt_pk_bf16(hv[0], hv[1]); pk.y = cvt_pk_bf16(hv[2], hv[3]);
            *(u32x2*)(HN + (size_t)r * 1024 + k0) = pk;
#pragma unroll
            for (int q = 0; q < 8; ++q) { const f32x4 wv = *(const f32x4*)(wg + q * 1024 + k0); g[q] += (xv[j][0] * wv[0] + xv[j][1] * wv[1]) + (xv[j][2] * wv[2] + xv[j][3] * wv[3]); } }
#pragma unroll
        for (int q = 0; q < 8; ++q) g[q] = wave_sum(g[q]);
        if (lane < 4) { const float iv = (lane == 0 ? g[0] : lane == 1 ? g[1] : lane == 2 ? g[2] : g[3]) * rstd + P.in[9][lane];
            const float fv = (lane == 0 ? g[4] : lane == 1 ? g[5] : lane == 2 ? g[6] : g[7]) * rstd + P.in[10][lane];
            gi[r * 4 + lane] = iv; gb[r * 4 + lane] = fminf(fv, 0.f) - log1pf(expf(-fabsf(fv))); }
    }
}
template <bool GU>
__device__ __forceinline__ void p0_wunit(const float* src, int ldsrc, int k0, int c0, bf16_t* dst, int lddst, int n0, int k0d, unsigned char* lds, int tid) {
    float* tile = (float*)(lds + 40960);
    f32x4 v[8];
#pragma unroll
    for (int p = 0; p < 8; ++p) v[p] = *(const f32x4*)(src + (size_t)(k0 + (tid >> 6) + 8 * p) * ldsrc + c0 + (tid & 63) * 4);
#pragma unroll
    for (int p = 0; p < 8; ++p) *(f32x4*)(tile + ((tid >> 6) + 8 * p) * 260 + (tid & 63) * 4) = v[p];
    __syncthreads();
    { const int n = tid >> 1, kc = (tid & 1) * 32; const float* s = tile + kc * 260 + n;
        const int nd = GU ? (256 * ((c0 + n) >> 7) + ((c0 + n) & 127) + n0) : (n0 + n);
        bf16_t* dp = dst + (size_t)nd * lddst + k0d + kc;
#pragma unroll
        for (int q = 0; q < 4; ++q) { u32x4 o; o.x = cvt_pk_bf16(s[(8 * q) * 260], s[(8 * q + 1) * 260]); o.y = cvt_pk_bf16(s[(8 * q + 2) * 260], s[(8 * q + 3) * 260]);
            o.z = cvt_pk_bf16(s[(8 * q + 4) * 260], s[(8 * q + 5) * 260]); o.w = cvt_pk_bf16(s[(8 * q + 6) * 260], s[(8 * q + 7) * 260]); *(u32x4*)(dp + 8 * q) = o; } }
    __syncthreads();
}
constexpr int NT_IN = 17 * 16, NT_AB = 64, NT_OUT = 64, NT_GU = 352, NT_D = 176, NT_ALL = NT_IN + NT_AB + NT_OUT + NT_GU + NT_D;
__device__ __forceinline__ void wtile_by_index(const Params& P, int r, unsigned char* lds, int tid) {
    if (r < NT_IN) { const int nt = r >> 4, kt = r & 15, c0 = nt * 256; p0_wunit<false>(P.in[8], DIN, kt * 64, c0 < 1536 ? c0 : c0 + 8, (bf16_t*)(P.ws + WS_WIN), 1024, c0, kt * 64, lds, tid); return; } r -= NT_IN;
    if (r < NT_AB) { const int which = r >> 5, rr = r & 31, nt = rr >> 3, kt = rr & 7; p0_wunit<false>(which ? P.in[16] : P.in[15], 1024, kt * 64, nt * 256, (bf16_t*)(P.ws + WS_WAB), 1024, nt * 256, which * 512 + kt * 64, lds, tid); return; } r -= NT_AB;
    if (r < NT_OUT) { const int nt = r >> 4, kt = r & 15; p0_wunit<false>(P.in[17], 1024, kt * 64, nt * 256, (bf16_t*)(P.ws + WS_WOUT), 1024, nt * 256, kt * 64, lds, tid); return; } r -= NT_OUT;
    if (r < NT_GU) { const int which = r / 176, rr = r % 176, jt = rr >> 4, kt = rr & 15; p0_wunit<true>(which ? P.in[20] : P.in[19], DFF, kt * 64, jt * 256, (bf16_t*)(P.ws + WS_WGU), 1024, which * 128, kt * 64, lds, tid); return; } r -= NT_GU;
    { const int nt = r / 44, kt = r % 44; p0_wunit<false>(P.in[21], 1024, kt * 64, nt * 256, (bf16_t*)(P.ws + WS_WD), DFF, nt * 256, kt * 64, lds, tid); }
}
__device__ __forceinline__ void p0_prep(const Params& P, unsigned char* lds, int tid, int G) {
    float* rowss = (float*)(P.ws + WS_ROWSS);
    for (int i = blockIdx.x * 512 + tid; i < MT; i += G * 512) rowss[i] = 0.f;
    { float* wg = (float*)lds; const float* w_in = P.in[8]; const float* nw = P.in[7];
        for (int idx = tid; idx < 8192; idx += 512) { const int k = idx >> 3, q = idx & 7; wg[q * 1024 + k] = w_in[(size_t)k * DIN + 1536 + q] * nw[k]; } }
    __syncthreads();
    p0_tokens(P, lds, tid, G);
    __syncthreads();
    for (int it = blockIdx.x; it < NT_IN; it += G) wtile_by_index(P, it, lds, tid);
}

template <int NQT>
__device__ __forceinline__ void attn_core(const unsigned char* lds, const bf16x8 (&qf)[NQT][2], int kt_lo, int kt_hi, int qbase, int jmin, float sink2, f32x4 (&o)[4][NQT], float (&l)[NQT]) {
    const bf16_t* Ks = (const bf16_t*)lds; const bf16_t* Vt = (const bf16_t*)(lds + 36864);
    const int lane = threadIdx.x & 63, fr = lane & 15, g = lane >> 4;
    float mrun[NQT];
#pragma unroll
    for (int qt = 0; qt < NQT; ++qt) { mrun[qt] = sink2; l[qt] = (g == 0) ? 1.f : 0.f;
#pragma unroll
        for (int dt = 0; dt < 4; ++dt) o[dt][qt] = (f32x4){0.f, 0.f, 0.f, 0.f}; }
#pragma unroll 1
    for (int kt = kt_lo; kt <= kt_hi; ++kt) {
        f32x4 s[4][NQT];
#pragma unroll
        for (int ks = 0; ks < 4; ++ks)
#pragma unroll
            for (int qt = 0; qt < NQT; ++qt) s[ks][qt] = (f32x4){0.f, 0.f, 0.f, 0.f};
#pragma unroll
        for (int ks = 0; ks < 4; ++ks)
#pragma unroll
            for (int kk = 0; kk < 2; ++kk) { const bf16x8 kf = *(const bf16x8*)(Ks + (kt * 64 + ks * 16 + fr) * 72 + g * 8 + kk * 32);
#pragma unroll
                for (int qt = 0; qt < NQT; ++qt) s[ks][qt] = mfma16(kf, qf[qt][kk], s[ks][qt]); }
#pragma unroll
        for (int qt = 0; qt < NQT; ++qt) { const int qi = qbase + 16 * qt + fr; float mx = -1e30f;
#pragma unroll
            for (int ks = 0; ks < 4; ++ks)
#pragma unroll
                for (int r = 0; r < 4; ++r) { const int j = kt * 64 + ks * 16 + g * 4 + r; const bool ok = (j > qi) && (j <= qi + 128) && (j >= jmin);
                    const float v = ok ? s[ks][qt][r] : -1e30f; s[ks][qt][r] = v; mx = fmaxf(mx, v); }
            mx = fmaxf(mx, __shfl_xor(mx, 16)); mx = fmaxf(mx, __shfl_xor(mx, 32));
            const float mnew = fmaxf(mrun[qt], mx), alpha = __builtin_amdgcn_exp2f(mrun[qt] - mnew); mrun[qt] = mnew;
            float ps = 0.f;
#pragma unroll
            for (int ks = 0; ks < 4; ++ks)
#pragma unroll
                for (int r = 0; r < 4; ++r) { const float p = __builtin_amdgcn_exp2f(s[ks][qt][r] - mnew); s[ks][qt][r] = p; ps += p; }
            l[qt] = l[qt] * alpha + ps;
#pragma unroll
            for (int dt = 0; dt < 4; ++dt) o[dt][qt] = o[dt][qt] * alpha; }
#pragma unroll
        for (int c = 0; c < 2; ++c) { bf16x8 pf[NQT];
#pragma unroll
            for (int qt = 0; qt < NQT; ++qt) pf[qt] = pack8(s[2 * c][qt], s[2 * c + 1][qt]);
#pragma unroll
            for (int dt = 0; dt < 4; ++dt) { const bf16_t* vp = Vt + (dt * 16 + fr) * 264 + kt * 64 + c * 32 + g * 4;
                const u32x2 v0 = *(const u32x2*)vp, v1 = *(const u32x2*)(vp + 16);
                const bf16x8 vf = __builtin_bit_cast(bf16x8, (u32x4){v0.x, v0.y, v1.x, v1.y});
#pragma unroll
                for (int qt = 0; qt < NQT; ++qt) o[dt][qt] = mfma16(vf, pf[qt], o[dt][qt]); } }
    }
}
__device__ __forceinline__ void attn_put(unsigned char* lds, int slot, int hh, const float* kf, const float* vf) {
    bf16_t* Ks = (bf16_t*)lds; bf16_t* Vt = (bf16_t*)(lds + 36864);
#pragma unroll
    for (int i = 0; i < 4; ++i) { u32x4 w; w.x = cvt_pk_bf16(kf[8 * i], kf[8 * i + 1]); w.y = cvt_pk_bf16(kf[8 * i + 2], kf[8 * i + 3]); w.z = cvt_pk_bf16(kf[8 * i + 4], kf[8 * i + 5]); w.w = cvt_pk_bf16(kf[8 * i + 6], kf[8 * i + 7]);
        *(u32x4*)(Ks + slot * 72 + hh * 32 + 8 * i) = w; }
#pragma unroll
    for (int i = 0; i < 32; ++i) Vt[(hh * 32 + i) * 264 + slot] = f2bf(vf[i]);
}
__device__ __forceinline__ void attn_prompt_item(const Params& P, int item, unsigned char* lds, int tid) {
    const int kvh = item & 1, n = (item >> 1) & 63, b = item >> 7;
    const bf16_t* mixin = (const bf16_t*)(P.ws + WS_MIXIN);
    { const int slot = tid >> 1, hh = tid & 1, tokb = n * 128 - 128 + slot;
        float kf[32], vf[32];
        if (tokb >= 0) { const bf16_t* rowp = mixin + (size_t)(b * 8192 + tokb) * NMIX + 2048 + kvh * 64 + hh * 32;
#pragma unroll
            for (int i = 0; i < 4; ++i) { const u32x4 kr = *(const u32x4*)(rowp + 8 * i), vr = *(const u32x4*)(rowp + 128 + 8 * i); unpack8(kr, kf + 8 * i); unpack8(vr, vf + 8 * i); } }
        else {
#pragma unroll
            for (int i = 0; i < 32; ++i) { kf[i] = 0.f; vf[i] = 0.f; } }
        float ss = 0.f;
#pragma unroll
        for (int i = 0; i < 32; ++i) ss += kf[i] * kf[i];
        ss += __shfl_xor(ss, 1);
        const float rstd = 1.0f / sqrtf(ss * (1.0f / 64.0f) + EPS);
#pragma unroll
        for (int i = 0; i < 32; ++i) kf[i] = kf[i] * rstd * P.in[13][hh * 32 + i];
        attn_put(lds, slot, hh, kf, vf);
        if (n == 63 && slot >= 128) { float* kw = P.out + O_KWP + ((size_t)(b * 128 + slot - 128) * 2 + kvh) * 64 + hh * 32; float* vw = P.out + O_VWP + ((size_t)(b * 128 + slot - 128) * 2 + kvh) * 64 + hh * 32;
#pragma unroll
            for (int i = 0; i < 8; ++i) { *(f32x4*)(kw + 4 * i) = (f32x4){kf[4 * i], kf[4 * i + 1], kf[4 * i + 2], kf[4 * i + 3]}; *(f32x4*)(vw + 4 * i) = (f32x4){vf[4 * i], vf[4 * i + 1], vf[4 * i + 2], vf[4 * i + 3]}; } }
    }
    __syncthreads();
    const int w = tid >> 6, lane = tid & 63, fr = lane & 15, g = lane >> 4, gq = w >> 1, half = w & 1, head = kvh * 4 + gq;
    bf16_t* hcat = (bf16_t*)(P.ws + WS_HCAT);
#pragma unroll 1
    for (int qh = 0; qh < 2; ++qh) {
    bf16x8 qf[2][2];
#pragma unroll
    for (int qt = 0; qt < 2; ++qt) { const int tok = b * 8192 + n * 128 + half * 64 + qh * 32 + qt * 16 + fr; const bf16_t* qp = mixin + (size_t)tok * NMIX + 1536 + head * 64 + g * 8;
        float f0[8], f1[8]; unpack8(*(const u32x4*)qp, f0); unpack8(*(const u32x4*)(qp + 32), f1);
        float ss = 0.f;
#pragma unroll
        for (int i = 0; i < 8; ++i) ss += f0[i] * f0[i] + f1[i] * f1[i];
        ss += __shfl_xor(ss, 16); ss += __shfl_xor(ss, 32);
        const float sc = (0.125f * LOG2E) / sqrtf(ss * (1.0f / 64.0f) + EPS);
#pragma unroll
        for (int i = 0; i < 8; ++i) { f0[i] = f0[i] * sc * P.in[12][g * 8 + i]; f1[i] = f1[i] * sc * P.in[12][32 + g * 8 + i]; }
        qf[qt][0] = pack8((f32x4){f0[0], f0[1], f0[2], f0[3]}, (f32x4){f0[4], f0[5], f0[6], f0[7]}); qf[qt][1] = pack8((f32x4){f1[0], f1[1], f1[2], f1[3]}, (f32x4){f1[4], f1[5], f1[6], f1[7]}); }
    f32x4 o[4][2]; float l[2];
    attn_core<2>(lds, qf, half, half + 2, half * 64 + qh * 32, n == 0 ? 128 : 0, P.in[14][head] * LOG2E, o, l);
#pragma unroll
    for (int qt = 0; qt < 2; ++qt) { float lt = l[qt]; lt += __shfl_xor(lt, 16); lt += __shfl_xor(lt, 32); const float inv = 1.0f / lt;
        const int tok = b * 8192 + n * 128 + half * 64 + qh * 32 + qt * 16 + fr;
#pragma unroll
        for (int dt = 0; dt < 4; ++dt) { const f32x4 v = o[dt][qt] * inv; u32x2 pk; pk.x = cvt_pk_bf16(v[0], v[1]); pk.y = cvt_pk_bf16(v[2], v[3]);
            *(u32x2*)(hcat + (size_t)tok * 1024 + 512 + head * 64 + dt * 16 + g * 4) = pk; } }
    }
    __syncthreads();
}
__device__ __forceinline__ void attn_sample_item(const Params& P, int item, unsigned char* lds, int tid) {
    const int kvh = item & 1, b = item >> 1;
    const bf16_t* mixin = (const bf16_t*)(P.ws + WS_MIXIN);
    { const int slot = tid >> 1, hh = tid & 1;
        if (slot < 192) { float kf[32], vf[32];
            if (slot < 128) { const size_t off = ((size_t)(b * 128 + slot) * 2 + kvh) * 64 + hh * 32; const float* kp = P.in[5] + off; const float* vp = P.in[6] + off;
#pragma unroll
                for (int i = 0; i < 8; ++i) { const f32x4 a = *(const f32x4*)(kp + 4 * i), c = *(const f32x4*)(vp + 4 * i);
                    kf[4 * i] = a[0]; kf[4 * i + 1] = a[1]; kf[4 * i + 2] = a[2]; kf[4 * i + 3] = a[3]; vf[4 * i] = c[0]; vf[4 * i + 1] = c[1]; vf[4 * i + 2] = c[2]; vf[4 * i + 3] = c[3]; } }
            else if (slot < 136) { const bf16_t* rowp = mixin + (size_t)(MP + b * 8 + slot - 128) * NMIX + 2048 + kvh * 64 + hh * 32;
#pragma unroll
                for (int i = 0; i < 4; ++i) { const u32x4 kr = *(const u32x4*)(rowp + 8 * i), vr = *(const u32x4*)(rowp + 128 + 8 * i); unpack8(kr, kf + 8 * i); unpack8(vr, vf + 8 * i); }
                float ss = 0.f;
#pragma unroll
                for (int i = 0; i < 32; ++i) ss += kf[i] * kf[i];
                ss += __shfl_xor(ss, 1);
                const float rstd = 1.0f / sqrtf(ss * (1.0f / 64.0f) + EPS);
#pragma unroll
                for (int i = 0; i < 32; ++i) kf[i] = kf[i] * rstd * P.in[13][hh * 32 + i]; }
            else {
#pragma unroll
                for (int i = 0; i < 32; ++i) { kf[i] = 0.f; vf[i] = 0.f; } }
            attn_put(lds, slot, hh, kf, vf);
            if (slot >= 8 && slot < 136) { const size_t off = ((size_t)(b * 128 + slot - 8) * 2 + kvh) * 64 + hh * 32; float* kw = P.out + O_KWS + off; float* vw = P.out + O_VWS + off;
#pragma unroll
                for (int i = 0; i < 8; ++i) { *(f32x4*)(kw + 4 * i) = (f32x4){kf[4 * i], kf[4 * i + 1], kf[4 * i + 2], kf[4 * i + 3]}; *(f32x4*)(vw + 4 * i) = (f32x4){vf[4 * i], vf[4 * i + 1], vf[4 * i + 2], vf[4 * i + 3]}; } }
        }
    }
    __syncthreads();
    const int w = tid >> 6, lane = tid & 63, fr = lane & 15, g = lane >> 4;
    if (w < 4) { const int head = kvh * 4 + w; const int tok = MP + b * 8 + (fr & 7);
        bf16x8 qf[1][2];
        { const bf16_t* qp = mixin + (size_t)tok * NMIX + 1536 + head * 64 + g * 8;
            float f0[8], f1[8]; unpack8(*(const u32x4*)qp, f0); unpack8(*(const u32x4*)(qp + 32), f1);
            float ss = 0.f;
#pragma unroll
            for (int i = 0; i < 8; ++i) ss += f0[i] * f0[i] + f1[i] * f1[i];
            ss += __shfl_xor(ss, 16); ss += __shfl_xor(ss, 32);
            const float sc = (0.125f * LOG2E) / sqrtf(ss * (1.0f / 64.0f) + EPS);
#pragma unroll
            for (int i = 0; i < 8; ++i) { f0[i] = f0[i] * sc * P.in[12][g * 8 + i]; f1[i] = f1[i] * sc * P.in[12][32 + g * 8 + i]; }
            qf[0][0] = pack8((f32x4){f0[0], f0[1], f0[2], f0[3]}, (f32x4){f0[4], f0[5], f0[6], f0[7]}); qf[0][1] = pack8((f32x4){f1[0], f1[1], f1[2], f1[3]}, (f32x4){f1[4], f1[5], f1[6], f1[7]}); }
        f32x4 o[4][1]; float l[1];
        attn_core<1>(lds, qf, 0, 2, 0, 0, P.in[14][head] * LOG2E, o, l);
        float lt = l[0]; lt += __shfl_xor(lt, 16); lt += __shfl_xor(lt, 32); const float inv = 1.0f / lt;
        bf16_t* hcat = (bf16_t*)(P.ws + WS_HCAT);
        if (fr < 8) {
#pragma unroll
            for (int dt = 0; dt < 4; ++dt) { const f32x4 v = o[dt][0] * inv; u32x2 pk; pk.x = cvt_pk_bf16(v[0], v[1]); pk.y = cvt_pk_bf16(v[2], v[3]);
                *(u32x2*)(hcat + (size_t)tok * 1024 + 512 + head * 64 + dt * 16 + g * 4) = pk; } }
    }
    __syncthreads();
}
#define LAS __attribute__((address_space(3)))
#define XB_TMO      128
#define XB_XCNT(j)  (256  + 64 * (j))
#define XB_XSUB(j)  (1280 + 64 * (j))
#define XB_XGEN(j)  (2304 + 64 * (j))
#define XB_TOP      3328
#define XB_TOPGEN   3392
#define XCD_BAR_WORDS 3456
#define XB_SPIN_CAP (1u << 18)

__device__ __forceinline__ unsigned xb_ld(unsigned* p)              { return __hip_atomic_load(p, __ATOMIC_RELAXED, __HIP_MEMORY_SCOPE_AGENT); }
__device__ __forceinline__ unsigned xb_add(unsigned* p, unsigned v) { return __hip_atomic_fetch_add(p, v, __ATOMIC_RELAXED, __HIP_MEMORY_SCOPE_AGENT); }
__device__ __forceinline__ unsigned xb_xcc_id() { return (unsigned)__builtin_amdgcn_s_getreg((3 << 11) | 20) & 0xFu; }
#define XB_SPIN(cond, bar) do { unsigned _sp = 0; while (cond) { __builtin_amdgcn_s_sleep(1); \
    if ((++_sp & 255u) == 0u) { if (xb_ld(&(bar)[XB_TMO])) break; if (_sp > XB_SPIN_CAP) { atomicAdd(&(bar)[XB_TMO], 1u); break; } } } } while (0)

struct XcdBarrier {
    unsigned* bar; unsigned x;
    volatile LAS unsigned* st;
};

__device__ __forceinline__ XcdBarrier xcd_barrier_post(unsigned* bar, volatile LAS unsigned* st) {
    XcdBarrier b; b.bar = bar; b.x = xb_xcc_id(); b.st = st;
    if (threadIdx.x == 0) (void)xb_add(&bar[XB_XCNT(b.x)], 1u);
    return b;
}
__device__ __forceinline__ void xcd_barrier_complete(unsigned* bar, unsigned x, unsigned& nloc, unsigned& nx) {
    const unsigned G = gridDim.x * gridDim.y * gridDim.z;
    unsigned sum, cnt, mine, sp = 0u;
    for (;;) {
        sum = 0u; cnt = 0u; mine = 0u;
#pragma unroll
        for (unsigned j = 0; j < 16; ++j) { const unsigned c = xb_ld(&bar[XB_XCNT(j)]); sum += c; cnt += (c > 0u) ? 1u : 0u; mine = (j == x) ? c : mine; }
        if (sum == G) break;
        __builtin_amdgcn_s_sleep(1);
        if ((++sp & 255u) == 0u) { if (xb_ld(&bar[XB_TMO])) break; if (sp > XB_SPIN_CAP) { atomicAdd(&bar[XB_TMO], 1u); break; } }
    }
    nloc = mine > 0u ? mine : 1u; nx = cnt > 0u ? cnt : 1u;
}

__device__ __forceinline__ void xcd_barrier(const XcdBarrier& b) {
    asm volatile("s_waitcnt vmcnt(0)" ::: "memory");
    __syncthreads();
    if (threadIdx.x == 0) {
        unsigned* bar = b.bar;
        __builtin_amdgcn_s_waitcnt(0);
        unsigned nloc = b.st[0], nx = b.st[1];
        if (nloc == 0u) { xcd_barrier_complete(bar, b.x, nloc, nx); b.st[0] = nloc; b.st[1] = nx; }
        const unsigned old = xb_add(&bar[XB_XSUB(b.x)], 1u);
        const unsigned gen = old / nloc;
        if (old + 1u == (gen + 1u) * nloc) {
            __builtin_amdgcn_fence(__ATOMIC_RELEASE, "agent");
            asm volatile("s_waitcnt vmcnt(0)" ::: "memory");
            const unsigned og = xb_add(&bar[XB_TOP], 1u);
            const unsigned tg = og / nx;
            if (og + 1u == (tg + 1u) * nx) xb_add(&bar[XB_TOPGEN], 1u);
            else XB_SPIN(xb_ld(&bar[XB_TOPGEN]) == tg, bar);
            __builtin_amdgcn_fence(__ATOMIC_ACQUIRE, "agent");
            xb_add(&bar[XB_XGEN(b.x)], 1u);
            asm volatile("s_waitcnt vmcnt(0)" ::: "memory");
        } else {
            XB_SPIN(xb_ld(&bar[XB_XGEN(b.x)]) == gen, bar);
            __builtin_amdgcn_fence(__ATOMIC_ACQUIRE, "agent");
            asm volatile("s_waitcnt vmcnt(0)" ::: "memory");
        }
    }
    __syncthreads();
}
__device__ __forceinline__ void mlstm_b_item(const Params& P, int item, unsigned char* lds, int tid) {
    const int c = item & 127, h = (item >> 7) & 3, b = item >> 9, r0 = b * 8192 + c * 64;
    float* wl = (float*)lds; bf16_t* Kt = (bf16_t*)(lds + 256); bf16_t* Vt = (bf16_t*)(lds + 256 + 9216);
    const bf16_t* mixin = (const bf16_t*)(P.ws + WS_MIXIN);
    if (tid < 64) { const float iv = ((const float*)(P.ws + WS_GI))[(r0 + tid) * 4 + h]; float bb = ((const float*)(P.ws + WS_GB))[(r0 + tid) * 4 + h];
#pragma unroll
        for (int o = 1; o < 64; o <<= 1) { const float nb = __shfl_up(bb, o); if (tid >= o) bb += nb; }
        const float A = __shfl(bb, 63), v = A - bb + iv, M = wave_max(v); wl[tid] = __expf(v - M) * 0.125f;
        if (tid == 0) { ((float*)(P.ws + WS_SUMA))[item] = A; ((float*)(P.ws + WS_SUMM))[item] = M; } }
    __syncthreads();
    { const int s = tid >> 3, ch = tid & 7; const bf16_t* rowp = mixin + (size_t)(r0 + s) * NMIX; const float ws_ = wl[s];
        float kf[8]; unpack8(*(const u32x4*)(rowp + 256 + h * 64 + ch * 8), kf);
#pragma unroll
        for (int i = 0; i < 8; ++i) Kt[(ch * 8 + i) * 72 + s] = f2bf(kf[i] * ws_);
        const u32x4 v0 = *(const u32x4*)(rowp + 512 + h * 128 + ch * 16), v1 = *(const u32x4*)(rowp + 512 + h * 128 + ch * 16 + 8);
        const unsigned vv[8] = {v0.x, v0.y, v0.z, v0.w, v1.x, v1.y, v1.z, v1.w};
#pragma unroll
        for (int i = 0; i < 8; ++i) { Vt[(ch * 16 + 2 * i) * 72 + s] = (bf16_t)(vv[i] & 0xffffu); Vt[(ch * 16 + 2 * i + 1) * 72 + s] = (bf16_t)(vv[i] >> 16); } }
    __syncthreads();
    { const int w = tid >> 6, lane = tid & 63, fr = lane & 15, g = lane >> 4, e0 = 16 * w;
        f32x4 acc[4];
#pragma unroll
        for (int dt = 0; dt < 4; ++dt) acc[dt] = (f32x4){0.f, 0.f, 0.f, 0.f};
#pragma unroll
        for (int kk = 0; kk < 2; ++kk) { const bf16x8 vf = *(const bf16x8*)(Vt + (e0 + fr) * 72 + g * 8 + kk * 32);
#pragma unroll
            for (int dt = 0; dt < 4; ++dt) { const bf16x8 kf = *(const bf16x8*)(Kt + (dt * 16 + fr) * 72 + g * 8 + kk * 32); acc[dt] = mfma16(kf, vf, acc[dt]); } }
        bf16_t* dct = (bf16_t*)((unsigned char*)P.out + OB_DCT) + ((size_t)item * 128 + e0 + fr) * 64;
#pragma unroll
        for (int dt = 0; dt < 4; ++dt) { u32x2 pk; pk.x = cvt_pk_bf16(acc[dt][0], acc[dt][1]); pk.y = cvt_pk_bf16(acc[dt][2], acc[dt][3]); *(u32x2*)(dct + dt * 16 + g * 4) = pk; } }
    if (tid < 64) { float sum = 0.f;
#pragma unroll 8
        for (int s = 0; s < 64; ++s) sum += bf2f(Kt[tid * 72 + s]);
        ((float*)(P.ws + WS_DN))[item * 64 + tid] = sum; }
    __syncthreads();
}
__device__ __forceinline__ void mlstm_scan(const Params& P, unsigned char* lds, int tid) {
    const int pair = blockIdx.x >> 3, sub = blockIdx.x & 7;
    float* ga = (float*)lds; float* ea = ga + 128; float* marr = ea + 128;
    if (tid < 128) { ga[tid] = ((const float*)(P.ws + WS_SUMA))[pair * 128 + tid]; ea[tid] = ((const float*)(P.ws + WS_SUMM))[pair * 128 + tid]; }
    __syncthreads();
    if (tid == 0) { float m = 0.f; const float* sA = ga; const float* sM = ea;
        for (int c = 0; c < 128; ++c) { const float A = sA[c], Mv = sM[c], mn = fmaxf(A + m, Mv); ga[c] = __expf(A + m - mn); ea[c] = __expf(Mv - mn); m = mn; marr[c] = mn; } }
    __syncthreads();
    if (sub == 0) { if (tid < 128) ((float*)(P.ws + WS_MCH))[pair * 128 + tid] = marr[tid]; if (tid == 0) P.out[O_MP + pair] = marr[127]; }
#ifndef P3_SCANMASK
#define P3_SCANMASK 3
#endif
    if (P3_SCANMASK & 1) { const int idx2 = sub * 512 + tid; float C0 = 0.f, C1 = 0.f;
        const unsigned* src = (const unsigned*)((unsigned char*)P.out + OB_DCT) + (size_t)pair * 128 * 4096 + idx2; unsigned* dst = (unsigned*)((unsigned char*)P.out + OB_CPT) + (size_t)pair * 128 * 4096 + idx2;
#pragma unroll 1
        for (int c = 0; c < 128; c += 32) { unsigned v[32];
#pragma unroll
            for (int j = 0; j < 32; ++j) v[j] = src[(size_t)(c + j) * 4096];
#pragma unroll
            for (int j = 0; j < 32; ++j) { dst[(size_t)(c + j) * 4096] = cvt_pk_bf16(C0, C1); const float gg = ga[c + j], ee = ea[c + j]; C0 = gg * C0 + ee * bflo(v[j]); C1 = gg * C1 + ee * bfhi(v[j]); } }
        const int i0 = 2 * idx2, e = i0 >> 6, d = i0 & 63;
        P.out[O_CP + ((size_t)pair * 64 + d) * 128 + e] = C0; P.out[O_CP + ((size_t)pair * 64 + d + 1) * 128 + e] = C1; }
    if ((P3_SCANMASK & 2) && sub == 0 && tid < 64) { float nn = 0.f; const float* dn = (const float*)(P.ws + WS_DN) + (size_t)pair * 128 * 64 + tid; float* np = (float*)(P.ws + WS_NPREV) + (size_t)pair * 128 * 64 + tid;
        for (int c = 0; c < 128; ++c) { np[c * 64] = nn; nn = ga[c] * nn + ea[c] * dn[c * 64]; }
        P.out[O_NP + pair * 64 + tid] = nn; }
    __syncthreads();
}
__device__ __forceinline__ void mlstm_sample_item(const Params& P, int item, unsigned char* lds, int tid) {
    const int h = item & 3, b = item >> 2, r0 = MP + b * 8;
    float* q = (float*)lds; float* k = q + 512; float* v = k + 512; float* sw = v + 1024; float* sc = sw + 64; float* n0s = sc + 64; float* part = n0s + 64; float* red = part + 4096;
    const bf16_t* mixin = (const bf16_t*)(P.ws + WS_MIXIN);
    if (tid < 256) {
        const int sel = tid >> 6, i = tid & 63;
        if (sel < 2) { const int t = i >> 3, p = i & 7; float f[8]; unpack8(*(const u32x4*)(mixin + (size_t)(r0 + t) * NMIX + sel * 256 + h * 64 + p * 8), f);
            float* dst = (sel ? k : q) + t * 64 + p * 8; const float sc_ = sel ? 0.125f : 1.0f;
#pragma unroll
            for (int j = 0; j < 8; ++j) dst[j] = f[j] * sc_; }
        else { const int i2 = tid - 128, t = i2 >> 4, p = i2 & 15; float f[8]; unpack8(*(const u32x4*)(mixin + (size_t)(r0 + t) * NMIX + 512 + h * 128 + p * 8), f);
#pragma unroll
            for (int j = 0; j < 8; ++j) v[t * 128 + p * 8 + j] = f[j]; } }
    if (tid < 64) n0s[tid] = P.in[3][(b * 4 + h) * 64 + tid];
    if (tid < 8) { float lf[8];
#pragma unroll
        for (int s = 0; s < 8; ++s) lf[s] = ((const float*)(P.ws + WS_GB))[(r0 + s) * 4 + h];
        float bb = 0.f;
#pragma unroll
        for (int s = 0; s < 8; ++s) bb += (s <= tid) ? lf[s] : 0.f;
        sc[tid] = bb; sc[8 + tid] = ((const float*)(P.ws + WS_GI))[(r0 + tid) * 4 + h] - bb; }
    __syncthreads();
    const float mprev = P.in[4][b * 4 + h];
    if (tid < 8) { float cm = mprev; for (int s = 0; s <= tid; ++s) cm = fmaxf(cm, sc[8 + s]); const float mt = sc[tid] + cm; sc[16 + tid] = mt; sc[24 + tid] = __expf(sc[tid] + mprev - mt); }
    __syncthreads();
    if (tid < 8) { const float b7 = sc[7], m7 = sc[23]; sc[32 + tid] = __expf(b7 + sc[8 + tid] - m7); if (tid == 0) { sc[48] = __expf(b7 + mprev - m7); P.out[O_MS + b * 4 + h] = m7; } }
    if (tid >= 64 && tid < 128) { const int i = tid - 64, t = i >> 3, s = i & 7; float dot = 0.f;
        for (int d = 0; d < 64; ++d) dot += q[t * 64 + d] * k[s * 64 + d];
        sw[i] = (s <= t) ? dot * __expf(sc[t] + sc[8 + s] - sc[16 + t]) : 0.f; }
    if (tid >= 128 && tid < 136) { const int t = tid - 128; float qn = 0.f; for (int d = 0; d < 64; ++d) qn += q[t * 64 + d] * n0s[d]; sc[40 + t] = qn; }
    __syncthreads();
    { const int e = tid & 127, dq = tid >> 7; const float gd = sc[48]; float num[8];
#pragma unroll
        for (int t = 0; t < 8; ++t) num[t] = 0.f;
        float c0v[16];
#pragma unroll
        for (int dd = 0; dd < 16; ++dd) c0v[dd] = P.in[2][((size_t)(b * 4 + h) * 64 + dq * 16 + dd) * 128 + e];
#pragma unroll
        for (int dd = 0; dd < 16; ++dd) { const int d = dq * 16 + dd; const size_t ic = ((size_t)(b * 4 + h) * 64 + d) * 128 + e; const float c0 = c0v[dd];
            float upd = 0.f;
#pragma unroll
            for (int s = 0; s < 8; ++s) upd += sc[32 + s] * k[s * 64 + d] * v[s * 128 + e];
            P.out[O_CS + ic] = gd * c0 + upd;
#pragma unroll
            for (int t = 0; t < 8; ++t) num[t] += q[t * 64 + d] * c0; }
#pragma unroll
        for (int t = 0; t < 8; ++t) part[(dq * 8 + t) * 128 + e] = num[t]; }
    if (tid < 64) { float nn = sc[48] * n0s[tid];
#pragma unroll
        for (int s = 0; s < 8; ++s) nn += sc[32 + s] * k[s * 64 + tid];
        P.out[O_NS + (b * 4 + h) * 64 + tid] = nn; }
    __syncthreads();
    { const int e = tid & 127, tq = tid >> 7, w = tid >> 6, lane = tid & 63; float hv[2];
#pragma unroll
        for (int u = 0; u < 2; ++u) { const int t = tq * 2 + u; float inter = 0.f, intra = 0.f, rs = 0.f;
#pragma unroll
            for (int dq = 0; dq < 4; ++dq) inter += part[(dq * 8 + t) * 128 + e];
#pragma unroll
            for (int s = 0; s < 8; ++s) { intra += sw[t * 8 + s] * v[s * 128 + e]; rs += sw[t * 8 + s]; }
            const float wi = sc[24 + t], den = wi * sc[40 + t] + rs; hv[u] = (wi * inter + intra) / fmaxf(fabsf(den), __expf(-sc[16 + t])); }
        const float s0 = wave_sum(hv[0] * hv[0]), s1 = wave_sum(hv[1] * hv[1]);
        if (lane == 0) { red[w * 2] = s0; red[w * 2 + 1] = s1; }
        __syncthreads();
        bf16_t* hcat = (bf16_t*)(P.ws + WS_HCAT);
#pragma unroll
        for (int u = 0; u < 2; ++u) { const int t = tq * 2 + u; const float tot = red[(w & ~1) * 2 + u] + red[(w | 1) * 2 + u]; const float rstd = 1.0f / sqrtf(tot * (1.0f / 128.0f) + EPS);
            const float so = bf2f(mixin[(size_t)(r0 + t) * NMIX + 1024 + h * 128 + e]);
            hcat[(size_t)(r0 + t) * 1024 + h * 128 + e] = f2bf(hv[u] * rstd * P.in[11][h * 128 + e] * so); } }
    __syncthreads();
}
__device__ __forceinline__ void mlstm_d_item(const Params& P, int item, unsigned char* lds, int tid) {
    const int c = item & 127, h = (item >> 7) & 3, b = item >> 9, r0 = b * 8192 + c * 64, pair = item >> 7;
    float* lb = (float*)lds; float* lu = lb + 64; float* lm = lb + 128; float* misc = lb + 192; float* npv = lb + 256; float* red = lb + 320;
    bf16_t* Kn = (bf16_t*)(lds + 2048); bf16_t* Vt = (bf16_t*)(lds + 11264); bf16_t* Cs = (bf16_t*)(lds + 29696);
    const bf16_t* mixin = (const bf16_t*)(P.ws + WS_MIXIN);
    if (tid < 64) { const float iv = ((const float*)(P.ws + WS_GI))[(r0 + tid) * 4 + h]; float bb = ((const float*)(P.ws + WS_GB))[(r0 + tid) * 4 + h];
#pragma unroll
        for (int o = 1; o < 64; o <<= 1) { const float nb = __shfl_up(bb, o); if (tid >= o) bb += nb; }
        const float mprev = c ? ((const float*)(P.ws + WS_MCH))[pair * 128 + c - 1] : 0.f;
        const float u = iv - bb; float cm = u;
#pragma unroll
        for (int o = 1; o < 64; o <<= 1) { const float nb = __shfl_up(cm, o); if (tid >= o) cm = fmaxf(cm, nb); }
        lb[tid] = bb; lu[tid] = u; lm[tid] = bb + fmaxf(mprev, cm); if (tid == 0) misc[0] = mprev;
        npv[tid] = ((const float*)(P.ws + WS_NPREV))[(size_t)item * 64 + tid]; }
    { const int s = tid >> 3, ch = tid & 7; const bf16_t* rowp = mixin + (size_t)(r0 + s) * NMIX;
        *(u32x4*)(Kn + s * 72 + ch * 8) = *(const u32x4*)(rowp + 256 + h * 64 + ch * 8);
        const u32x4 v0 = *(const u32x4*)(rowp + 512 + h * 128 + ch * 16), v1 = *(const u32x4*)(rowp + 512 + h * 128 + ch * 16 + 8);
        const unsigned vv[8] = {v0.x, v0.y, v0.z, v0.w, v1.x, v1.y, v1.z, v1.w};
#pragma unroll
        for (int i = 0; i < 8; ++i) { Vt[(ch * 16 + 2 * i) * 72 + s] = (bf16_t)(vv[i] & 0xffffu); Vt[(ch * 16 + 2 * i + 1) * 72 + s] = (bf16_t)(vv[i] >> 16); }
        const bf16_t* cp = (const bf16_t*)((unsigned char*)P.out + OB_CPT) + (size_t)item * 8192;
#pragma unroll
        for (int j = 0; j < 2; ++j) { const int idx = tid + 512 * j, e = idx >> 3, dch = idx & 7; *(u32x4*)(Cs + e * 72 + dch * 8) = *(const u32x4*)(cp + e * 64 + dch * 8); } }
    __syncthreads();
    const int w = tid >> 6, lane = tid & 63, fr = lane & 15, g = lane >> 4, tt = w & 3, eh = w >> 2, t = tt * 16 + fr, tok = r0 + t;
    bf16x8 qf[2]; float qv0[8], qv1[8];
    { const bf16_t* qp = mixin + (size_t)tok * NMIX + h * 64 + g * 8; const u32x4 a = *(const u32x4*)qp, bq = *(const u32x4*)(qp + 32);
        qf[0] = __builtin_bit_cast(bf16x8, a); qf[1] = __builtin_bit_cast(bf16x8, bq); unpack8(a, qv0); unpack8(bq, qv1); }
    f32x4 s[4];
#pragma unroll
    for (int st = 0; st < 4; ++st) { s[st] = (f32x4){0.f, 0.f, 0.f, 0.f};
#pragma unroll
        for (int kk = 0; kk < 2; ++kk) { const bf16x8 kf = *(const bf16x8*)(Kn + (st * 16 + fr) * 72 + g * 8 + kk * 32); s[st] = mfma16(kf, qf[kk], s[st]); } }
    const float bt = lb[t], mt = lm[t], mprev = misc[0];
    float rs = 0.f;
#pragma unroll
    for (int st = 0; st < 4; ++st)
#pragma unroll
        for (int r = 0; r < 4; ++r) { const int si = st * 16 + g * 4 + r; const float wv = (si <= t) ? __expf(bt + lu[si] - mt) : 0.f; const float val = s[st][r] * 0.125f * wv; s[st][r] = val; rs += val; }
    rs += __shfl_xor(rs, 16); rs += __shfl_xor(rs, 32);
    float qn = 0.f;
#pragma unroll
    for (int i = 0; i < 8; ++i) qn += qv0[i] * npv[g * 8 + i] + qv1[i] * npv[32 + g * 8 + i];
    qn += __shfl_xor(qn, 16); qn += __shfl_xor(qn, 32);
    const float wi = __expf(bt + mprev - mt), den = wi * qn + rs, inv = 1.0f / fmaxf(fabsf(den), __expf(-mt));
    bf16x8 pf[2]; pf[0] = pack8(s[0], s[1]); pf[1] = pack8(s[2], s[3]);
    f32x4 h1[4], h2[4];
#pragma unroll
    for (int et = 0; et < 4; ++et) { const int e = eh * 64 + et * 16 + fr; h1[et] = (f32x4){0.f, 0.f, 0.f, 0.f}; h2[et] = (f32x4){0.f, 0.f, 0.f, 0.f};
#pragma unroll
        for (int cc = 0; cc < 2; ++cc) { const bf16_t* vp = Vt + e * 72 + cc * 32 + g * 4; const u32x2 v0 = *(const u32x2*)vp, v1 = *(const u32x2*)(vp + 16);
            h2[et] = mfma16(__builtin_bit_cast(bf16x8, (u32x4){v0.x, v0.y, v1.x, v1.y}), pf[cc], h2[et]); }
#pragma unroll
        for (int kk = 0; kk < 2; ++kk) { const bf16x8 cf = *(const bf16x8*)(Cs + e * 72 + g * 8 + kk * 32); h1[et] = mfma16(cf, qf[kk], h1[et]); } }
    float ss = 0.f;
#pragma unroll
    for (int et = 0; et < 4; ++et)
#pragma unroll
        for (int r = 0; r < 4; ++r) { const float hv = (wi * h1[et][r] + h2[et][r]) * inv; h2[et][r] = hv; ss += hv * hv; }
    ss += __shfl_xor(ss, 16); ss += __shfl_xor(ss, 32);
    if (g == 0) red[w * 16 + fr] = ss;
    __syncthreads();
    { const float tot = red[w * 16 + fr] + red[(w ^ 4) * 16 + fr]; const float rstd = 1.0f / sqrtf(tot * (1.0f / 128.0f) + EPS);
        bf16_t* hcat = (bf16_t*)(P.ws + WS_HCAT);
#pragma unroll
        for (int et = 0; et < 4; ++et) { const int e0 = eh * 64 + et * 16 + g * 4; const u32x2 so = *(const u32x2*)(mixin + (size_t)tok * NMIX + 1024 + h * 128 + e0); const f32x4 mw = *(const f32x4*)(P.in[11] + h * 128 + e0);
            const float o0 = h2[et][0] * rstd * mw[0] * bflo(so.x), o1 = h2[et][1] * rstd * mw[1] * bfhi(so.x), o2 = h2[et][2] * rstd * mw[2] * bflo(so.y), o3 = h2[et][3] * rstd * mw[3] * bfhi(so.y);
            u32x2 pk; pk.x = cvt_pk_bf16(o0, o1); pk.y = cvt_pk_bf16(o2, o3); *(u32x2*)(hcat + (size_t)tok * 1024 + h * 128 + e0) = pk; } }
    __syncthreads();
}


__device__ __forceinline__ void tail_mma(unsigned char* lds, const bf16_t* A, const bf16_t* Bt, int K, int r0, int c0, int nchunk, int nseg0, int tid, f32x4 (&acc)[2][2]) {
    const int w = tid >> 6, lane = tid & 63, fr = lane & 15, g = lane >> 4, wr = w & 3, wc = w >> 2;
    const bf16_t* gp[4]; unsigned lo_[4];
#pragma unroll
    for (int j = 0; j < 4; ++j) { const int idx = tid + 512 * j, mat = idx >> 10, rem = idx & 1023, row = rem >> 4, seg = rem & 15;
        gp[j] = (mat ? Bt + (size_t)(c0 + row) * K : A + (size_t)(r0 + row) * K) + seg * 8; lo_[j] = (unsigned)(mat * 17408 + row * 272 + seg * 16); }
    u32x4 st[4];
#pragma unroll
    for (int j = 0; j < 4; ++j) st[j] = *(const u32x4*)gp[j];
#pragma unroll
    for (int j = 0; j < 4; ++j) *(u32x4*)(lds + lo_[j]) = st[j];
    __syncthreads();
    const unsigned aoff = (unsigned)((16 * wr + fr) * 272 + g * 16), boff = (unsigned)(17408 + (32 * wc + fr) * 272 + g * 16);
#pragma unroll 1
    for (int ch = 0; ch < nchunk; ++ch) {
        const unsigned cur = (unsigned)(ch & 1) * 34816u, nxt = 34816u - cur;
        const bool more = ch + 1 < nchunk;
        if (more) {
#pragma unroll
            for (int j = 0; j < 4; ++j) st[j] = *(const u32x4*)(gp[j] + (size_t)(ch + 1) * 128); }
        bf16x8 fa[4], f0[4], f1[4];
#pragma unroll
        for (int kk = 0; kk < 4; ++kk) { fa[kk] = *(const bf16x8*)(lds + cur + aoff + kk * 64); f0[kk] = *(const bf16x8*)(lds + cur + boff + kk * 64); f1[kk] = *(const bf16x8*)(lds + cur + boff + 16 * 272 + kk * 64); }
        if (ch < nseg0) {
#pragma unroll
            for (int kk = 0; kk < 4; ++kk) { acc[0][0] = mfma16(f0[kk], fa[kk], acc[0][0]); acc[0][1] = mfma16(f1[kk], fa[kk], acc[0][1]); } }
        else {
#pragma unroll
            for (int kk = 0; kk < 4; ++kk) { acc[1][0] = mfma16(f0[kk], fa[kk], acc[1][0]); acc[1][1] = mfma16(f1[kk], fa[kk], acc[1][1]); } }
        if (more) {
#pragma unroll
            for (int j = 0; j < 4; ++j) *(u32x4*)(lds + nxt + lo_[j]) = st[j]; }
        __syncthreads();
    }
}
__device__ __forceinline__ void tail_mix(const Params& P, unsigned char* lds, int tb, int tid) {
    const int w = tid >> 6, lane = tid & 63, fr = lane & 15, g = lane >> 4, tok = MP + (tb >> 4) * 64 + 16 * (w & 3) + fr, col0 = (tb & 15) * 64 + 32 * (w >> 2);
    const bf16_t* hcat = (const bf16_t*)(P.ws + WS_HCAT); const bf16_t* wab = (const bf16_t*)(P.ws + WS_WAB); const bf16_t* gates = (const bf16_t*)(P.ws + WS_GATES); bf16_t* mix = (bf16_t*)(P.ws + WS_MIXIN);
    f32x4 ab[2][2]; ab[0][0] = ab[0][1] = ab[1][0] = ab[1][1] = (f32x4){0.f, 0.f, 0.f, 0.f};
    tail_mma(lds, hcat, wab, 1024, MP + (tb >> 4) * 64, (tb & 15) * 64, 8, 4, tid, ab);
    const f32x4 (&a)[2] = ab[0]; const f32x4 (&b)[2] = ab[1];
#pragma unroll
    for (int mt = 0; mt < 2; ++mt) { const int c = col0 + mt * 16 + g * 4; const u32x2 sa = *(const u32x2*)(gates + (size_t)tok * 2048 + c), sb = *(const u32x2*)(gates + (size_t)tok * 2048 + 1024 + c);
        const float v0 = bflo(sa.x) * a[mt][0] + bflo(sb.x) * b[mt][0], v1 = bfhi(sa.x) * a[mt][1] + bfhi(sb.x) * b[mt][1], v2 = bflo(sa.y) * a[mt][2] + bflo(sb.y) * b[mt][2], v3 = bfhi(sa.y) * a[mt][3] + bfhi(sb.y) * b[mt][3];
        u32x2 pk; pk.x = cvt_pk_bf16(v0, v1); pk.y = cvt_pk_bf16(v2, v3); *(u32x2*)(mix + (size_t)tok * 1024 + c) = pk; }
}
__device__ __forceinline__ void tail_out(const Params& P, unsigned char* lds, int tb, int tid) {
    const int w = tid >> 6, lane = tid & 63, fr = lane & 15, g = lane >> 4, tok = MP + (tb >> 4) * 64 + 16 * (w & 3) + fr, col0 = (tb & 15) * 64 + 32 * (w >> 2);
    f32x4 ab[2][2]; ab[0][0] = ab[0][1] = ab[1][0] = ab[1][1] = (f32x4){0.f, 0.f, 0.f, 0.f};
    tail_mma(lds, (const bf16_t*)(P.ws + WS_MIXIN), (const bf16_t*)(P.ws + WS_WOUT), 1024, MP + (tb >> 4) * 64, (tb & 15) * 64, 8, 8, tid, ab);
    const f32x4 (&acc)[2] = ab[0];
    const float* xrow = P.in[1] + (size_t)(tok - MP) * 1024; bf16_t* hfw = (bf16_t*)(P.ws + WS_HN); float ss = 0.f;
#pragma unroll
    for (int mt = 0; mt < 2; ++mt) { const int c = col0 + mt * 16 + g * 4; const f32x4 y = *(const f32x4*)(xrow + c) + acc[mt]; *(f32x4*)(P.out + (size_t)tok * 1024 + c) = y;
        ss += (y[0] * y[0] + y[1] * y[1]) + (y[2] * y[2] + y[3] * y[3]); const f32x4 z = y * *(const f32x4*)(P.in[18] + c);
        u32x2 pk; pk.x = cvt_pk_bf16(z[0], z[1]); pk.y = cvt_pk_bf16(z[2], z[3]); *(u32x2*)(hfw + (size_t)tok * 1024 + c) = pk; }
    ss += __shfl_xor(ss, 16); ss += __shfl_xor(ss, 32);
    if (g == 0) unsafeAtomicAdd((float*)(P.ws + WS_ROWSS) + tok, ss);
}
__device__ __forceinline__ void tail_down(const Params& P, unsigned char* lds, int tb, int tid) {
    const int w = tid >> 6, lane = tid & 63, fr = lane & 15, g = lane >> 4, tok = MP + (tb >> 4) * 64 + 16 * (w & 3) + fr, col0 = (tb & 15) * 64 + 32 * (w >> 2);
    f32x4 ab[2][2]; ab[0][0] = ab[0][1] = ab[1][0] = ab[1][1] = (f32x4){0.f, 0.f, 0.f, 0.f};
    tail_mma(lds, (const bf16_t*)(P.ws + WS_MIXIN), (const bf16_t*)(P.ws + WS_WD), DFF, MP + (tb >> 4) * 64, (tb & 15) * 64, 22, 22, tid, ab);
    const f32x4 (&acc)[2] = ab[0];
#pragma unroll
    for (int mt = 0; mt < 2; ++mt) { float* p = P.out + (size_t)tok * 1024 + col0 + mt * 16 + g * 4; *(f32x4*)p = *(const f32x4*)p + acc[mt]; }
}
#define GSYNC_F(grid) xcd_barrier(xbar)
__global__ void __launch_bounds__(512, 2) fwd_kernel(Params P) {
    extern __shared__ __attribute__((aligned(16))) unsigned char lds[];
    cg::grid_group grid = cg::this_grid();
    const int tid = threadIdx.x, G = gridDim.x;
    const int lo = P.ph_lo, hi = P.ph_hi;
    volatile LAS unsigned* xst = (volatile LAS unsigned*)((LAS unsigned char*)lds + 131072);
    if (tid < 4) xst[tid] = 0u;
    __syncthreads();
    XcdBarrier xbar = xcd_barrier_post((unsigned*)(P.ws + WS_BAR), xst);
#ifndef PHASE_MASK
#define PHASE_MASK 0x1ff
#endif
#define IN(k) (((PHASE_MASK >> (k)) & 1) && lo <= (k) && (k) < hi)
#define GSYNC() xcd_barrier(xbar)
#define SEAM(k) do { if (IN(k) && IN((k) + 1)) GSYNC(); } while (0)
#ifndef DUP_MASK
#define DUP_MASK 0
#endif
#ifndef EXTRA_SYNCS
#define EXTRA_SYNCS 0
#endif
#define REP(k) for (int rep_ = 0; rep_ <= ((DUP_MASK >> (k)) & 1); ++rep_) if (rep_ == 0 || (GSYNC_F(grid), true))
    bf16_t* HN = (bf16_t*)(P.ws + WS_HN); bf16_t* MIXIN = (bf16_t*)(P.ws + WS_MIXIN); bf16_t* GATES = (bf16_t*)(P.ws + WS_GATES); bf16_t* HCAT = (bf16_t*)(P.ws + WS_HCAT);
    PG8_LAS unsigned char* ldsa = (PG8_LAS unsigned char*)lds;
    if (IN(0)) REP(0) p0_prep(P, lds, tid, G);
    if (lo < 0) grid.sync();
    SEAM(0);
    for (int xs_ = 0; xs_ < EXTRA_SYNCS; ++xs_) GSYNC();
    if (IN(1)) REP(1) { pg8::Gemm g{HN, (const bf16_t*)(P.ws + WS_WIN), MT, NPROJ, 1024}; pg8::StaticOrder S; S.init(MT, NPROJ, G, (int)blockIdx.x);
        pg8::EpiProj E{MIXIN, GATES}; pg8::gemm_phase<pg8::EpiProj, pg8::StaticOrder, true, true>(ldsa, g, S, E); }
    SEAM(1);
    if (IN(2)) REP(2) {
        for (int it = blockIdx.x; it < 256 + 256 + 1024; it += G) {
            if (it < 256) attn_prompt_item(P, it, lds, tid);
            else if (it < 512) attn_sample_item(P, it - 256, lds, tid);
            else mlstm_b_item(P, it - 512, lds, tid);
        } }
    SEAM(2);
    if (IN(3)) REP(3) {
        const int nscan = (G > 64) ? 64 : 0;
#ifndef P3_VARIANT
#define P3_VARIANT 3
#endif
        if (nscan) { if ((int)blockIdx.x < 64) { if (P3_VARIANT & 1) mlstm_scan(P, lds, tid); } else if (P3_VARIANT & 2) { for (int it = blockIdx.x - 64; it < 512; it += G - 64) mlstm_sample_item(P, it, lds, tid);
            for (int it = NT_IN + (int)blockIdx.x - 64; it < NT_ALL; it += G - 64) wtile_by_index(P, it, lds, tid); } }
        else { for (int it = blockIdx.x; it < 512; it += G) mlstm_sample_item(P, it, lds, tid); for (int it = NT_IN + (int)blockIdx.x; it < NT_ALL; it += G) wtile_by_index(P, it, lds, tid); }
    }
    SEAM(3);
    if (IN(4)) REP(4) { for (int it = blockIdx.x; it < 1024; it += G) mlstm_d_item(P, it, lds, tid); }
    SEAM(4);
    if (IN(5)) REP(5) { pg8::Gemm g{HCAT, (const bf16_t*)(P.ws + WS_WAB), MP, 1024, 1024}; pg8::StaticOrder S; S.init(MP, 1024, G, (int)blockIdx.x);
        pg8::EpiMix E{GATES, MIXIN}; pg8::gemm_phase<pg8::EpiMix, pg8::StaticOrder, true, true>(ldsa, g, S, E);
        for (int tb = blockIdx.x; tb < 256; tb += G) tail_mix(P, lds, tb, tid); }
    SEAM(5);
    if (IN(6)) REP(6) { pg8::Gemm g{MIXIN, (const bf16_t*)(P.ws + WS_WOUT), MP, 1024, 1024}; pg8::StaticOrder S; S.init(MP, 1024, G, (int)blockIdx.x);
        pg8::EpiOut E{P.in[0], P.in[1], P.out, HN, P.in[18], (float*)(P.ws + WS_ROWSS)}; pg8::gemm_phase<pg8::EpiOut, pg8::StaticOrder, true, true>(ldsa, g, S, E);
        for (int tb = blockIdx.x; tb < 256; tb += G) tail_out(P, lds, tb, tid); }
    SEAM(6);
    if (IN(7)) REP(7) { pg8::Gemm g{HN, (const bf16_t*)(P.ws + WS_WGU), MT, 2 * DFF, 1024}; pg8::StaticOrder S; S.init(MT, 2 * DFF, G, (int)blockIdx.x);
        pg8::EpiGU E{MIXIN, (const float*)(P.ws + WS_ROWSS)}; pg8::gemm_phase<pg8::EpiGU, pg8::StaticOrder, true, true>(ldsa, g, S, E); }
    SEAM(7);
    if (IN(8)) REP(8) { pg8::Gemm g{MIXIN, (const bf16_t*)(P.ws + WS_WD), MP, 1024, DFF}; pg8::StaticOrder S; S.init(MP, 1024, G, (int)blockIdx.x);
        pg8::EpiDown E{P.out}; pg8::gemm_phase<pg8::EpiDown, pg8::StaticOrder, true, true>(ldsa, g, S, E);
        for (int tb = blockIdx.x; tb < 256; tb += G) tail_down(P, lds, tb, tid); }
#ifdef DBG_DUMP
    GSYNC();
    if (DBG_DUMP == 1) { for (size_t i = (size_t)blockIdx.x * 512 + tid; i < (size_t)MT * 1024; i += (size_t)G * 512) { const size_t r = i >> 10, c = i & 1023; P.out[i] = bf2f(MIXIN[r * NMIX + c]); } }
    if (DBG_DUMP == 2) { const bf16_t* d = (const bf16_t*)((unsigned char*)P.out + OB_DCT); for (size_t i = (size_t)blockIdx.x * 512 + tid; i < (size_t)1024 * 8192; i += (size_t)G * 512) P.out[i] = bf2f(d[i]); }
    if (DBG_DUMP == 4) { unsigned* d = (unsigned*)((unsigned char*)P.out + OB_DCT); for (size_t i = (size_t)blockIdx.x * 512 + tid; i < (size_t)1024 * 4096; i += (size_t)G * 512) { const unsigned w = __hip_atomic_load(d + i, __ATOMIC_RELAXED, __HIP_MEMORY_SCOPE_AGENT); P.out[2 * i] = bflo(w); P.out[2 * i + 1] = bfhi(w); } }
    if (DBG_DUMP == 5) { const float* a = (const float*)(P.ws + WS_GI); const float* bq = (const float*)(P.ws + WS_GB); for (int i = blockIdx.x * 512 + tid; i < MT * 4; i += G * 512) { P.out[i] = a[i]; P.out[MT * 4 + i] = bq[i]; } }
    if (DBG_DUMP == 6) { const float* a = (const float*)(P.ws + WS_DN); for (int i = blockIdx.x * 512 + tid; i < 65536; i += G * 512) P.out[i] = a[i]; }
    if (DBG_DUMP == 3) { for (size_t i = (size_t)blockIdx.x * 512 + tid; i < (size_t)MT * 1024; i += (size_t)G * 512) P.out[i] = bf2f(HN[i]); }
#endif
#undef IN
#undef SEAM
}

extern "C" void kernel_launch(void* const* d_in, const int* in_sizes, int n_in, void* d_out, int out_size, void* d_ws, size_t ws_size, hipStream_t stream) {
    static int grid = 0;
    if (grid == 0) {
        if (n_in != 22 || (size_t)out_size != O_END || ws_size < WS_END) { fprintf(stderr, "kernel_launch: unexpected shapes (n_in %d, out %d, ws %zu)\n", n_in, out_size, ws_size); grid = -1; return; }
        int dev = 0, cus = 0, per_cu = 0;
        (void)hipGetDevice(&dev); (void)hipDeviceGetAttribute(&cus, hipDeviceAttributeMultiprocessorCount, dev);
        if (hipFuncSetAttribute((const void*)fwd_kernel, hipFuncAttributeMaxDynamicSharedMemorySize, LDS_BYTES) != hipSuccess) { fprintf(stderr, "kernel_launch: hipFuncSetAttribute failed\n"); grid = -1; return; }
        if (hipOccupancyMaxActiveBlocksPerMultiprocessor(&per_cu, (const void*)fwd_kernel, 512, LDS_BYTES) != hipSuccess || per_cu < 1) { fprintf(stderr, "kernel_launch: occupancy query failed (%d)\n", per_cu); (void)hipGetLastError(); per_cu = 1; }
        grid = cus * 1;
        if (grid < 65) { fprintf(stderr, "kernel_launch: needs more than 64 CUs\n"); grid = -1; return; }
    }
    if (grid < 0) return;
    if (hipMemsetAsync((char*)d_ws + WS_BAR, 0, XCD_BAR_WORDS * 4, stream) != hipSuccess) { fprintf(stderr, "kernel_launch: memset failed\n"); return; }
    Params p{};
    for (int i = 0; i < 22; ++i) p.in[i] = (const float*)d_in[i];
    p.out = (float*)d_out; p.ws = (unsigned char*)d_ws;
    constexpr int NPH = 9;
    for (int li = 0; li < N_LAUNCHES; ++li) {
        p.ph_lo = (N_LAUNCHES == 1) ? 0 : li; p.ph_hi = (N_LAUNCHES == 1) ? NPH : li + 1;
        void* args[] = {&p};
        const hipError_t e = hipLaunchCooperativeKernel((const void*)fwd_kernel, dim3(grid), dim3(512), args, LDS_BYTES, stream);
        if (e != hipSuccess) { fprintf(stderr, "kernel_launch: cooperative launch %d failed: %s (grid %d)\n", li, hipGetErrorString(e), grid); break; }
    }
}
```

```cpp
#include <hip/hip_runtime.h>
#include <hip/hip_cooperative_groups.h>
#include <cstdio>
#include <cstdint>
namespace cg = cooperative_groups;

#ifndef N_LAUNCHES
#define N_LAUNCHES 1
#endif

namespace pg8 {
#define PG8_LAS __attribute__((address_space(3)))
typedef unsigned short bf16_t;
typedef short bf16x8 __attribute__((ext_vector_type(8)));
typedef float f32x4 __attribute__((ext_vector_type(4)));
typedef unsigned u32x4 __attribute__((ext_vector_type(4)));
constexpr int BM = 256, BK = 64, HALF = 128, HTB = HALF * BK * 2  , STAGE_BYTES = 8 * HTB, NXCD = 8, WGM = 8;

__host__ __device__ __forceinline__ int lds_byte(int r, int c) { const int st = (r >> 4) * 2 + (c >> 5), rr = r & 15, cc = c & 31, ob = rr * 64 + cc * 2; return st * 1024 + (ob ^ (((ob >> 9) & 1) << 5)); }
__host__ __device__ __forceinline__ void stage_rc(int b, int& R, int& C) { const int st = b / 1024, sb = b % 1024, swz = sb ^ (((sb >> 9) & 1) << 5); R = (st >> 1) * 16 + swz / 64; C = (st & 1) * 32 + (swz % 64) / 2; }
__host__ __device__ __forceinline__ int perm32(int rho) { const int n = rho >> 4, i = rho & 15; return 8 * (i >> 2) + 4 * n + (i & 3); }

struct Unit { int pm, pn; };
struct Gemm { const bf16_t* A; const bf16_t* Bt; int M, N, K; };

struct StaticOrder {
    int nM, nN, nwg, G, c;
    __host__ __device__ void init(int M, int N, int G_, int c_) { nM = M / BM; nN = N / BM; nwg = nM * nN; G = G_; c = c_; }
    __host__ __device__ bool next(int i, Unit& u) const {
        const long L = (long)i * G + c; if (L >= nwg) return false;
        int wgid = (int)L; { const int q = nwg / NXCD, r = nwg % NXCD, xcd = wgid % NXCD, off = wgid / NXCD; wgid = (xcd < r ? xcd * (q + 1) : r * (q + 1) + (xcd - r) * q) + off; }
        const int nig = WGM * nN, gid = wgid / nig, fm = gid * WGM, gsz = (nM - fm) < WGM ? (nM - fm) : WGM;
        u.pm = fm + ((wgid % nig) % gsz); u.pn = (wgid % nig) / gsz; return true;
    }
    __device__ __forceinline__ void a_ready(const Unit&) const {}
    __device__ __forceinline__ void done(const Unit&) const {}
};

__device__ __forceinline__ unsigned cvt_pk_bf16(float lo, float hi) { unsigned r; asm volatile("v_cvt_pk_bf16_f32 %0, %1, %2" : "=v"(r) : "v"(lo), "v"(hi)); return r; }
__device__ __forceinline__ float bflo(unsigned w) { return __builtin_bit_cast(float, w << 16); }
__device__ __forceinline__ float bfhi(unsigned w) { return __builtin_bit_cast(float, w & 0xffff0000u); }
__device__ __forceinline__ float sigm(float x) { return 1.0f / (1.0f + __expf(-x)); }

struct EpiProj {
    static constexpr bool PERM = true, AFTER_DRAIN = false, HAS_MID = false;
    bf16_t* mixin; bf16_t* gates;
    __device__ __forceinline__ void operator()(const f32x4 (&acc)[2][2][4][2], const Unit& u, int wr, int wc, int fr, int fq) const {
        const bool isg = u.pn >= 9; const bool sg = isg || u.pn == 4 || u.pn == 5;
        bf16_t* base = isg ? gates : mixin; const int ldc = isg ? 2048 : 2304;
        const int col0 = (isg ? (u.pn - 9) : u.pn) * 256 + wc * 32 + 8 * fq, row0 = u.pm * BM + wr * 64 + fr;
#pragma unroll
        for (int ai = 0; ai < 2; ++ai)
#pragma unroll
            for (int m = 0; m < 4; ++m) { bf16_t* rowp = base + (size_t)(row0 + ai * HALF + m * 16) * ldc + col0;
#pragma unroll
                for (int bj = 0; bj < 2; ++bj) { f32x4 v0 = acc[ai][bj][m][0], v1 = acc[ai][bj][m][1];
                    if (sg) {
#pragma unroll
                        for (int i = 0; i < 4; ++i) { v0[i] = sigm(v0[i]); v1[i] = sigm(v1[i]); } }
                    u32x4 w; w.x = cvt_pk_bf16(v0[0], v0[1]); w.y = cvt_pk_bf16(v0[2], v0[3]); w.z = cvt_pk_bf16(v1[0], v1[1]); w.w = cvt_pk_bf16(v1[2], v1[3]);
                    *(u32x4*)(rowp + bj * HALF) = w; } }
    }
};

struct EpiMix {
    static constexpr bool PERM = true, AFTER_DRAIN = false, HAS_MID = true;
    const bf16_t* gates; bf16_t* mix;
    __device__ __forceinline__ void mid(f32x4 (&acc)[2][2][4][2], const Unit& u, int wr, int wc, int fr, int fq) const {
        unsigned rb = (unsigned)(u.pm * BM + wr * 64 + fr) * 2048u + (unsigned)(u.pn * BM + wc * 32 + 8 * fq);
        asm volatile("" : "+v"(rb));
#pragma unroll
        for (int ai = 0; ai < 2; ++ai)
#pragma unroll
            for (int m = 0; m < 4; ++m) { const bf16_t* rowp = gates + (rb + (unsigned)((ai * HALF + m * 16) * 2048));
#pragma unroll
                for (int bj = 0; bj < 2; ++bj) { const u32x4 a = *(const u32x4*)(rowp + bj * HALF), b = *(const u32x4*)(rowp + 1024 + bj * HALF);
                    const float tiny = 8.673617379884035e-19f;
                    f32x4 r0, r1;
                    r0[0] = bflo(a.x) * __builtin_amdgcn_rcpf(fmaxf(bflo(b.x), tiny)); r0[1] = bfhi(a.x) * __builtin_amdgcn_rcpf(fmaxf(bfhi(b.x), tiny)); r0[2] = bflo(a.y) * __builtin_amdgcn_rcpf(fmaxf(bflo(b.y), tiny)); r0[3] = bfhi(a.y) * __builtin_amdgcn_rcpf(fmaxf(bfhi(b.y), tiny));
                    r1[0] = bflo(a.z) * __builtin_amdgcn_rcpf(fmaxf(bflo(b.z), tiny)); r1[1] = bfhi(a.z) * __builtin_amdgcn_rcpf(fmaxf(bfhi(b.z), tiny)); r1[2] = bflo(a.w) * __builtin_amdgcn_rcpf(fmaxf(bflo(b.w), tiny)); r1[3] = bfhi(a.w) * __builtin_amdgcn_rcpf(fmaxf(bfhi(b.w), tiny));
                    acc[ai][bj][m][0] = acc[ai][bj][m][0] * r0; acc[ai][bj][m][1] = acc[ai][bj][m][1] * r1; }
                if (m == 3) __builtin_amdgcn_sched_barrier(0); }
    }
    __device__ __forceinline__ void operator()(const f32x4 (&acc)[2][2][4][2], const Unit& u, int wr, int wc, int fr, int fq) const {
        const int col0 = u.pn * BM + wc * 32 + 8 * fq, row0 = u.pm * BM + wr * 64 + fr;
#pragma unroll
        for (int ai = 0; ai < 2; ++ai)
#pragma unroll
            for (int m = 0; m < 4; ++m) { const size_t row = (size_t)(row0 + ai * HALF + m * 16);
#pragma unroll
                for (int bj = 0; bj < 2; ++bj) { const u32x4 b = *(const u32x4*)(gates + row * 2048 + 1024 + col0 + bj * HALF);
                    const float tiny = 8.673617379884035e-19f;
                    f32x4 s0, s1;
                    s0[0] = fmaxf(bflo(b.x), tiny); s0[1] = fmaxf(bfhi(b.x), tiny); s0[2] = fmaxf(bflo(b.y), tiny); s0[3] = fmaxf(bfhi(b.y), tiny);
                    s1[0] = fmaxf(bflo(b.z), tiny); s1[1] = fmaxf(bfhi(b.z), tiny); s1[2] = fmaxf(bflo(b.w), tiny); s1[3] = fmaxf(bfhi(b.w), tiny);
                    const f32x4 v0 = acc[ai][bj][m][0] * s0, v1 = acc[ai][bj][m][1] * s1;
                    u32x4 w; w.x = cvt_pk_bf16(v0[0], v0[1]); w.y = cvt_pk_bf16(v0[2], v0[3]); w.z = cvt_pk_bf16(v1[0], v1[1]); w.w = cvt_pk_bf16(v1[2], v1[3]);
                    *(u32x4*)(mix + row * 1024 + col0 + bj * HALF) = w; } }
    }
};

struct EpiOut {
    static constexpr bool PERM = true, AFTER_DRAIN = false, HAS_MID = false;
    const float* xp; const float* xs; float* out; bf16_t* hfw; const float* nfw; float* rowss;
    __device__ __forceinline__ void operator()(const f32x4 (&acc)[2][2][4][2], const Unit& u, int wr, int wc, int fr, int fq) const {
        const int col0 = u.pn * BM + wc * 32 + 8 * fq, row0 = u.pm * BM + wr * 64 + fr;
#pragma unroll
        for (int ai = 0; ai < 2; ++ai)
#pragma unroll
            for (int m = 0; m < 4; ++m) { const int row = row0 + ai * HALF + m * 16;
                const float* xrow = row < 16384 ? xp + (size_t)row * 1024 : xs + (size_t)(row - 16384) * 1024;
                float ss = 0.f;
#pragma unroll
                for (int bj = 0; bj < 2; ++bj) { const int c = col0 + bj * HALF;
                    const f32x4 y0 = *(const f32x4*)(xrow + c) + acc[ai][bj][m][0], y1 = *(const f32x4*)(xrow + c + 4) + acc[ai][bj][m][1];
                    *(f32x4*)(out + (size_t)row * 1024 + c) = y0; *(f32x4*)(out + (size_t)row * 1024 + c + 4) = y1;
                    ss += (y0[0] * y0[0] + y0[1] * y0[1]) + (y0[2] * y0[2] + y0[3] * y0[3]) + (y1[0] * y1[0] + y1[1] * y1[1]) + (y1[2] * y1[2] + y1[3] * y1[3]);
                    const f32x4 w0 = *(const f32x4*)(nfw + c), w1 = *(const f32x4*)(nfw + c + 4);
                    const f32x4 z0 = y0 * w0, z1 = y1 * w1;
                    u32x4 w; w.x = cvt_pk_bf16(z0[0], z0[1]); w.y = cvt_pk_bf16(z0[2], z0[3]); w.z = cvt_pk_bf16(z1[0], z1[1]); w.w = cvt_pk_bf16(z1[2], z1[3]);
                    *(u32x4*)(hfw + (size_t)row * 1024 + c) = w; }
                ss += __shfl_xor(ss, 16); ss += __shfl_xor(ss, 32);
                if (fq == 0) unsafeAtomicAdd(rowss + row, ss); }
    }
};

struct EpiGU {
    static constexpr bool PERM = true, AFTER_DRAIN = false, HAS_MID = false;
    bf16_t* act; const float* rowss;
    __device__ __forceinline__ void operator()(const f32x4 (&acc)[2][2][4][2], const Unit& u, int wr, int wc, int fr, int fq) const {
        const int col0 = u.pn * HALF + wc * 32 + 8 * fq, row0 = u.pm * BM + wr * 64 + fr;
#pragma unroll
        for (int ai = 0; ai < 2; ++ai)
#pragma unroll
            for (int m = 0; m < 4; ++m) { const int row = row0 + ai * HALF + m * 16;
                const float rstd = __builtin_amdgcn_rsqf(rowss[row] * (1.0f / 1024.0f) + 1e-6f);
                float o[8];
#pragma unroll
                for (int n = 0; n < 2; ++n)
#pragma unroll
                    for (int j = 0; j < 4; ++j) { const float g = acc[ai][0][m][n][j] * rstd, up = acc[ai][1][m][n][j] * rstd; o[n * 4 + j] = g * sigm(g) * up; }
                u32x4 w; w.x = cvt_pk_bf16(o[0], o[1]); w.y = cvt_pk_bf16(o[2], o[3]); w.z = cvt_pk_bf16(o[4], o[5]); w.w = cvt_pk_bf16(o[6], o[7]);
                *(u32x4*)(act + (size_t)row * 2816 + col0) = w; }
    }
};

struct EpiDown {
    static constexpr bool PERM = true, AFTER_DRAIN = false, HAS_MID = false;
    float* out;
    __device__ __forceinline__ void operator()(const f32x4 (&acc)[2][2][4][2], const Unit& u, int wr, int wc, int fr, int fq) const {
        const int col0 = u.pn * BM + wc * 32 + 8 * fq, row0 = u.pm * BM + wr * 64 + fr;
#pragma unroll
        for (int ai = 0; ai < 2; ++ai)
#pragma unroll
            for (int m = 0; m < 4; ++m) { float* rowp = out + (size_t)(row0 + ai * HALF + m * 16) * 1024 + col0;
#pragma unroll
                for (int bj = 0; bj < 2; ++bj) { const f32x4 y0 = *(const f32x4*)(rowp + bj * HALF) + acc[ai][bj][m][0], y1 = *(const f32x4*)(rowp + bj * HALF + 4) + acc[ai][bj][m][1];
                    *(f32x4*)(rowp + bj * HALF) = y0; *(f32x4*)(rowp + bj * HALF + 4) = y1; } }
    }
};

template <class Epi, class Sched, bool ALIGN_EPI = false, bool SP2 = false>
__device__ __forceinline__ void gemm_phase(PG8_LAS unsigned char* lds, const Gemm g, const Sched& S, const Epi& E) {
    const int tid = threadIdx.x, wid = __builtin_amdgcn_readfirstlane(tid >> 6), lane = tid & 63, wr = wid >> 2, wc = wid & 3, fr = lane & 15, fq = lane >> 4;
    const int K = g.K, nt = K / BK;
    unsigned voffA[2], voffB[2];
#pragma unroll
    for (int i = 0; i < 2; ++i) { int R, C; stage_rc(tid * 16 + i * 8192, R, C); const int Rb = Epi::PERM ? ((R & ~31) + perm32(R & 31)) : R;
        voffA[i] = (unsigned)(R * K + C) * 2u; voffB[i] = (unsigned)(Rb * K + C) * 2u; }
    const size_t kstep = (size_t)(BK * 2);
    const size_t hstep = (size_t)HALF * K * 2;
    const size_t tstep = 2 * hstep;
    const unsigned ldsw = (unsigned)wid * 1024u;
    const int aoff = lds_byte(wr * 64 + fr, fq * 8), boff = lds_byte(wc * 32 + fr, fq * 8);
#define PG8_SA(b, h) (((b) * 2 + (h)) * HTB)
#define PG8_SB(b, h) ((4 + (b) * 2 + (h)) * HTB)
#define PG8_STAGE(bufoff, gbase, voff) do { _Pragma("unroll") for (int _i = 0; _i < 2; ++_i) \
        __builtin_amdgcn_global_load_lds((const unsigned*)((const char*)(gbase) + (voff)[_i]), (PG8_LAS unsigned*)(lds + (bufoff) + ldsw + _i * 8192), 16, 0, 0); } while (0)
#define PG8_LDA(dst, b, h) do { _Pragma("unroll") for (int m = 0; m < 4; ++m) _Pragma("unroll") for (int k = 0; k < 2; ++k) dst[m][k] = *(const PG8_LAS bf16x8*)(lds + PG8_SA(b, h) + aoff + m * 2048 + k * 1024); } while (0)
#define PG8_LDB(dst, b, h) do { _Pragma("unroll") for (int n = 0; n < 2; ++n) _Pragma("unroll") for (int k = 0; k < 2; ++k) dst[n][k] = *(const PG8_LAS bf16x8*)(lds + PG8_SB(b, h) + boff + n * 2048 + k * 1024); } while (0)
#define PG8_MMA(ai, bj, At, Bt) do { __builtin_amdgcn_s_setprio(1); _Pragma("unroll") for (int m = 0; m < 4; ++m) _Pragma("unroll") for (int n = 0; n < 2; ++n) _Pragma("unroll") for (int k = 0; k < 2; ++k) \
        acc[ai][bj][m][n] = __builtin_amdgcn_mfma_f32_16x16x32_bf16(Bt[n][k], At[m][k], acc[ai][bj][m][n], 0, 0, 0); __builtin_amdgcn_s_setprio(0); } while (0)
#define PG8_WAIT_V(n) asm volatile("s_waitcnt vmcnt(" #n ")" ::: "memory")
#define PG8_WAIT_L(n) asm volatile("s_waitcnt lgkmcnt(" #n ")" ::: "memory")
#define PG8_BAR __builtin_amdgcn_s_barrier()
#define PG8_SCHED __builtin_amdgcn_sched_barrier(0)
    Unit cur, nxt; int ui = 0;
    if (!S.next(0, cur)) return;
    f32x4 acc[2][2][4][2];
#pragma unroll
    for (int a = 0; a < 2; ++a)
#pragma unroll
        for (int b = 0; b < 2; ++b)
#pragma unroll
            for (int m = 0; m < 4; ++m)
#pragma unroll
                for (int n = 0; n < 2; ++n) acc[a][b][m][n] = (f32x4){0.f, 0.f, 0.f, 0.f};
    bf16x8 At[4][2], B0[2][2], B1[2][2];
    const char* cA = (const char*)g.A + (size_t)cur.pm * tstep; const char* cB = (const char*)g.Bt + (size_t)cur.pn * tstep;
    S.a_ready(cur);
    if constexpr (SP2) {
        PG8_STAGE(PG8_SB(0, 0), cB, voffB); PG8_STAGE(PG8_SB(0, 1), cB + hstep, voffB); PG8_STAGE(PG8_SA(0, 0), cA, voffA); PG8_STAGE(PG8_SA(0, 1), cA + hstep, voffA);
        if (wr == 1) PG8_BAR;
        PG8_WAIT_V(2); PG8_BAR;
        PG8_STAGE(PG8_SB(1, 0), cB + kstep, voffB); PG8_STAGE(PG8_SA(1, 0), cA + kstep, voffA); PG8_STAGE(PG8_SB(1, 1), cB + hstep + kstep, voffB);
        PG8_WAIT_V(6); PG8_BAR;
    } else {
        PG8_STAGE(PG8_SB(0, 0), cB, voffB); PG8_STAGE(PG8_SA(0, 0), cA, voffA); PG8_STAGE(PG8_SB(0, 1), cB + hstep, voffB); PG8_STAGE(PG8_SA(0, 1), cA + hstep, voffA);
        if (wr == 1) PG8_BAR;
        PG8_WAIT_V(4); PG8_BAR;
        PG8_STAGE(PG8_SB(1, 0), cB + kstep, voffB); PG8_STAGE(PG8_SA(1, 0), cA + kstep, voffA); PG8_STAGE(PG8_SB(1, 1), cB + hstep + kstep, voffB);
        PG8_WAIT_V(6); PG8_BAR;
    }
    for (;;) {
        const bool has_next = S.next(ui + 1, nxt);
        const char* nA = has_next ? (const char*)g.A + (size_t)nxt.pm * tstep : cA; const char* nB = has_next ? (const char*)g.Bt + (size_t)nxt.pn * tstep : cB;
        for (int t = 0; t < nt; t += 2) {
            if constexpr (Epi::HAS_MID) { if (t == (nt >> 1)) E.mid(acc, cur, wr, wc, fr, fq); }
            const bool last = (t == nt - 2);
            const char* a1 = cA + (size_t)(t + 1) * kstep;
            const char* a2 = last ? nA : cA + (size_t)(t + 2) * kstep; const char* b2 = last ? nB : cB + (size_t)(t + 2) * kstep;
            const char* a3 = a2 + kstep; const char* b3 = b2 + kstep;
            if (last && has_next) S.a_ready(nxt);
            if constexpr (SP2) {
            PG8_LDB(B0, 0, 0); PG8_LDB(B1, 0, 1); PG8_SCHED; PG8_LDA(At, 0, 0); PG8_STAGE(PG8_SA(1, 1), a1 + hstep, voffA);
            PG8_WAIT_V(8); PG8_WAIT_L(0); PG8_BAR; PG8_MMA(0, 0, At, B0); PG8_MMA(0, 1, At, B1); PG8_BAR; PG8_SCHED;
            PG8_LDA(At, 0, 1); PG8_STAGE(PG8_SB(0, 0), b2, voffB); PG8_STAGE(PG8_SB(0, 1), b2 + hstep, voffB); PG8_STAGE(PG8_SA(0, 0), a2, voffA);
            PG8_WAIT_V(8); PG8_WAIT_L(0); PG8_BAR; PG8_MMA(1, 0, At, B0); PG8_MMA(1, 1, At, B1); PG8_BAR; PG8_SCHED;
            PG8_LDB(B0, 1, 0); PG8_LDB(B1, 1, 1); PG8_SCHED; PG8_LDA(At, 1, 0); PG8_STAGE(PG8_SA(0, 1), a2 + hstep, voffA);
            PG8_WAIT_V(8); PG8_WAIT_L(0); PG8_BAR; PG8_MMA(0, 0, At, B0); PG8_MMA(0, 1, At, B1); PG8_BAR; PG8_SCHED;
            PG8_LDA(At, 1, 1); PG8_STAGE(PG8_SB(1, 0), b3, voffB); PG8_STAGE(PG8_SB(1, 1), b3 + hstep, voffB); PG8_STAGE(PG8_SA(1, 0), a3, voffA);
            PG8_WAIT_V(8); PG8_WAIT_L(0); PG8_BAR; PG8_MMA(1, 0, At, B0); PG8_MMA(1, 1, At, B1); PG8_BAR; PG8_SCHED;
            } else {
            PG8_LDB(B0, 0, 0); PG8_SCHED; PG8_LDA(At, 0, 0); PG8_STAGE(PG8_SA(1, 1), a1 + hstep, voffA);
            PG8_WAIT_L(8); PG8_BAR; PG8_WAIT_L(0); PG8_MMA(0, 0, At, B0); PG8_BAR; PG8_SCHED;
            PG8_LDB(B1, 0, 1); PG8_STAGE(PG8_SB(0, 0), b2, voffB);
            PG8_BAR; PG8_WAIT_L(0); PG8_MMA(0, 1, At, B1); PG8_BAR;
            PG8_LDA(At, 0, 1); PG8_STAGE(PG8_SA(0, 0), a2, voffA);
            PG8_BAR; PG8_WAIT_L(0); PG8_MMA(1, 0, At, B0); PG8_BAR; PG8_SCHED;
            PG8_STAGE(PG8_SB(0, 1), b2 + hstep, voffB);
            PG8_WAIT_V(6); PG8_BAR; PG8_MMA(1, 1, At, B1); PG8_BAR;
            PG8_LDB(B0, 1, 0); PG8_SCHED; PG8_LDA(At, 1, 0); PG8_STAGE(PG8_SA(0, 1), a2 + hstep, voffA);
            PG8_WAIT_L(8); PG8_BAR; PG8_WAIT_L(0); PG8_MMA(0, 0, At, B0); PG8_BAR; PG8_SCHED;
            PG8_LDB(B1, 1, 1); PG8_STAGE(PG8_SB(1, 0), b3, voffB);
            PG8_BAR; PG8_WAIT_L(0); PG8_MMA(0, 1, At, B1); PG8_BAR;
            PG8_LDA(At, 1, 1); PG8_STAGE(PG8_SA(1, 0), a3, voffA);
            PG8_BAR; PG8_WAIT_L(0); PG8_MMA(1, 0, At, B0); PG8_BAR; PG8_SCHED;
            PG8_STAGE(PG8_SB(1, 1), b3 + hstep, voffB);
            PG8_WAIT_V(6); PG8_BAR; PG8_MMA(1, 1, At, B1); PG8_BAR;
            }
        }
        if constexpr (ALIGN_EPI) { if (wr == 0) PG8_BAR; }
        if constexpr (!Epi::AFTER_DRAIN) { E(acc, cur, wr, wc, fr, fq); S.done(cur); }
        if (!has_next) break;
#pragma unroll
        for (int a = 0; a < 2; ++a)
#pragma unroll
            for (int b = 0; b < 2; ++b)
#pragma unroll
                for (int m = 0; m < 4; ++m)
#pragma unroll
                    for (int n = 0; n < 2; ++n) acc[a][b][m][n] = (f32x4){0.f, 0.f, 0.f, 0.f};
        cur = nxt; cA = nA; cB = nB; ++ui;
        if constexpr (ALIGN_EPI) { if (wr == 1) PG8_BAR; }
    }
    PG8_WAIT_V(0);
    if constexpr (!ALIGN_EPI) { if (wr == 0) PG8_BAR; }
    PG8_BAR;
    if constexpr (Epi::AFTER_DRAIN) { E.fused(acc, cur, wr, wc, fr, fq, lds, wid, lane); S.done(cur); }
#undef PG8_SA
#undef PG8_SB
#undef PG8_STAGE
#undef PG8_LDA
#undef PG8_LDB
#undef PG8_MMA
#undef PG8_WAIT_V
#undef PG8_WAIT_L
#undef PG8_BAR
#undef PG8_SCHED
}
}
using pg8::bf16_t; using pg8::bf16x8; using pg8::f32x4; using pg8::u32x4; using pg8::cvt_pk_bf16; using pg8::bflo; using pg8::bfhi; using pg8::sigm;
typedef unsigned u32x2 __attribute__((ext_vector_type(2)));
constexpr int MP = 16384, MS = 1024, MT = MP + MS;
constexpr int DIN = 4360, NPROJ = 4352, NMIX = 2304, NGATE = 2048, DFF = 2816;
constexpr float EPS = 1e-6f, LOG2E = 1.4426950408889634f;
constexpr size_t MiB = 1u << 20;
constexpr size_t WS_ROWSS = 0;
constexpr size_t WS_SUMA = 128 * 1024, WS_SUMM = WS_SUMA + 4096, WS_MCH = WS_SUMM + 4096;
constexpr size_t WS_GI = 256 * 1024, WS_GB = WS_GI + 320 * 1024;
constexpr size_t WS_DN = 1 * MiB, WS_NPREV = WS_DN + 256 * 1024;
constexpr size_t WS_WIN = 2 * MiB;
constexpr size_t WS_WAB = WS_WIN + 17 * MiB / 2;
constexpr size_t WS_WOUT = WS_WAB + 2 * MiB;
constexpr size_t WS_WGU = WS_WOUT + 2 * MiB;
constexpr size_t WS_WD = WS_WGU + 11 * MiB;
constexpr size_t WS_HN = WS_WD + 11 * MiB / 2;
constexpr size_t OB_DCT = 34 * MiB, OB_CPT = 50 * MiB;
constexpr size_t WS_MIXIN = WS_HN + 34 * MiB;
constexpr size_t WS_GATES = WS_MIXIN + 153 * MiB / 2;
constexpr size_t WS_HCAT = WS_GATES + 68 * MiB;
constexpr size_t WS_END = WS_HCAT + 34 * MiB;
static_assert(WS_END <= 256 * MiB, "workspace map");
constexpr size_t O_Y = 0, O_CP = (size_t)MT * 1024, O_NP = O_CP + 65536, O_MP = O_NP + 512, O_KWP = O_MP + 8, O_VWP = O_KWP + 32768,
                 O_CS = O_VWP + 32768, O_NS = O_CS + 4194304, O_MS = O_NS + 32768, O_KWS = O_MS + 512, O_VWS = O_KWS + 2097152, O_END = O_VWS + 2097152;
constexpr size_t WS_BAR = 1536 * 1024;
constexpr int LDS_BYTES = 131072 + 256;

struct Params { const float* in[22]; float* out; unsigned char* ws; int ph_lo, ph_hi; };

__device__ __forceinline__ float bf2f(bf16_t h) { return __builtin_bit_cast(float, (unsigned)h << 16); }
__device__ __forceinline__ bf16_t f2bf(float f) { return (bf16_t)(cvt_pk_bf16(f, 0.f) & 0xffffu); }
__device__ __forceinline__ float wave_sum(float v) {
#pragma unroll
    for (int o = 1; o < 64; o <<= 1) v += __shfl_xor(v, o);
    return v; }
__device__ __forceinline__ float wave_max(float v) {
#pragma unroll
    for (int o = 1; o < 64; o <<= 1) v = fmaxf(v, __shfl_xor(v, o));
    return v; }
__device__ __forceinline__ f32x4 mfma16(bf16x8 a, bf16x8 b, f32x4 c) { f32x4 d = __builtin_amdgcn_mfma_f32_16x16x32_bf16(a, b, c, 0, 0, 0); asm volatile("" : "+v"(d) : "v"(a), "v"(b)); return d; }
__device__ __forceinline__ bf16x8 pack8(const f32x4& a, const f32x4& b) { u32x4 t; t.x = cvt_pk_bf16(a[0], a[1]); t.y = cvt_pk_bf16(a[2], a[3]); t.z = cvt_pk_bf16(b[0], b[1]); t.w = cvt_pk_bf16(b[2], b[3]); return __builtin_bit_cast(bf16x8, t); }
__device__ __forceinline__ void unpack8(const u32x4& r, float* f) { f[0] = bflo(r.x); f[1] = bfhi(r.x); f[2] = bflo(r.y); f[3] = bfhi(r.y); f[4] = bflo(r.z); f[5] = bfhi(r.z); f[6] = bflo(r.w); f[7] = bfhi(r.w); }

__device__ __forceinline__ void p0_tokens(const Params& P, unsigned char* lds, int tid, int G) {
    const float* wg = (const float*)lds; const float* nw = P.in[7];
    bf16_t* HN = (bf16_t*)(P.ws + WS_HN); float* gi = (float*)(P.ws + WS_GI); float* gb = (float*)(P.ws + WS_GB);
    const int lane = tid & 63, w = tid >> 6;
    f32x4 xn[4];
    { const int r = blockIdx.x * 8 + w; const float* xrow = r < MP ? P.in[0] + (size_t)r * 1024 : P.in[1] + (size_t)(r - MP) * 1024;
#pragma unroll
        for (int j = 0; j < 4; ++j) xn[j] = ((const f32x4*)xrow)[lane + 64 * j]; }
#pragma unroll 1
    for (int r = blockIdx.x * 8 + w; r < MT; r += G * 8) {
        f32x4 xv[4]; float ss = 0.f;
#pragma unroll
        for (int j = 0; j < 4; ++j) xv[j] = xn[j];
        { const int rn = (r + G * 8 < MT) ? r + G * 8 : r; const float* xrow = rn < MP ? P.in[0] + (size_t)rn * 1024 : P.in[1] + (size_t)(rn - MP) * 1024;
#pragma unroll
            for (int j = 0; j < 4; ++j) xn[j] = ((const f32x4*)xrow)[lane + 64 * j]; }
#pragma unroll
        for (int j = 0; j < 4; ++j) ss += (xv[j][0] * xv[j][0] + xv[j][1] * xv[j][1]) + (xv[j][2] * xv[j][2] + xv[j][3] * xv[j][3]);
        ss = wave_sum(ss);
        const float rstd = 1.0f / sqrtf(ss * (1.0f / 1024.0f) + EPS);
        float g[8];
#pragma unroll
        for (int q = 0; q < 8; ++q) g[q] = 0.f;
#pragma unroll
        for (int j = 0; j < 4; ++j) { const int k0 = 4 * (lane + 64 * j);
            const f32x4 nv = *(const f32x4*)(nw + k0); const f32x4 hv = xv[j] * rstd * nv;
            u32x2 pk; pk.x = cvt_pk_bf16(hv[0], hv[1]); pk.y = cvt_pk_bf16(hv[2], hv[3]);
            *(u32x2*)(HN + (size_t)r * 1024 + k0) = pk;
#pragma unroll
            for (int q = 0; q < 8; ++q) { const f32x4 wv = *(const f32x4*)(wg + q * 1024 + k0); g[q] += (xv[j][0] * wv[0] + xv[j][1] * wv[1]) + (xv[j][2] * wv[2] + xv[j][3] * wv[3]); } }
#pragma unroll
        for (int q = 0; q < 8; ++q) g[q] = wave_sum(g[q]);
        if (lane < 4) { const float iv = (lane == 0 ? g[0] : lane == 1 ? g[1] : lane == 2 ? g[2] : g[3]) * rstd + P.in[9][lane];
            const float fv = (lane == 0 ? g[4] : lane == 1 ? g[5] : lane == 2 ? g[6] : g[7]) * rstd + P.in[10][lane];
            gi[r * 4 + lane] = iv; gb[r * 4 + lane] = fminf(fv, 0.f) - log1pf(expf(-fabsf(fv))); }
    }
}
template <bool GU>
__device__ __forceinline__ void p0_wunit(const float* src, int ldsrc, int k0, int c0, bf16_t* dst, int lddst, int n0, int k0d, unsigned char* lds, int tid) {
    float* tile = (float*)(lds + 40960);
    f32x4 v[8];
#pragma unroll
    for (int p = 0; p < 8; ++p) v[p] = *(const f32x4*)(src + (size_t)(k0 + (tid >> 6) + 8 * p) * ldsrc + c0 + (tid & 63) * 4);
#pragma unroll
    for (int p = 0; p < 8; ++p) *(f32x4*)(tile + ((tid >> 6) + 8 * p) * 260 + (tid & 63) * 4) = v[p];
    __syncthreads();
    { const int n = tid >> 1, kc = (tid & 1) * 32; const float* s = tile + kc * 260 + n;
        const int nd = GU ? (256 * ((c0 + n) >> 7) + ((c0 + n) & 127) + n0) : (n0 + n);
        bf16_t* dp = dst + (size_t)nd * lddst + k0d + kc;
#pragma unroll
        for (int q = 0; q < 4; ++q) { u32x4 o; o.x = cvt_pk_bf16(s[(8 * q) * 260], s[(8 * q + 1) * 260]); o.y = cvt_pk_bf16(s[(8 * q + 2) * 260], s[(8 * q + 3) * 260]);
            o.z = cvt_pk_bf16(s[(8 * q + 4) * 260], s[(8 * q + 5) * 260]); o.w = cvt_pk_bf16(s[(8 * q + 6) * 260], s[(8 * q + 7) * 260]); *(u32x4*)(dp + 8 * q) = o; } }
    __syncthreads();
}
constexpr int NT_IN = 17 * 16, NT_AB = 64, NT_OUT = 64, NT_GU = 352, NT_D = 176, NT_ALL = NT_IN + NT_AB + NT_OUT + NT_GU + NT_D;
__device__ __forceinline__ void wtile_by_index(const Params& P, int r, unsigned char* lds, int tid) {
    if (r < NT_IN) { const int nt = r >> 4, kt = r & 15, c0 = nt * 256; p0_wunit<false>(P.in[8], DIN, kt * 64, c0 < 1536 ? c0 : c0 + 8, (bf16_t*)(P.ws + WS_WIN), 1024, c0, kt * 64, lds, tid); return; } r -= NT_IN;
    if (r < NT_AB) { const int which = r >> 5, rr = r & 31, nt = rr >> 3, kt = rr & 7; p0_wunit<false>(which ? P.in[16] : P.in[15], 1024, kt * 64, nt * 256, (bf16_t*)(P.ws + WS_WAB), 1024, nt * 256, which * 512 + kt * 64, lds, tid); return; } r -= NT_AB;
    if (r < NT_OUT) { const int nt = r >> 4, kt = r & 15; p0_wunit<false>(P.in[17], 1024, kt * 64, nt * 256, (bf16_t*)(P.ws + WS_WOUT), 1024, nt * 256, kt * 64, lds, tid); return; } r -= NT_OUT;
    if (r < NT_GU) { const int which = r / 176, rr = r % 176, jt = rr >> 4, kt = rr & 15; p0_wunit<true>(which ? P.in[20] : P.in[19], DFF, kt * 64, jt * 256, (bf16_t*)(P.ws + WS_WGU), 1024, which * 128, kt * 64, lds, tid); return; } r -= NT_GU;
    { const int nt = r / 44, kt = r % 44; p0_wunit<false>(P.in[21], 1024, kt * 64, nt * 256, (bf16_t*)(P.ws + WS_WD), DFF, nt * 256, kt * 64, lds, tid); }
}
__device__ __forceinline__ void p0_prep(const Params& P, unsigned char* lds, int tid, int G) {
    float* rowss = (float*)(P.ws + WS_ROWSS);
    for (int i = blockIdx.x * 512 + tid; i < MT; i += G * 512) rowss[i] = 0.f;
    { float* wg = (float*)lds; const float* w_in = P.in[8]; const float* nw = P.in[7];
        for (int idx = tid; idx < 8192; idx += 512) { const int k = idx >> 3, q = idx & 7; wg[q * 1024 + k] = w_in[(size_t)k * DIN + 1536 + q] * nw[k]; } }
    __syncthreads();
    p0_tokens(P, lds, tid, G);
    __syncthreads();
    for (int it = blockIdx.x; it < NT_IN; it += G) wtile_by_index(P, it, lds, tid);
}

template <int NQT>
__device__ __forceinline__ void attn_core(const unsigned char* lds, const bf16x8 (&qf)[NQT][2], int kt_lo, int kt_hi, int qbase, int jmin, float sink2, f32x4 (&o)[4][NQT], float (&l)[NQT]) {
    const bf16_t* Ks = (const bf16_t*)lds; const bf16_t* Vt = (const bf16_t*)(lds + 36864);
    const int lane = threadIdx.x & 63, fr = lane & 15, g = lane >> 4;
    float mrun[NQT];
#pragma unroll
    for (int qt = 0; qt < NQT; ++qt) { mrun[qt] = sink2; l[qt] = (g == 0) ? 1.f : 0.f;
#pragma unroll
        for (int dt = 0; dt < 4; ++dt) o[dt][qt] = (f32x4){0.f, 0.f, 0.f, 0.f}; }
#pragma unroll 1
    for (int kt = kt_lo; kt <= kt_hi; ++kt) {
        f32x4 s[4][NQT];
#pragma unroll
        for (int ks = 0; ks < 4; ++ks)
#pragma unroll
            for (int qt = 0; qt < NQT; ++qt) s[ks][qt] = (f32x4){0.f, 0.f, 0.f, 0.f};
        { bf16x8 kfr[4][2];
#pragma unroll
        for (int ks = 0; ks < 4; ++ks)
#pragma unroll
            for (int kk = 0; kk < 2; ++kk) kfr[ks][kk] = *(const bf16x8*)(Ks + (kt * 64 + ks * 16 + fr) * 72 + g * 8 + kk * 32);
#pragma unroll
        for (int ks = 0; ks < 4; ++ks)
#pragma unroll
            for (int kk = 0; kk < 2; ++kk)
#pragma unroll
                for (int qt = 0; qt < NQT; ++qt) s[ks][qt] = mfma16(kfr[ks][kk], qf[qt][kk], s[ks][qt]); }
#pragma unroll
        for (int qt = 0; qt < NQT; ++qt) { const int qi = qbase + 16 * qt + fr; float mx = -1e30f;
#pragma unroll
            for (int ks = 0; ks < 4; ++ks)
#pragma unroll
                for (int r = 0; r < 4; ++r) { const int j = kt * 64 + ks * 16 + g * 4 + r; const bool ok = (j > qi) && (j <= qi + 128) && (j >= jmin);
                    const float v = ok ? s[ks][qt][r] : -1e30f; s[ks][qt][r] = v; mx = fmaxf(mx, v); }
            mx = fmaxf(mx, __shfl_xor(mx, 16)); mx = fmaxf(mx, __shfl_xor(mx, 32));
            const float mnew = fmaxf(mrun[qt], mx), alpha = __builtin_amdgcn_exp2f(mrun[qt] - mnew); mrun[qt] = mnew;
            float ps = 0.f;
#pragma unroll
            for (int ks = 0; ks < 4; ++ks)
#pragma unroll
                for (int r = 0; r < 4; ++r) { const float p = __builtin_amdgcn_exp2f(s[ks][qt][r] - mnew); s[ks][qt][r] = p; ps += p; }
            l[qt] = l[qt] * alpha + ps;
#pragma unroll
            for (int dt = 0; dt < 4; ++dt) o[dt][qt] = o[dt][qt] * alpha; }
        { bf16x8 vfr[2][4], pf[2][NQT];
#pragma unroll
        for (int c = 0; c < 2; ++c) {
#pragma unroll
            for (int dt = 0; dt < 4; ++dt) { const bf16_t* vp = Vt + (dt * 16 + fr) * 264 + kt * 64 + c * 32 + g * 4;
                const u32x2 v0 = *(const u32x2*)vp, v1 = *(const u32x2*)(vp + 16);
                vfr[c][dt] = __builtin_bit_cast(bf16x8, (u32x4){v0.x, v0.y, v1.x, v1.y}); }
#pragma unroll
            for (int qt = 0; qt < NQT; ++qt) pf[c][qt] = pack8(s[2 * c][qt], s[2 * c + 1][qt]); }
#pragma unroll
        for (int c = 0; c < 2; ++c)
#pragma unroll
            for (int dt = 0; dt < 4; ++dt)
#pragma unroll
                for (int qt = 0; qt < NQT; ++qt) o[dt][qt] = mfma16(vfr[c][dt], pf[c][qt], o[dt][qt]); }
    }
}
__device__ __forceinline__ void attn_put(unsigned char* lds, int slot, int hh, const float* kf, const float* vf) {
    bf16_t* Ks = (bf16_t*)lds; bf16_t* Vt = (bf16_t*)(lds + 36864);
#pragma unroll
    for (int i = 0; i < 4; ++i) { u32x4 w; w.x = cvt_pk_bf16(kf[8 * i], kf[8 * i + 1]); w.y = cvt_pk_bf16(kf[8 * i + 2], kf[8 * i + 3]); w.z = cvt_pk_bf16(kf[8 * i + 4], kf[8 * i + 5]); w.w = cvt_pk_bf16(kf[8 * i + 6], kf[8 * i + 7]);
        *(u32x4*)(Ks + slot * 72 + hh * 32 + 8 * i) = w; }
#pragma unroll
    for (int i = 0; i < 32; ++i) Vt[(hh * 32 + i) * 264 + slot] = f2bf(vf[i]);
}
__device__ __forceinline__ void attn_prompt_item(const Params& P, int item, unsigned char* lds, int tid) {
    const int kvh = item & 1, n = (item >> 1) & 63, b = item >> 7;
    const bf16_t* mixin = (const bf16_t*)(P.ws + WS_MIXIN);
    { const int slot = tid >> 1, hh = tid & 1, tokb = n * 128 - 128 + slot;
        float kf[32], vf[32];
        if (tokb >= 0) { const bf16_t* rowp = mixin + (size_t)(b * 8192 + tokb) * NMIX + 2048 + kvh * 64 + hh * 32;
#pragma unroll
            for (int i = 0; i < 4; ++i) { const u32x4 kr = *(const u32x4*)(rowp + 8 * i), vr = *(const u32x4*)(rowp + 128 + 8 * i); unpack8(kr, kf + 8 * i); unpack8(vr, vf + 8 * i); } }
        else {
#pragma unroll
            for (int i = 0; i < 32; ++i) { kf[i] = 0.f; vf[i] = 0.f; } }
        float ss = 0.f;
#pragma unroll
        for (int i = 0; i < 32; ++i) ss += kf[i] * kf[i];
        ss += __shfl_xor(ss, 1);
        const float rstd = 1.0f / sqrtf(ss * (1.0f / 64.0f) + EPS);
#pragma unroll
        for (int i = 0; i < 32; ++i) kf[i] = kf[i] * rstd * P.in[13][hh * 32 + i];
        attn_put(lds, slot, hh, kf, vf);
        if (n == 63 && slot >= 128) { float* kw = P.out + O_KWP + ((size_t)(b * 128 + slot - 128) * 2 + kvh) * 64 + hh * 32; float* vw = P.out + O_VWP + ((size_t)(b * 128 + slot - 128) * 2 + kvh) * 64 + hh * 32;
#pragma unroll
            for (int i = 0; i < 8; ++i) { *(f32x4*)(kw + 4 * i) = (f32x4){kf[4 * i], kf[4 * i + 1], kf[4 * i + 2], kf[4 * i + 3]}; *(f32x4*)(vw + 4 * i) = (f32x4){vf[4 * i], vf[4 * i + 1], vf[4 * i + 2], vf[4 * i + 3]}; } }
    }
    __syncthreads();
    const int w = tid >> 6, lane = tid & 63, fr = lane & 15, g = lane >> 4, gq = w >> 1, half = w & 1, head = kvh * 4 + gq;
    bf16_t* hcat = (bf16_t*)(P.ws + WS_HCAT);
#pragma unroll 1
    for (int qh = 0; qh < 2; ++qh) {
    bf16x8 qf[2][2];
#pragma unroll
    for (int qt = 0; qt < 2; ++qt) { const int tok = b * 8192 + n * 128 + half * 64 + qh * 32 + qt * 16 + fr; const bf16_t* qp = mixin + (size_t)tok * NMIX + 1536 + head * 64 + g * 8;
        float f0[8], f1[8]; unpack8(*(const u32x4*)qp, f0); unpack8(*(const u32x4*)(qp + 32), f1);
        float ss = 0.f;
#pragma unroll
        for (int i = 0; i < 8; ++i) ss += f0[i] * f0[i] + f1[i] * f1[i];
        ss += __shfl_xor(ss, 16); ss += __shfl_xor(ss, 32);
        const float sc = (0.125f * LOG2E) / sqrtf(ss * (1.0f / 64.0f) + EPS);
#pragma unroll
        for (int i = 0; i < 8; ++i) { f0[i] = f0[i] * sc * P.in[12][g * 8 + i]; f1[i] = f1[i] * sc * P.in[12][32 + g * 8 + i]; }
        qf[qt][0] = pack8((f32x4){f0[0], f0[1], f0[2], f0[3]}, (f32x4){f0[4], f0[5], f0[6], f0[7]}); qf[qt][1] = pack8((f32x4){f1[0], f1[1], f1[2], f1[3]}, (f32x4){f1[4], f1[5], f1[6], f1[7]}); }
    f32x4 o[4][2]; float l[2];
    attn_core<2>(lds, qf, half, half + 2, half * 64 + qh * 32, n == 0 ? 128 : 0, P.in[14][head] * LOG2E, o, l);
#pragma unroll
    for (int qt = 0; qt < 2; ++qt) { float lt = l[qt]; lt += __shfl_xor(lt, 16); lt += __shfl_xor(lt, 32); const float inv = 1.0f / lt;
        const int tok = b * 8192 + n * 128 + half * 64 + qh * 32 + qt * 16 + fr;
#pragma unroll
        for (int dt = 0; dt < 4; ++dt) { const f32x4 v = o[dt][qt] * inv; u32x2 pk; pk.x = cvt_pk_bf16(v[0], v[1]); pk.y = cvt_pk_bf16(v[2], v[3]);
            *(u32x2*)(hcat + (size_t)tok * 1024 + 512 + head * 64 + dt * 16 + g * 4) = pk; } }
    }
    __syncthreads();
}
__device__ __forceinline__ void attn_sample_item(const Params& P, int item, unsigned char* lds, int tid) {
    const int kvh = item & 1, b = item >> 1;
    const bf16_t* mixin = (const bf16_t*)(P.ws + WS_MIXIN);
    { const int slot = tid >> 1, hh = tid & 1;
        if (slot < 192) { float kf[32], vf[32];
            if (slot < 128) { const size_t off = ((size_t)(b * 128 + slot) * 2 + kvh) * 64 + hh * 32; const float* kp = P.in[5] + off; const float* vp = P.in[6] + off;
#pragma unroll
                for (int i = 0; i < 8; ++i) { const f32x4 a = *(const f32x4*)(kp + 4 * i), c = *(const f32x4*)(vp + 4 * i);
                    kf[4 * i] = a[0]; kf[4 * i + 1] = a[1]; kf[4 * i + 2] = a[2]; kf[4 * i + 3] = a[3]; vf[4 * i] = c[0]; vf[4 * i + 1] = c[1]; vf[4 * i + 2] = c[2]; vf[4 * i + 3] = c[3]; } }
            else if (slot < 136) { const bf16_t* rowp = mixin + (size_t)(MP + b * 8 + slot - 128) * NMIX + 2048 + kvh * 64 + hh * 32;
#pragma unroll
                for (int i = 0; i < 4; ++i) { const u32x4 kr = *(const u32x4*)(rowp + 8 * i), vr = *(const u32x4*)(rowp + 128 + 8 * i); unpack8(kr, kf + 8 * i); unpack8(vr, vf + 8 * i); }
                float ss = 0.f;
#pragma unroll
                for (int i = 0; i < 32; ++i) ss += kf[i] * kf[i];
                ss += __shfl_xor(ss, 1);
                const float rstd = 1.0f / sqrtf(ss * (1.0f / 64.0f) + EPS);
#pragma unroll
                for (int i = 0; i < 32; ++i) kf[i] = kf[i] * rstd * P.in[13][hh * 32 + i]; }
            else {
#pragma unroll
                for (int i = 0; i < 32; ++i) { kf[i] = 0.f; vf[i] = 0.f; } }
            attn_put(lds, slot, hh, kf, vf);
            if (slot >= 8 && slot < 136) { const size_t off = ((size_t)(b * 128 + slot - 8) * 2 + kvh) * 64 + hh * 32; float* kw = P.out + O_KWS + off; float* vw = P.out + O_VWS + off;
#pragma unroll
                for (int i = 0; i < 8; ++i) { *(f32x4*)(kw + 4 * i) = (f32x4){kf[4 * i], kf[4 * i + 1], kf[4 * i + 2], kf[4 * i + 3]}; *(f32x4*)(vw + 4 * i) = (f32x4){vf[4 * i], vf[4 * i + 1], vf[4 * i + 2], vf[4 * i + 3]}; } }
        }
    }
    __syncthreads();
    const int w = tid >> 6, lane = tid & 63, fr = lane & 15, g = lane >> 4;
    if (w < 4) { const int head = kvh * 4 + w; const int tok = MP + b * 8 + (fr & 7);
        bf16x8 qf[1][2];
        { const bf16_t* qp = mixin + (size_t)tok * NMIX + 1536 + head * 64 + g * 8;
            float f0[8], f1[8]; unpack8(*(const u32x4*)qp, f0); unpack8(*(const u32x4*)(qp + 32), f1);
            float ss = 0.f;
#pragma unroll
            for (int i = 0; i < 8; ++i) ss += f0[i] * f0[i] + f1[i] * f1[i];
            ss += __shfl_xor(ss, 16); ss += __shfl_xor(ss, 32);
            const float sc = (0.125f * LOG2E) / sqrtf(ss * (1.0f / 64.0f) + EPS);
#pragma unroll
            for (int i = 0; i < 8; ++i) { f0[i] = f0[i] * sc * P.in[12][g * 8 + i]; f1[i] = f1[i] * sc * P.in[12][32 + g * 8 + i]; }
            qf[0][0] = pack8((f32x4){f0[0], f0[1], f0[2], f0[3]}, (f32x4){f0[4], f0[5], f0[6], f0[7]}); qf[0][1] = pack8((f32x4){f1[0], f1[1], f1[2], f1[3]}, (f32x4){f1[4], f1[5], f1[6], f1[7]}); }
        f32x4 o[4][1]; float l[1];
        attn_core<1>(lds, qf, 0, 2, 0, 0, P.in[14][head] * LOG2E, o, l);
        float lt = l[0]; lt += __shfl_xor(lt, 16); lt += __shfl_xor(lt, 32); const float inv = 1.0f / lt;
        bf16_t* hcat = (bf16_t*)(P.ws + WS_HCAT);
        if (fr < 8) {
#pragma unroll
            for (int dt = 0; dt < 4; ++dt) { const f32x4 v = o[dt][0] * inv; u32x2 pk; pk.x = cvt_pk_bf16(v[0], v[1]); pk.y = cvt_pk_bf16(v[2], v[3]);
                *(u32x2*)(hcat + (size_t)tok * 1024 + 512 + head * 64 + dt * 16 + g * 4) = pk; } }
    }
    __syncthreads();
}
#define LAS __attribute__((address_space(3)))
#define XB_TMO      128
#define XB_XCNT(j)  (256  + 64 * (j))
#define XB_XSUB(j)  (1280 + 64 * (j))
#define XB_XGEN(j)  (2304 + 64 * (j))
#define XB_TOP      3328
#define XB_TOPGEN   3392
#define XCD_BAR_WORDS 3456
#define XB_SPIN_CAP (1u << 18)

__device__ __forceinline__ unsigned xb_ld(unsigned* p)              { return __hip_atomic_load(p, __ATOMIC_RELAXED, __HIP_MEMORY_SCOPE_AGENT); }
__device__ __forceinline__ unsigned xb_add(unsigned* p, unsigned v) { return __hip_atomic_fetch_add(p, v, __ATOMIC_RELAXED, __HIP_MEMORY_SCOPE_AGENT); }
__device__ __forceinline__ unsigned xb_xcc_id() { return (unsigned)__builtin_amdgcn_s_getreg((3 << 11) | 20) & 0xFu; }
#define XB_SPIN(cond, bar) do { unsigned _sp = 0; while (cond) { __builtin_amdgcn_s_sleep(1); \
    if ((++_sp & 255u) == 0u) { if (xb_ld(&(bar)[XB_TMO])) break; if (_sp > XB_SPIN_CAP) { atomicAdd(&(bar)[XB_TMO], 1u); break; } } } } while (0)

struct XcdBarrier {
    unsigned* bar; unsigned x;
    volatile LAS unsigned* st;
};

__device__ __forceinline__ XcdBarrier xcd_barrier_post(unsigned* bar, volatile LAS unsigned* st) {
    XcdBarrier b; b.bar = bar; b.x = xb_xcc_id(); b.st = st;
    if (threadIdx.x == 0) (void)xb_add(&bar[XB_XCNT(b.x)], 1u);
    return b;
}
__device__ __forceinline__ void xcd_barrier_complete(unsigned* bar, unsigned x, unsigned& nloc, unsigned& nx) {
    const unsigned G = gridDim.x * gridDim.y * gridDim.z;
    unsigned sum, cnt, mine, sp = 0u;
    for (;;) {
        sum = 0u; cnt = 0u; mine = 0u;
#pragma unroll
        for (unsigned j = 0; j < 16; ++j) { const unsigned c = xb_ld(&bar[XB_XCNT(j)]); sum += c; cnt += (c > 0u) ? 1u : 0u; mine = (j == x) ? c : mine; }
        if (sum == G) break;
        __builtin_amdgcn_s_sleep(1);
        if ((++sp & 255u) == 0u) { if (xb_ld(&bar[XB_TMO])) break; if (sp > XB_SPIN_CAP) { atomicAdd(&bar[XB_TMO], 1u); break; } }
    }
    nloc = mine > 0u ? mine : 1u; nx = cnt > 0u ? cnt : 1u;
}

__device__ __forceinline__ void xcd_barrier(const XcdBarrier& b) {
    asm volatile("s_waitcnt vmcnt(0)" ::: "memory");
    __syncthreads();
    if (threadIdx.x == 0) {
        unsigned* bar = b.bar;
        __builtin_amdgcn_s_waitcnt(0);
        unsigned nloc = b.st[0], nx = b.st[1];
        if (nloc == 0u) { xcd_barrier_complete(bar, b.x, nloc, nx); b.st[0] = nloc; b.st[1] = nx; }
        const unsigned old = xb_add(&bar[XB_XSUB(b.x)], 1u);
        const unsigned gen = old / nloc;
        if (old + 1u == (gen + 1u) * nloc) {
            __builtin_amdgcn_fence(__ATOMIC_RELEASE, "agent");
            asm volatile("s_waitcnt vmcnt(0)" ::: "memory");
            const unsigned og = xb_add(&bar[XB_TOP], 1u);
            const unsigned tg = og / nx;
            if (og + 1u == (tg + 1u) * nx) xb_add(&bar[XB_TOPGEN], 1u);
            else XB_SPIN(xb_ld(&bar[XB_TOPGEN]) == tg, bar);
            __builtin_amdgcn_fence(__ATOMIC_ACQUIRE, "agent");
            xb_add(&bar[XB_XGEN(b.x)], 1u);
            asm volatile("s_waitcnt vmcnt(0)" ::: "memory");
        } else {
            XB_SPIN(xb_ld(&bar[XB_XGEN(b.x)]) == gen, bar);
            __builtin_amdgcn_fence(__ATOMIC_ACQUIRE, "agent");
            asm volatile("s_waitcnt vmcnt(0)" ::: "memory");
        }
    }
    __syncthreads();
}
__device__ __forceinline__ void mlstm_b_item(const Params& P, int item, unsigned char* lds, int tid) {
    const int c = item & 127, h = (item >> 7) & 3, b = item >> 9, r0 = b * 8192 + c * 64;
    float* wl = (float*)lds; bf16_t* Kt = (bf16_t*)(lds + 256); bf16_t* Vt = (bf16_t*)(lds + 256 + 9216);
    const bf16_t* mixin = (const bf16_t*)(P.ws + WS_MIXIN);
    if (tid < 64) { const float iv = ((const float*)(P.ws + WS_GI))[(r0 + tid) * 4 + h]; float bb = ((const float*)(P.ws + WS_GB))[(r0 + tid) * 4 + h];
#pragma unroll
        for (int o = 1; o < 64; o <<= 1) { const float nb = __shfl_up(bb, o); if (tid >= o) bb += nb; }
        const float A = __shfl(bb, 63), v = A - bb + iv, M = wave_max(v); wl[tid] = __expf(v - M) * 0.125f;
        if (tid == 0) { ((float*)(P.ws + WS_SUMA))[item] = A; ((float*)(P.ws + WS_SUMM))[item] = M; } }
    __syncthreads();
    { const int s = tid >> 3, ch = tid & 7; const bf16_t* rowp = mixin + (size_t)(r0 + s) * NMIX; const float ws_ = wl[s];
        float kf[8]; unpack8(*(const u32x4*)(rowp + 256 + h * 64 + ch * 8), kf);
#pragma unroll
        for (int i = 0; i < 8; ++i) Kt[(ch * 8 + i) * 72 + s] = f2bf(kf[i] * ws_);
        const u32x4 v0 = *(const u32x4*)(rowp + 512 + h * 128 + ch * 16), v1 = *(const u32x4*)(rowp + 512 + h * 128 + ch * 16 + 8);
        const unsigned vv[8] = {v0.x, v0.y, v0.z, v0.w, v1.x, v1.y, v1.z, v1.w};
#pragma unroll
        for (int i = 0; i < 8; ++i) { Vt[(ch * 16 + 2 * i) * 72 + s] = (bf16_t)(vv[i] & 0xffffu); Vt[(ch * 16 + 2 * i + 1) * 72 + s] = (bf16_t)(vv[i] >> 16); } }
    __syncthreads();
    { const int w = tid >> 6, lane = tid & 63, fr = lane & 15, g = lane >> 4, e0 = 16 * w;
        f32x4 acc[4];
#pragma unroll
        for (int dt = 0; dt < 4; ++dt) acc[dt] = (f32x4){0.f, 0.f, 0.f, 0.f};
        bf16x8 vfr[2], kfr[2][4];
#pragma unroll
        for (int kk = 0; kk < 2; ++kk) { vfr[kk] = *(const bf16x8*)(Vt + (e0 + fr) * 72 + g * 8 + kk * 32);
#pragma unroll
            for (int dt = 0; dt < 4; ++dt) kfr[kk][dt] = *(const bf16x8*)(Kt + (dt * 16 + fr) * 72 + g * 8 + kk * 32); }
#pragma unroll
        for (int kk = 0; kk < 2; ++kk)
#pragma unroll
            for (int dt = 0; dt < 4; ++dt) acc[dt] = mfma16(kfr[kk][dt], vfr[kk], acc[dt]);
        bf16_t* dct = (bf16_t*)((unsigned char*)P.out + OB_DCT) + ((size_t)item * 128 + e0 + fr) * 64;
#pragma unroll
        for (int dt = 0; dt < 4; ++dt) { u32x2 pk; pk.x = cvt_pk_bf16(acc[dt][0], acc[dt][1]); pk.y = cvt_pk_bf16(acc[dt][2], acc[dt][3]); *(u32x2*)(dct + dt * 16 + g * 4) = pk; } }
    if (tid < 64) { float sum = 0.f;
#pragma unroll 8
        for (int s = 0; s < 64; ++s) sum += bf2f(Kt[tid * 72 + s]);
        ((float*)(P.ws + WS_DN))[item * 64 + tid] = sum; }
    __syncthreads();
}
__device__ __forceinline__ void mlstm_scan(const Params& P, unsigned char* lds, int tid) {
    const int pair = blockIdx.x >> 3, sub = blockIdx.x & 7;
    float* ga = (float*)lds; float* ea = ga + 128; float* marr = ea + 128;
    if (tid < 128) { ga[tid] = ((const float*)(P.ws + WS_SUMA))[pair * 128 + tid]; ea[tid] = ((const float*)(P.ws + WS_SUMM))[pair * 128 + tid]; }
    __syncthreads();
    if (tid == 0) { float m = 0.f; const float* sA = ga; const float* sM = ea;
        for (int c = 0; c < 128; ++c) { const float A = sA[c], Mv = sM[c], mn = fmaxf(A + m, Mv); ga[c] = __expf(A + m - mn); ea[c] = __expf(Mv - mn); m = mn; marr[c] = mn; } }
    __syncthreads();
    if (sub == 0) { if (tid < 128) ((float*)(P.ws + WS_MCH))[pair * 128 + tid] = marr[tid]; if (tid == 0) P.out[O_MP + pair] = marr[127]; }
#ifndef P3_SCANMASK
#define P3_SCANMASK 3
#endif
    if (P3_SCANMASK & 1) { const int idx2 = sub * 512 + tid; float C0 = 0.f, C1 = 0.f;
        const unsigned* src = (const unsigned*)((unsigned char*)P.out + OB_DCT) + (size_t)pair * 128 * 4096 + idx2; unsigned* dst = (unsigned*)((unsigned char*)P.out + OB_CPT) + (size_t)pair * 128 * 4096 + idx2;
#pragma unroll 1
        for (int c = 0; c < 128; c += 32) { unsigned v[32];
#pragma unroll
            for (int j = 0; j < 32; ++j) v[j] = src[(size_t)(c + j) * 4096];
#pragma unroll
            for (int j = 0; j < 32; ++j) { dst[(size_t)(c + j) * 4096] = cvt_pk_bf16(C0, C1); const float gg = ga[c + j], ee = ea[c + j]; C0 = gg * C0 + ee * bflo(v[j]); C1 = gg * C1 + ee * bfhi(v[j]); } }
        const int i0 = 2 * idx2, e = i0 >> 6, d = i0 & 63;
        P.out[O_CP + ((size_t)pair * 64 + d) * 128 + e] = C0; P.out[O_CP + ((size_t)pair * 64 + d + 1) * 128 + e] = C1; }
    if ((P3_SCANMASK & 2) && sub == 0 && tid < 64) { float nn = 0.f; const float* dn = (const float*)(P.ws + WS_DN) + (size_t)pair * 128 * 64 + tid; float* np = (float*)(P.ws + WS_NPREV) + (size_t)pair * 128 * 64 + tid;
        for (int c = 0; c < 128; ++c) { np[c * 64] = nn; nn = ga[c] * nn + ea[c] * dn[c * 64]; }
        P.out[O_NP + pair * 64 + tid] = nn; }
    __syncthreads();
}
__device__ __forceinline__ void mlstm_sample_item(const Params& P, int item, unsigned char* lds, int tid) {
    const int h = item & 3, b = item >> 2, r0 = MP + b * 8;
    float* q = (float*)lds; float* k = q + 512; float* v = k + 512; float* sw = v + 1024; float* sc = sw + 64; float* n0s = sc + 64; float* part = n0s + 64; float* red = part + 4096;
    const bf16_t* mixin = (const bf16_t*)(P.ws + WS_MIXIN);
    if (tid < 256) {
        const int sel = tid >> 6, i = tid & 63;
        if (sel < 2) { const int t = i >> 3, p = i & 7; float f[8]; unpack8(*(const u32x4*)(mixin + (size_t)(r0 + t) * NMIX + sel * 256 + h * 64 + p * 8), f);
            float* dst = (sel ? k : q) + t * 64 + p * 8; const float sc_ = sel ? 0.125f : 1.0f;
#pragma unroll
            for (int j = 0; j < 8; ++j) dst[j] = f[j] * sc_; }
        else { const int i2 = tid - 128, t = i2 >> 4, p = i2 & 15; float f[8]; unpack8(*(const u32x4*)(mixin + (size_t)(r0 + t) * NMIX + 512 + h * 128 + p * 8), f);
#pragma unroll
            for (int j = 0; j < 8; ++j) v[t * 128 + p * 8 + j] = f[j]; } }
    if (tid < 64) n0s[tid] = P.in[3][(b * 4 + h) * 64 + tid];
    if (tid < 8) { float lf[8];
#pragma unroll
        for (int s = 0; s < 8; ++s) lf[s] = ((const float*)(P.ws + WS_GB))[(r0 + s) * 4 + h];
        float bb = 0.f;
#pragma unroll
        for (int s = 0; s < 8; ++s) bb += (s <= tid) ? lf[s] : 0.f;
        sc[tid] = bb; sc[8 + tid] = ((const float*)(P.ws + WS_GI))[(r0 + tid) * 4 + h] - bb; }
    __syncthreads();
    const float mprev = P.in[4][b * 4 + h];
    if (tid < 8) { float cm = mprev; for (int s = 0; s <= tid; ++s) cm = fmaxf(cm, sc[8 + s]); const float mt = sc[tid] + cm; sc[16 + tid] = mt; sc[24 + tid] = __expf(sc[tid] + mprev - mt); }
    __syncthreads();
    if (tid < 8) { const float b7 = sc[7], m7 = sc[23]; sc[32 + tid] = __expf(b7 + sc[8 + tid] - m7); if (tid == 0) { sc[48] = __expf(b7 + mprev - m7); P.out[O_MS + b * 4 + h] = m7; } }
    if (tid >= 64 && tid < 128) { const int i = tid - 64, t = i >> 3, s = i & 7; float dot = 0.f;
        for (int d = 0; d < 64; ++d) dot += q[t * 64 + d] * k[s * 64 + d];
        sw[i] = (s <= t) ? dot * __expf(sc[t] + sc[8 + s] - sc[16 + t]) : 0.f; }
    if (tid >= 128 && tid < 136) { const int t = tid - 128; float qn = 0.f; for (int d = 0; d < 64; ++d) qn += q[t * 64 + d] * n0s[d]; sc[40 + t] = qn; }
    __syncthreads();
    { const int e = tid & 127, dq = tid >> 7; const float gd = sc[48]; float num[8];
#pragma unroll
        for (int t = 0; t < 8; ++t) num[t] = 0.f;
        float c0v[16];
#pragma unroll
        for (int dd = 0; dd < 16; ++dd) c0v[dd] = P.in[2][((size_t)(b * 4 + h) * 64 + dq * 16 + dd) * 128 + e];
#pragma unroll
        for (int dd = 0; dd < 16; ++dd) { const int d = dq * 16 + dd; const size_t ic = ((size_t)(b * 4 + h) * 64 + d) * 128 + e; const float c0 = c0v[dd];
            float upd = 0.f;
#pragma unroll
            for (int s = 0; s < 8; ++s) upd += sc[32 + s] * k[s * 64 + d] * v[s * 128 + e];
            P.out[O_CS + ic] = gd * c0 + upd;
#pragma unroll
            for (int t = 0; t < 8; ++t) num[t] += q[t * 64 + d] * c0; }
#pragma unroll
        for (int t = 0; t < 8; ++t) part[(dq * 8 + t) * 128 + e] = num[t]; }
    if (tid < 64) { float nn = sc[48] * n0s[tid];
#pragma unroll
        for (int s = 0; s < 8; ++s) nn += sc[32 + s] * k[s * 64 + tid];
        P.out[O_NS + (b * 4 + h) * 64 + tid] = nn; }
    __syncthreads();
    { const int e = tid & 127, tq = tid >> 7, w = tid >> 6, lane = tid & 63; float hv[2];
#pragma unroll
        for (int u = 0; u < 2; ++u) { const int t = tq * 2 + u; float inter = 0.f, intra = 0.f, rs = 0.f;
#pragma unroll
            for (int dq = 0; dq < 4; ++dq) inter += part[(dq * 8 + t) * 128 + e];
#pragma unroll
            for (int s = 0; s < 8; ++s) { intra += sw[t * 8 + s] * v[s * 128 + e]; rs += sw[t * 8 + s]; }
            const float wi = sc[24 + t], den = wi * sc[40 + t] + rs; hv[u] = (wi * inter + intra) / fmaxf(fabsf(den), __expf(-sc[16 + t])); }
        const float s0 = wave_sum(hv[0] * hv[0]), s1 = wave_sum(hv[1] * hv[1]);
        if (lane == 0) { red[w * 2] = s0; red[w * 2 + 1] = s1; }
        __syncthreads();
        bf16_t* hcat = (bf16_t*)(P.ws + WS_HCAT);
#pragma unroll
        for (int u = 0; u < 2; ++u) { const int t = tq * 2 + u; const float tot = red[(w & ~1) * 2 + u] + red[(w | 1) * 2 + u]; const float rstd = 1.0f / sqrtf(tot * (1.0f / 128.0f) + EPS);
            const float so = bf2f(mixin[(size_t)(r0 + t) * NMIX + 1024 + h * 128 + e]);
            hcat[(size_t)(r0 + t) * 1024 + h * 128 + e] = f2bf(hv[u] * rstd * P.in[11][h * 128 + e] * so); } }
    __syncthreads();
}
__device__ __forceinline__ void mlstm_d_item(const Params& P, int item, unsigned char* lds, int tid) {
    const int c = item & 127, h = (item >> 7) & 3, b = item >> 9, r0 = b * 8192 + c * 64, pair = item >> 7;
    float* lb = (float*)lds; float* lu = lb + 64; float* lm = lb + 128; float* misc = lb + 192; float* npv = lb + 256; float* red = lb + 320;
    bf16_t* Kn = (bf16_t*)(lds + 2048); bf16_t* Vt = (bf16_t*)(lds + 11264); bf16_t* Cs = (bf16_t*)(lds + 29696);
    const bf16_t* mixin = (const bf16_t*)(P.ws + WS_MIXIN);
    if (tid < 64) { const float iv = ((const float*)(P.ws + WS_GI))[(r0 + tid) * 4 + h]; float bb = ((const float*)(P.ws + WS_GB))[(r0 + tid) * 4 + h];
#pragma unroll
        for (int o = 1; o < 64; o <<= 1) { const float nb = __shfl_up(bb, o); if (tid >= o) bb += nb; }
        const float mprev = c ? ((const float*)(P.ws + WS_MCH))[pair * 128 + c - 1] : 0.f;
        const float u = iv - bb; float cm = u;
#pragma unroll
        for (int o = 1; o < 64; o <<= 1) { const float nb = __shfl_up(cm, o); if (tid >= o) cm = fmaxf(cm, nb); }
        lb[tid] = bb; lu[tid] = u; lm[tid] = bb + fmaxf(mprev, cm); if (tid == 0) misc[0] = mprev;
        npv[tid] = ((const float*)(P.ws + WS_NPREV))[(size_t)item * 64 + tid]; }
    { const int s = tid >> 3, ch = tid & 7; const bf16_t* rowp = mixin + (size_t)(r0 + s) * NMIX;
        *(u32x4*)(Kn + s * 72 + ch * 8) = *(const u32x4*)(rowp + 256 + h * 64 + ch * 8);
        const u32x4 v0 = *(const u32x4*)(rowp + 512 + h * 128 + ch * 16), v1 = *(const u32x4*)(rowp + 512 + h * 128 + ch * 16 + 8);
        const unsigned vv[8] = {v0.x, v0.y, v0.z, v0.w, v1.x, v1.y, v1.z, v1.w};
#pragma unroll
        for (int i = 0; i < 8; ++i) { Vt[(ch * 16 + 2 * i) * 72 + s] = (bf16_t)(vv[i] & 0xffffu); Vt[(ch * 16 + 2 * i + 1) * 72 + s] = (bf16_t)(vv[i] >> 16); }
        const bf16_t* cp = (const bf16_t*)((unsigned char*)P.out + OB_CPT) + (size_t)item * 8192;
#pragma unroll
        for (int j = 0; j < 2; ++j) { const int idx = tid + 512 * j, e = idx >> 3, dch = idx & 7; *(u32x4*)(Cs + e * 72 + dch * 8) = *(const u32x4*)(cp + e * 64 + dch * 8); } }
    __syncthreads();
    const int w = tid >> 6, lane = tid & 63, fr = lane & 15, g = lane >> 4, tt = w & 3, eh = w >> 2, t = tt * 16 + fr, tok = r0 + t;
    bf16x8 qf[2]; float qv0[8], qv1[8];
    { const bf16_t* qp = mixin + (size_t)tok * NMIX + h * 64 + g * 8; const u32x4 a = *(const u32x4*)qp, bq = *(const u32x4*)(qp + 32);
        qf[0] = __builtin_bit_cast(bf16x8, a); qf[1] = __builtin_bit_cast(bf16x8, bq); unpack8(a, qv0); unpack8(bq, qv1); }
    f32x4 s[4];
    { bf16x8 kfr[4][2];
#pragma unroll
    for (int st = 0; st < 4; ++st)
#pragma unroll
        for (int kk = 0; kk < 2; ++kk) kfr[st][kk] = *(const bf16x8*)(Kn + (st * 16 + fr) * 72 + g * 8 + kk * 32);
#pragma unroll
    for (int st = 0; st < 4; ++st) { s[st] = (f32x4){0.f, 0.f, 0.f, 0.f};
#pragma unroll
        for (int kk = 0; kk < 2; ++kk) s[st] = mfma16(kfr[st][kk], qf[kk], s[st]); } }
    const float bt = lb[t], mt = lm[t], mprev = misc[0];
    float rs = 0.f;
#pragma unroll
    for (int st = 0; st < 4; ++st)
#pragma unroll
        for (int r = 0; r < 4; ++r) { const int si = st * 16 + g * 4 + r; const float wv = (si <= t) ? __expf(bt + lu[si] - mt) : 0.f; const float val = s[st][r] * 0.125f * wv; s[st][r] = val; rs += val; }
    rs += __shfl_xor(rs, 16); rs += __shfl_xor(rs, 32);
    float qn = 0.f;
#pragma unroll
    for (int i = 0; i < 8; ++i) qn += qv0[i] * npv[g * 8 + i] + qv1[i] * npv[32 + g * 8 + i];
    qn += __shfl_xor(qn, 16); qn += __shfl_xor(qn, 32);
    const float wi = __expf(bt + mprev - mt), den = wi * qn + rs, inv = 1.0f / fmaxf(fabsf(den), __expf(-mt));
    bf16x8 pf[2]; pf[0] = pack8(s[0], s[1]); pf[1] = pack8(s[2], s[3]);
    f32x4 h1[4], h2[4];
    { bf16x8 vfr[4][2], cfr[4][2];
#pragma unroll
    for (int et = 0; et < 4; ++et) { const int e = eh * 64 + et * 16 + fr;
#pragma unroll
        for (int cc = 0; cc < 2; ++cc) { const bf16_t* vp = Vt + e * 72 + cc * 32 + g * 4; const u32x2 v0 = *(const u32x2*)vp, v1 = *(const u32x2*)(vp + 16);
            vfr[et][cc] = __builtin_bit_cast(bf16x8, (u32x4){v0.x, v0.y, v1.x, v1.y}); cfr[et][cc] = *(const bf16x8*)(Cs + e * 72 + g * 8 + cc * 32); } }
#pragma unroll
    for (int et = 0; et < 4; ++et) { h1[et] = (f32x4){0.f, 0.f, 0.f, 0.f}; h2[et] = (f32x4){0.f, 0.f, 0.f, 0.f};
#pragma unroll
        for (int cc = 0; cc < 2; ++cc) { h2[et] = mfma16(vfr[et][cc], pf[cc], h2[et]); h1[et] = mfma16(cfr[et][cc], qf[cc], h1[et]); } } }
    float ss = 0.f;
#pragma unroll
    for (int et = 0; et < 4; ++et)
#pragma unroll
        for (int r = 0; r < 4; ++r) { const float hv = (wi * h1[et][r] + h2[et][r]) * inv; h2[et][r] = hv; ss += hv * hv; }
    ss += __shfl_xor(ss, 16); ss += __shfl_xor(ss, 32);
    if (g == 0) red[w * 16 + fr] = ss;
    __syncthreads();
    { const float tot = red[w * 16 + fr] + red[(w ^ 4) * 16 + fr]; const float rstd = 1.0f / sqrtf(tot * (1.0f / 128.0f) + EPS);
        bf16_t* hcat = (bf16_t*)(P.ws + WS_HCAT);
#pragma unroll
        for (int et = 0; et < 4; ++et) { const int e0 = eh * 64 + et * 16 + g * 4; const u32x2 so = *(const u32x2*)(mixin + (size_t)tok * NMIX + 1024 + h * 128 + e0); const f32x4 mw = *(const f32x4*)(P.in[11] + h * 128 + e0);
            const float o0 = h2[et][0] * rstd * mw[0] * bflo(so.x), o1 = h2[et][1] * rstd * mw[1] * bfhi(so.x), o2 = h2[et][2] * rstd * mw[2] * bflo(so.y), o3 = h2[et][3] * rstd * mw[3] * bfhi(so.y);
            u32x2 pk; pk.x = cvt_pk_bf16(o0, o1); pk.y = cvt_pk_bf16(o2, o3); *(u32x2*)(hcat + (size_t)tok * 1024 + h * 128 + e0) = pk; } }
    __syncthreads();
}


__device__ __forceinline__ void tail_mma(unsigned char* lds, const bf16_t* A, const bf16_t* Bt, int K, int r0, int c0, int nchunk, int nseg0, int tid, f32x4 (&acc)[2][2]) {
    const int w = tid >> 6, lane = tid & 63, fr = lane & 15, g = lane >> 4, wr = w & 3, wc = w >> 2;
    const bf16_t* gp[4]; unsigned lo_[4];
#pragma unroll
    for (int j = 0; j < 4; ++j) { const int idx = tid + 512 * j, mat = idx >> 10, rem = idx & 1023, row = rem >> 4, seg = rem & 15;
        gp[j] = (mat ? Bt + (size_t)(c0 + row) * K : A + (size_t)(r0 + row) * K) + seg * 8; lo_[j] = (unsigned)(mat * 17408 + row * 272 + seg * 16); }
    u32x4 st[4], st2[4];
#pragma unroll
    for (int j = 0; j < 4; ++j) st[j] = *(const u32x4*)gp[j];
#pragma unroll
    for (int j = 0; j < 4; ++j) *(u32x4*)(lds + lo_[j]) = st[j];
    if (nchunk > 1) {
#pragma unroll
        for (int j = 0; j < 4; ++j) st[j] = *(const u32x4*)(gp[j] + 128); }
    __syncthreads();
    const unsigned aoff = (unsigned)((16 * wr + fr) * 272 + g * 16), boff = (unsigned)(17408 + (32 * wc + fr) * 272 + g * 16);
#pragma unroll 1
    for (int ch = 0; ch < nchunk; ++ch) {
        const unsigned cur = (unsigned)(ch & 1) * 34816u, nxt = 34816u - cur;
        if (ch + 2 < nchunk) {
#pragma unroll
            for (int j = 0; j < 4; ++j) st2[j] = *(const u32x4*)(gp[j] + (size_t)(ch + 2) * 128); }
        bf16x8 fa[4], f0[4], f1[4];
#pragma unroll
        for (int kk = 0; kk < 4; ++kk) { fa[kk] = *(const bf16x8*)(lds + cur + aoff + kk * 64); f0[kk] = *(const bf16x8*)(lds + cur + boff + kk * 64); f1[kk] = *(const bf16x8*)(lds + cur + boff + 16 * 272 + kk * 64); }
        if (ch < nseg0) {
#pragma unroll
            for (int kk = 0; kk < 4; ++kk) { acc[0][0] = mfma16(f0[kk], fa[kk], acc[0][0]); acc[0][1] = mfma16(f1[kk], fa[kk], acc[0][1]); } }
        else {
#pragma unroll
            for (int kk = 0; kk < 4; ++kk) { acc[1][0] = mfma16(f0[kk], fa[kk], acc[1][0]); acc[1][1] = mfma16(f1[kk], fa[kk], acc[1][1]); } }
        if (ch + 1 < nchunk) {
#pragma unroll
            for (int j = 0; j < 4; ++j) *(u32x4*)(lds + nxt + lo_[j]) = st[j]; }
        __syncthreads();
#pragma unroll
        for (int j = 0; j < 4; ++j) st[j] = st2[j];
    }
}
__device__ __forceinline__ void tail_mix(const Params& P, unsigned char* lds, int tb, int tid) {
    const int w = tid >> 6, lane = tid & 63, fr = lane & 15, g = lane >> 4, tok = MP + (tb >> 4) * 64 + 16 * (w & 3) + fr, col0 = (tb & 15) * 64 + 32 * (w >> 2);
    const bf16_t* hcat = (const bf16_t*)(P.ws + WS_HCAT); const bf16_t* wab = (const bf16_t*)(P.ws + WS_WAB); const bf16_t* gates = (const bf16_t*)(P.ws + WS_GATES); bf16_t* mix = (bf16_t*)(P.ws + WS_MIXIN);
    f32x4 ab[2][2]; ab[0][0] = ab[0][1] = ab[1][0] = ab[1][1] = (f32x4){0.f, 0.f, 0.f, 0.f};
    tail_mma(lds, hcat, wab, 1024, MP + (tb >> 4) * 64, (tb & 15) * 64, 8, 4, tid, ab);
    const f32x4 (&a)[2] = ab[0]; const f32x4 (&b)[2] = ab[1];
#pragma unroll
    for (int mt = 0; mt < 2; ++mt) { const int c = col0 + mt * 16 + g * 4; const u32x2 sa = *(const u32x2*)(gates + (size_t)tok * 2048 + c), sb = *(const u32x2*)(gates + (size_t)tok * 2048 + 1024 + c);
        const float v0 = bflo(sa.x) * a[mt][0] + bflo(sb.x) * b[mt][0], v1 = bfhi(sa.x) * a[mt][1] + bfhi(sb.x) * b[mt][1], v2 = bflo(sa.y) * a[mt][2] + bflo(sb.y) * b[mt][2], v3 = bfhi(sa.y) * a[mt][3] + bfhi(sb.y) * b[mt][3];
        u32x2 pk; pk.x = cvt_pk_bf16(v0, v1); pk.y = cvt_pk_bf16(v2, v3); *(u32x2*)(mix + (size_t)tok * 1024 + c) = pk; }
}
__device__ __forceinline__ void tail_out(const Params& P, unsigned char* lds, int tb, int tid) {
    const int w = tid >> 6, lane = tid & 63, fr = lane & 15, g = lane >> 4, tok = MP + (tb >> 4) * 64 + 16 * (w & 3) + fr, col0 = (tb & 15) * 64 + 32 * (w >> 2);
    f32x4 ab[2][2]; ab[0][0] = ab[0][1] = ab[1][0] = ab[1][1] = (f32x4){0.f, 0.f, 0.f, 0.f};
    tail_mma(lds, (const bf16_t*)(P.ws + WS_MIXIN), (const bf16_t*)(P.ws + WS_WOUT), 1024, MP + (tb >> 4) * 64, (tb & 15) * 64, 8, 8, tid, ab);
    const f32x4 (&acc)[2] = ab[0];
    const float* xrow = P.in[1] + (size_t)(tok - MP) * 1024; bf16_t* hfw = (bf16_t*)(P.ws + WS_HN); float ss = 0.f;
#pragma unroll
    for (int mt = 0; mt < 2; ++mt) { const int c = col0 + mt * 16 + g * 4; const f32x4 y = *(const f32x4*)(xrow + c) + acc[mt]; *(f32x4*)(P.out + (size_t)tok * 1024 + c) = y;
        ss += (y[0] * y[0] + y[1] * y[1]) + (y[2] * y[2] + y[3] * y[3]); const f32x4 z = y * *(const f32x4*)(P.in[18] + c);
        u32x2 pk; pk.x = cvt_pk_bf16(z[0], z[1]); pk.y = cvt_pk_bf16(z[2], z[3]); *(u32x2*)(hfw + (size_t)tok * 1024 + c) = pk; }
    ss += __shfl_xor(ss, 16); ss += __shfl_xor(ss, 32);
    if (g == 0) unsafeAtomicAdd((float*)(P.ws + WS_ROWSS) + tok, ss);
}
__device__ __forceinline__ void tail_down(const Params& P, unsigned char* lds, int tb, int tid) {
    const int w = tid >> 6, lane = tid & 63, fr = lane & 15, g = lane >> 4, tok = MP + (tb >> 4) * 64 + 16 * (w & 3) + fr, col0 = (tb & 15) * 64 + 32 * (w >> 2);
    f32x4 ab[2][2]; ab[0][0] = ab[0][1] = ab[1][0] = ab[1][1] = (f32x4){0.f, 0.f, 0.f, 0.f};
    tail_mma(lds, (const bf16_t*)(P.ws + WS_MIXIN), (const bf16_t*)(P.ws + WS_WD), DFF, MP + (tb >> 4) * 64, (tb & 15) * 64, 22, 22, tid, ab);
    const f32x4 (&acc)[2] = ab[0];
#pragma unroll
    for (int mt = 0; mt < 2; ++mt) { float* p = P.out + (size_t)tok * 1024 + col0 + mt * 16 + g * 4; *(f32x4*)p = *(const f32x4*)p + acc[mt]; }
}
#define GSYNC_F(grid) xcd_barrier(xbar)
__global__ void __launch_bounds__(512, 2) fwd_kernel(Params P) {
    extern __shared__ __attribute__((aligned(16))) unsigned char lds[];
    cg::grid_group grid = cg::this_grid();
    const int tid = threadIdx.x, G = gridDim.x;
    const int lo = P.ph_lo, hi = P.ph_hi;
    volatile LAS unsigned* xst = (volatile LAS unsigned*)((LAS unsigned char*)lds + 131072);
    if (tid < 4) xst[tid] = 0u;
    __syncthreads();
    XcdBarrier xbar = xcd_barrier_post((unsigned*)(P.ws + WS_BAR), xst);
#ifndef PHASE_MASK
#define PHASE_MASK 0x1ff
#endif
#define IN(k) (((PHASE_MASK >> (k)) & 1) && lo <= (k) && (k) < hi)
#define GSYNC() xcd_barrier(xbar)
#define SEAM(k) do { if (IN(k) && IN((k) + 1)) GSYNC(); } while (0)
#ifndef DUP_MASK
#define DUP_MASK 0
#endif
#ifndef EXTRA_SYNCS
#define EXTRA_SYNCS 0
#endif
#define REP(k) for (int rep_ = 0; rep_ <= ((DUP_MASK >> (k)) & 1); ++rep_) if (rep_ == 0 || (GSYNC_F(grid), true))
    bf16_t* HN = (bf16_t*)(P.ws + WS_HN); bf16_t* MIXIN = (bf16_t*)(P.ws + WS_MIXIN); bf16_t* GATES = (bf16_t*)(P.ws + WS_GATES); bf16_t* HCAT = (bf16_t*)(P.ws + WS_HCAT);
    PG8_LAS unsigned char* ldsa = (PG8_LAS unsigned char*)lds;
    if (IN(0)) REP(0) p0_prep(P, lds, tid, G);
    if (lo < 0) grid.sync();
    SEAM(0);
    for (int xs_ = 0; xs_ < EXTRA_SYNCS; ++xs_) GSYNC();
    if (IN(1)) REP(1) { pg8::Gemm g{HN, (const bf16_t*)(P.ws + WS_WIN), MT, NPROJ, 1024}; pg8::StaticOrder S; S.init(MT, NPROJ, G, (int)blockIdx.x);
        pg8::EpiProj E{MIXIN, GATES}; pg8::gemm_phase<pg8::EpiProj, pg8::StaticOrder, true, true>(ldsa, g, S, E);
        { const int nfull = (MT / 256) * (NPROJ / 256) / G, nlast = (MT / 256) * (NPROJ / 256) - nfull * G;
            if (nlast > 0 && nlast < G && (int)blockIdx.x >= nlast) for (int it = NT_IN + (int)blockIdx.x - nlast; it < NT_ALL; it += G - nlast) wtile_by_index(P, it, lds, tid);
            else if (nlast == 0 || nlast >= G) for (int it = NT_IN + (int)blockIdx.x; it < NT_ALL; it += G) wtile_by_index(P, it, lds, tid); } }
    SEAM(1);
    if (IN(2)) REP(2) {
        for (int it = blockIdx.x; it < 256 + 256 + 1024; it += G) {
            if (it < 256) attn_prompt_item(P, it, lds, tid);
            else if (it < 512) attn_sample_item(P, it - 256, lds, tid);
            else mlstm_b_item(P, it - 512, lds, tid);
        } }
    SEAM(2);
    if (IN(3)) REP(3) {
        const int nscan = (G > 64) ? 64 : 0;
#ifndef P3_VARIANT
#define P3_VARIANT 3
#endif
        if (nscan) { if ((int)blockIdx.x < 64) { if (P3_VARIANT & 1) mlstm_scan(P, lds, tid); } else if (P3_VARIANT & 2) { for (int it = blockIdx.x - 64; it < 512; it += G - 64) mlstm_sample_item(P, it, lds, tid); } }
        else { for (int it = blockIdx.x; it < 512; it += G) mlstm_sample_item(P, it, lds, tid); }
    }
    SEAM(3);
    if (IN(4)) REP(4) { for (int it = blockIdx.x; it < 1024; it += G) mlstm_d_item(P, it, lds, tid); }
    SEAM(4);
    if (IN(5)) REP(5) { pg8::Gemm g{HCAT, (const bf16_t*)(P.ws + WS_WAB), MP, 1024, 1024}; pg8::StaticOrder S; S.init(MP, 1024, G, (int)blockIdx.x);
        pg8::EpiMix E{GATES, MIXIN}; pg8::gemm_phase<pg8::EpiMix, pg8::StaticOrder, true, true>(ldsa, g, S, E);
        for (int tb = blockIdx.x; tb < 256; tb += G) tail_mix(P, lds, tb, tid); }
    SEAM(5);
    if (IN(6)) REP(6) { pg8::Gemm g{MIXIN, (const bf16_t*)(P.ws + WS_WOUT), MP, 1024, 1024}; pg8::StaticOrder S; S.init(MP, 1024, G, (int)blockIdx.x);
        pg8::EpiOut E{P.in[0], P.in[1], P.out, HN, P.in[18], (float*)(P.ws + WS_ROWSS)}; pg8::gemm_phase<pg8::EpiOut, pg8::StaticOrder, true, true>(ldsa, g, S, E);
        for (int tb = blockIdx.x; tb < 256; tb += G) tail_out(P, lds, tb, tid); }
    SEAM(6);
    if (IN(7)) REP(7) { pg8::Gemm g{HN, (const bf16_t*)(P.ws + WS_WGU), MT, 2 * DFF, 1024}; pg8::StaticOrder S; S.init(MT, 2 * DFF, G, (int)blockIdx.x);
        pg8::EpiGU E{MIXIN, (const float*)(P.ws + WS_ROWSS)}; pg8::gemm_phase<pg8::EpiGU, pg8::StaticOrder, true, true>(ldsa, g, S, E); }
    SEAM(7);
    if (IN(8)) REP(8) { pg8::Gemm g{MIXIN, (const bf16_t*)(P.ws + WS_WD), MP, 1024, DFF}; pg8::StaticOrder S; S.init(MP, 1024, G, (int)blockIdx.x);
        pg8::EpiDown E{P.out}; pg8::gemm_phase<pg8::EpiDown, pg8::StaticOrder, true, true>(ldsa, g, S, E);
        for (int tb = blockIdx.x; tb < 256; tb += G) tail_down(P, lds, tb, tid); }
#ifdef DBG_DUMP
    GSYNC();
    if (DBG_DUMP == 1) { for (size_t i = (size_t)blockIdx.x * 512 + tid; i < (size_t)MT * 1024; i += (size_t)G * 512) { const size_t r = i >> 10, c = i & 1023; P.out[i] = bf2f(MIXIN[r * NMIX + c]); } }
    if (DBG_DUMP == 2) { const bf16_t* d = (const bf16_t*)((unsigned char*)P.out + OB_DCT); for (size_t i = (size_t)blockIdx.x * 512 + tid; i < (size_t)1024 * 8192; i += (size_t)G * 512) P.out[i] = bf2f(d[i]); }
    if (DBG_DUMP == 4) { unsigned* d = (unsigned*)((unsigned char*)P.out + OB_DCT); for (size_t i = (size_t)blockIdx.x * 512 + tid; i < (size_t)1024 * 4096; i += (size_t)G * 512) { const unsigned w = __hip_atomic_load(d + i, __ATOMIC_RELAXED, __HIP_MEMORY_SCOPE_AGENT); P.out[2 * i] = bflo(w); P.out[2 * i + 1] = bfhi(w); } }
    if (DBG_DUMP == 5) { const float* a = (const float*)(P.ws + WS_GI); const float* bq = (const float*)(P.ws + WS_GB); for (int i = blockIdx.x * 512 + tid; i < MT * 4; i += G * 512) { P.out[i] = a[i]; P.out[MT * 4 + i] = bq[i]; } }
    if (DBG_DUMP == 6) { const float* a = (const float*)(P.ws + WS_DN); for (int i = blockIdx.x * 512 + tid; i < 65536; i += G * 512) P.out[i] = a[i]; }
    if (DBG_DUMP == 3) { for (size_t i = (size_t)blockIdx.x * 512 + tid; i < (size_t)MT * 1024; i += (size_t)G * 512) P.out[i] = bf2f(HN[i]); }
#endif
#undef IN
#undef SEAM
}

extern "C" void kernel_launch(void* const* d_in, const int* in_sizes, int n_in, void* d_out, int out_size, void* d_ws, size_t ws_size, hipStream_t stream) {
    static int grid = 0;
    if (grid == 0) {
        if (n_in != 22 || (size_t)out_size != O_END || ws_size < WS_END) { fprintf(stderr, "kernel_launch: unexpected shapes (n_in %d, out %d, ws %zu)\n", n_in, out_size, ws_size); grid = -1; return; }
        int dev = 0, cus = 0, per_cu = 0;
        (void)hipGetDevice(&dev); (void)hipDeviceGetAttribute(&cus, hipDeviceAttributeMultiprocessorCount, dev);
        if (hipFuncSetAttribute((const void*)fwd_kernel, hipFuncAttributeMaxDynamicSharedMemorySize, LDS_BYTES) != hipSuccess) { fprintf(stderr, "kernel_launch: hipFuncSetAttribute failed\n"); grid = -1; return; }
        if (hipOccupancyMaxActiveBlocksPerMultiprocessor(&per_cu, (const void*)fwd_kernel, 512, LDS_BYTES) != hipSuccess || per_cu < 1) { fprintf(stderr, "kernel_launch: occupancy query failed (%d)\n", per_cu); (void)hipGetLastError(); per_cu = 1; }
        grid = cus * 1;
        if (grid < 65) { fprintf(stderr, "kernel_launch: needs more than 64 CUs\n"); grid = -1; return; }
    }
    if (grid < 0) return;
    if (hipMemsetAsync((char*)d_ws + WS_BAR, 0, XCD_BAR_WORDS * 4, stream) != hipSuccess) { fprintf(stderr, "kernel_launch: memset failed\n"); return; }
    Params p{};
    for (int i = 0; i < 22; ++i) p.in[i] = (const float*)d_in[i];
    p.out = (float*)d_out; p.ws = (unsigned char*)d_ws;
    constexpr int NPH = 9;
    for (int li = 0; li < N_LAUNCHES; ++li) {
        p.ph_lo = (N_LAUNCHES == 1) ? 0 : li; p.ph_hi = (N_LAUNCHES == 1) ? NPH : li + 1;
        void* args[] = {&p};
        const hipError_t e = hipLaunchCooperativeKernel((const void*)fwd_kernel, dim3(grid), dim3(512), args, LDS_BYTES, stream);
        if (e != hipSuccess) { fprintf(stderr, "kernel_launch: cooperative launch %d failed: %s (grid %d)\n", li, hipGetErrorString(e), grid); break; }
    }
}
```

```cpp
#include <hip/hip_runtime.h>
#include <hip/hip_cooperative_groups.h>
#include <cstdio>
#include <cstdint>
namespace cg = cooperative_groups;

#ifndef N_LAUNCHES
#define N_LAUNCHES 1
#endif

namespace pg8 {
#define PG8_LAS __attribute__((address_space(3)))
typedef unsigned short bf16_t;
typedef short bf16x8 __attribute__((ext_vector_type(8)));
typedef float f32x4 __attribute__((ext_vector_type(4)));
typedef unsigned u32x4 __attribute__((ext_vector_type(4)));
constexpr int BM = 256, BK = 64, HALF = 128, HTB = HALF * BK * 2  , STAGE_BYTES = 8 * HTB, NXCD = 8, WGM = 8;

__host__ __device__ __forceinline__ int lds_byte(int r, int c) { const int st = (r >> 4) * 2 + (c >> 5), rr = r & 15, cc = c & 31, ob = rr * 64 + cc * 2; return st * 1024 + (ob ^ (((ob >> 9) & 1) << 5)); }
__host__ __device__ __forceinline__ void stage_rc(int b, int& R, int& C) { const int st = b / 1024, sb = b % 1024, swz = sb ^ (((sb >> 9) & 1) << 5); R = (st >> 1) * 16 + swz / 64; C = (st & 1) * 32 + (swz % 64) / 2; }
__host__ __device__ __forceinline__ int perm32(int rho) { const int n = rho >> 4, i = rho & 15; return 8 * (i >> 2) + 4 * n + (i & 3); }

struct Unit { int pm, pn; };
struct Gemm { const bf16_t* A; const bf16_t* Bt; int M, N, K; };

struct StaticOrder {
    int nM, nN, nwg, G, c;
    __host__ __device__ void init(int M, int N, int G_, int c_) { nM = M / BM; nN = N / BM; nwg = nM * nN; G = G_; c = c_; }
    __host__ __device__ bool next(int i, Unit& u) const {
        const long L = (long)i * G + c; if (L >= nwg) return false;
        int wgid = (int)L; { const int q = nwg / NXCD, r = nwg % NXCD, xcd = wgid % NXCD, off = wgid / NXCD; wgid = (xcd < r ? xcd * (q + 1) : r * (q + 1) + (xcd - r) * q) + off; }
        const int nig = WGM * nN, gid = wgid / nig, fm = gid * WGM, gsz = (nM - fm) < WGM ? (nM - fm) : WGM;
        u.pm = fm + ((wgid % nig) % gsz); u.pn = (wgid % nig) / gsz; return true;
    }
    __device__ __forceinline__ void a_ready(const Unit&) const {}
    __device__ __forceinline__ void done(const Unit&) const {}
};

__device__ __forceinline__ unsigned cvt_pk_bf16(float lo, float hi) { unsigned r; asm volatile("v_cvt_pk_bf16_f32 %0, %1, %2" : "=v"(r) : "v"(lo), "v"(hi)); return r; }
__device__ __forceinline__ float bflo(unsigned w) { return __builtin_bit_cast(float, w << 16); }
__device__ __forceinline__ float bfhi(unsigned w) { return __builtin_bit_cast(float, w & 0xffff0000u); }
__device__ __forceinline__ float sigm(float x) { return 1.0f / (1.0f + __expf(-x)); }

struct EpiProj {
    static constexpr bool PERM = true, AFTER_DRAIN = false, HAS_MID = false;
    bf16_t* mixin; bf16_t* gates;
    __device__ __forceinline__ void operator()(const f32x4 (&acc)[2][2][4][2], const Unit& u, int wr, int wc, int fr, int fq) const {
        const bool isg = u.pn >= 9; const bool sg = isg || u.pn == 4 || u.pn == 5;
        bf16_t* base = isg ? gates : mixin; const int ldc = isg ? 2048 : 2304;
        const int col0 = (isg ? (u.pn - 9) : u.pn) * 256 + wc * 32 + 8 * fq, row0 = u.pm * BM + wr * 64 + fr;
#pragma unroll
        for (int ai = 0; ai < 2; ++ai)
#pragma unroll
            for (int m = 0; m < 4; ++m) { bf16_t* rowp = base + (size_t)(row0 + ai * HALF + m * 16) * ldc + col0;
#pragma unroll
                for (int bj = 0; bj < 2; ++bj) { f32x4 v0 = acc[ai][bj][m][0], v1 = acc[ai][bj][m][1];
                    if (sg) {
#pragma unroll
                        for (int i = 0; i < 4; ++i) { v0[i] = sigm(v0[i]); v1[i] = sigm(v1[i]); } }
                    u32x4 w; w.x = cvt_pk_bf16(v0[0], v0[1]); w.y = cvt_pk_bf16(v0[2], v0[3]); w.z = cvt_pk_bf16(v1[0], v1[1]); w.w = cvt_pk_bf16(v1[2], v1[3]);
                    *(u32x4*)(rowp + bj * HALF) = w; } }
    }
};

struct EpiMix {
    static constexpr bool PERM = true, AFTER_DRAIN = false, HAS_MID = true;
    const bf16_t* gates; bf16_t* mix;
    __device__ __forceinline__ void mid(f32x4 (&acc)[2][2][4][2], const Unit& u, int wr, int wc, int fr, int fq) const {
        unsigned rb = (unsigned)(u.pm * BM + wr * 64 + fr) * 2048u + (unsigned)(u.pn * BM + wc * 32 + 8 * fq);
        asm volatile("" : "+v"(rb));
#pragma unroll
        for (int ai = 0; ai < 2; ++ai)
#pragma unroll
            for (int m = 0; m < 4; ++m) { const bf16_t* rowp = gates + (rb + (unsigned)((ai * HALF + m * 16) * 2048));
#pragma unroll
                for (int bj = 0; bj < 2; ++bj) { const u32x4 a = *(const u32x4*)(rowp + bj * HALF), b = *(const u32x4*)(rowp + 1024 + bj * HALF);
                    const float tiny = 8.673617379884035e-19f;
                    f32x4 r0, r1;
                    r0[0] = bflo(a.x) * __builtin_amdgcn_rcpf(fmaxf(bflo(b.x), tiny)); r0[1] = bfhi(a.x) * __builtin_amdgcn_rcpf(fmaxf(bfhi(b.x), tiny)); r0[2] = bflo(a.y) * __builtin_amdgcn_rcpf(fmaxf(bflo(b.y), tiny)); r0[3] = bfhi(a.y) * __builtin_amdgcn_rcpf(fmaxf(bfhi(b.y), tiny));
                    r1[0] = bflo(a.z) * __builtin_amdgcn_rcpf(fmaxf(bflo(b.z), tiny)); r1[1] = bfhi(a.z) * __builtin_amdgcn_rcpf(fmaxf(bfhi(b.z), tiny)); r1[2] = bflo(a.w) * __builtin_amdgcn_rcpf(fmaxf(bflo(b.w), tiny)); r1[3] = bfhi(a.w) * __builtin_amdgcn_rcpf(fmaxf(bfhi(b.w), tiny));
                    acc[ai][bj][m][0] = acc[ai][bj][m][0] * r0; acc[ai][bj][m][1] = acc[ai][bj][m][1] * r1; }
                if (m == 3) __builtin_amdgcn_sched_barrier(0); }
    }
    __device__ __forceinline__ void operator()(const f32x4 (&acc)[2][2][4][2], const Unit& u, int wr, int wc, int fr, int fq) const {
        const int col0 = u.pn * BM + wc * 32 + 8 * fq, row0 = u.pm * BM + wr * 64 + fr;
#pragma unroll
        for (int ai = 0; ai < 2; ++ai)
#pragma unroll
            for (int m = 0; m < 4; ++m) { const size_t row = (size_t)(row0 + ai * HALF + m * 16);
#pragma unroll
                for (int bj = 0; bj < 2; ++bj) { const u32x4 b = *(const u32x4*)(gates + row * 2048 + 1024 + col0 + bj * HALF);
                    const float tiny = 8.673617379884035e-19f;
                    f32x4 s0, s1;
                    s0[0] = fmaxf(bflo(b.x), tiny); s0[1] = fmaxf(bfhi(b.x), tiny); s0[2] = fmaxf(bflo(b.y), tiny); s0[3] = fmaxf(bfhi(b.y), tiny);
                    s1[0] = fmaxf(bflo(b.z), tiny); s1[1] = fmaxf(bfhi(b.z), tiny); s1[2] = fmaxf(bflo(b.w), tiny); s1[3] = fmaxf(bfhi(b.w), tiny);
                    const f32x4 v0 = acc[ai][bj][m][0] * s0, v1 = acc[ai][bj][m][1] * s1;
                    u32x4 w; w.x = cvt_pk_bf16(v0[0], v0[1]); w.y = cvt_pk_bf16(v0[2], v0[3]); w.z = cvt_pk_bf16(v1[0], v1[1]); w.w = cvt_pk_bf16(v1[2], v1[3]);
                    *(u32x4*)(mix + row * 1024 + col0 + bj * HALF) = w; } }
    }
};

struct EpiOut {
    static constexpr bool PERM = true, AFTER_DRAIN = false, HAS_MID = false;
    const float* xp; const float* xs; float* out; bf16_t* hfw; const float* nfw; float* rowss;
    __device__ __forceinline__ void operator()(const f32x4 (&acc)[2][2][4][2], const Unit& u, int wr, int wc, int fr, int fq) const {
        const int col0 = u.pn * BM + wc * 32 + 8 * fq, row0 = u.pm * BM + wr * 64 + fr;
#pragma unroll
        for (int ai = 0; ai < 2; ++ai)
#pragma unroll
            for (int m = 0; m < 4; ++m) { const int row = row0 + ai * HALF + m * 16;
                const float* xrow = row < 16384 ? xp + (size_t)row * 1024 : xs + (size_t)(row - 16384) * 1024;
                float ss = 0.f;
#pragma unroll
                for (int bj = 0; bj < 2; ++bj) { const int c = col0 + bj * HALF;
                    const f32x4 y0 = *(const f32x4*)(xrow + c) + acc[ai][bj][m][0], y1 = *(const f32x4*)(xrow + c + 4) + acc[ai][bj][m][1];
                    *(f32x4*)(out + (size_t)row * 1024 + c) = y0; *(f32x4*)(out + (size_t)row * 1024 + c + 4) = y1;
                    ss += (y0[0] * y0[0] + y0[1] * y0[1]) + (y0[2] * y0[2] + y0[3] * y0[3]) + (y1[0] * y1[0] + y1[1] * y1[1]) + (y1[2] * y1[2] + y1[3] * y1[3]);
                    const f32x4 w0 = *(const f32x4*)(nfw + c), w1 = *(const f32x4*)(nfw + c + 4);
                    const f32x4 z0 = y0 * w0, z1 = y1 * w1;
                    u32x4 w; w.x = cvt_pk_bf16(z0[0], z0[1]); w.y = cvt_pk_bf16(z0[2], z0[3]); w.z = cvt_pk_bf16(z1[0], z1[1]); w.w = cvt_pk_bf16(z1[2], z1[3]);
                    *(u32x4*)(hfw + (size_t)row * 1024 + c) = w; }
                ss += __shfl_xor(ss, 16); ss += __shfl_xor(ss, 32);
                if (fq == 0) unsafeAtomicAdd(rowss + row, ss); }
    }
};

struct EpiGU {
    static constexpr bool PERM = true, AFTER_DRAIN = false, HAS_MID = false;
    bf16_t* act; const float* rowss;
    __device__ __forceinline__ void operator()(const f32x4 (&acc)[2][2][4][2], const Unit& u, int wr, int wc, int fr, int fq) const {
        const int col0 = u.pn * HALF + wc * 32 + 8 * fq, row0 = u.pm * BM + wr * 64 + fr;
#pragma unroll
        for (int ai = 0; ai < 2; ++ai)
#pragma unroll
            for (int m = 0; m < 4; ++m) { const int row = row0 + ai * HALF + m * 16;
                const float rstd = __builtin_amdgcn_rsqf(rowss[row] * (1.0f / 1024.0f) + 1e-6f);
                float o[8];
#pragma unroll
                for (int n = 0; n < 2; ++n)
#pragma unroll
                    for (int j = 0; j < 4; ++j) { const float g = acc[ai][0][m][n][j] * rstd, up = acc[ai][1][m][n][j] * rstd; o[n * 4 + j] = g * sigm(g) * up; }
                u32x4 w; w.x = cvt_pk_bf16(o[0], o[1]); w.y = cvt_pk_bf16(o[2], o[3]); w.z = cvt_pk_bf16(o[4], o[5]); w.w = cvt_pk_bf16(o[6], o[7]);
                *(u32x4*)(act + (size_t)row * 2816 + col0) = w; }
    }
};

struct EpiDown {
    static constexpr bool PERM = true, AFTER_DRAIN = false, HAS_MID = false;
    float* out;
    __device__ __forceinline__ void operator()(const f32x4 (&acc)[2][2][4][2], const Unit& u, int wr, int wc, int fr, int fq) const {
        const int col0 = u.pn * BM + wc * 32 + 8 * fq, row0 = u.pm * BM + wr * 64 + fr;
#pragma unroll
        for (int ai = 0; ai < 2; ++ai)
#pragma unroll
            for (int m = 0; m < 4; ++m) { float* rowp = out + (size_t)(row0 + ai * HALF + m * 16) * 1024 + col0;
#pragma unroll
                for (int bj = 0; bj < 2; ++bj) { const f32x4 y0 = *(const f32x4*)(rowp + bj * HALF) + acc[ai][bj][m][0], y1 = *(const f32x4*)(rowp + bj * HALF + 4) + acc[ai][bj][m][1];
                    *(f32x4*)(rowp + bj * HALF) = y0; *(f32x4*)(rowp + bj * HALF + 4) = y1; } }
    }
};

template <class Epi, class Sched, bool ALIGN_EPI = false, bool SP2 = false>
__device__ __forceinline__ void gemm_phase(PG8_LAS unsigned char* lds, const Gemm g, const Sched& S, const Epi& E) {
    const int tid = threadIdx.x, wid = __builtin_amdgcn_readfirstlane(tid >> 6), lane = tid & 63, wr = wid >> 2, wc = wid & 3, fr = lane & 15, fq = lane >> 4;
    const int K = g.K, nt = K / BK;
    unsigned voffA[2], voffB[2];
#pragma unroll
    for (int i = 0; i < 2; ++i) { int R, C; stage_rc(tid * 16 + i * 8192, R, C); const int Rb = Epi::PERM ? ((R & ~31) + perm32(R & 31)) : R;
        voffA[i] = (unsigned)(R * K + C) * 2u; voffB[i] = (unsigned)(Rb * K + C) * 2u; }
    const size_t kstep = (size_t)(BK * 2);
    const size_t hstep = (size_t)HALF * K * 2;
    const size_t tstep = 2 * hstep;
    const unsigned ldsw = (unsigned)wid * 1024u;
    const int aoff = lds_byte(wr * 64 + fr, fq * 8), boff = lds_byte(wc * 32 + fr, fq * 8);
#define PG8_SA(b, h) (((b) * 2 + (h)) * HTB)
#define PG8_SB(b, h) ((4 + (b) * 2 + (h)) * HTB)
#define PG8_STAGE(bufoff, gbase, voff) do { _Pragma("unroll") for (int _i = 0; _i < 2; ++_i) \
        __builtin_amdgcn_global_load_lds((const unsigned*)((const char*)(gbase) + (voff)[_i]), (PG8_LAS unsigned*)(lds + (bufoff) + ldsw + _i * 8192), 16, 0, 0); } while (0)
#define PG8_LDA(dst, b, h) do { _Pragma("unroll") for (int m = 0; m < 4; ++m) _Pragma("unroll") for (int k = 0; k < 2; ++k) dst[m][k] = *(const PG8_LAS bf16x8*)(lds + PG8_SA(b, h) + aoff + m * 2048 + k * 1024); } while (0)
#define PG8_LDB(dst, b, h) do { _Pragma("unroll") for (int n = 0; n < 2; ++n) _Pragma("unroll") for (int k = 0; k < 2; ++k) dst[n][k] = *(const PG8_LAS bf16x8*)(lds + PG8_SB(b, h) + boff + n * 2048 + k * 1024); } while (0)
#define PG8_MMA(ai, bj, At, Bt) do { __builtin_amdgcn_s_setprio(1); _Pragma("unroll") for (int m = 0; m < 4; ++m) _Pragma("unroll") for (int n = 0; n < 2; ++n) _Pragma("unroll") for (int k = 0; k < 2; ++k) \
        acc[ai][bj][m][n] = __builtin_amdgcn_mfma_f32_16x16x32_bf16(Bt[n][k], At[m][k], acc[ai][bj][m][n], 0, 0, 0); __builtin_amdgcn_s_setprio(0); } while (0)
#define PG8_WAIT_V(n) asm volatile("s_waitcnt vmcnt(" #n ")" ::: "memory")
#define PG8_WAIT_L(n) asm volatile("s_waitcnt lgkmcnt(" #n ")" ::: "memory")
#define PG8_BAR __builtin_amdgcn_s_barrier()
#define PG8_SCHED __builtin_amdgcn_sched_barrier(0)
    Unit cur, nxt; int ui = 0;
    if (!S.next(0, cur)) return;
    f32x4 acc[2][2][4][2];
#pragma unroll
    for (int a = 0; a < 2; ++a)
#pragma unroll
        for (int b = 0; b < 2; ++b)
#pragma unroll
            for (int m = 0; m < 4; ++m)
#pragma unroll
                for (int n = 0; n < 2; ++n) acc[a][b][m][n] = (f32x4){0.f, 0.f, 0.f, 0.f};
    bf16x8 At[4][2], B0[2][2], B1[2][2];
    const char* cA = (const char*)g.A + (size_t)cur.pm * tstep; const char* cB = (const char*)g.Bt + (size_t)cur.pn * tstep;
    S.a_ready(cur);
    if constexpr (SP2) {
        PG8_STAGE(PG8_SB(0, 0), cB, voffB); PG8_STAGE(PG8_SB(0, 1), cB + hstep, voffB); PG8_STAGE(PG8_SA(0, 0), cA, voffA); PG8_STAGE(PG8_SA(0, 1), cA + hstep, voffA);
        if (wr == 1) PG8_BAR;
        PG8_WAIT_V(2); PG8_BAR;
        PG8_STAGE(PG8_SB(1, 0), cB + kstep, voffB); PG8_STAGE(PG8_SA(1, 0), cA + kstep, voffA); PG8_STAGE(PG8_SB(1, 1), cB + hstep + kstep, voffB);
        PG8_WAIT_V(6); PG8_BAR;
    } else {
        PG8_STAGE(PG8_SB(0, 0), cB, voffB); PG8_STAGE(PG8_SA(0, 0), cA, voffA); PG8_STAGE(PG8_SB(0, 1), cB + hstep, voffB); PG8_STAGE(PG8_SA(0, 1), cA + hstep, voffA);
        if (wr == 1) PG8_BAR;
        PG8_WAIT_V(4); PG8_BAR;
        PG8_STAGE(PG8_SB(1, 0), cB + kstep, voffB); PG8_STAGE(PG8_SA(1, 0), cA + kstep, voffA); PG8_STAGE(PG8_SB(1, 1), cB + hstep + kstep, voffB);
        PG8_WAIT_V(6); PG8_BAR;
    }
    for (;;) {
        const bool has_next = S.next(ui + 1, nxt);
        const char* nA = has_next ? (const char*)g.A + (size_t)nxt.pm * tstep : cA; const char* nB = has_next ? (const char*)g.Bt + (size_t)nxt.pn * tstep : cB;
        for (int t = 0; t < nt; t += 2) {
            if constexpr (Epi::HAS_MID) { if (t == (nt >> 1)) E.mid(acc, cur, wr, wc, fr, fq); }
            const bool last = (t == nt - 2);
            const char* a1 = cA + (size_t)(t + 1) * kstep;
            const char* a2 = last ? nA : cA + (size_t)(t + 2) * kstep; const char* b2 = last ? nB : cB + (size_t)(t + 2) * kstep;
            const char* a3 = a2 + kstep; const char* b3 = b2 + kstep;
            if (last && has_next) S.a_ready(nxt);
            if constexpr (SP2) {
            PG8_LDB(B0, 0, 0); PG8_LDB(B1, 0, 1); PG8_SCHED; PG8_LDA(At, 0, 0); PG8_STAGE(PG8_SA(1, 1), a1 + hstep, voffA);
            PG8_WAIT_V(8); PG8_WAIT_L(0); PG8_BAR; PG8_MMA(0, 0, At, B0); PG8_MMA(0, 1, At, B1); PG8_BAR; PG8_SCHED;
            PG8_LDA(At, 0, 1); PG8_STAGE(PG8_SB(0, 0), b2, voffB); PG8_STAGE(PG8_SB(0, 1), b2 + hstep, voffB); PG8_STAGE(PG8_SA(0, 0), a2, voffA);
            PG8_WAIT_V(8); PG8_WAIT_L(0); PG8_BAR; PG8_MMA(1, 0, At, B0); PG8_MMA(1, 1, At, B1); PG8_BAR; PG8_SCHED;
            PG8_LDB(B0, 1, 0); PG8_LDB(B1, 1, 1); PG8_SCHED; PG8_LDA(At, 1, 0); PG8_STAGE(PG8_SA(0, 1), a2 + hstep, voffA);
            PG8_WAIT_V(8); PG8_WAIT_L(0); PG8_BAR; PG8_MMA(0, 0, At, B0); PG8_MMA(0, 1, At, B1); PG8_BAR; PG8_SCHED;
            PG8_LDA(At, 1, 1); PG8_STAGE(PG8_SB(1, 0), b3, voffB); PG8_STAGE(PG8_SB(1, 1), b3 + hstep, voffB); PG8_STAGE(PG8_SA(1, 0), a3, voffA);
            PG8_WAIT_V(8); PG8_WAIT_L(0); PG8_BAR; PG8_MMA(1, 0, At, B0); PG8_MMA(1, 1, At, B1); PG8_BAR; PG8_SCHED;
            } else {
            PG8_LDB(B0, 0, 0); PG8_SCHED; PG8_LDA(At, 0, 0); PG8_STAGE(PG8_SA(1, 1), a1 + hstep, voffA);
            PG8_WAIT_L(8); PG8_BAR; PG8_WAIT_L(0); PG8_MMA(0, 0, At, B0); PG8_BAR; PG8_SCHED;
            PG8_LDB(B1, 0, 1); PG8_STAGE(PG8_SB(0, 0), b2, voffB);
            PG8_BAR; PG8_WAIT_L(0); PG8_MMA(0, 1, At, B1); PG8_BAR;
            PG8_LDA(At, 0, 1); PG8_STAGE(PG8_SA(0, 0), a2, voffA);
            PG8_BAR; PG8_WAIT_L(0); PG8_MMA(1, 0, At, B0); PG8_BAR; PG8_SCHED;
            PG8_STAGE(PG8_SB(0, 1), b2 + hstep, voffB);
            PG8_WAIT_V(6); PG8_BAR; PG8_MMA(1, 1, At, B1); PG8_BAR;
            PG8_LDB(B0, 1, 0); PG8_SCHED; PG8_LDA(At, 1, 0); PG8_STAGE(PG8_SA(0, 1), a2 + hstep, voffA);
            PG8_WAIT_L(8); PG8_BAR; PG8_WAIT_L(0); PG8_MMA(0, 0, At, B0); PG8_BAR; PG8_SCHED;
            PG8_LDB(B1, 1, 1); PG8_STAGE(PG8_SB(1, 0), b3, voffB);
            PG8_BAR; PG8_WAIT_L(0); PG8_MMA(0, 1, At, B1); PG8_BAR;
            PG8_LDA(At, 1, 1); PG8_STAGE(PG8_SA(1, 0), a3, voffA);
            PG8_BAR; PG8_WAIT_L(0); PG8_MMA(1, 0, At, B0); PG8_BAR; PG8_SCHED;
            PG8_STAGE(PG8_SB(1, 1), b3 + hstep, voffB);
            PG8_WAIT_V(6); PG8_BAR; PG8_MMA(1, 1, At, B1); PG8_BAR;
            }
        }
        if constexpr (ALIGN_EPI) { if (wr == 0) PG8_BAR; }
        if constexpr (!Epi::AFTER_DRAIN) { E(acc, cur, wr, wc, fr, fq); S.done(cur); }
        if (!has_next) break;
#pragma unroll
        for (int a = 0; a < 2; ++a)
#pragma unroll
            for (int b = 0; b < 2; ++b)
#pragma unroll
                for (int m = 0; m < 4; ++m)
#pragma unroll
                    for (int n = 0; n < 2; ++n) acc[a][b][m][n] = (f32x4){0.f, 0.f, 0.f, 0.f};
        cur = nxt; cA = nA; cB = nB; ++ui;
        if constexpr (ALIGN_EPI) { if (wr == 1) PG8_BAR; }
    }
    PG8_WAIT_V(0);
    if constexpr (!ALIGN_EPI) { if (wr == 0) PG8_BAR; }
    PG8_BAR;
    if constexpr (Epi::AFTER_DRAIN) { E.fused(acc, cur, wr, wc, fr, fq, lds, wid, lane); S.done(cur); }
#undef PG8_SA
#undef PG8_SB
#undef PG8_STAGE
#undef PG8_LDA
#undef PG8_LDB
#undef PG8_MMA
#undef PG8_WAIT_V
#undef PG8_WAIT_L
#undef PG8_BAR
#undef PG8_SCHED
}
}
using pg8::bf16_t; using pg8::bf16x8; using pg8::f32x4; using pg8::u32x4; using pg8::cvt_pk_bf16; using pg8::bflo; using pg8::bfhi; using pg8::sigm;
typedef unsigned u32x2 __attribute__((ext_vector_type(2)));
constexpr int MP = 16384, MS = 1024, MT = MP + MS;
constexpr int DIN = 4360, NPROJ = 4352, NMIX = 2304, NGATE = 2048, DFF = 2816;
constexpr float EPS = 1e-6f, LOG2E = 1.4426950408889634f;
constexpr size_t MiB = 1u << 20;
constexpr size_t WS_ROWSS = 0;
constexpr size_t WS_SUMA = 128 * 1024, WS_SUMM = WS_SUMA + 4096, WS_MCH = WS_SUMM + 4096;
constexpr size_t WS_GI = 256 * 1024, WS_GB = WS_GI + 320 * 1024;
constexpr size_t WS_DN = 1 * MiB, WS_NPREV = WS_DN + 256 * 1024;
constexpr size_t WS_WIN = 2 * MiB;
constexpr size_t WS_WAB = WS_WIN + 17 * MiB / 2;
constexpr size_t WS_WOUT = WS_WAB + 2 * MiB;
constexpr size_t WS_WGU = WS_WOUT + 2 * MiB;
constexpr size_t WS_WD = WS_WGU + 11 * MiB;
constexpr size_t WS_HN = WS_WD + 11 * MiB / 2;
constexpr size_t OB_DCT = 34 * MiB, OB_CPT = 50 * MiB;
constexpr size_t WS_MIXIN = WS_HN + 34 * MiB;
constexpr size_t WS_GATES = WS_MIXIN + 153 * MiB / 2;
constexpr size_t WS_HCAT = WS_GATES + 68 * MiB;
constexpr size_t WS_END = WS_HCAT + 34 * MiB;
static_assert(WS_END <= 256 * MiB, "workspace map");
constexpr size_t O_Y = 0, O_CP = (size_t)MT * 1024, O_NP = O_CP + 65536, O_MP = O_NP + 512, O_KWP = O_MP + 8, O_VWP = O_KWP + 32768,
                 O_CS = O_VWP + 32768, O_NS = O_CS + 4194304, O_MS = O_NS + 32768, O_KWS = O_MS + 512, O_VWS = O_KWS + 2097152, O_END = O_VWS + 2097152;
constexpr size_t WS_BAR = 1536 * 1024;
constexpr int LDS_BYTES = 131072 + 256;

struct Params { const float* in[22]; float* out; unsigned char* ws; int ph_lo, ph_hi; };

__device__ __forceinline__ float bf2f(bf16_t h) { return __builtin_bit_cast(float, (unsigned)h << 16); }
__device__ __forceinline__ bf16_t f2bf(float f) { return (bf16_t)(cvt_pk_bf16(f, 0.f) & 0xffffu); }
__device__ __forceinline__ float wave_sum(float v) {
#pragma unroll
    for (int o = 1; o < 64; o <<= 1) v += __shfl_xor(v, o);
    return v; }
__device__ __forceinline__ float wave_max(float v) {
#pragma unroll
    for (int o = 1; o < 64; o <<= 1) v = fmaxf(v, __shfl_xor(v, o));
    return v; }
__device__ __forceinline__ f32x4 mfma16(bf16x8 a, bf16x8 b, f32x4 c) { f32x4 d = __builtin_amdgcn_mfma_f32_16x16x32_bf16(a, b, c, 0, 0, 0); asm volatile("" : "+v"(d) : "v"(a), "v"(b)); return d; }
__device__ __forceinline__ bf16x8 pack8(const f32x4& a, const f32x4& b) { u32x4 t; t.x = cvt_pk_bf16(a[0], a[1]); t.y = cvt_pk_bf16(a[2], a[3]); t.z = cvt_pk_bf16(b[0], b[1]); t.w = cvt_pk_bf16(b[2], b[3]); return __builtin_bit_cast(bf16x8, t); }
__device__ __forceinline__ void unpack8(const u32x4& r, float* f) { f[0] = bflo(r.x); f[1] = bfhi(r.x); f[2] = bflo(r.y); f[3] = bfhi(r.y); f[4] = bflo(r.z); f[5] = bfhi(r.z); f[6] = bflo(r.w); f[7] = bfhi(r.w); }

__device__ __forceinline__ void p0_tokens(const Params& P, unsigned char* lds, int tid, int G) {
    const float* wg = (const float*)lds; const float* nw = P.in[7];
    bf16_t* HN = (bf16_t*)(P.ws + WS_HN); float* gi = (float*)(P.ws + WS_GI); float* gb = (float*)(P.ws + WS_GB);
    const int lane = tid & 63, w = tid >> 6;
    f32x4 xn[4];
    { const int r = blockIdx.x * 8 + w; const float* xrow = r < MP ? P.in[0] + (size_t)r * 1024 : P.in[1] + (size_t)(r - MP) * 1024;
#pragma unroll
        for (int j = 0; j < 4; ++j) xn[j] = ((const f32x4*)xrow)[lane + 64 * j]; }
#pragma unroll 1
    for (int r = blockIdx.x * 8 + w; r < MT; r += G * 8) {
        f32x4 xv[4]; float ss = 0.f;
#pragma unroll
        for (int j = 0; j < 4; ++j) xv[j] = xn[j];
        { const int rn = (r + G * 8 < MT) ? r + G * 8 : r; const float* xrow = rn < MP ? P.in[0] + (size_t)rn * 1024 : P.in[1] + (size_t)(rn - MP) * 1024;
#pragma unroll
            for (int j = 0; j < 4; ++j) xn[j] = ((const f32x4*)xrow)[lane + 64 * j]; }
#pragma unroll
        for (int j = 0; j < 4; ++j) ss += (xv[j][0] * xv[j][0] + xv[j][1] * xv[j][1]) + (xv[j][2] * xv[j][2] + xv[j][3] * xv[j][3]);
        ss = wave_sum(ss);
        const float rstd = 1.0f / sqrtf(ss * (1.0f / 1024.0f) + EPS);
        float g[8];
#pragma unroll
        for (int q = 0; q < 8; ++q) g[q] = 0.f;
#pragma unroll
        for (int j = 0; j < 4; ++j) { const int k0 = 4 * (lane + 64 * j);
            const f32x4 nv = *(const f32x4*)(nw + k0); const f32x4 hv = xv[j] * rstd * nv;
            u32x2 pk; pk.x = cvt_pk_bf16(hv[0], hv[1]); pk.y = cvt_pk_bf16(hv[2], hv[3]);
            *(u32x2*)(HN + (size_t)r * 1024 + k0) = pk;
#pragma unroll
            for (int q = 0; q < 8; ++q) { const f32x4 wv = *(const f32x4*)(wg + q * 1024 + k0); g[q] += (xv[j][0] * wv[0] + xv[j][1] * wv[1]) + (xv[j][2] * wv[2] + xv[j][3] * wv[3]); } }
#pragma unroll
        for (int q = 0; q < 8; ++q) g[q] = wave_sum(g[q]);
        if (lane < 4) { const float iv = (lane == 0 ? g[0] : lane == 1 ? g[1] : lane == 2 ? g[2] : g[3]) * rstd + P.in[9][lane];
            const float fv = (lane == 0 ? g[4] : lane == 1 ? g[5] : lane == 2 ? g[6] : g[7]) * rstd + P.in[10][lane];
            gi[r * 4 + lane] = iv; gb[r * 4 + lane] = fminf(fv, 0.f) - log1pf(expf(-fabsf(fv))); }
    }
}
template <bool GU>
__device__ __forceinline__ void p0_wunit(const float* src, int ldsrc, int k0, int c0, bf16_t* dst, int lddst, int n0, int k0d, unsigned char* lds, int tid) {
    float* tile = (float*)(lds + 40960);
    f32x4 v[8];
#pragma unroll
    for (int p = 0; p < 8; ++p) v[p] = *(const f32x4*)(src + (size_t)(k0 + (tid >> 6) + 8 * p) * ldsrc + c0 + (tid & 63) * 4);
#pragma unroll
    for (int p = 0; p < 8; ++p) *(f32x4*)(tile + ((tid >> 6) + 8 * p) * 260 + (tid & 63) * 4) = v[p];
    __syncthreads();
    { const int n = tid >> 1, kc = (tid & 1) * 32; const float* s = tile + kc * 260 + n;
        const int nd = GU ? (256 * ((c0 + n) >> 7) + ((c0 + n) & 127) + n0) : (n0 + n);
        bf16_t* dp = dst + (size_t)nd * lddst + k0d + kc;
#pragma unroll
        for (int q = 0; q < 4; ++q) { u32x4 o; o.x = cvt_pk_bf16(s[(8 * q) * 260], s[(8 * q + 1) * 260]); o.y = cvt_pk_bf16(s[(8 * q + 2) * 260], s[(8 * q + 3) * 260]);
            o.z = cvt_pk_bf16(s[(8 * q + 4) * 260], s[(8 * q + 5) * 260]); o.w = cvt_pk_bf16(s[(8 * q + 6) * 260], s[(8 * q + 7) * 260]); *(u32x4*)(dp + 8 * q) = o; } }
    __syncthreads();
}
constexpr int NT_IN = 17 * 16, NT_AB = 64, NT_OUT = 64, NT_GU = 352, NT_D = 176, NT_ALL = NT_IN + NT_AB + NT_OUT + NT_GU + NT_D;
__device__ __forceinline__ void wtile_by_index(const Params& P, int r, unsigned char* lds, int tid) {
    if (r < NT_IN) { const int nt = r >> 4, kt = r & 15, c0 = nt * 256; p0_wunit<false>(P.in[8], DIN, kt * 64, c0 < 1536 ? c0 : c0 + 8, (bf16_t*)(P.ws + WS_WIN), 1024, c0, kt * 64, lds, tid); return; } r -= NT_IN;
    if (r < NT_AB) { const int which = r >> 5, rr = r & 31, nt = rr >> 3, kt = rr & 7; p0_wunit<false>(which ? P.in[16] : P.in[15], 1024, kt * 64, nt * 256, (bf16_t*)(P.ws + WS_WAB), 1024, nt * 256, which * 512 + kt * 64, lds, tid); return; } r -= NT_AB;
    if (r < NT_OUT) { const int nt = r >> 4, kt = r & 15; p0_wunit<false>(P.in[17], 1024, kt * 64, nt * 256, (bf16_t*)(P.ws + WS_WOUT), 1024, nt * 256, kt * 64, lds, tid); return; } r -= NT_OUT;
    if (r < NT_GU) { const int which = r / 176, rr = r % 176, jt = rr >> 4, kt = rr & 15; p0_wunit<true>(which ? P.in[20] : P.in[19], DFF, kt * 64, jt * 256, (bf16_t*)(P.ws + WS_WGU), 1024, which * 128, kt * 64, lds, tid); return; } r -= NT_GU;
    { const int nt = r / 44, kt = r % 44; p0_wunit<false>(P.in[21], 1024, kt * 64, nt * 256, (bf16_t*)(P.ws + WS_WD), DFF, nt * 256, kt * 64, lds, tid); }
}
__device__ __forceinline__ void p0_prep(const Params& P, unsigned char* lds, int tid, int G) {
    float* rowss = (float*)(P.ws + WS_ROWSS);
    for (int i = blockIdx.x * 512 + tid; i < MT; i += G * 512) rowss[i] = 0.f;
    { float* wg = (float*)lds; const float* w_in = P.in[8]; const float* nw = P.in[7];
        for (int idx = tid; idx < 8192; idx += 512) { const int k = idx >> 3, q = idx & 7; wg[q * 1024 + k] = w_in[(size_t)k * DIN + 1536 + q] * nw[k]; } }
    __syncthreads();
    p0_tokens(P, lds, tid, G);
    __syncthreads();
    for (int it = blockIdx.x; it < NT_IN; it += G) wtile_by_index(P, it, lds, tid);
}

template <int NQT>
__device__ __forceinline__ void attn_core(const unsigned char* lds, const bf16x8 (&qf)[NQT][2], int kt_lo, int kt_hi, int qbase, int jmin, float sink2, f32x4 (&o)[4][NQT], float (&l)[NQT]) {
    const bf16_t* Ks = (const bf16_t*)lds; const bf16_t* Vt = (const bf16_t*)(lds + 36864);
    const int lane = threadIdx.x & 63, fr = lane & 15, g = lane >> 4;
    float mrun[NQT];
#pragma unroll
    for (int qt = 0; qt < NQT; ++qt) { mrun[qt] = sink2; l[qt] = (g == 0) ? 1.f : 0.f;
#pragma unroll
        for (int dt = 0; dt < 4; ++dt) o[dt][qt] = (f32x4){0.f, 0.f, 0.f, 0.f}; }
#pragma unroll 1
    for (int kt = kt_lo; kt <= kt_hi; ++kt) {
        f32x4 s[4][NQT];
#pragma unroll
        for (int ks = 0; ks < 4; ++ks)
#pragma unroll
            for (int qt = 0; qt < NQT; ++qt) s[ks][qt] = (f32x4){0.f, 0.f, 0.f, 0.f};
        { bf16x8 kfr[4][2];
#pragma unroll
        for (int ks = 0; ks < 4; ++ks)
#pragma unroll
            for (int kk = 0; kk < 2; ++kk) kfr[ks][kk] = *(const bf16x8*)(Ks + (kt * 64 + ks * 16 + fr) * 72 + g * 8 + kk * 32);
#pragma unroll
        for (int ks = 0; ks < 4; ++ks)
#pragma unroll
            for (int kk = 0; kk < 2; ++kk)
#pragma unroll
                for (int qt = 0; qt < NQT; ++qt) s[ks][qt] = mfma16(kfr[ks][kk], qf[qt][kk], s[ks][qt]); }
#pragma unroll
        for (int qt = 0; qt < NQT; ++qt) { const int qi = qbase + 16 * qt + fr; float mx = -1e30f;
#pragma unroll
            for (int ks = 0; ks < 4; ++ks)
#pragma unroll
                for (int r = 0; r < 4; ++r) { const int j = kt * 64 + ks * 16 + g * 4 + r; const bool ok = (j > qi) && (j <= qi + 128) && (j >= jmin);
                    const float v = ok ? s[ks][qt][r] : -1e30f; s[ks][qt][r] = v; mx = fmaxf(mx, v); }
            mx = fmaxf(mx, __shfl_xor(mx, 16)); mx = fmaxf(mx, __shfl_xor(mx, 32));
            const float mnew = fmaxf(mrun[qt], mx), alpha = __builtin_amdgcn_exp2f(mrun[qt] - mnew); mrun[qt] = mnew;
            float ps = 0.f;
#pragma unroll
            for (int ks = 0; ks < 4; ++ks)
#pragma unroll
                for (int r = 0; r < 4; ++r) { const float p = __builtin_amdgcn_exp2f(s[ks][qt][r] - mnew); s[ks][qt][r] = p; ps += p; }
            l[qt] = l[qt] * alpha + ps;
#pragma unroll
            for (int dt = 0; dt < 4; ++dt) o[dt][qt] = o[dt][qt] * alpha; }
        { bf16x8 vfr[2][4], pf[2][NQT];
#pragma unroll
        for (int c = 0; c < 2; ++c) {
#pragma unroll
            for (int dt = 0; dt < 4; ++dt) { const bf16_t* vp = Vt + (dt * 16 + fr) * 264 + kt * 64 + c * 32 + g * 4;
                const u32x2 v0 = *(const u32x2*)vp, v1 = *(const u32x2*)(vp + 16);
                vfr[c][dt] = __builtin_bit_cast(bf16x8, (u32x4){v0.x, v0.y, v1.x, v1.y}); }
#pragma unroll
            for (int qt = 0; qt < NQT; ++qt) pf[c][qt] = pack8(s[2 * c][qt], s[2 * c + 1][qt]); }
#pragma unroll
        for (int c = 0; c < 2; ++c)
#pragma unroll
            for (int dt = 0; dt < 4; ++dt)
#pragma unroll
                for (int qt = 0; qt < NQT; ++qt) o[dt][qt] = mfma16(vfr[c][dt], pf[c][qt], o[dt][qt]); }
    }
}
__device__ __forceinline__ void attn_put(unsigned char* lds, int slot, int hh, const float* kf, const float* vf) {
    bf16_t* Ks = (bf16_t*)lds; bf16_t* Vt = (bf16_t*)(lds + 36864);
#pragma unroll
    for (int i = 0; i < 4; ++i) { u32x4 w; w.x = cvt_pk_bf16(kf[8 * i], kf[8 * i + 1]); w.y = cvt_pk_bf16(kf[8 * i + 2], kf[8 * i + 3]); w.z = cvt_pk_bf16(kf[8 * i + 4], kf[8 * i + 5]); w.w = cvt_pk_bf16(kf[8 * i + 6], kf[8 * i + 7]);
        *(u32x4*)(Ks + slot * 72 + hh * 32 + 8 * i) = w; }
#pragma unroll
    for (int i = 0; i < 32; ++i) Vt[(hh * 32 + i) * 264 + slot] = f2bf(vf[i]);
}
__device__ __forceinline__ void attn_prompt_item(const Params& P, int item, unsigned char* lds, int tid) {
    const int kvh = item & 1, n = (item >> 1) & 63, b = item >> 7;
    const bf16_t* mixin = (const bf16_t*)(P.ws + WS_MIXIN);
    { const int slot = tid >> 1, hh = tid & 1, tokb = n * 128 - 128 + slot;
        float kf[32], vf[32];
        if (tokb >= 0) { const bf16_t* rowp = mixin + (size_t)(b * 8192 + tokb) * NMIX + 2048 + kvh * 64 + hh * 32;
#pragma unroll
            for (int i = 0; i < 4; ++i) { const u32x4 kr = *(const u32x4*)(rowp + 8 * i), vr = *(const u32x4*)(rowp + 128 + 8 * i); unpack8(kr, kf + 8 * i); unpack8(vr, vf + 8 * i); } }
        else {
#pragma unroll
            for (int i = 0; i < 32; ++i) { kf[i] = 0.f; vf[i] = 0.f; } }
        float ss = 0.f;
#pragma unroll
        for (int i = 0; i < 32; ++i) ss += kf[i] * kf[i];
        ss += __shfl_xor(ss, 1);
        const float rstd = 1.0f / sqrtf(ss * (1.0f / 64.0f) + EPS);
#pragma unroll
        for (int i = 0; i < 32; ++i) kf[i] = kf[i] * rstd * P.in[13][hh * 32 + i];
        attn_put(lds, slot, hh, kf, vf);
        if (n == 63 && slot >= 128) { float* kw = P.out + O_KWP + ((size_t)(b * 128 + slot - 128) * 2 + kvh) * 64 + hh * 32; float* vw = P.out + O_VWP + ((size_t)(b * 128 + slot - 128) * 2 + kvh) * 64 + hh * 32;
#pragma unroll
            for (int i = 0; i < 8; ++i) { *(f32x4*)(kw + 4 * i) = (f32x4){kf[4 * i], kf[4 * i + 1], kf[4 * i + 2], kf[4 * i + 3]}; *(f32x4*)(vw + 4 * i) = (f32x4){vf[4 * i], vf[4 * i + 1], vf[4 * i + 2], vf[4 * i + 3]}; } }
    }
    __syncthreads();
    const int w = tid >> 6, lane = tid & 63, fr = lane & 15, g = lane >> 4, gq = w >> 1, half = w & 1, head = kvh * 4 + gq;
    bf16_t* hcat = (bf16_t*)(P.ws + WS_HCAT);
#pragma unroll 1
    for (int qh = 0; qh < 2; ++qh) {
    bf16x8 qf[2][2];
#pragma unroll
    for (int qt = 0; qt < 2; ++qt) { const int tok = b * 8192 + n * 128 + half * 64 + qh * 32 + qt * 16 + fr; const bf16_t* qp = mixin + (size_t)tok * NMIX + 1536 + head * 64 + g * 8;
        float f0[8], f1[8]; unpack8(*(const u32x4*)qp, f0); unpack8(*(const u32x4*)(qp + 32), f1);
        float ss = 0.f;
#pragma unroll
        for (int i = 0; i < 8; ++i) ss += f0[i] * f0[i] + f1[i] * f1[i];
        ss += __shfl_xor(ss, 16); ss += __shfl_xor(ss, 32);
        const float sc = (0.125f * LOG2E) / sqrtf(ss * (1.0f / 64.0f) + EPS);
#pragma unroll
        for (int i = 0; i < 8; ++i) { f0[i] = f0[i] * sc * P.in[12][g * 8 + i]; f1[i] = f1[i] * sc * P.in[12][32 + g * 8 + i]; }
        qf[qt][0] = pack8((f32x4){f0[0], f0[1], f0[2], f0[3]}, (f32x4){f0[4], f0[5], f0[6], f0[7]}); qf[qt][1] = pack8((f32x4){f1[0], f1[1], f1[2], f1[3]}, (f32x4){f1[4], f1[5], f1[6], f1[7]}); }
    f32x4 o[4][2]; float l[2];
    attn_core<2>(lds, qf, half, half + 2, half * 64 + qh * 32, n == 0 ? 128 : 0, P.in[14][head] * LOG2E, o, l);
#pragma unroll
    for (int qt = 0; qt < 2; ++qt) { float lt = l[qt]; lt += __shfl_xor(lt, 16); lt += __shfl_xor(lt, 32); const float inv = 1.0f / lt;
        const int tok = b * 8192 + n * 128 + half * 64 + qh * 32 + qt * 16 + fr;
#pragma unroll
        for (int dt = 0; dt < 4; ++dt) { const f32x4 v = o[dt][qt] * inv; u32x2 pk; pk.x = cvt_pk_bf16(v[0], v[1]); pk.y = cvt_pk_bf16(v[2], v[3]);
            *(u32x2*)(hcat + (size_t)tok * 1024 + 512 + head * 64 + dt * 16 + g * 4) = pk; } }
    }
    __syncthreads();
}
__device__ __forceinline__ void attn_sample_item(const Params& P, int item, unsigned char* lds, int tid) {
    const int kvh = item & 1, b = item >> 1;
    const bf16_t* mixin = (const bf16_t*)(P.ws + WS_MIXIN);
    { const int slot = tid >> 1, hh = tid & 1;
        if (slot < 192) { float kf[32], vf[32];
            if (slot < 128) { const size_t off = ((size_t)(b * 128 + slot) * 2 + kvh) * 64 + hh * 32; const float* kp = P.in[5] + off; const float* vp = P.in[6] + off;
#pragma unroll
                for (int i = 0; i < 8; ++i) { const f32x4 a = *(const f32x4*)(kp + 4 * i), c = *(const f32x4*)(vp + 4 * i);
                    kf[4 * i] = a[0]; kf[4 * i + 1] = a[1]; kf[4 * i + 2] = a[2]; kf[4 * i + 3] = a[3]; vf[4 * i] = c[0]; vf[4 * i + 1] = c[1]; vf[4 * i + 2] = c[2]; vf[4 * i + 3] = c[3]; } }
            else if (slot < 136) { const bf16_t* rowp = mixin + (size_t)(MP + b * 8 + slot - 128) * NMIX + 2048 + kvh * 64 + hh * 32;
#pragma unroll
                for (int i = 0; i < 4; ++i) { const u32x4 kr = *(const u32x4*)(rowp + 8 * i), vr = *(const u32x4*)(rowp + 128 + 8 * i); unpack8(kr, kf + 8 * i); unpack8(vr, vf + 8 * i); }
                float ss = 0.f;
#pragma unroll
                for (int i = 0; i < 32; ++i) ss += kf[i] * kf[i];
                ss += __shfl_xor(ss, 1);
                const float rstd = 1.0f / sqrtf(ss * (1.0f / 64.0f) + EPS);
#pragma unroll
                for (int i = 0; i < 32; ++i) kf[i] = kf[i] * rstd * P.in[13][hh * 32 + i]; }
            else {
#pragma unroll
                for (int i = 0; i < 32; ++i) { kf[i] = 0.f; vf[i] = 0.f; } }
            attn_put(lds, slot, hh, kf, vf);
            if (slot >= 8 && slot < 136) { const size_t off = ((size_t)(b * 128 + slot - 8) * 2 + kvh) * 64 + hh * 32; float* kw = P.out + O_KWS + off; float* vw = P.out + O_VWS + off;
#pragma unroll
                for (int i = 0; i < 8; ++i) { *(f32x4*)(kw + 4 * i) = (f32x4){kf[4 * i], kf[4 * i + 1], kf[4 * i + 2], kf[4 * i + 3]}; *(f32x4*)(vw + 4 * i) = (f32x4){vf[4 * i], vf[4 * i + 1], vf[4 * i + 2], vf[4 * i + 3]}; } }
        }
    }
    __syncthreads();
    const int w = tid >> 6, lane = tid & 63, fr = lane & 15, g = lane >> 4;
    if (w < 4) { const int head = kvh * 4 + w; const int tok = MP + b * 8 + (fr & 7);
        bf16x8 qf[1][2];
        { const bf16_t* qp = mixin + (size_t)tok * NMIX + 1536 + head * 64 + g * 8;
            float f0[8], f1[8]; unpack8(*(const u32x4*)qp, f0); unpack8(*(const u32x4*)(qp + 32), f1);
            float ss = 0.f;
#pragma unroll
            for (int i = 0; i < 8; ++i) ss += f0[i] * f0[i] + f1[i] * f1[i];
            ss += __shfl_xor(ss, 16); ss += __shfl_xor(ss, 32);
            const float sc = (0.125f * LOG2E) / sqrtf(ss * (1.0f / 64.0f) + EPS);
#pragma unroll
            for (int i = 0; i < 8; ++i) { f0[i] = f0[i] * sc * P.in[12][g * 8 + i]; f1[i] = f1[i] * sc * P.in[12][32 + g * 8 + i]; }
            qf[0][0] = pack8((f32x4){f0[0], f0[1], f0[2], f0[3]}, (f32x4){f0[4], f0[5], f0[6], f0[7]}); qf[0][1] = pack8((f32x4){f1[0], f1[1], f1[2], f1[3]}, (f32x4){f1[4], f1[5], f1[6], f1[7]}); }
        f32x4 o[4][1]; float l[1];
        attn_core<1>(lds, qf, 0, 2, 0, 0, P.in[14][head] * LOG2E, o, l);
        float lt = l[0]; lt += __shfl_xor(lt, 16); lt += __shfl_xor(lt, 32); const float inv = 1.0f / lt;
        bf16_t* hcat = (bf16_t*)(P.ws + WS_HCAT);
        if (fr < 8) {
#pragma unroll
            for (int dt = 0; dt < 4; ++dt) { const f32x4 v = o[dt][0] * inv; u32x2 pk; pk.x = cvt_pk_bf16(v[0], v[1]); pk.y = cvt_pk_bf16(v[2], v[3]);
                *(u32x2*)(hcat + (size_t)tok * 1024 + 512 + head * 64 + dt * 16 + g * 4) = pk; } }
    }
    __syncthreads();
}
#define LAS __attribute__((address_space(3)))
#define XB_TMO      128
#define XB_XCNT(j)  (256  + 64 * (j))
#define XB_XSUB(j)  (1280 + 64 * (j))
#define XB_XGEN(j)  (2304 + 64 * (j))
#define XB_TOP      3328
#define XB_TOPGEN   3392
#define XCD_BAR_WORDS 3456
#define XB_SPIN_CAP (1u << 18)

__device__ __forceinline__ unsigned xb_ld(unsigned* p)              { return __hip_atomic_load(p, __ATOMIC_RELAXED, __HIP_MEMORY_SCOPE_AGENT); }
__device__ __forceinline__ unsigned xb_add(unsigned* p, unsigned v) { return __hip_atomic_fetch_add(p, v, __ATOMIC_RELAXED, __HIP_MEMORY_SCOPE_AGENT); }
__device__ __forceinline__ unsigned xb_xcc_id() { return (unsigned)__builtin_amdgcn_s_getreg((3 << 11) | 20) & 0xFu; }
#define XB_SPIN(cond, bar) do { unsigned _sp = 0; while (cond) { __builtin_amdgcn_s_sleep(1); \
    if ((++_sp & 255u) == 0u) { if (xb_ld(&(bar)[XB_TMO])) break; if (_sp > XB_SPIN_CAP) { atomicAdd(&(bar)[XB_TMO], 1u); break; } } } } while (0)

struct XcdBarrier {
    unsigned* bar; unsigned x;
    volatile LAS unsigned* st;
};

__device__ __forceinline__ XcdBarrier xcd_barrier_post(unsigned* bar, volatile LAS unsigned* st) {
    XcdBarrier b; b.bar = bar; b.x = xb_xcc_id(); b.st = st;
    if (threadIdx.x == 0) (void)xb_add(&bar[XB_XCNT(b.x)], 1u);
    return b;
}
__device__ __forceinline__ void xcd_barrier_complete(unsigned* bar, unsigned x, unsigned& nloc, unsigned& nx) {
    const unsigned G = gridDim.x * gridDim.y * gridDim.z;
    unsigned sum, cnt, mine, sp = 0u;
    for (;;) {
        sum = 0u; cnt = 0u; mine = 0u;
#pragma unroll
        for (unsigned j = 0; j < 16; ++j) { const unsigned c = xb_ld(&bar[XB_XCNT(j)]); sum += c; cnt += (c > 0u) ? 1u : 0u; mine = (j == x) ? c : mine; }
        if (sum == G) break;
        __builtin_amdgcn_s_sleep(1);
        if ((++sp & 255u) == 0u) { if (xb_ld(&bar[XB_TMO])) break; if (sp > XB_SPIN_CAP) { atomicAdd(&bar[XB_TMO], 1u); break; } }
    }
    nloc = mine > 0u ? mine : 1u; nx = cnt > 0u ? cnt : 1u;
}

__device__ __forceinline__ void xcd_barrier(const XcdBarrier& b) {
    asm volatile("s_waitcnt vmcnt(0)" ::: "memory");
    __syncthreads();
    if (threadIdx.x == 0) {
        unsigned* bar = b.bar;
        __builtin_amdgcn_s_waitcnt(0);
        unsigned nloc = b.st[0], nx = b.st[1];
        if (nloc == 0u) { xcd_barrier_complete(bar, b.x, nloc, nx); b.st[0] = nloc; b.st[1] = nx; }
        const unsigned old = xb_add(&bar[XB_XSUB(b.x)], 1u);
        const unsigned gen = old / nloc;
        if (old + 1u == (gen + 1u) * nloc) {
            __builtin_amdgcn_fence(__ATOMIC_RELEASE, "agent");
            asm volatile("s_waitcnt vmcnt(0)" ::: "memory");
            const unsigned og = xb_add(&bar[XB_TOP], 1u);
            const unsigned tg = og / nx;
            if (og + 1u == (tg + 1u) * nx) xb_add(&bar[XB_TOPGEN], 1u);
            else XB_SPIN(xb_ld(&bar[XB_TOPGEN]) == tg, bar);
            __builtin_amdgcn_fence(__ATOMIC_ACQUIRE, "agent");
            xb_add(&bar[XB_XGEN(b.x)], 1u);
            asm volatile("s_waitcnt vmcnt(0)" ::: "memory");
        } else {
            XB_SPIN(xb_ld(&bar[XB_XGEN(b.x)]) == gen, bar);
            __builtin_amdgcn_fence(__ATOMIC_ACQUIRE, "agent");
            asm volatile("s_waitcnt vmcnt(0)" ::: "memory");
        }
    }
    __syncthreads();
}
__device__ __forceinline__ void mlstm_b_item(const Params& P, int item, unsigned char* lds, int tid) {
    const int c = item & 127, h = (item >> 7) & 3, b = item >> 9, r0 = b * 8192 + c * 64;
    float* wl = (float*)lds; bf16_t* Kt = (bf16_t*)(lds + 256); bf16_t* Vt = (bf16_t*)(lds + 256 + 9216);
    const bf16_t* mixin = (const bf16_t*)(P.ws + WS_MIXIN);
    if (tid < 64) { const float iv = ((const float*)(P.ws + WS_GI))[(r0 + tid) * 4 + h]; float bb = ((const float*)(P.ws + WS_GB))[(r0 + tid) * 4 + h];
#pragma unroll
        for (int o = 1; o < 64; o <<= 1) { const float nb = __shfl_up(bb, o); if (tid >= o) bb += nb; }
        const float A = __shfl(bb, 63), v = A - bb + iv, M = wave_max(v); wl[tid] = __expf(v - M) * 0.125f;
        if (tid == 0) { ((float*)(P.ws + WS_SUMA))[item] = A; ((float*)(P.ws + WS_SUMM))[item] = M; } }
    __syncthreads();
    { const int s = tid >> 3, ch = tid & 7; const bf16_t* rowp = mixin + (size_t)(r0 + s) * NMIX; const float ws_ = wl[s];
        float kf[8]; unpack8(*(const u32x4*)(rowp + 256 + h * 64 + ch * 8), kf);
#pragma unroll
        for (int i = 0; i < 8; ++i) Kt[(ch * 8 + i) * 72 + s] = f2bf(kf[i] * ws_);
        const u32x4 v0 = *(const u32x4*)(rowp + 512 + h * 128 + ch * 16), v1 = *(const u32x4*)(rowp + 512 + h * 128 + ch * 16 + 8);
        const unsigned vv[8] = {v0.x, v0.y, v0.z, v0.w, v1.x, v1.y, v1.z, v1.w};
#pragma unroll
        for (int i = 0; i < 8; ++i) { Vt[(ch * 16 + 2 * i) * 72 + s] = (bf16_t)(vv[i] & 0xffffu); Vt[(ch * 16 + 2 * i + 1) * 72 + s] = (bf16_t)(vv[i] >> 16); } }
    __syncthreads();
    { const int w = tid >> 6, lane = tid & 63, fr = lane & 15, g = lane >> 4, e0 = 16 * w;
        f32x4 acc[4];
#pragma unroll
        for (int dt = 0; dt < 4; ++dt) acc[dt] = (f32x4){0.f, 0.f, 0.f, 0.f};
        bf16x8 vfr[2], kfr[2][4];
#pragma unroll
        for (int kk = 0; kk < 2; ++kk) { vfr[kk] = *(const bf16x8*)(Vt + (e0 + fr) * 72 + g * 8 + kk * 32);
#pragma unroll
            for (int dt = 0; dt < 4; ++dt) kfr[kk][dt] = *(const bf16x8*)(Kt + (dt * 16 + fr) * 72 + g * 8 + kk * 32); }
#pragma unroll
        for (int kk = 0; kk < 2; ++kk)
#pragma unroll
            for (int dt = 0; dt < 4; ++dt) acc[dt] = mfma16(kfr[kk][dt], vfr[kk], acc[dt]);
        bf16_t* dct = (bf16_t*)((unsigned char*)P.out + OB_DCT) + ((size_t)item * 128 + e0 + fr) * 64;
#pragma unroll
        for (int dt = 0; dt < 4; ++dt) { u32x2 pk; pk.x = cvt_pk_bf16(acc[dt][0], acc[dt][1]); pk.y = cvt_pk_bf16(acc[dt][2], acc[dt][3]); *(u32x2*)(dct + dt * 16 + g * 4) = pk; } }
    if (tid < 64) { float sum = 0.f;
#pragma unroll 8
        for (int s = 0; s < 64; ++s) sum += bf2f(Kt[tid * 72 + s]);
        ((float*)(P.ws + WS_DN))[item * 64 + tid] = sum; }
    __syncthreads();
}
__device__ __forceinline__ void mlstm_scan(const Params& P, unsigned char* lds, int tid) {
    const int pair = blockIdx.x >> 3, sub = blockIdx.x & 7;
    float* ga = (float*)lds; float* ea = ga + 128; float* marr = ea + 128;
    if (tid < 128) { ga[tid] = ((const float*)(P.ws + WS_SUMA))[pair * 128 + tid]; ea[tid] = ((const float*)(P.ws + WS_SUMM))[pair * 128 + tid]; }
    __syncthreads();
    if (tid == 0) { float m = 0.f; const float* sA = ga; const float* sM = ea;
        for (int c = 0; c < 128; ++c) { const float A = sA[c], Mv = sM[c], mn = fmaxf(A + m, Mv); ga[c] = __expf(A + m - mn); ea[c] = __expf(Mv - mn); m = mn; marr[c] = mn; } }
    __syncthreads();
    if (sub == 0) { if (tid < 128) ((float*)(P.ws + WS_MCH))[pair * 128 + tid] = marr[tid]; if (tid == 0) P.out[O_MP + pair] = marr[127]; }
#ifndef P3_SCANMASK
#define P3_SCANMASK 3
#endif
    if (P3_SCANMASK & 1) { const int idx2 = sub * 512 + tid; float C0 = 0.f, C1 = 0.f;
        const unsigned* src = (const unsigned*)((unsigned char*)P.out + OB_DCT) + (size_t)pair * 128 * 4096 + idx2; unsigned* dst = (unsigned*)((unsigned char*)P.out + OB_CPT) + (size_t)pair * 128 * 4096 + idx2;
#pragma unroll 1
        for (int c = 0; c < 128; c += 32) { unsigned v[32];
#pragma unroll
            for (int j = 0; j < 32; ++j) v[j] = src[(size_t)(c + j) * 4096];
#pragma unroll
            for (int j = 0; j < 32; ++j) { dst[(size_t)(c + j) * 4096] = cvt_pk_bf16(C0, C1); const float gg = ga[c + j], ee = ea[c + j]; C0 = gg * C0 + ee * bflo(v[j]); C1 = gg * C1 + ee * bfhi(v[j]); } }
        const int i0 = 2 * idx2, e = i0 >> 6, d = i0 & 63;
        P.out[O_CP + ((size_t)pair * 64 + d) * 128 + e] = C0; P.out[O_CP + ((size_t)pair * 64 + d + 1) * 128 + e] = C1; }
    if ((P3_SCANMASK & 2) && sub == 0 && tid < 64) { float nn = 0.f; const float* dn = (const float*)(P.ws + WS_DN) + (size_t)pair * 128 * 64 + tid; float* np = (float*)(P.ws + WS_NPREV) + (size_t)pair * 128 * 64 + tid;
        for (int c = 0; c < 128; ++c) { np[c * 64] = nn; nn = ga[c] * nn + ea[c] * dn[c * 64]; }
        P.out[O_NP + pair * 64 + tid] = nn; }
    __syncthreads();
}
__device__ __forceinline__ void mlstm_sample_item(const Params& P, int item, unsigned char* lds, int tid) {
    const int h = item & 3, b = item >> 2, r0 = MP + b * 8;
    float* q = (float*)lds; float* k = q + 512; float* v = k + 512; float* sw = v + 1024; float* sc = sw + 64; float* n0s = sc + 64; float* part = n0s + 64; float* red = part + 4096;
    const bf16_t* mixin = (const bf16_t*)(P.ws + WS_MIXIN);
    if (tid < 256) {
        const int sel = tid >> 6, i = tid & 63;
        if (sel < 2) { const int t = i >> 3, p = i & 7; float f[8]; unpack8(*(const u32x4*)(mixin + (size_t)(r0 + t) * NMIX + sel * 256 + h * 64 + p * 8), f);
            float* dst = (sel ? k : q) + t * 64 + p * 8; const float sc_ = sel ? 0.125f : 1.0f;
#pragma unroll
            for (int j = 0; j < 8; ++j) dst[j] = f[j] * sc_; }
        else { const int i2 = tid - 128, t = i2 >> 4, p = i2 & 15; float f[8]; unpack8(*(const u32x4*)(mixin + (size_t)(r0 + t) * NMIX + 512 + h * 128 + p * 8), f);
#pragma unroll
            for (int j = 0; j < 8; ++j) v[t * 128 + p * 8 + j] = f[j]; } }
    if (tid < 64) n0s[tid] = P.in[3][(b * 4 + h) * 64 + tid];
    if (tid < 8) { float lf[8];
#pragma unroll
        for (int s = 0; s < 8; ++s) lf[s] = ((const float*)(P.ws + WS_GB))[(r0 + s) * 4 + h];
        float bb = 0.f;
#pragma unroll
        for (int s = 0; s < 8; ++s) bb += (s <= tid) ? lf[s] : 0.f;
        sc[tid] = bb; sc[8 + tid] = ((const float*)(P.ws + WS_GI))[(r0 + tid) * 4 + h] - bb; }
    __syncthreads();
    const float mprev = P.in[4][b * 4 + h];
    if (tid < 8) { float cm = mprev; for (int s = 0; s <= tid; ++s) cm = fmaxf(cm, sc[8 + s]); const float mt = sc[tid] + cm; sc[16 + tid] = mt; sc[24 + tid] = __expf(sc[tid] + mprev - mt); }
    __syncthreads();
    if (tid < 8) { const float b7 = sc[7], m7 = sc[23]; sc[32 + tid] = __expf(b7 + sc[8 + tid] - m7); if (tid == 0) { sc[48] = __expf(b7 + mprev - m7); P.out[O_MS + b * 4 + h] = m7; } }
    if (tid >= 64 && tid < 128) { const int i = tid - 64, t = i >> 3, s = i & 7; float dot = 0.f;
        for (int d = 0; d < 64; ++d) dot += q[t * 64 + d] * k[s * 64 + d];
        sw[i] = (s <= t) ? dot * __expf(sc[t] + sc[8 + s] - sc[16 + t]) : 0.f; }
    if (tid >= 128 && tid < 136) { const int t = tid - 128; float qn = 0.f; for (int d = 0; d < 64; ++d) qn += q[t * 64 + d] * n0s[d]; sc[40 + t] = qn; }
    __syncthreads();
    { const int e = tid & 127, dq = tid >> 7; const float gd = sc[48]; float num[8];
#pragma unroll
        for (int t = 0; t < 8; ++t) num[t] = 0.f;
        float c0v[16];
#pragma unroll
        for (int dd = 0; dd < 16; ++dd) c0v[dd] = P.in[2][((size_t)(b * 4 + h) * 64 + dq * 16 + dd) * 128 + e];
#pragma unroll
        for (int dd = 0; dd < 16; ++dd) { const int d = dq * 16 + dd; const size_t ic = ((size_t)(b * 4 + h) * 64 + d) * 128 + e; const float c0 = c0v[dd];
            float upd = 0.f;
#pragma unroll
            for (int s = 0; s < 8; ++s) upd += sc[32 + s] * k[s * 64 + d] * v[s * 128 + e];
            P.out[O_CS + ic] = gd * c0 + upd;
#pragma unroll
            for (int t = 0; t < 8; ++t) num[t] += q[t * 64 + d] * c0; }
#pragma unroll
        for (int t = 0; t < 8; ++t) part[(dq * 8 + t) * 128 + e] = num[t]; }
    if (tid < 64) { float nn = sc[48] * n0s[tid];
#pragma unroll
        for (int s = 0; s < 8; ++s) nn += sc[32 + s] * k[s * 64 + tid];
        P.out[O_NS + (b * 4 + h) * 64 + tid] = nn; }
    __syncthreads();
    { const int e = tid & 127, tq = tid >> 7, w = tid >> 6, lane = tid & 63; float hv[2];
#pragma unroll
        for (int u = 0; u < 2; ++u) { const int t = tq * 2 + u; float inter = 0.f, intra = 0.f, rs = 0.f;
#pragma unroll
            for (int dq = 0; dq < 4; ++dq) inter += part[(dq * 8 + t) * 128 + e];
#pragma unroll
            for (int s = 0; s < 8; ++s) { intra += sw[t * 8 + s] * v[s * 128 + e]; rs += sw[t * 8 + s]; }
            const float wi = sc[24 + t], den = wi * sc[40 + t] + rs; hv[u] = (wi * inter + intra) / fmaxf(fabsf(den), __expf(-sc[16 + t])); }
        const float s0 = wave_sum(hv[0] * hv[0]), s1 = wave_sum(hv[1] * hv[1]);
        if (lane == 0) { red[w * 2] = s0; red[w * 2 + 1] = s1; }
        __syncthreads();
        bf16_t* hcat = (bf16_t*)(P.ws + WS_HCAT);
#pragma unroll
        for (int u = 0; u < 2; ++u) { const int t = tq * 2 + u; const float tot = red[(w & ~1) * 2 + u] + red[(w | 1) * 2 + u]; const float rstd = 1.0f / sqrtf(tot * (1.0f / 128.0f) + EPS);
            const float so = bf2f(mixin[(size_t)(r0 + t) * NMIX + 1024 + h * 128 + e]);
            hcat[(size_t)(r0 + t) * 1024 + h * 128 + e] = f2bf(hv[u] * rstd * P.in[11][h * 128 + e] * so); } }
    __syncthreads();
}
__device__ __forceinline__ void mlstm_d_item(const Params& P, int item, unsigned char* lds, int tid) {
    const int c = item & 127, h = (item >> 7) & 3, b = item >> 9, r0 = b * 8192 + c * 64, pair = item >> 7;
    float* lb = (float*)lds; float* lu = lb + 64; float* lm = lb + 128; float* misc = lb + 192; float* npv = lb + 256; float* red = lb + 320;
    bf16_t* Kn = (bf16_t*)(lds + 2048); bf16_t* Vt = (bf16_t*)(lds + 11264); bf16_t* Cs = (bf16_t*)(lds + 29696);
    const bf16_t* mixin = (const bf16_t*)(P.ws + WS_MIXIN);
    if (tid < 64) { const float iv = ((const float*)(P.ws + WS_GI))[(r0 + tid) * 4 + h]; float bb = ((const float*)(P.ws + WS_GB))[(r0 + tid) * 4 + h];
#pragma unroll
        for (int o = 1; o < 64; o <<= 1) { const float nb = __shfl_up(bb, o); if (tid >= o) bb += nb; }
        const float mprev = c ? ((const float*)(P.ws + WS_MCH))[pair * 128 + c - 1] : 0.f;
        const float u = iv - bb; float cm = u;
#pragma unroll
        for (int o = 1; o < 64; o <<= 1) { const float nb = __shfl_up(cm, o); if (tid >= o) cm = fmaxf(cm, nb); }
        lb[tid] = bb; lu[tid] = u; lm[tid] = bb + fmaxf(mprev, cm); if (tid == 0) misc[0] = mprev;
        npv[tid] = ((const float*)(P.ws + WS_NPREV))[(size_t)item * 64 + tid]; }
    { const int s = tid >> 3, ch = tid & 7; const bf16_t* rowp = mixin + (size_t)(r0 + s) * NMIX;
        *(u32x4*)(Kn + s * 72 + ch * 8) = *(const u32x4*)(rowp + 256 + h * 64 + ch * 8);
        const u32x4 v0 = *(const u32x4*)(rowp + 512 + h * 128 + ch * 16), v1 = *(const u32x4*)(rowp + 512 + h * 128 + ch * 16 + 8);
        const unsigned vv[8] = {v0.x, v0.y, v0.z, v0.w, v1.x, v1.y, v1.z, v1.w};
#pragma unroll
        for (int i = 0; i < 8; ++i) { Vt[(ch * 16 + 2 * i) * 72 + s] = (bf16_t)(vv[i] & 0xffffu); Vt[(ch * 16 + 2 * i + 1) * 72 + s] = (bf16_t)(vv[i] >> 16); }
        const bf16_t* cp = (const bf16_t*)((unsigned char*)P.out + OB_CPT) + (size_t)item * 8192;
#pragma unroll
        for (int j = 0; j < 2; ++j) { const int idx = tid + 512 * j, e = idx >> 3, dch = idx & 7; *(u32x4*)(Cs + e * 72 + dch * 8) = *(const u32x4*)(cp + e * 64 + dch * 8); } }
    const int w = tid >> 6, lane = tid & 63, fr = lane & 15, g = lane >> 4, tt = w & 3, eh = w >> 2, t = tt * 16 + fr, tok = r0 + t;
    bf16x8 qf[2]; float qv0[8], qv1[8]; u32x2 so_[4]; f32x4 mw_[4];
    { const bf16_t* qp = mixin + (size_t)tok * NMIX + h * 64 + g * 8; const u32x4 a = *(const u32x4*)qp, bq = *(const u32x4*)(qp + 32);
        qf[0] = __builtin_bit_cast(bf16x8, a); qf[1] = __builtin_bit_cast(bf16x8, bq); unpack8(a, qv0); unpack8(bq, qv1);
#pragma unroll
        for (int et = 0; et < 4; ++et) { const int e0 = eh * 64 + et * 16 + g * 4; so_[et] = *(const u32x2*)(mixin + (size_t)tok * NMIX + 1024 + h * 128 + e0); mw_[et] = *(const f32x4*)(P.in[11] + h * 128 + e0); } }
    __syncthreads();
    f32x4 s[4];
    { bf16x8 kfr[4][2];
#pragma unroll
    for (int st = 0; st < 4; ++st)
#pragma unroll
        for (int kk = 0; kk < 2; ++kk) kfr[st][kk] = *(const bf16x8*)(Kn + (st * 16 + fr) * 72 + g * 8 + kk * 32);
#pragma unroll
    for (int st = 0; st < 4; ++st) { s[st] = (f32x4){0.f, 0.f, 0.f, 0.f};
#pragma unroll
        for (int kk = 0; kk < 2; ++kk) s[st] = mfma16(kfr[st][kk], qf[kk], s[st]); } }
    const float bt = lb[t], mt = lm[t], mprev = misc[0];
    float rs = 0.f;
#pragma unroll
    for (int st = 0; st < 4; ++st)
#pragma unroll
        for (int r = 0; r < 4; ++r) { const int si = st * 16 + g * 4 + r; const float wv = (si <= t) ? __expf(bt + lu[si] - mt) : 0.f; const float val = s[st][r] * 0.125f * wv; s[st][r] = val; rs += val; }
    rs += __shfl_xor(rs, 16); rs += __shfl_xor(rs, 32);
    float qn = 0.f;
#pragma unroll
    for (int i = 0; i < 8; ++i) qn += qv0[i] * npv[g * 8 + i] + qv1[i] * npv[32 + g * 8 + i];
    qn += __shfl_xor(qn, 16); qn += __shfl_xor(qn, 32);
    const float wi = __expf(bt + mprev - mt), den = wi * qn + rs, inv = 1.0f / fmaxf(fabsf(den), __expf(-mt));
    bf16x8 pf[2]; pf[0] = pack8(s[0], s[1]); pf[1] = pack8(s[2], s[3]);
    f32x4 h1[4], h2[4];
    { bf16x8 vfr[4][2], cfr[4][2];
#pragma unroll
    for (int et = 0; et < 4; ++et) { const int e = eh * 64 + et * 16 + fr;
#pragma unroll
        for (int cc = 0; cc < 2; ++cc) { const bf16_t* vp = Vt + e * 72 + cc * 32 + g * 4; const u32x2 v0 = *(const u32x2*)vp, v1 = *(const u32x2*)(vp + 16);
            vfr[et][cc] = __builtin_bit_cast(bf16x8, (u32x4){v0.x, v0.y, v1.x, v1.y}); cfr[et][cc] = *(const bf16x8*)(Cs + e * 72 + g * 8 + cc * 32); } }
#pragma unroll
    for (int et = 0; et < 4; ++et) { h1[et] = (f32x4){0.f, 0.f, 0.f, 0.f}; h2[et] = (f32x4){0.f, 0.f, 0.f, 0.f};
#pragma unroll
        for (int cc = 0; cc < 2; ++cc) { h2[et] = mfma16(vfr[et][cc], pf[cc], h2[et]); h1[et] = mfma16(cfr[et][cc], qf[cc], h1[et]); } } }
    float ss = 0.f;
#pragma unroll
    for (int et = 0; et < 4; ++et)
#pragma unroll
        for (int r = 0; r < 4; ++r) { const float hv = (wi * h1[et][r] + h2[et][r]) * inv; h2[et][r] = hv; ss += hv * hv; }
    ss += __shfl_xor(ss, 16); ss += __shfl_xor(ss, 32);
    if (g == 0) red[w * 16 + fr] = ss;
    __syncthreads();
    { const float tot = red[w * 16 + fr] + red[(w ^ 4) * 16 + fr]; const float rstd = 1.0f / sqrtf(tot * (1.0f / 128.0f) + EPS);
        bf16_t* hcat = (bf16_t*)(P.ws + WS_HCAT);
#pragma unroll
        for (int et = 0; et < 4; ++et) { const int e0 = eh * 64 + et * 16 + g * 4; const u32x2 so = so_[et]; const f32x4 mw = mw_[et];
            const float o0 = h2[et][0] * rstd * mw[0] * bflo(so.x), o1 = h2[et][1] * rstd * mw[1] * bfhi(so.x), o2 = h2[et][2] * rstd * mw[2] * bflo(so.y), o3 = h2[et][3] * rstd * mw[3] * bfhi(so.y);
            u32x2 pk; pk.x = cvt_pk_bf16(o0, o1); pk.y = cvt_pk_bf16(o2, o3); *(u32x2*)(hcat + (size_t)tok * 1024 + h * 128 + e0) = pk; } }
    __syncthreads();
}


__device__ __forceinline__ void tail_mma(unsigned char* lds, const bf16_t* A, const bf16_t* Bt, int K, int r0, int c0, int nchunk, int nseg0, int tid, f32x4 (&acc)[2][2]) {
    const int w = tid >> 6, lane = tid & 63, fr = lane & 15, g = lane >> 4, wr = w & 3, wc = w >> 2;
    const bf16_t* gp[4]; unsigned lo_[4];
#pragma unroll
    for (int j = 0; j < 4; ++j) { const int idx = tid + 512 * j, mat = idx >> 10, rem = idx & 1023, row = rem >> 4, seg = rem & 15;
        gp[j] = (mat ? Bt + (size_t)(c0 + row) * K : A + (size_t)(r0 + row) * K) + seg * 8; lo_[j] = (unsigned)(mat * 17408 + row * 272 + seg * 16); }
    u32x4 st[4], st2[4];
#pragma unroll
    for (int j = 0; j < 4; ++j) st[j] = *(const u32x4*)gp[j];
#pragma unroll
    for (int j = 0; j < 4; ++j) *(u32x4*)(lds + lo_[j]) = st[j];
    if (nchunk > 1) {
#pragma unroll
        for (int j = 0; j < 4; ++j) st[j] = *(const u32x4*)(gp[j] + 128); }
    __syncthreads();
    const unsigned aoff = (unsigned)((16 * wr + fr) * 272 + g * 16), boff = (unsigned)(17408 + (32 * wc + fr) * 272 + g * 16);
#pragma unroll 1
    for (int ch = 0; ch < nchunk; ++ch) {
        const unsigned cur = (unsigned)(ch & 1) * 34816u, nxt = 34816u - cur;
        if (ch + 2 < nchunk) {
#pragma unroll
            for (int j = 0; j < 4; ++j) st2[j] = *(const u32x4*)(gp[j] + (size_t)(ch + 2) * 128); }
        bf16x8 fa[4], f0[4], f1[4];
#pragma unroll
        for (int kk = 0; kk < 4; ++kk) { fa[kk] = *(const bf16x8*)(lds + cur + aoff + kk * 64); f0[kk] = *(const bf16x8*)(lds + cur + boff + kk * 64); f1[kk] = *(const bf16x8*)(lds + cur + boff + 16 * 272 + kk * 64); }
        if (ch < nseg0) {
#pragma unroll
            for (int kk = 0; kk < 4; ++kk) { acc[0][0] = mfma16(f0[kk], fa[kk], acc[0][0]); acc[0][1] = mfma16(f1[kk], fa[kk], acc[0][1]); } }
        else {
#pragma unroll
            for (int kk = 0; kk < 4; ++kk) { acc[1][0] = mfma16(f0[kk], fa[kk], acc[1][0]); acc[1][1] = mfma16(f1[kk], fa[kk], acc[1][1]); } }
        if (ch + 1 < nchunk) {
#pragma unroll
            for (int j = 0; j < 4; ++j) *(u32x4*)(lds + nxt + lo_[j]) = st[j]; }
        __syncthreads();
#pragma unroll
        for (int j = 0; j < 4; ++j) st[j] = st2[j];
    }
}
__device__ __forceinline__ void tail_mix(const Params& P, unsigned char* lds, int tb, int tid) {
    const int w = tid >> 6, lane = tid & 63, fr = lane & 15, g = lane >> 4, tok = MP + (tb >> 4) * 64 + 16 * (w & 3) + fr, col0 = (tb & 15) * 64 + 32 * (w >> 2);
    const bf16_t* hcat = (const bf16_t*)(P.ws + WS_HCAT); const bf16_t* wab = (const bf16_t*)(P.ws + WS_WAB); const bf16_t* gates = (const bf16_t*)(P.ws + WS_GATES); bf16_t* mix = (bf16_t*)(P.ws + WS_MIXIN);
    f32x4 ab[2][2]; ab[0][0] = ab[0][1] = ab[1][0] = ab[1][1] = (f32x4){0.f, 0.f, 0.f, 0.f};
    tail_mma(lds, hcat, wab, 1024, MP + (tb >> 4) * 64, (tb & 15) * 64, 8, 4, tid, ab);
    const f32x4 (&a)[2] = ab[0]; const f32x4 (&b)[2] = ab[1];
#pragma unroll
    for (int mt = 0; mt < 2; ++mt) { const int c = col0 + mt * 16 + g * 4; const u32x2 sa = *(const u32x2*)(gates + (size_t)tok * 2048 + c), sb = *(const u32x2*)(gates + (size_t)tok * 2048 + 1024 + c);
        const float v0 = bflo(sa.x) * a[mt][0] + bflo(sb.x) * b[mt][0], v1 = bfhi(sa.x) * a[mt][1] + bfhi(sb.x) * b[mt][1], v2 = bflo(sa.y) * a[mt][2] + bflo(sb.y) * b[mt][2], v3 = bfhi(sa.y) * a[mt][3] + bfhi(sb.y) * b[mt][3];
        u32x2 pk; pk.x = cvt_pk_bf16(v0, v1); pk.y = cvt_pk_bf16(v2, v3); *(u32x2*)(mix + (size_t)tok * 1024 + c) = pk; }
}
__device__ __forceinline__ void tail_out(const Params& P, unsigned char* lds, int tb, int tid) {
    const int w = tid >> 6, lane = tid & 63, fr = lane & 15, g = lane >> 4, tok = MP + (tb >> 4) * 64 + 16 * (w & 3) + fr, col0 = (tb & 15) * 64 + 32 * (w >> 2);
    f32x4 ab[2][2]; ab[0][0] = ab[0][1] = ab[1][0] = ab[1][1] = (f32x4){0.f, 0.f, 0.f, 0.f};
    tail_mma(lds, (const bf16_t*)(P.ws + WS_MIXIN), (const bf16_t*)(P.ws + WS_WOUT), 1024, MP + (tb >> 4) * 64, (tb & 15) * 64, 8, 8, tid, ab);
    const f32x4 (&acc)[2] = ab[0];
    const float* xrow = P.in[1] + (size_t)(tok - MP) * 1024; bf16_t* hfw = (bf16_t*)(P.ws + WS_HN); float ss = 0.f;
#pragma unroll
    for (int mt = 0; mt < 2; ++mt) { const int c = col0 + mt * 16 + g * 4; const f32x4 y = *(const f32x4*)(xrow + c) + acc[mt]; *(f32x4*)(P.out + (size_t)tok * 1024 + c) = y;
        ss += (y[0] * y[0] + y[1] * y[1]) + (y[2] * y[2] + y[3] * y[3]); const f32x4 z = y * *(const f32x4*)(P.in[18] + c);
        u32x2 pk; pk.x = cvt_pk_bf16(z[0], z[1]); pk.y = cvt_pk_bf16(z[2], z[3]); *(u32x2*)(hfw + (size_t)tok * 1024 + c) = pk; }
    ss += __shfl_xor(ss, 16); ss += __shfl_xor(ss, 32);
    if (g == 0) unsafeAtomicAdd((float*)(P.ws + WS_ROWSS) + tok, ss);
}
__device__ __forceinline__ void tail_down(const Params& P, unsigned char* lds, int tb, int tid) {
    const int w = tid >> 6, lane = tid & 63, fr = lane & 15, g = lane >> 4, tok = MP + (tb >> 4) * 64 + 16 * (w & 3) + fr, col0 = (tb & 15) * 64 + 32 * (w >> 2);
    f32x4 ab[2][2]; ab[0][0] = ab[0][1] = ab[1][0] = ab[1][1] = (f32x4){0.f, 0.f, 0.f, 0.f};
    tail_mma(lds, (const bf16_t*)(P.ws + WS_MIXIN), (const bf16_t*)(P.ws + WS_WD), DFF, MP + (tb >> 4) * 64, (tb & 15) * 64, 22, 22, tid, ab);
    const f32x4 (&acc)[2] = ab[0];
#pragma unroll
    for (int mt = 0; mt < 2; ++mt) { float* p = P.out + (size_t)tok * 1024 + col0 + mt * 16 + g * 4; *(f32x4*)p = *(const f32x4*)p + acc[mt]; }
}
#define GSYNC_F(grid) xcd_barrier(xbar)
__global__ void __launch_bounds__(512, 2) fwd_kernel(Params P) {
    extern __shared__ __attribute__((aligned(16))) unsigned char lds[];
    cg::grid_group grid = cg::this_grid();
    const int tid = threadIdx.x, G = gridDim.x;
    const int lo = P.ph_lo, hi = P.ph_hi;
    volatile LAS unsigned* xst = (volatile LAS unsigned*)((LAS unsigned char*)lds + 131072);
    if (tid < 4) xst[tid] = 0u;
    __syncthreads();
    XcdBarrier xbar = xcd_barrier_post((unsigned*)(P.ws + WS_BAR), xst);
#ifndef PHASE_MASK
#define PHASE_MASK 0x1ff
#endif
#define IN(k) (((PHASE_MASK >> (k)) & 1) && lo <= (k) && (k) < hi)
#define GSYNC() xcd_barrier(xbar)
#define SEAM(k) do { if (IN(k) && IN((k) + 1)) GSYNC(); } while (0)
#ifndef DUP_MASK
#define DUP_MASK 0
#endif
#ifndef EXTRA_SYNCS
#define EXTRA_SYNCS 0
#endif
#define REP(k) for (int rep_ = 0; rep_ <= ((DUP_MASK >> (k)) & 1); ++rep_) if (rep_ == 0 || (GSYNC_F(grid), true))
    bf16_t* HN = (bf16_t*)(P.ws + WS_HN); bf16_t* MIXIN = (bf16_t*)(P.ws + WS_MIXIN); bf16_t* GATES = (bf16_t*)(P.ws + WS_GATES); bf16_t* HCAT = (bf16_t*)(P.ws + WS_HCAT);
    PG8_LAS unsigned char* ldsa = (PG8_LAS unsigned char*)lds;
    if (IN(0)) REP(0) p0_prep(P, lds, tid, G);
    if (lo < 0) grid.sync();
    SEAM(0);
    for (int xs_ = 0; xs_ < EXTRA_SYNCS; ++xs_) GSYNC();
    if (IN(1)) REP(1) { pg8::Gemm g{HN, (const bf16_t*)(P.ws + WS_WIN), MT, NPROJ, 1024}; pg8::StaticOrder S; S.init(MT, NPROJ, G, (int)blockIdx.x);
        pg8::EpiProj E{MIXIN, GATES}; pg8::gemm_phase<pg8::EpiProj, pg8::StaticOrder, true, true>(ldsa, g, S, E);
        { const int nfull = (MT / 256) * (NPROJ / 256) / G, nlast = (MT / 256) * (NPROJ / 256) - nfull * G;
            if (nlast > 0 && nlast < G && (int)blockIdx.x >= nlast) for (int it = NT_IN + (int)blockIdx.x - nlast; it < NT_ALL; it += G - nlast) wtile_by_index(P, it, lds, tid);
            else if (nlast == 0 || nlast >= G) for (int it = NT_IN + (int)blockIdx.x; it < NT_ALL; it += G) wtile_by_index(P, it, lds, tid); } }
    SEAM(1);
    if (IN(2)) REP(2) {
        for (int it = blockIdx.x; it < 256 + 256 + 1024; it += G) {
            if (it < 256) attn_prompt_item(P, it, lds, tid);
            else if (it < 512) attn_sample_item(P, it - 256, lds, tid);
            else mlstm_b_item(P, it - 512, lds, tid);
        } }
    SEAM(2);
    if (IN(3)) REP(3) {
        const int nscan = (G > 64) ? 64 : 0;
#ifndef P3_VARIANT
#define P3_VARIANT 3
#endif
        if (nscan) { if ((int)blockIdx.x < 64) { if (P3_VARIANT & 1) mlstm_scan(P, lds, tid); } else if (P3_VARIANT & 2) { for (int it = blockIdx.x - 64; it < 512; it += G - 64) mlstm_sample_item(P, it, lds, tid); } }
        else { for (int it = blockIdx.x; it < 512; it += G) mlstm_sample_item(P, it, lds, tid); }
    }
    SEAM(3);
    if (IN(4)) REP(4) { for (int it = blockIdx.x; it < 1024; it += G) mlstm_d_item(P, it, lds, tid); }
    SEAM(4);
    if (IN(5)) REP(5) { pg8::Gemm g{HCAT, (const bf16_t*)(P.ws + WS_WAB), MP, 1024, 1024}; pg8::StaticOrder S; S.init(MP, 1024, G, (int)blockIdx.x);
        pg8::EpiMix E{GATES, MIXIN}; pg8::gemm_phase<pg8::EpiMix, pg8::StaticOrder, true, true>(ldsa, g, S, E);
        for (int tb = blockIdx.x; tb < 256; tb += G) tail_mix(P, lds, tb, tid); }
    SEAM(5);
    if (IN(6)) REP(6) { pg8::Gemm g{MIXIN, (const bf16_t*)(P.ws + WS_WOUT), MP, 1024, 1024}; pg8::StaticOrder S; S.init(MP, 1024, G, (int)blockIdx.x);
        pg8::EpiOut E{P.in[0], P.in[1], P.out, HN, P.in[18], (float*)(P.ws + WS_ROWSS)}; pg8::gemm_phase<pg8::EpiOut, pg8::StaticOrder, true, true>(ldsa, g, S, E);
        for (int tb = blockIdx.x; tb < 256; tb += G) tail_out(P, lds, tb, tid); }
    SEAM(6);
    if (IN(7)) REP(7) { pg8::Gemm g{HN, (const bf16_t*)(P.ws + WS_WGU), MT, 2 * DFF, 1024}; pg8::StaticOrder S; S.init(MT, 2 * DFF, G, (int)blockIdx.x);
        pg8::EpiGU E{MIXIN, (const float*)(P.ws + WS_ROWSS)}; pg8::gemm_phase<pg8::EpiGU, pg8::StaticOrder, true, true>(ldsa, g, S, E); }
    SEAM(7);
    if (IN(8)) REP(8) { pg8::Gemm g{MIXIN, (const bf16_t*)(P.ws + WS_WD), MP, 1024, DFF}; pg8::StaticOrder S; S.init(MP, 1024, G, (int)blockIdx.x);
        pg8::EpiDown E{P.out}; pg8::gemm_phase<pg8::EpiDown, pg8::StaticOrder, true, true>(ldsa, g, S, E);
        for (int tb = blockIdx.x; tb < 256; tb += G) tail_down(P, lds, tb, tid); }
#ifdef DBG_DUMP
    GSYNC();
    if (DBG_DUMP == 1) { for (size_t i = (size_t)blockIdx.x * 512 + tid; i < (size_t)MT * 1024; i += (size_t)G * 512) { const size_t r = i >> 10, c = i & 1023; P.out[i] = bf2f(MIXIN[r * NMIX + c]); } }
    if (DBG_DUMP == 2) { const bf16_t* d = (const bf16_t*)((unsigned char*)P.out + OB_DCT); for (size_t i = (size_t)blockIdx.x * 512 + tid; i < (size_t)1024 * 8192; i += (size_t)G * 512) P.out[i] = bf2f(d[i]); }
    if (DBG_DUMP == 4) { unsigned* d = (unsigned*)((unsigned char*)P.out + OB_DCT); for (size_t i = (size_t)blockIdx.x * 512 + tid; i < (size_t)1024 * 4096; i += (size_t)G * 512) { const unsigned w = __hip_atomic_load(d + i, __ATOMIC_RELAXED, __HIP_MEMORY_SCOPE_AGENT); P.out[2 * i] = bflo(w); P.out[2 * i + 1] = bfhi(w); } }
    if (DBG_DUMP == 5) { const float* a = (const float*)(P.ws + WS_GI); const float* bq = (const float*)(P.ws + WS_GB); for (int i = blockIdx.x * 512 + tid; i < MT * 4; i += G * 512) { P.out[i] = a[i]; P.out[MT * 4 + i] = bq[i]; } }
    if (DBG_DUMP == 6) { const float* a = (const float*)(P.ws + WS_DN); for (int i = blockIdx.x * 512 + tid; i < 65536; i += G * 512) P.out[i] = a[i]; }
    if (DBG_DUMP == 3) { for (size_t i = (size_t)blockIdx.x * 512 + tid; i < (size_t)MT * 1024; i += (size_t)G * 512) P.out[i] = bf2f(HN[i]); }
#endif
#undef IN
#undef SEAM
}

extern "C" void kernel_launch(void* const* d_in, const int* in_sizes, int n_in, void* d_out, int out_size, void* d_ws, size_t ws_size, hipStream_t stream) {
    static int grid = 0;
    if (grid == 0) {
        if (n_in != 22 || (size_t)out_size != O_END || ws_size < WS_END) { fprintf(stderr, "kernel_launch: unexpected shapes (n_in %d, out %d, ws %zu)\n", n_in, out_size, ws_size); grid = -1; return; }
        int dev = 0, cus = 0, per_cu = 0;
        (void)hipGetDevice(&dev); (void)hipDeviceGetAttribute(&cus, hipDeviceAttributeMultiprocessorCount, dev);
        if (hipFuncSetAttribute((const void*)fwd_kernel, hipFuncAttributeMaxDynamicSharedMemorySize, LDS_BYTES) != hipSuccess) { fprintf(stderr, "kernel_launch: hipFuncSetAttribute failed\n"); grid = -1; return; }
        if (hipOccupancyMaxActiveBlocksPerMultiprocessor(&per_cu, (const void*)fwd_kernel, 512, LDS_BYTES) != hipSuccess || per_cu < 1) { fprintf(stderr, "kernel_launch: occupancy query failed (%d)\n", per_cu); (void)hipGetLastError(); per_cu = 1; }
        grid = cus * 1;
        if (grid < 65) { fprintf(stderr, "kernel_launch: needs more than 64 CUs\n"); grid = -1; return; }
    }
    if (grid < 0) return;
    if (hipMemsetAsync((char*)d_ws + WS_BAR, 0, XCD_BAR_WORDS * 4, stream) != hipSuccess) { fprintf(stderr, "kernel_launch: memset failed\n"); return; }
    Params p{};
    for (int i = 0; i < 22; ++i) p.in[i] = (const float*)d_in[i];
    p.out = (float*)d_out; p.ws = (unsigned char*)d_ws;
    constexpr int NPH = 9;
    for (int li = 0; li < N_LAUNCHES; ++li) {
        p.ph_lo = (N_LAUNCHES == 1) ? 0 : li; p.ph_hi = (N_LAUNCHES == 1) ? NPH : li + 1;
        void* args[] = {&p};
        const hipError_t e = hipLaunchCooperativeKernel((const void*)fwd_kernel, dim3(grid), dim3(512), args, LDS_BYTES, stream);
        if (e != hipSuccess) { fprintf(stderr, "kernel_launch: cooperative launch %d failed: %s (grid %d)\n", li, hipGetErrorString(e), grid); break; }
    }
}
```

```cpp
#include <hip/hip_runtime.h>
#include <hip/hip_cooperative_groups.h>
#include <cstdio>
#include <cstdint>
namespace cg = cooperative_groups;

#ifndef N_LAUNCHES
#define N_LAUNCHES 1
#endif

namespace pg8 {
#define PG8_LAS __attribute__((address_space(3)))
typedef unsigned short bf16_t;
typedef short bf16x8 __attribute__((ext_vector_type(8)));
typedef float f32x4 __attribute__((ext_vector_type(4)));
typedef unsigned u32x4 __attribute__((ext_vector_type(4)));
constexpr int BM = 256, BK = 64, HALF = 128, HTB = HALF * BK * 2  , STAGE_BYTES = 8 * HTB, NXCD = 8, WGM = 8;

__host__ __device__ __forceinline__ int lds_byte(int r, int c) { const int st = (r >> 4) * 2 + (c >> 5), rr = r & 15, cc = c & 31, ob = rr * 64 + cc * 2; return st * 1024 + (ob ^ (((ob >> 9) & 1) << 5)); }
__host__ __device__ __forceinline__ void stage_rc(int b, int& R, int& C) { const int st = b / 1024, sb = b % 1024, swz = sb ^ (((sb >> 9) & 1) << 5); R = (st >> 1) * 16 + swz / 64; C = (st & 1) * 32 + (swz % 64) / 2; }
__host__ __device__ __forceinline__ int perm32(int rho) { const int n = rho >> 4, i = rho & 15; return 8 * (i >> 2) + 4 * n + (i & 3); }

struct Unit { int pm, pn; };
struct Gemm { const bf16_t* A; const bf16_t* Bt; int M, N, K; };

struct StaticOrder {
    int nM, nN, nwg, G, c;
    __host__ __device__ void init(int M, int N, int G_, int c_) { nM = M / BM; nN = N / BM; nwg = nM * nN; G = G_; c = c_; }
    __host__ __device__ bool next(int i, Unit& u) const {
        const long L = (long)i * G + c; if (L >= nwg) return false;
        int wgid = (int)L; { const int q = nwg / NXCD, r = nwg % NXCD, xcd = wgid % NXCD, off = wgid / NXCD; wgid = (xcd < r ? xcd * (q + 1) : r * (q + 1) + (xcd - r) * q) + off; }
        const int nig = WGM * nN, gid = wgid / nig, fm = gid * WGM, gsz = (nM - fm) < WGM ? (nM - fm) : WGM;
        u.pm = fm + ((wgid % nig) % gsz); u.pn = (wgid % nig) / gsz; return true;
    }
    __device__ __forceinline__ void a_ready(const Unit&) const {}
    __device__ __forceinline__ void done(const Unit&) const {}
};

__device__ __forceinline__ unsigned cvt_pk_bf16(float lo, float hi) { unsigned r; asm volatile("v_cvt_pk_bf16_f32 %0, %1, %2" : "=v"(r) : "v"(lo), "v"(hi)); return r; }
__device__ __forceinline__ float bflo(unsigned w) { return __builtin_bit_cast(float, w << 16); }
__device__ __forceinline__ float bfhi(unsigned w) { return __builtin_bit_cast(float, w & 0xffff0000u); }
__device__ __forceinline__ float sigm(float x) { return 1.0f / (1.0f + __expf(-x)); }

struct EpiProj {
    static constexpr bool PERM = true, AFTER_DRAIN = false, HAS_MID = false;
    bf16_t* mixin; bf16_t* gates;
    __device__ __forceinline__ void operator()(const f32x4 (&acc)[2][2][4][2], const Unit& u, int wr, int wc, int fr, int fq) const {
        const bool isg = u.pn >= 9; const bool sg = isg || u.pn == 4 || u.pn == 5;
        bf16_t* base = isg ? gates : mixin; const int ldc = isg ? 2048 : 2304;
        const int col0 = (isg ? (u.pn - 9) : u.pn) * 256 + wc * 32 + 8 * fq, row0 = u.pm * BM + wr * 64 + fr;
#pragma unroll
        for (int ai = 0; ai < 2; ++ai)
#pragma unroll
            for (int m = 0; m < 4; ++m) { bf16_t* rowp = base + (size_t)(row0 + ai * HALF + m * 16) * ldc + col0;
#pragma unroll
                for (int bj = 0; bj < 2; ++bj) { f32x4 v0 = acc[ai][bj][m][0], v1 = acc[ai][bj][m][1];
                    if (sg) {
#pragma unroll
                        for (int i = 0; i < 4; ++i) { v0[i] = sigm(v0[i]); v1[i] = sigm(v1[i]); } }
                    u32x4 w; w.x = cvt_pk_bf16(v0[0], v0[1]); w.y = cvt_pk_bf16(v0[2], v0[3]); w.z = cvt_pk_bf16(v1[0], v1[1]); w.w = cvt_pk_bf16(v1[2], v1[3]);
                    *(u32x4*)(rowp + bj * HALF) = w; } }
    }
};

struct EpiMix {
    static constexpr bool PERM = true, AFTER_DRAIN = false, HAS_MID = true;
    const bf16_t* gates; bf16_t* mix;
    __device__ __forceinline__ void mid(f32x4 (&acc)[2][2][4][2], const Unit& u, int wr, int wc, int fr, int fq) const {
        unsigned rb = (unsigned)(u.pm * BM + wr * 64 + fr) * 2048u + (unsigned)(u.pn * BM + wc * 32 + 8 * fq);
        asm volatile("" : "+v"(rb));
#pragma unroll
        for (int ai = 0; ai < 2; ++ai)
#pragma unroll
            for (int m = 0; m < 4; ++m) { const bf16_t* rowp = gates + (rb + (unsigned)((ai * HALF + m * 16) * 2048));
#pragma unroll
                for (int bj = 0; bj < 2; ++bj) { const u32x4 a = *(const u32x4*)(rowp + bj * HALF), b = *(const u32x4*)(rowp + 1024 + bj * HALF);
                    const float tiny = 8.673617379884035e-19f;
                    f32x4 r0, r1;
                    r0[0] = bflo(a.x) * __builtin_amdgcn_rcpf(fmaxf(bflo(b.x), tiny)); r0[1] = bfhi(a.x) * __builtin_amdgcn_rcpf(fmaxf(bfhi(b.x), tiny)); r0[2] = bflo(a.y) * __builtin_amdgcn_rcpf(fmaxf(bflo(b.y), tiny)); r0[3] = bfhi(a.y) * __builtin_amdgcn_rcpf(fmaxf(bfhi(b.y), tiny));
                    r1[0] = bflo(a.z) * __builtin_amdgcn_rcpf(fmaxf(bflo(b.z), tiny)); r1[1] = bfhi(a.z) * __builtin_amdgcn_rcpf(fmaxf(bfhi(b.z), tiny)); r1[2] = bflo(a.w) * __builtin_amdgcn_rcpf(fmaxf(bflo(b.w), tiny)); r1[3] = bfhi(a.w) * __builtin_amdgcn_rcpf(fmaxf(bfhi(b.w), tiny));
                    acc[ai][bj][m][0] = acc[ai][bj][m][0] * r0; acc[ai][bj][m][1] = acc[ai][bj][m][1] * r1; }
                if (m == 3) __builtin_amdgcn_sched_barrier(0); }
    }
    __device__ __forceinline__ void operator()(const f32x4 (&acc)[2][2][4][2], const Unit& u, int wr, int wc, int fr, int fq) const {
        const int col0 = u.pn * BM + wc * 32 + 8 * fq, row0 = u.pm * BM + wr * 64 + fr;
#pragma unroll
        for (int ai = 0; ai < 2; ++ai)
#pragma unroll
            for (int m = 0; m < 4; ++m) { const size_t row = (size_t)(row0 + ai * HALF + m * 16);
#pragma unroll
                for (int bj = 0; bj < 2; ++bj) { const u32x4 b = *(const u32x4*)(gates + row * 2048 + 1024 + col0 + bj * HALF);
                    const float tiny = 8.673617379884035e-19f;
                    f32x4 s0, s1;
                    s0[0] = fmaxf(bflo(b.x), tiny); s0[1] = fmaxf(bfhi(b.x), tiny); s0[2] = fmaxf(bflo(b.y), tiny); s0[3] = fmaxf(bfhi(b.y), tiny);
                    s1[0] = fmaxf(bflo(b.z), tiny); s1[1] = fmaxf(bfhi(b.z), tiny); s1[2] = fmaxf(bflo(b.w), tiny); s1[3] = fmaxf(bfhi(b.w), tiny);
                    const f32x4 v0 = acc[ai][bj][m][0] * s0, v1 = acc[ai][bj][m][1] * s1;
                    u32x4 w; w.x = cvt_pk_bf16(v0[0], v0[1]); w.y = cvt_pk_bf16(v0[2], v0[3]); w.z = cvt_pk_bf16(v1[0], v1[1]); w.w = cvt_pk_bf16(v1[2], v1[3]);
                    *(u32x4*)(mix + row * 1024 + col0 + bj * HALF) = w; } }
    }
};

struct EpiOut {
    static constexpr bool PERM = true, AFTER_DRAIN = false, HAS_MID = false;
    const float* xp; const float* xs; bf16_t* x1b; float* rowss;
    __device__ __forceinline__ void operator()(const f32x4 (&acc)[2][2][4][2], const Unit& u, int wr, int wc, int fr, int fq) const {
        const int col0 = u.pn * BM + wc * 32 + 8 * fq, row0 = u.pm * BM + wr * 64 + fr;
#pragma unroll
        for (int ai = 0; ai < 2; ++ai)
#pragma unroll
            for (int m = 0; m < 4; ++m) { const int row = row0 + ai * HALF + m * 16;
                const float* xrow = row < 16384 ? xp + (size_t)row * 1024 : xs + (size_t)(row - 16384) * 1024;
                float ss = 0.f;
#pragma unroll
                for (int bj = 0; bj < 2; ++bj) { const int c = col0 + bj * HALF;
                    const f32x4 y0 = *(const f32x4*)(xrow + c) + acc[ai][bj][m][0], y1 = *(const f32x4*)(xrow + c + 4) + acc[ai][bj][m][1];
                    ss += (y0[0] * y0[0] + y0[1] * y0[1]) + (y0[2] * y0[2] + y0[3] * y0[3]) + (y1[0] * y1[0] + y1[1] * y1[1]) + (y1[2] * y1[2] + y1[3] * y1[3]);
                    u32x4 w; w.x = cvt_pk_bf16(y0[0], y0[1]); w.y = cvt_pk_bf16(y0[2], y0[3]); w.z = cvt_pk_bf16(y1[0], y1[1]); w.w = cvt_pk_bf16(y1[2], y1[3]);
                    *(u32x4*)(x1b + (size_t)row * 1024 + c) = w; }
                ss += __shfl_xor(ss, 16); ss += __shfl_xor(ss, 32);
                if (fq == 0) unsafeAtomicAdd(rowss + row, ss); }
    }
};

struct EpiGU {
    static constexpr bool PERM = true, AFTER_DRAIN = false, HAS_MID = false;
    bf16_t* act; const float* rowss;
    __device__ __forceinline__ void operator()(const f32x4 (&acc)[2][2][4][2], const Unit& u, int wr, int wc, int fr, int fq) const {
        const int col0 = u.pn * HALF + wc * 32 + 8 * fq, row0 = u.pm * BM + wr * 64 + fr;
#pragma unroll
        for (int ai = 0; ai < 2; ++ai)
#pragma unroll
            for (int m = 0; m < 4; ++m) { const int row = row0 + ai * HALF + m * 16;
                const float rstd = __builtin_amdgcn_rsqf(rowss[row] * (1.0f / 1024.0f) + 1e-6f);
                float o[8];
#pragma unroll
                for (int n = 0; n < 2; ++n)
#pragma unroll
                    for (int j = 0; j < 4; ++j) { const float g = acc[ai][0][m][n][j] * rstd, up = acc[ai][1][m][n][j] * rstd; o[n * 4 + j] = g * sigm(g) * up; }
                u32x4 w; w.x = cvt_pk_bf16(o[0], o[1]); w.y = cvt_pk_bf16(o[2], o[3]); w.z = cvt_pk_bf16(o[4], o[5]); w.w = cvt_pk_bf16(o[6], o[7]);
                *(u32x4*)(act + (size_t)row * 2816 + col0) = w; }
    }
};

struct EpiDown {
    static constexpr bool PERM = true, AFTER_DRAIN = false, HAS_MID = false;
    const bf16_t* x1b; float* out;
    __device__ __forceinline__ void operator()(const f32x4 (&acc)[2][2][4][2], const Unit& u, int wr, int wc, int fr, int fq) const {
        const int col0 = u.pn * BM + wc * 32 + 8 * fq, row0 = u.pm * BM + wr * 64 + fr;
#pragma unroll
        for (int ai = 0; ai < 2; ++ai)
#pragma unroll
            for (int m = 0; m < 4; ++m) { const size_t ro = (size_t)(row0 + ai * HALF + m * 16) * 1024 + col0;
#pragma unroll
                for (int bj = 0; bj < 2; ++bj) { const u32x4 r = *(const u32x4*)(x1b + ro + bj * HALF);
                    const f32x4 y0 = (f32x4){bflo(r.x), bfhi(r.x), bflo(r.y), bfhi(r.y)} + acc[ai][bj][m][0], y1 = (f32x4){bflo(r.z), bfhi(r.z), bflo(r.w), bfhi(r.w)} + acc[ai][bj][m][1];
                    *(f32x4*)(out + ro + bj * HALF) = y0; *(f32x4*)(out + ro + bj * HALF + 4) = y1; } }
    }
};

template <class Epi, class Sched, bool ALIGN_EPI = false, bool SP2 = false>
__device__ __forceinline__ void gemm_phase(PG8_LAS unsigned char* lds, const Gemm g, const Sched& S, const Epi& E) {
    const int tid = threadIdx.x, wid = __builtin_amdgcn_readfirstlane(tid >> 6), lane = tid & 63, wr = wid >> 2, wc = wid & 3, fr = lane & 15, fq = lane >> 4;
    const int K = g.K, nt = K / BK;
    unsigned voffA[2], voffB[2];
#pragma unroll
    for (int i = 0; i < 2; ++i) { int R, C; stage_rc(tid * 16 + i * 8192, R, C); const int Rb = Epi::PERM ? ((R & ~31) + perm32(R & 31)) : R;
        voffA[i] = (unsigned)(R * K + C) * 2u; voffB[i] = (unsigned)(Rb * K + C) * 2u; }
    const size_t kstep = (size_t)(BK * 2);
    const size_t hstep = (size_t)HALF * K * 2;
    const size_t tstep = 2 * hstep;
    const unsigned ldsw = (unsigned)wid * 1024u;
    const int aoff = lds_byte(wr * 64 + fr, fq * 8), boff = lds_byte(wc * 32 + fr, fq * 8);
#define PG8_SA(b, h) (((b) * 2 + (h)) * HTB)
#define PG8_SB(b, h) ((4 + (b) * 2 + (h)) * HTB)
#define PG8_STAGE(bufoff, gbase, voff) do { _Pragma("unroll") for (int _i = 0; _i < 2; ++_i) \
        __builtin_amdgcn_global_load_lds((const unsigned*)((const char*)(gbase) + (voff)[_i]), (PG8_LAS unsigned*)(lds + (bufoff) + ldsw + _i * 8192), 16, 0, 0); } while (0)
#define PG8_LDA(dst, b, h) do { _Pragma("unroll") for (int m = 0; m < 4; ++m) _Pragma("unroll") for (int k = 0; k < 2; ++k) dst[m][k] = *(const PG8_LAS bf16x8*)(lds + PG8_SA(b, h) + aoff + m * 2048 + k * 1024); } while (0)
#define PG8_LDB(dst, b, h) do { _Pragma("unroll") for (int n = 0; n < 2; ++n) _Pragma("unroll") for (int k = 0; k < 2; ++k) dst[n][k] = *(const PG8_LAS bf16x8*)(lds + PG8_SB(b, h) + boff + n * 2048 + k * 1024); } while (0)
#define PG8_MMA(ai, bj, At, Bt) do { __builtin_amdgcn_s_setprio(1); _Pragma("unroll") for (int m = 0; m < 4; ++m) _Pragma("unroll") for (int n = 0; n < 2; ++n) _Pragma("unroll") for (int k = 0; k < 2; ++k) \
        acc[ai][bj][m][n] = __builtin_amdgcn_mfma_f32_16x16x32_bf16(Bt[n][k], At[m][k], acc[ai][bj][m][n], 0, 0, 0); __builtin_amdgcn_s_setprio(0); } while (0)
#define PG8_WAIT_V(n) asm volatile("s_waitcnt vmcnt(" #n ")" ::: "memory")
#define PG8_WAIT_L(n) asm volatile("s_waitcnt lgkmcnt(" #n ")" ::: "memory")
#define PG8_BAR __builtin_amdgcn_s_barrier()
#define PG8_SCHED __builtin_amdgcn_sched_barrier(0)
    Unit cur, nxt; int ui = 0;
    if (!S.next(0, cur)) return;
    f32x4 acc[2][2][4][2];
#pragma unroll
    for (int a = 0; a < 2; ++a)
#pragma unroll
        for (int b = 0; b < 2; ++b)
#pragma unroll
            for (int m = 0; m < 4; ++m)
#pragma unroll
                for (int n = 0; n < 2; ++n) acc[a][b][m][n] = (f32x4){0.f, 0.f, 0.f, 0.f};
    bf16x8 At[4][2], B0[2][2], B1[2][2];
    const char* cA = (const char*)g.A + (size_t)cur.pm * tstep; const char* cB = (const char*)g.Bt + (size_t)cur.pn * tstep;
    S.a_ready(cur);
    if constexpr (SP2) {
        PG8_STAGE(PG8_SB(0, 0), cB, voffB); PG8_STAGE(PG8_SB(0, 1), cB + hstep, voffB); PG8_STAGE(PG8_SA(0, 0), cA, voffA); PG8_STAGE(PG8_SA(0, 1), cA + hstep, voffA);
        if (wr == 1) PG8_BAR;
        PG8_WAIT_V(2); PG8_BAR;
        PG8_STAGE(PG8_SB(1, 0), cB + kstep, voffB); PG8_STAGE(PG8_SA(1, 0), cA + kstep, voffA); PG8_STAGE(PG8_SB(1, 1), cB + hstep + kstep, voffB);
        PG8_WAIT_V(6); PG8_BAR;
    } else {
        PG8_STAGE(PG8_SB(0, 0), cB, voffB); PG8_STAGE(PG8_SA(0, 0), cA, voffA); PG8_STAGE(PG8_SB(0, 1), cB + hstep, voffB); PG8_STAGE(PG8_SA(0, 1), cA + hstep, voffA);
        if (wr == 1) PG8_BAR;
        PG8_WAIT_V(4); PG8_BAR;
        PG8_STAGE(PG8_SB(1, 0), cB + kstep, voffB); PG8_STAGE(PG8_SA(1, 0), cA + kstep, voffA); PG8_STAGE(PG8_SB(1, 1), cB + hstep + kstep, voffB);
        PG8_WAIT_V(6); PG8_BAR;
    }
    for (;;) {
        const bool has_next = S.next(ui + 1, nxt);
        const char* nA = has_next ? (const char*)g.A + (size_t)nxt.pm * tstep : cA; const char* nB = has_next ? (const char*)g.Bt + (size_t)nxt.pn * tstep : cB;
        for (int t = 0; t < nt; t += 2) {
            if constexpr (Epi::HAS_MID) { if (t == (nt >> 1)) E.mid(acc, cur, wr, wc, fr, fq); }
            const bool last = (t == nt - 2);
            const char* a1 = cA + (size_t)(t + 1) * kstep;
            const char* a2 = last ? nA : cA + (size_t)(t + 2) * kstep; const char* b2 = last ? nB : cB + (size_t)(t + 2) * kstep;
            const char* a3 = a2 + kstep; const char* b3 = b2 + kstep;
            if (last && has_next) S.a_ready(nxt);
            if constexpr (SP2) {
            PG8_LDB(B0, 0, 0); PG8_LDB(B1, 0, 1); PG8_SCHED; PG8_LDA(At, 0, 0); PG8_STAGE(PG8_SA(1, 1), a1 + hstep, voffA);
            PG8_WAIT_V(8); PG8_WAIT_L(0); PG8_BAR; PG8_MMA(0, 0, At, B0); PG8_MMA(0, 1, At, B1); PG8_BAR; PG8_SCHED;
            PG8_LDA(At, 0, 1); PG8_STAGE(PG8_SB(0, 0), b2, voffB); PG8_STAGE(PG8_SB(0, 1), b2 + hstep, voffB); PG8_STAGE(PG8_SA(0, 0), a2, voffA);
            PG8_WAIT_V(8); PG8_WAIT_L(0); PG8_BAR; PG8_MMA(1, 0, At, B0); PG8_MMA(1, 1, At, B1); PG8_BAR; PG8_SCHED;
            PG8_LDB(B0, 1, 0); PG8_LDB(B1, 1, 1); PG8_SCHED; PG8_LDA(At, 1, 0); PG8_STAGE(PG8_SA(0, 1), a2 + hstep, voffA);
            PG8_WAIT_V(8); PG8_WAIT_L(0); PG8_BAR; PG8_MMA(0, 0, At, B0); PG8_MMA(0, 1, At, B1); PG8_BAR; PG8_SCHED;
            PG8_LDA(At, 1, 1); PG8_STAGE(PG8_SB(1, 0), b3, voffB); PG8_STAGE(PG8_SB(1, 1), b3 + hstep, voffB); PG8_STAGE(PG8_SA(1, 0), a3, voffA);
            PG8_WAIT_V(8); PG8_WAIT_L(0); PG8_BAR; PG8_MMA(1, 0, At, B0); PG8_MMA(1, 1, At, B1); PG8_BAR; PG8_SCHED;
            } else {
            PG8_LDB(B0, 0, 0); PG8_SCHED; PG8_LDA(At, 0, 0); PG8_STAGE(PG8_SA(1, 1), a1 + hstep, voffA);
            PG8_WAIT_L(8); PG8_BAR; PG8_WAIT_L(0); PG8_MMA(0, 0, At, B0); PG8_BAR; PG8_SCHED;
            PG8_LDB(B1, 0, 1); PG8_STAGE(PG8_SB(0, 0), b2, voffB);
            PG8_BAR; PG8_WAIT_L(0); PG8_MMA(0, 1, At, B1); PG8_BAR;
            PG8_LDA(At, 0, 1); PG8_STAGE(PG8_SA(0, 0), a2, voffA);
            PG8_BAR; PG8_WAIT_L(0); PG8_MMA(1, 0, At, B0); PG8_BAR; PG8_SCHED;
            PG8_STAGE(PG8_SB(0, 1), b2 + hstep, voffB);
            PG8_WAIT_V(6); PG8_BAR; PG8_MMA(1, 1, At, B1); PG8_BAR;
            PG8_LDB(B0, 1, 0); PG8_SCHED; PG8_LDA(At, 1, 0); PG8_STAGE(PG8_SA(0, 1), a2 + hstep, voffA);
            PG8_WAIT_L(8); PG8_BAR; PG8_WAIT_L(0); PG8_MMA(0, 0, At, B0); PG8_BAR; PG8_SCHED;
            PG8_LDB(B1, 1, 1); PG8_STAGE(PG8_SB(1, 0), b3, voffB);
            PG8_BAR; PG8_WAIT_L(0); PG8_MMA(0, 1, At, B1); PG8_BAR;
            PG8_LDA(At, 1, 1); PG8_STAGE(PG8_SA(1, 0), a3, voffA);
            PG8_BAR; PG8_WAIT_L(0); PG8_MMA(1, 0, At, B0); PG8_BAR; PG8_SCHED;
            PG8_STAGE(PG8_SB(1, 1), b3 + hstep, voffB);
            PG8_WAIT_V(6); PG8_BAR; PG8_MMA(1, 1, At, B1); PG8_BAR;
            }
        }
        if constexpr (ALIGN_EPI) { if (wr == 0) PG8_BAR; }
        if constexpr (!Epi::AFTER_DRAIN) { E(acc, cur, wr, wc, fr, fq); S.done(cur); }
        if (!has_next) break;
#pragma unroll
        for (int a = 0; a < 2; ++a)
#pragma unroll
            for (int b = 0; b < 2; ++b)
#pragma unroll
                for (int m = 0; m < 4; ++m)
#pragma unroll
                    for (int n = 0; n < 2; ++n) acc[a][b][m][n] = (f32x4){0.f, 0.f, 0.f, 0.f};
        cur = nxt; cA = nA; cB = nB; ++ui;
        if constexpr (ALIGN_EPI) { if (wr == 1) PG8_BAR; }
    }
    PG8_WAIT_V(0);
    if constexpr (!ALIGN_EPI) { if (wr == 0) PG8_BAR; }
    PG8_BAR;
    if constexpr (Epi::AFTER_DRAIN) { E.fused(acc, cur, wr, wc, fr, fq, lds, wid, lane); S.done(cur); }
#undef PG8_SA
#undef PG8_SB
#undef PG8_STAGE
#undef PG8_LDA
#undef PG8_LDB
#undef PG8_MMA
#undef PG8_WAIT_V
#undef PG8_WAIT_L
#undef PG8_BAR
#undef PG8_SCHED
}
}
using pg8::bf16_t; using pg8::bf16x8; using pg8::f32x4; using pg8::u32x4; using pg8::cvt_pk_bf16; using pg8::bflo; using pg8::bfhi; using pg8::sigm;
typedef unsigned u32x2 __attribute__((ext_vector_type(2)));
constexpr int MP = 16384, MS = 1024, MT = MP + MS;
constexpr int DIN = 4360, NPROJ = 4352, NMIX = 2304, NGATE = 2048, DFF = 2816;
constexpr float EPS = 1e-6f, LOG2E = 1.4426950408889634f;
constexpr size_t MiB = 1u << 20;
constexpr size_t WS_ROWSS = 0;
constexpr size_t WS_SUMA = 128 * 1024, WS_SUMM = WS_SUMA + 4096, WS_MCH = WS_SUMM + 4096;
constexpr size_t WS_GI = 256 * 1024, WS_GB = WS_GI + 320 * 1024;
constexpr size_t WS_DN = 1 * MiB, WS_NPREV = WS_DN + 256 * 1024;
constexpr size_t WS_WIN = 2 * MiB;
constexpr size_t WS_WAB = WS_WIN + 17 * MiB / 2;
constexpr size_t WS_WOUT = WS_WAB + 2 * MiB;
constexpr size_t WS_WGU = WS_WOUT + 2 * MiB;
constexpr size_t WS_WD = WS_WGU + 11 * MiB;
constexpr size_t WS_HN = WS_WD + 11 * MiB / 2;
constexpr size_t OB_DCT = 34 * MiB, OB_CPT = 50 * MiB;
constexpr size_t WS_MIXIN = WS_HN + 34 * MiB;
constexpr size_t WS_GATES = WS_MIXIN + 153 * MiB / 2;
constexpr size_t WS_HCAT = WS_GATES + 68 * MiB;
constexpr size_t WS_END = WS_HCAT + 34 * MiB;
static_assert(WS_END <= 256 * MiB, "workspace map");
constexpr size_t O_Y = 0, O_CP = (size_t)MT * 1024, O_NP = O_CP + 65536, O_MP = O_NP + 512, O_KWP = O_MP + 8, O_VWP = O_KWP + 32768,
                 O_CS = O_VWP + 32768, O_NS = O_CS + 4194304, O_MS = O_NS + 32768, O_KWS = O_MS + 512, O_VWS = O_KWS + 2097152, O_END = O_VWS + 2097152;
constexpr size_t WS_BAR = 1536 * 1024;
constexpr int LDS_BYTES = 131072 + 256;

struct Params { const float* in[22]; float* out; unsigned char* ws; int ph_lo, ph_hi; };

__device__ __forceinline__ float bf2f(bf16_t h) { return __builtin_bit_cast(float, (unsigned)h << 16); }
__device__ __forceinline__ bf16_t f2bf(float f) { return (bf16_t)(cvt_pk_bf16(f, 0.f) & 0xffffu); }
__device__ __forceinline__ float wave_sum(float v) {
#pragma unroll
    for (int o = 1; o < 64; o <<= 1) v += __shfl_xor(v, o);
    return v; }
__device__ __forceinline__ float wave_max(float v) {
#pragma unroll
    for (int o = 1; o < 64; o <<= 1) v = fmaxf(v, __shfl_xor(v, o));
    return v; }
__device__ __forceinline__ f32x4 mfma16(bf16x8 a, bf16x8 b, f32x4 c) { f32x4 d = __builtin_amdgcn_mfma_f32_16x16x32_bf16(a, b, c, 0, 0, 0); asm volatile("" : "+v"(d) : "v"(a), "v"(b)); return d; }
__device__ __forceinline__ bf16x8 pack8(const f32x4& a, const f32x4& b) { u32x4 t; t.x = cvt_pk_bf16(a[0], a[1]); t.y = cvt_pk_bf16(a[2], a[3]); t.z = cvt_pk_bf16(b[0], b[1]); t.w = cvt_pk_bf16(b[2], b[3]); return __builtin_bit_cast(bf16x8, t); }
__device__ __forceinline__ void unpack8(const u32x4& r, float* f) { f[0] = bflo(r.x); f[1] = bfhi(r.x); f[2] = bflo(r.y); f[3] = bfhi(r.y); f[4] = bflo(r.z); f[5] = bfhi(r.z); f[6] = bflo(r.w); f[7] = bfhi(r.w); }

__device__ __forceinline__ void p0_tokens(const Params& P, unsigned char* lds, int tid, int G) {
    const float* wg = (const float*)lds; const float* nw = P.in[7];
    bf16_t* HN = (bf16_t*)(P.ws + WS_HN); float* gi = (float*)(P.ws + WS_GI); float* gb = (float*)(P.ws + WS_GB);
    const int lane = tid & 63, w = tid >> 6;
    f32x4 xn[4];
    { const int r = blockIdx.x * 8 + w; const float* xrow = r < MP ? P.in[0] + (size_t)r * 1024 : P.in[1] + (size_t)(r - MP) * 1024;
#pragma unroll
        for (int j = 0; j < 4; ++j) xn[j] = ((const f32x4*)xrow)[lane + 64 * j]; }
#pragma unroll 1
    for (int r = blockIdx.x * 8 + w; r < MT; r += G * 8) {
        f32x4 xv[4]; float ss = 0.f;
#pragma unroll
        for (int j = 0; j < 4; ++j) xv[j] = xn[j];
        { const int rn = (r + G * 8 < MT) ? r + G * 8 : r; const float* xrow = rn < MP ? P.in[0] + (size_t)rn * 1024 : P.in[1] + (size_t)(rn - MP) * 1024;
#pragma unroll
            for (int j = 0; j < 4; ++j) xn[j] = ((const f32x4*)xrow)[lane + 64 * j]; }
#pragma unroll
        for (int j = 0; j < 4; ++j) ss += (xv[j][0] * xv[j][0] + xv[j][1] * xv[j][1]) + (xv[j][2] * xv[j][2] + xv[j][3] * xv[j][3]);
        ss = wave_sum(ss);
        const float rstd = 1.0f / sqrtf(ss * (1.0f / 1024.0f) + EPS);
        float g[8];
#pragma unroll
        for (int q = 0; q < 8; ++q) g[q] = 0.f;
#pragma unroll
        for (int j = 0; j < 4; ++j) { const int k0 = 4 * (lane + 64 * j);
            const f32x4 nv = *(const f32x4*)(nw + k0); const f32x4 hv = xv[j] * rstd * nv;
            u32x2 pk; pk.x = cvt_pk_bf16(hv[0], hv[1]); pk.y = cvt_pk_bf16(hv[2], hv[3]);
            *(u32x2*)(HN + (size_t)r * 1024 + k0) = pk;
#pragma unroll
            for (int q = 0; q < 8; ++q) { const f32x4 wv = *(const f32x4*)(wg + q * 1024 + k0); g[q] += (xv[j][0] * wv[0] + xv[j][1] * wv[1]) + (xv[j][2] * wv[2] + xv[j][3] * wv[3]); } }
#pragma unroll
        for (int q = 0; q < 8; ++q) g[q] = wave_sum(g[q]);
        if (lane < 4) { const float iv = (lane == 0 ? g[0] : lane == 1 ? g[1] : lane == 2 ? g[2] : g[3]) * rstd + P.in[9][lane];
            const float fv = (lane == 0 ? g[4] : lane == 1 ? g[5] : lane == 2 ? g[6] : g[7]) * rstd + P.in[10][lane];
            gi[r * 4 + lane] = iv; gb[r * 4 + lane] = fminf(fv, 0.f) - log1pf(expf(-fabsf(fv))); }
    }
}
template <bool GU>
__device__ __forceinline__ void p0_wunit(const float* src, int ldsrc, int k0, int c0, bf16_t* dst, int lddst, int n0, int k0d, unsigned char* lds, int tid, const float* kscale = nullptr) {
    float* tile = (float*)(lds + 40960);
    f32x4 v[8];
#pragma unroll
    for (int p = 0; p < 8; ++p) v[p] = *(const f32x4*)(src + (size_t)(k0 + (tid >> 6) + 8 * p) * ldsrc + c0 + (tid & 63) * 4);
    if (kscale) {
#pragma unroll
        for (int p = 0; p < 8; ++p) v[p] = v[p] * kscale[k0 + (tid >> 6) + 8 * p]; }
#pragma unroll
    for (int p = 0; p < 8; ++p) *(f32x4*)(tile + ((tid >> 6) + 8 * p) * 260 + (tid & 63) * 4) = v[p];
    __syncthreads();
    { const int n = tid >> 1, kc = (tid & 1) * 32; const float* s = tile + kc * 260 + n;
        const int nd = GU ? (256 * ((c0 + n) >> 7) + ((c0 + n) & 127) + n0) : (n0 + n);
        bf16_t* dp = dst + (size_t)nd * lddst + k0d + kc;
#pragma unroll
        for (int q = 0; q < 4; ++q) { u32x4 o; o.x = cvt_pk_bf16(s[(8 * q) * 260], s[(8 * q + 1) * 260]); o.y = cvt_pk_bf16(s[(8 * q + 2) * 260], s[(8 * q + 3) * 260]);
            o.z = cvt_pk_bf16(s[(8 * q + 4) * 260], s[(8 * q + 5) * 260]); o.w = cvt_pk_bf16(s[(8 * q + 6) * 260], s[(8 * q + 7) * 260]); *(u32x4*)(dp + 8 * q) = o; } }
    __syncthreads();
}
constexpr int NT_IN = 17 * 16, NT_AB = 64, NT_OUT = 64, NT_GU = 352, NT_D = 176, NT_ALL = NT_IN + NT_AB + NT_OUT + NT_GU + NT_D;
__device__ __forceinline__ void wtile_by_index(const Params& P, int r, unsigned char* lds, int tid) {
    if (r < NT_IN) { const int nt = r >> 4, kt = r & 15, c0 = nt * 256; p0_wunit<false>(P.in[8], DIN, kt * 64, c0 < 1536 ? c0 : c0 + 8, (bf16_t*)(P.ws + WS_WIN), 1024, c0, kt * 64, lds, tid); return; } r -= NT_IN;
    if (r < NT_AB) { const int which = r >> 5, rr = r & 31, nt = rr >> 3, kt = rr & 7; p0_wunit<false>(which ? P.in[16] : P.in[15], 1024, kt * 64, nt * 256, (bf16_t*)(P.ws + WS_WAB), 1024, nt * 256, which * 512 + kt * 64, lds, tid); return; } r -= NT_AB;
    if (r < NT_OUT) { const int nt = r >> 4, kt = r & 15; p0_wunit<false>(P.in[17], 1024, kt * 64, nt * 256, (bf16_t*)(P.ws + WS_WOUT), 1024, nt * 256, kt * 64, lds, tid); return; } r -= NT_OUT;
    if (r < NT_GU) { const int which = r / 176, rr = r % 176, jt = rr >> 4, kt = rr & 15; p0_wunit<true>(which ? P.in[20] : P.in[19], DFF, kt * 64, jt * 256, (bf16_t*)(P.ws + WS_WGU), 1024, which * 128, kt * 64, lds, tid, P.in[18]); return; } r -= NT_GU;
    { const int nt = r / 44, kt = r % 44; p0_wunit<false>(P.in[21], 1024, kt * 64, nt * 256, (bf16_t*)(P.ws + WS_WD), DFF, nt * 256, kt * 64, lds, tid); }
}
__device__ __forceinline__ void p0_prep(const Params& P, unsigned char* lds, int tid, int G) {
    float* rowss = (float*)(P.ws + WS_ROWSS);
    for (int i = blockIdx.x * 512 + tid; i < MT; i += G * 512) rowss[i] = 0.f;
    { float* wg = (float*)lds; const float* w_in = P.in[8]; const float* nw = P.in[7];
        for (int idx = tid; idx < 8192; idx += 512) { const int k = idx >> 3, q = idx & 7; wg[q * 1024 + k] = w_in[(size_t)k * DIN + 1536 + q] * nw[k]; } }
    __syncthreads();
    p0_tokens(P, lds, tid, G);
    __syncthreads();
    for (int it = blockIdx.x; it < NT_IN; it += G) wtile_by_index(P, it, lds, tid);
}

template <int NQT>
__device__ __forceinline__ void attn_core(const unsigned char* lds, const bf16x8 (&qf)[NQT][2], int kt_lo, int kt_hi, int qbase, int jmin, float sink2, f32x4 (&o)[4][NQT], float (&l)[NQT]) {
    const bf16_t* Ks = (const bf16_t*)lds; const bf16_t* Vt = (const bf16_t*)(lds + 36864);
    const int lane = threadIdx.x & 63, fr = lane & 15, g = lane >> 4;
    float mrun[NQT];
#pragma unroll
    for (int qt = 0; qt < NQT; ++qt) { mrun[qt] = sink2; l[qt] = (g == 0) ? 1.f : 0.f;
#pragma unroll
        for (int dt = 0; dt < 4; ++dt) o[dt][qt] = (f32x4){0.f, 0.f, 0.f, 0.f}; }
#pragma unroll 1
    for (int kt = kt_lo; kt <= kt_hi; ++kt) {
        f32x4 s[4][NQT];
#pragma unroll
        for (int ks = 0; ks < 4; ++ks)
#pragma unroll
            for (int qt = 0; qt < NQT; ++qt) s[ks][qt] = (f32x4){0.f, 0.f, 0.f, 0.f};
        { bf16x8 kfr[4][2];
#pragma unroll
        for (int ks = 0; ks < 4; ++ks)
#pragma unroll
            for (int kk = 0; kk < 2; ++kk) kfr[ks][kk] = *(const bf16x8*)(Ks + (kt * 64 + ks * 16 + fr) * 72 + g * 8 + kk * 32);
#pragma unroll
        for (int ks = 0; ks < 4; ++ks)
#pragma unroll
            for (int kk = 0; kk < 2; ++kk)
#pragma unroll
                for (int qt = 0; qt < NQT; ++qt) s[ks][qt] = mfma16(kfr[ks][kk], qf[qt][kk], s[ks][qt]); }
#pragma unroll
        for (int qt = 0; qt < NQT; ++qt) { const int qi = qbase + 16 * qt + fr; float mx = -1e30f;
#pragma unroll
            for (int ks = 0; ks < 4; ++ks)
#pragma unroll
                for (int r = 0; r < 4; ++r) { const int j = kt * 64 + ks * 16 + g * 4 + r; const bool ok = (j > qi) && (j <= qi + 128) && (j >= jmin);
                    const float v = ok ? s[ks][qt][r] : -1e30f; s[ks][qt][r] = v; mx = fmaxf(mx, v); }
            mx = fmaxf(mx, __shfl_xor(mx, 16)); mx = fmaxf(mx, __shfl_xor(mx, 32));
            const float mnew = fmaxf(mrun[qt], mx), alpha = __builtin_amdgcn_exp2f(mrun[qt] - mnew); mrun[qt] = mnew;
            float ps = 0.f;
#pragma unroll
            for (int ks = 0; ks < 4; ++ks)
#pragma unroll
                for (int r = 0; r < 4; ++r) { const float p = __builtin_amdgcn_exp2f(s[ks][qt][r] - mnew); s[ks][qt][r] = p; ps += p; }
            l[qt] = l[qt] * alpha + ps;
#pragma unroll
            for (int dt = 0; dt < 4; ++dt) o[dt][qt] = o[dt][qt] * alpha; }
        { bf16x8 vfr[2][4], pf[2][NQT];
#pragma unroll
        for (int c = 0; c < 2; ++c) {
#pragma unroll
            for (int dt = 0; dt < 4; ++dt) { const bf16_t* vp = Vt + (dt * 16 + fr) * 264 + kt * 64 + c * 32 + g * 4;
                const u32x2 v0 = *(const u32x2*)vp, v1 = *(const u32x2*)(vp + 16);
                vfr[c][dt] = __builtin_bit_cast(bf16x8, (u32x4){v0.x, v0.y, v1.x, v1.y}); }
#pragma unroll
            for (int qt = 0; qt < NQT; ++qt) pf[c][qt] = pack8(s[2 * c][qt], s[2 * c + 1][qt]); }
#pragma unroll
        for (int c = 0; c < 2; ++c)
#pragma unroll
            for (int dt = 0; dt < 4; ++dt)
#pragma unroll
                for (int qt = 0; qt < NQT; ++qt) o[dt][qt] = mfma16(vfr[c][dt], pf[c][qt], o[dt][qt]); }
    }
}
__device__ __forceinline__ void attn_put(unsigned char* lds, int slot, int hh, const float* kf, const float* vf) {
    bf16_t* Ks = (bf16_t*)lds; bf16_t* Vt = (bf16_t*)(lds + 36864);
#pragma unroll
    for (int i = 0; i < 4; ++i) { u32x4 w; w.x = cvt_pk_bf16(kf[8 * i], kf[8 * i + 1]); w.y = cvt_pk_bf16(kf[8 * i + 2], kf[8 * i + 3]); w.z = cvt_pk_bf16(kf[8 * i + 4], kf[8 * i + 5]); w.w = cvt_pk_bf16(kf[8 * i + 6], kf[8 * i + 7]);
        *(u32x4*)(Ks + slot * 72 + hh * 32 + 8 * i) = w; }
#pragma unroll
    for (int i = 0; i < 32; ++i) Vt[(hh * 32 + i) * 264 + slot] = f2bf(vf[i]);
}
__device__ __forceinline__ void attn_prompt_item(const Params& P, int item, unsigned char* lds, int tid) {
    const int kvh = item & 1, n = (item >> 1) & 63, b = item >> 7;
    const bf16_t* mixin = (const bf16_t*)(P.ws + WS_MIXIN);
    { const int slot = tid >> 1, hh = tid & 1, tokb = n * 128 - 128 + slot;
        float kf[32], vf[32];
        if (tokb >= 0) { const bf16_t* rowp = mixin + (size_t)(b * 8192 + tokb) * NMIX + 2048 + kvh * 64 + hh * 32;
#pragma unroll
            for (int i = 0; i < 4; ++i) { const u32x4 kr = *(const u32x4*)(rowp + 8 * i), vr = *(const u32x4*)(rowp + 128 + 8 * i); unpack8(kr, kf + 8 * i); unpack8(vr, vf + 8 * i); } }
        else {
#pragma unroll
            for (int i = 0; i < 32; ++i) { kf[i] = 0.f; vf[i] = 0.f; } }
        float ss = 0.f;
#pragma unroll
        for (int i = 0; i < 32; ++i) ss += kf[i] * kf[i];
        ss += __shfl_xor(ss, 1);
        const float rstd = 1.0f / sqrtf(ss * (1.0f / 64.0f) + EPS);
#pragma unroll
        for (int i = 0; i < 32; ++i) kf[i] = kf[i] * rstd * P.in[13][hh * 32 + i];
        attn_put(lds, slot, hh, kf, vf);
        if (n == 63 && slot >= 128) { float* kw = P.out + O_KWP + ((size_t)(b * 128 + slot - 128) * 2 + kvh) * 64 + hh * 32; float* vw = P.out + O_VWP + ((size_t)(b * 128 + slot - 128) * 2 + kvh) * 64 + hh * 32;
#pragma unroll
            for (int i = 0; i < 8; ++i) { *(f32x4*)(kw + 4 * i) = (f32x4){kf[4 * i], kf[4 * i + 1], kf[4 * i + 2], kf[4 * i + 3]}; *(f32x4*)(vw + 4 * i) = (f32x4){vf[4 * i], vf[4 * i + 1], vf[4 * i + 2], vf[4 * i + 3]}; } }
    }
    __syncthreads();
    const int w = tid >> 6, lane = tid & 63, fr = lane & 15, g = lane >> 4, gq = w >> 1, half = w & 1, head = kvh * 4 + gq;
    bf16_t* hcat = (bf16_t*)(P.ws + WS_HCAT);
#pragma unroll 1
    for (int qh = 0; qh < 2; ++qh) {
    bf16x8 qf[2][2];
#pragma unroll
    for (int qt = 0; qt < 2; ++qt) { const int tok = b * 8192 + n * 128 + half * 64 + qh * 32 + qt * 16 + fr; const bf16_t* qp = mixin + (size_t)tok * NMIX + 1536 + head * 64 + g * 8;
        float f0[8], f1[8]; unpack8(*(const u32x4*)qp, f0); unpack8(*(const u32x4*)(qp + 32), f1);
        float ss = 0.f;
#pragma unroll
        for (int i = 0; i < 8; ++i) ss += f0[i] * f0[i] + f1[i] * f1[i];
        ss += __shfl_xor(ss, 16); ss += __shfl_xor(ss, 32);
        const float sc = (0.125f * LOG2E) / sqrtf(ss * (1.0f / 64.0f) + EPS);
#pragma unroll
        for (int i = 0; i < 8; ++i) { f0[i] = f0[i] * sc * P.in[12][g * 8 + i]; f1[i] = f1[i] * sc * P.in[12][32 + g * 8 + i]; }
        qf[qt][0] = pack8((f32x4){f0[0], f0[1], f0[2], f0[3]}, (f32x4){f0[4], f0[5], f0[6], f0[7]}); qf[qt][1] = pack8((f32x4){f1[0], f1[1], f1[2], f1[3]}, (f32x4){f1[4], f1[5], f1[6], f1[7]}); }
    f32x4 o[4][2]; float l[2];
    attn_core<2>(lds, qf, half, half + 2, half * 64 + qh * 32, n == 0 ? 128 : 0, P.in[14][head] * LOG2E, o, l);
#pragma unroll
    for (int qt = 0; qt < 2; ++qt) { float lt = l[qt]; lt += __shfl_xor(lt, 16); lt += __shfl_xor(lt, 32); const float inv = 1.0f / lt;
        const int tok = b * 8192 + n * 128 + half * 64 + qh * 32 + qt * 16 + fr;
#pragma unroll
        for (int dt = 0; dt < 4; ++dt) { const f32x4 v = o[dt][qt] * inv; u32x2 pk; pk.x = cvt_pk_bf16(v[0], v[1]); pk.y = cvt_pk_bf16(v[2], v[3]);
            *(u32x2*)(hcat + (size_t)tok * 1024 + 512 + head * 64 + dt * 16 + g * 4) = pk; } }
    }
    __syncthreads();
}
__device__ __forceinline__ void attn_sample_item(const Params& P, int item, unsigned char* lds, int tid) {
    const int kvh = item & 1, b = item >> 1;
    const bf16_t* mixin = (const bf16_t*)(P.ws + WS_MIXIN);
    { const int slot = tid >> 1, hh = tid & 1;
        if (slot < 192) { float kf[32], vf[32];
            if (slot < 128) { const size_t off = ((size_t)(b * 128 + slot) * 2 + kvh) * 64 + hh * 32; const float* kp = P.in[5] + off; const float* vp = P.in[6] + off;
#pragma unroll
                for (int i = 0; i < 8; ++i) { const f32x4 a = *(const f32x4*)(kp + 4 * i), c = *(const f32x4*)(vp + 4 * i);
                    kf[4 * i] = a[0]; kf[4 * i + 1] = a[1]; kf[4 * i + 2] = a[2]; kf[4 * i + 3] = a[3]; vf[4 * i] = c[0]; vf[4 * i + 1] = c[1]; vf[4 * i + 2] = c[2]; vf[4 * i + 3] = c[3]; } }
            else if (slot < 136) { const bf16_t* rowp = mixin + (size_t)(MP + b * 8 + slot - 128) * NMIX + 2048 + kvh * 64 + hh * 32;
#pragma unroll
                for (int i = 0; i < 4; ++i) { const u32x4 kr = *(const u32x4*)(rowp + 8 * i), vr = *(const u32x4*)(rowp + 128 + 8 * i); unpack8(kr, kf + 8 * i); unpack8(vr, vf + 8 * i); }
                float ss = 0.f;
#pragma unroll
                for (int i = 0; i < 32; ++i) ss += kf[i] * kf[i];
                ss += __shfl_xor(ss, 1);
                const float rstd = 1.0f / sqrtf(ss * (1.0f / 64.0f) + EPS);
#pragma unroll
                for (int i = 0; i < 32; ++i) kf[i] = kf[i] * rstd * P.in[13][hh * 32 + i]; }
            else {
#pragma unroll
                for (int i = 0; i < 32; ++i) { kf[i] = 0.f; vf[i] = 0.f; } }
            attn_put(lds, slot, hh, kf, vf);
            if (slot >= 8 && slot < 136) { const size_t off = ((size_t)(b * 128 + slot - 8) * 2 + kvh) * 64 + hh * 32; float* kw = P.out + O_KWS + off; float* vw = P.out + O_VWS + off;
#pragma unroll
                for (int i = 0; i < 8; ++i) { *(f32x4*)(kw + 4 * i) = (f32x4){kf[4 * i], kf[4 * i + 1], kf[4 * i + 2], kf[4 * i + 3]}; *(f32x4*)(vw + 4 * i) = (f32x4){vf[4 * i], vf[4 * i + 1], vf[4 * i + 2], vf[4 * i + 3]}; } }
        }
    }
    __syncthreads();
    const int w = tid >> 6, lane = tid & 63, fr = lane & 15, g = lane >> 4;
    if (w < 4) { const int head = kvh * 4 + w; const int tok = MP + b * 8 + (fr & 7);
        bf16x8 qf[1][2];
        { const bf16_t* qp = mixin + (size_t)tok * NMIX + 1536 + head * 64 + g * 8;
            float f0[8], f1[8]; unpack8(*(const u32x4*)qp, f0); unpack8(*(const u32x4*)(qp + 32), f1);
            float ss = 0.f;
#pragma unroll
            for (int i = 0; i < 8; ++i) ss += f0[i] * f0[i] + f1[i] * f1[i];
            ss += __shfl_xor(ss, 16); ss += __shfl_xor(ss, 32);
            const float sc = (0.125f * LOG2E) / sqrtf(ss * (1.0f / 64.0f) + EPS);
#pragma unroll
            for (int i = 0; i < 8; ++i) { f0[i] = f0[i] * sc * P.in[12][g * 8 + i]; f1[i] = f1[i] * sc * P.in[12][32 + g * 8 + i]; }
            qf[0][0] = pack8((f32x4){f0[0], f0[1], f0[2], f0[3]}, (f32x4){f0[4], f0[5], f0[6], f0[7]}); qf[0][1] = pack8((f32x4){f1[0], f1[1], f1[2], f1[3]}, (f32x4){f1[4], f1[5], f1[6], f1[7]}); }
        f32x4 o[4][1]; float l[1];
        attn_core<1>(lds, qf, 0, 2, 0, 0, P.in[14][head] * LOG2E, o, l);
        float lt = l[0]; lt += __shfl_xor(lt, 16); lt += __shfl_xor(lt, 32); const float inv = 1.0f / lt;
        bf16_t* hcat = (bf16_t*)(P.ws + WS_HCAT);
        if (fr < 8) {
#pragma unroll
            for (int dt = 0; dt < 4; ++dt) { const f32x4 v = o[dt][0] * inv; u32x2 pk; pk.x = cvt_pk_bf16(v[0], v[1]); pk.y = cvt_pk_bf16(v[2], v[3]);
                *(u32x2*)(hcat + (size_t)tok * 1024 + 512 + head * 64 + dt * 16 + g * 4) = pk; } }
    }
    __syncthreads();
}
#define LAS __attribute__((address_space(3)))
#define XB_TMO      128
#define XB_XCNT(j)  (256  + 64 * (j))
#define XB_XSUB(j)  (1280 + 64 * (j))
#define XB_XGEN(j)  (2304 + 64 * (j))
#define XB_TOP      3328
#define XB_TOPGEN   3392
#define XCD_BAR_WORDS 3456
#define XB_SPIN_CAP (1u << 18)

__device__ __forceinline__ unsigned xb_ld(unsigned* p)              { return __hip_atomic_load(p, __ATOMIC_RELAXED, __HIP_MEMORY_SCOPE_AGENT); }
__device__ __forceinline__ unsigned xb_add(unsigned* p, unsigned v) { return __hip_atomic_fetch_add(p, v, __ATOMIC_RELAXED, __HIP_MEMORY_SCOPE_AGENT); }
__device__ __forceinline__ unsigned xb_xcc_id() { return (unsigned)__builtin_amdgcn_s_getreg((3 << 11) | 20) & 0xFu; }
#define XB_SPIN(cond, bar) do { unsigned _sp = 0; while (cond) { __builtin_amdgcn_s_sleep(1); \
    if ((++_sp & 255u) == 0u) { if (xb_ld(&(bar)[XB_TMO])) break; if (_sp > XB_SPIN_CAP) { atomicAdd(&(bar)[XB_TMO], 1u); break; } } } } while (0)

struct XcdBarrier {
    unsigned* bar; unsigned x;
    volatile LAS unsigned* st;
};

__device__ __forceinline__ XcdBarrier xcd_barrier_post(unsigned* bar, volatile LAS unsigned* st) {
    XcdBarrier b; b.bar = bar; b.x = xb_xcc_id(); b.st = st;
    if (threadIdx.x == 0) (void)xb_add(&bar[XB_XCNT(b.x)], 1u);
    return b;
}
__device__ __forceinline__ void xcd_barrier_complete(unsigned* bar, unsigned x, unsigned& nloc, unsigned& nx) {
    const unsigned G = gridDim.x * gridDim.y * gridDim.z;
    unsigned sum, cnt, mine, sp = 0u;
    for (;;) {
        sum = 0u; cnt = 0u; mine = 0u;
#pragma unroll
        for (unsigned j = 0; j < 16; ++j) { const unsigned c = xb_ld(&bar[XB_XCNT(j)]); sum += c; cnt += (c > 0u) ? 1u : 0u; mine = (j == x) ? c : mine; }
        if (sum == G) break;
        __builtin_amdgcn_s_sleep(1);
        if ((++sp & 255u) == 0u) { if (xb_ld(&bar[XB_TMO])) break; if (sp > XB_SPIN_CAP) { atomicAdd(&bar[XB_TMO], 1u); break; } }
    }
    nloc = mine > 0u ? mine : 1u; nx = cnt > 0u ? cnt : 1u;
}

__device__ __forceinline__ void xcd_barrier(const XcdBarrier& b) {
    asm volatile("s_waitcnt vmcnt(0)" ::: "memory");
    __syncthreads();
    if (threadIdx.x == 0) {
        unsigned* bar = b.bar;
        __builtin_amdgcn_s_waitcnt(0);
        unsigned nloc = b.st[0], nx = b.st[1];
        if (nloc == 0u) { xcd_barrier_complete(bar, b.x, nloc, nx); b.st[0] = nloc; b.st[1] = nx; }
        const unsigned old = xb_add(&bar[XB_XSUB(b.x)], 1u);
        const unsigned gen = old / nloc;
        if (old + 1u == (gen + 1u) * nloc) {
            __builtin_amdgcn_fence(__ATOMIC_RELEASE, "agent");
            asm volatile("s_waitcnt vmcnt(0)" ::: "memory");
            const unsigned og = xb_add(&bar[XB_TOP], 1u);
            const unsigned tg = og / nx;
            if (og + 1u == (tg + 1u) * nx) xb_add(&bar[XB_TOPGEN], 1u);
            else XB_SPIN(xb_ld(&bar[XB_TOPGEN]) == tg, bar);
            __builtin_amdgcn_fence(__ATOMIC_ACQUIRE, "agent");
            xb_add(&bar[XB_XGEN(b.x)], 1u);
            asm volatile("s_waitcnt vmcnt(0)" ::: "memory");
        } else {
            XB_SPIN(xb_ld(&bar[XB_XGEN(b.x)]) == gen, bar);
            __builtin_amdgcn_fence(__ATOMIC_ACQUIRE, "agent");
            asm volatile("s_waitcnt vmcnt(0)" ::: "memory");
        }
    }
    __syncthreads();
}
__device__ __forceinline__ void mlstm_b_item(const Params& P, int item, unsigned char* lds, int tid) {
    const int c = item & 127, h = (item >> 7) & 3, b = item >> 9, r0 = b * 8192 + c * 64;
    float* wl = (float*)lds; bf16_t* Kt = (bf16_t*)(lds + 256); bf16_t* Vt = (bf16_t*)(lds + 256 + 9216);
    const bf16_t* mixin = (const bf16_t*)(P.ws + WS_MIXIN);
    if (tid < 64) { const float iv = ((const float*)(P.ws + WS_GI))[(r0 + tid) * 4 + h]; float bb = ((const float*)(P.ws + WS_GB))[(r0 + tid) * 4 + h];
#pragma unroll
        for (int o = 1; o < 64; o <<= 1) { const float nb = __shfl_up(bb, o); if (tid >= o) bb += nb; }
        const float A = __shfl(bb, 63), v = A - bb + iv, M = wave_max(v); wl[tid] = __expf(v - M) * 0.125f;
        if (tid == 0) { ((float*)(P.ws + WS_SUMA))[item] = A; ((float*)(P.ws + WS_SUMM))[item] = M; } }
    __syncthreads();
    { const int s = tid >> 3, ch = tid & 7; const bf16_t* rowp = mixin + (size_t)(r0 + s) * NMIX; const float ws_ = wl[s];
        float kf[8]; unpack8(*(const u32x4*)(rowp + 256 + h * 64 + ch * 8), kf);
#pragma unroll
        for (int i = 0; i < 8; ++i) Kt[(ch * 8 + i) * 72 + s] = f2bf(kf[i] * ws_);
        const u32x4 v0 = *(const u32x4*)(rowp + 512 + h * 128 + ch * 16), v1 = *(const u32x4*)(rowp + 512 + h * 128 + ch * 16 + 8);
        const unsigned vv[8] = {v0.x, v0.y, v0.z, v0.w, v1.x, v1.y, v1.z, v1.w};
#pragma unroll
        for (int i = 0; i < 8; ++i) { Vt[(ch * 16 + 2 * i) * 72 + s] = (bf16_t)(vv[i] & 0xffffu); Vt[(ch * 16 + 2 * i + 1) * 72 + s] = (bf16_t)(vv[i] >> 16); } }
    __syncthreads();
    { const int w = tid >> 6, lane = tid & 63, fr = lane & 15, g = lane >> 4, e0 = 16 * w;
        f32x4 acc[4];
#pragma unroll
        for (int dt = 0; dt < 4; ++dt) acc[dt] = (f32x4){0.f, 0.f, 0.f, 0.f};
        bf16x8 vfr[2], kfr[2][4];
#pragma unroll
        for (int kk = 0; kk < 2; ++kk) { vfr[kk] = *(const bf16x8*)(Vt + (e0 + fr) * 72 + g * 8 + kk * 32);
#pragma unroll
            for (int dt = 0; dt < 4; ++dt) kfr[kk][dt] = *(const bf16x8*)(Kt + (dt * 16 + fr) * 72 + g * 8 + kk * 32); }
#pragma unroll
        for (int kk = 0; kk < 2; ++kk)
#pragma unroll
            for (int dt = 0; dt < 4; ++dt) acc[dt] = mfma16(kfr[kk][dt], vfr[kk], acc[dt]);
        bf16_t* dct = (bf16_t*)((unsigned char*)P.out + OB_DCT) + ((size_t)item * 128 + e0 + fr) * 64;
#pragma unroll
        for (int dt = 0; dt < 4; ++dt) { u32x2 pk; pk.x = cvt_pk_bf16(acc[dt][0], acc[dt][1]); pk.y = cvt_pk_bf16(acc[dt][2], acc[dt][3]); *(u32x2*)(dct + dt * 16 + g * 4) = pk; } }
    if (tid < 64) { float sum = 0.f;
#pragma unroll 8
        for (int s = 0; s < 64; ++s) sum += bf2f(Kt[tid * 72 + s]);
        ((float*)(P.ws + WS_DN))[item * 64 + tid] = sum; }
    __syncthreads();
}
__device__ __forceinline__ void mlstm_scan(const Params& P, unsigned char* lds, int tid) {
    const int pair = blockIdx.x >> 3, sub = blockIdx.x & 7;
    float* ga = (float*)lds; float* ea = ga + 128; float* marr = ea + 128;
    if (tid < 128) { ga[tid] = ((const float*)(P.ws + WS_SUMA))[pair * 128 + tid]; ea[tid] = ((const float*)(P.ws + WS_SUMM))[pair * 128 + tid]; }
    __syncthreads();
    if (tid == 0) { float m = 0.f; const float* sA = ga; const float* sM = ea;
        for (int c = 0; c < 128; ++c) { const float A = sA[c], Mv = sM[c], mn = fmaxf(A + m, Mv); ga[c] = __expf(A + m - mn); ea[c] = __expf(Mv - mn); m = mn; marr[c] = mn; } }
    __syncthreads();
    if (sub == 0) { if (tid < 128) ((float*)(P.ws + WS_MCH))[pair * 128 + tid] = marr[tid]; if (tid == 0) P.out[O_MP + pair] = marr[127]; }
#ifndef P3_SCANMASK
#define P3_SCANMASK 3
#endif
    if (P3_SCANMASK & 1) { const int idx2 = sub * 512 + tid; float C0 = 0.f, C1 = 0.f;
        const unsigned* src = (const unsigned*)((unsigned char*)P.out + OB_DCT) + (size_t)pair * 128 * 4096 + idx2; unsigned* dst = (unsigned*)((unsigned char*)P.out + OB_CPT) + (size_t)pair * 128 * 4096 + idx2;
#pragma unroll 1
        for (int c = 0; c < 128; c += 32) { unsigned v[32];
#pragma unroll
            for (int j = 0; j < 32; ++j) v[j] = src[(size_t)(c + j) * 4096];
#pragma unroll
            for (int j = 0; j < 32; ++j) { dst[(size_t)(c + j) * 4096] = cvt_pk_bf16(C0, C1); const float gg = ga[c + j], ee = ea[c + j]; C0 = gg * C0 + ee * bflo(v[j]); C1 = gg * C1 + ee * bfhi(v[j]); } }
        const int i0 = 2 * idx2, e = i0 >> 6, d = i0 & 63;
        P.out[O_CP + ((size_t)pair * 64 + d) * 128 + e] = C0; P.out[O_CP + ((size_t)pair * 64 + d + 1) * 128 + e] = C1; }
    if ((P3_SCANMASK & 2) && sub == 0 && tid < 64) { float nn = 0.f; const float* dn = (const float*)(P.ws + WS_DN) + (size_t)pair * 128 * 64 + tid; float* np = (float*)(P.ws + WS_NPREV) + (size_t)pair * 128 * 64 + tid;
        for (int c = 0; c < 128; ++c) { np[c * 64] = nn; nn = ga[c] * nn + ea[c] * dn[c * 64]; }
        P.out[O_NP + pair * 64 + tid] = nn; }
    __syncthreads();
}
__device__ __forceinline__ void mlstm_sample_item(const Params& P, int item, unsigned char* lds, int tid) {
    const int h = item & 3, b = item >> 2, r0 = MP + b * 8;
    float* q = (float*)lds; float* k = q + 512; float* v = k + 512; float* sw = v + 1024; float* sc = sw + 64; float* n0s = sc + 64; float* part = n0s + 64; float* red = part + 4096;
    const bf16_t* mixin = (const bf16_t*)(P.ws + WS_MIXIN);
    if (tid < 256) {
        const int sel = tid >> 6, i = tid & 63;
        if (sel < 2) { const int t = i >> 3, p = i & 7; float f[8]; unpack8(*(const u32x4*)(mixin + (size_t)(r0 + t) * NMIX + sel * 256 + h * 64 + p * 8), f);
            float* dst = (sel ? k : q) + t * 64 + p * 8; const float sc_ = sel ? 0.125f : 1.0f;
#pragma unroll
            for (int j = 0; j < 8; ++j) dst[j] = f[j] * sc_; }
        else { const int i2 = tid - 128, t = i2 >> 4, p = i2 & 15; float f[8]; unpack8(*(const u32x4*)(mixin + (size_t)(r0 + t) * NMIX + 512 + h * 128 + p * 8), f);
#pragma unroll
            for (int j = 0; j < 8; ++j) v[t * 128 + p * 8 + j] = f[j]; } }
    if (tid < 64) n0s[tid] = P.in[3][(b * 4 + h) * 64 + tid];
    if (tid < 8) { float lf[8];
#pragma unroll
        for (int s = 0; s < 8; ++s) lf[s] = ((const float*)(P.ws + WS_GB))[(r0 + s) * 4 + h];
        float bb = 0.f;
#pragma unroll
        for (int s = 0; s < 8; ++s) bb += (s <= tid) ? lf[s] : 0.f;
        sc[tid] = bb; sc[8 + tid] = ((const float*)(P.ws + WS_GI))[(r0 + tid) * 4 + h] - bb; }
    __syncthreads();
    const float mprev = P.in[4][b * 4 + h];
    if (tid < 8) { float cm = mprev; for (int s = 0; s <= tid; ++s) cm = fmaxf(cm, sc[8 + s]); const float mt = sc[tid] + cm; sc[16 + tid] = mt; sc[24 + tid] = __expf(sc[tid] + mprev - mt); }
    __syncthreads();
    if (tid < 8) { const float b7 = sc[7], m7 = sc[23]; sc[32 + tid] = __expf(b7 + sc[8 + tid] - m7); if (tid == 0) { sc[48] = __expf(b7 + mprev - m7); P.out[O_MS + b * 4 + h] = m7; } }
    if (tid >= 64 && tid < 128) { const int i = tid - 64, t = i >> 3, s = i & 7; float dot = 0.f;
        for (int d = 0; d < 64; ++d) dot += q[t * 64 + d] * k[s * 64 + d];
        sw[i] = (s <= t) ? dot * __expf(sc[t] + sc[8 + s] - sc[16 + t]) : 0.f; }
    if (tid >= 128 && tid < 136) { const int t = tid - 128; float qn = 0.f; for (int d = 0; d < 64; ++d) qn += q[t * 64 + d] * n0s[d]; sc[40 + t] = qn; }
    __syncthreads();
    { const int e = tid & 127, dq = tid >> 7; const float gd = sc[48]; float num[8];
#pragma unroll
        for (int t = 0; t < 8; ++t) num[t] = 0.f;
        float c0v[16];
#pragma unroll
        for (int dd = 0; dd < 16; ++dd) c0v[dd] = P.in[2][((size_t)(b * 4 + h) * 64 + dq * 16 + dd) * 128 + e];
#pragma unroll
        for (int dd = 0; dd < 16; ++dd) { const int d = dq * 16 + dd; const size_t ic = ((size_t)(b * 4 + h) * 64 + d) * 128 + e; const float c0 = c0v[dd];
            float upd = 0.f;
#pragma unroll
            for (int s = 0; s < 8; ++s) upd += sc[32 + s] * k[s * 64 + d] * v[s * 128 + e];
            P.out[O_CS + ic] = gd * c0 + upd;
#pragma unroll
            for (int t = 0; t < 8; ++t) num[t] += q[t * 64 + d] * c0; }
#pragma unroll
        for (int t = 0; t < 8; ++t) part[(dq * 8 + t) * 128 + e] = num[t]; }
    if (tid < 64) { float nn = sc[48] * n0s[tid];
#pragma unroll
        for (int s = 0; s < 8; ++s) nn += sc[32 + s] * k[s * 64 + tid];
        P.out[O_NS + (b * 4 + h) * 64 + tid] = nn; }
    __syncthreads();
    { const int e = tid & 127, tq = tid >> 7, w = tid >> 6, lane = tid & 63; float hv[2];
#pragma unroll
        for (int u = 0; u < 2; ++u) { const int t = tq * 2 + u; float inter = 0.f, intra = 0.f, rs = 0.f;
#pragma unroll
            for (int dq = 0; dq < 4; ++dq) inter += part[(dq * 8 + t) * 128 + e];
#pragma unroll
            for (int s = 0; s < 8; ++s) { intra += sw[t * 8 + s] * v[s * 128 + e]; rs += sw[t * 8 + s]; }
            const float wi = sc[24 + t], den = wi * sc[40 + t] + rs; hv[u] = (wi * inter + intra) / fmaxf(fabsf(den), __expf(-sc[16 + t])); }
        const float s0 = wave_sum(hv[0] * hv[0]), s1 = wave_sum(hv[1] * hv[1]);
        if (lane == 0) { red[w * 2] = s0; red[w * 2 + 1] = s1; }
        __syncthreads();
        bf16_t* hcat = (bf16_t*)(P.ws + WS_HCAT);
#pragma unroll
        for (int u = 0; u < 2; ++u) { const int t = tq * 2 + u; const float tot = red[(w & ~1) * 2 + u] + red[(w | 1) * 2 + u]; const float rstd = 1.0f / sqrtf(tot * (1.0f / 128.0f) + EPS);
            const float so = bf2f(mixin[(size_t)(r0 + t) * NMIX + 1024 + h * 128 + e]);
            hcat[(size_t)(r0 + t) * 1024 + h * 128 + e] = f2bf(hv[u] * rstd * P.in[11][h * 128 + e] * so); } }
    __syncthreads();
}
__device__ __forceinline__ void mlstm_d_item(const Params& P, int item, unsigned char* lds, int tid) {
    const int c = item & 127, h = (item >> 7) & 3, b = item >> 9, r0 = b * 8192 + c * 64, pair = item >> 7;
    float* lb = (float*)lds; float* lu = lb + 64; float* lm = lb + 128; float* misc = lb + 192; float* npv = lb + 256; float* red = lb + 320;
    bf16_t* Kn = (bf16_t*)(lds + 2048); bf16_t* Vt = (bf16_t*)(lds + 11264); bf16_t* Cs = (bf16_t*)(lds + 29696);
    const bf16_t* mixin = (const bf16_t*)(P.ws + WS_MIXIN);
    if (tid < 64) { const float iv = ((const float*)(P.ws + WS_GI))[(r0 + tid) * 4 + h]; float bb = ((const float*)(P.ws + WS_GB))[(r0 + tid) * 4 + h];
#pragma unroll
        for (int o = 1; o < 64; o <<= 1) { const float nb = __shfl_up(bb, o); if (tid >= o) bb += nb; }
        const float mprev = c ? ((const float*)(P.ws + WS_MCH))[pair * 128 + c - 1] : 0.f;
        const float u = iv - bb; float cm = u;
#pragma unroll
        for (int o = 1; o < 64; o <<= 1) { const float nb = __shfl_up(cm, o); if (tid >= o) cm = fmaxf(cm, nb); }
        lb[tid] = bb; lu[tid] = u; lm[tid] = bb + fmaxf(mprev, cm); if (tid == 0) misc[0] = mprev;
        npv[tid] = ((const float*)(P.ws + WS_NPREV))[(size_t)item * 64 + tid]; }
    { const int s = tid >> 3, ch = tid & 7; const bf16_t* rowp = mixin + (size_t)(r0 + s) * NMIX;
        *(u32x4*)(Kn + s * 72 + ch * 8) = *(const u32x4*)(rowp + 256 + h * 64 + ch * 8);
        const u32x4 v0 = *(const u32x4*)(rowp + 512 + h * 128 + ch * 16), v1 = *(const u32x4*)(rowp + 512 + h * 128 + ch * 16 + 8);
        const unsigned vv[8] = {v0.x, v0.y, v0.z, v0.w, v1.x, v1.y, v1.z, v1.w};
#pragma unroll
        for (int i = 0; i < 8; ++i) { Vt[(ch * 16 + 2 * i) * 72 + s] = (bf16_t)(vv[i] & 0xffffu); Vt[(ch * 16 + 2 * i + 1) * 72 + s] = (bf16_t)(vv[i] >> 16); }
        const bf16_t* cp = (const bf16_t*)((unsigned char*)P.out + OB_CPT) + (size_t)item * 8192;
#pragma unroll
        for (int j = 0; j < 2; ++j) { const int idx = tid + 512 * j, e = idx >> 3, dch = idx & 7; *(u32x4*)(Cs + e * 72 + dch * 8) = *(const u32x4*)(cp + e * 64 + dch * 8); } }
    const int w = tid >> 6, lane = tid & 63, fr = lane & 15, g = lane >> 4, tt = w & 3, eh = w >> 2, t = tt * 16 + fr, tok = r0 + t;
    bf16x8 qf[2]; float qv0[8], qv1[8]; u32x2 so_[4]; f32x4 mw_[4];
    { const bf16_t* qp = mixin + (size_t)tok * NMIX + h * 64 + g * 8; const u32x4 a = *(const u32x4*)qp, bq = *(const u32x4*)(qp + 32);
        qf[0] = __builtin_bit_cast(bf16x8, a); qf[1] = __builtin_bit_cast(bf16x8, bq); unpack8(a, qv0); unpack8(bq, qv1);
#pragma unroll
        for (int et = 0; et < 4; ++et) { const int e0 = eh * 64 + et * 16 + g * 4; so_[et] = *(const u32x2*)(mixin + (size_t)tok * NMIX + 1024 + h * 128 + e0); mw_[et] = *(const f32x4*)(P.in[11] + h * 128 + e0); } }
    __syncthreads();
    f32x4 s[4];
    { bf16x8 kfr[4][2];
#pragma unroll
    for (int st = 0; st < 4; ++st)
#pragma unroll
        for (int kk = 0; kk < 2; ++kk) kfr[st][kk] = *(const bf16x8*)(Kn + (st * 16 + fr) * 72 + g * 8 + kk * 32);
#pragma unroll
    for (int st = 0; st < 4; ++st) { s[st] = (f32x4){0.f, 0.f, 0.f, 0.f};
#pragma unroll
        for (int kk = 0; kk < 2; ++kk) s[st] = mfma16(kfr[st][kk], qf[kk], s[st]); } }
    const float bt = lb[t], mt = lm[t], mprev = misc[0];
    float rs = 0.f;
#pragma unroll
    for (int st = 0; st < 4; ++st)
#pragma unroll
        for (int r = 0; r < 4; ++r) { const int si = st * 16 + g * 4 + r; const float wv = (si <= t) ? __expf(bt + lu[si] - mt) : 0.f; const float val = s[st][r] * 0.125f * wv; s[st][r] = val; rs += val; }
    rs += __shfl_xor(rs, 16); rs += __shfl_xor(rs, 32);
    float qn = 0.f;
#pragma unroll
    for (int i = 0; i < 8; ++i) qn += qv0[i] * npv[g * 8 + i] + qv1[i] * npv[32 + g * 8 + i];
    qn += __shfl_xor(qn, 16); qn += __shfl_xor(qn, 32);
    const float wi = __expf(bt + mprev - mt), den = wi * qn + rs, inv = 1.0f / fmaxf(fabsf(den), __expf(-mt));
    bf16x8 pf[2]; pf[0] = pack8(s[0], s[1]); pf[1] = pack8(s[2], s[3]);
    f32x4 h1[4], h2[4];
    { bf16x8 vfr[4][2], cfr[4][2];
#pragma unroll
    for (int et = 0; et < 4; ++et) { const int e = eh * 64 + et * 16 + fr;
#pragma unroll
        for (int cc = 0; cc < 2; ++cc) { const bf16_t* vp = Vt + e * 72 + cc * 32 + g * 4; const u32x2 v0 = *(const u32x2*)vp, v1 = *(const u32x2*)(vp + 16);
            vfr[et][cc] = __builtin_bit_cast(bf16x8, (u32x4){v0.x, v0.y, v1.x, v1.y}); cfr[et][cc] = *(const bf16x8*)(Cs + e * 72 + g * 8 + cc * 32); } }
#pragma unroll
    for (int et = 0; et < 4; ++et) { h1[et] = (f32x4){0.f, 0.f, 0.f, 0.f}; h2[et] = (f32x4){0.f, 0.f, 0.f, 0.f};
#pragma unroll
        for (int cc = 0; cc < 2; ++cc) { h2[et] = mfma16(vfr[et][cc], pf[cc], h2[et]); h1[et] = mfma16(cfr[et][cc], qf[cc], h1[et]); } } }
    float ss = 0.f;
#pragma unroll
    for (int et = 0; et < 4; ++et)
#pragma unroll
        for (int r = 0; r < 4; ++r) { const float hv = (wi * h1[et][r] + h2[et][r]) * inv; h2[et][r] = hv; ss += hv * hv; }
    ss += __shfl_xor(ss, 16); ss += __shfl_xor(ss, 32);
    if (g == 0) red[w * 16 + fr] = ss;
    __syncthreads();
    { const float tot = red[w * 16 + fr] + red[(w ^ 4) * 16 + fr]; const float rstd = 1.0f / sqrtf(tot * (1.0f / 128.0f) + EPS);
        bf16_t* hcat = (bf16_t*)(P.ws + WS_HCAT);
#pragma unroll
        for (int et = 0; et < 4; ++et) { const int e0 = eh * 64 + et * 16 + g * 4; const u32x2 so = so_[et]; const f32x4 mw = mw_[et];
            const float o0 = h2[et][0] * rstd * mw[0] * bflo(so.x), o1 = h2[et][1] * rstd * mw[1] * bfhi(so.x), o2 = h2[et][2] * rstd * mw[2] * bflo(so.y), o3 = h2[et][3] * rstd * mw[3] * bfhi(so.y);
            u32x2 pk; pk.x = cvt_pk_bf16(o0, o1); pk.y = cvt_pk_bf16(o2, o3); *(u32x2*)(hcat + (size_t)tok * 1024 + h * 128 + e0) = pk; } }
    __syncthreads();
}


__device__ __forceinline__ void tail_mma(unsigned char* lds, const bf16_t* A, const bf16_t* Bt, int K, int r0, int c0, int nchunk, int nseg0, int tid, f32x4 (&acc)[2][2]) {
    const int w = tid >> 6, lane = tid & 63, fr = lane & 15, g = lane >> 4, wr = w & 3, wc = w >> 2;
    const bf16_t* gp[4]; unsigned lo_[4];
#pragma unroll
    for (int j = 0; j < 4; ++j) { const int idx = tid + 512 * j, mat = idx >> 10, rem = idx & 1023, row = rem >> 4, seg = rem & 15;
        gp[j] = (mat ? Bt + (size_t)(c0 + row) * K : A + (size_t)(r0 + row) * K) + seg * 8; lo_[j] = (unsigned)(mat * 17408 + row * 272 + seg * 16); }
    u32x4 st[4], st2[4];
#pragma unroll
    for (int j = 0; j < 4; ++j) st[j] = *(const u32x4*)gp[j];
#pragma unroll
    for (int j = 0; j < 4; ++j) *(u32x4*)(lds + lo_[j]) = st[j];
    if (nchunk > 1) {
#pragma unroll
        for (int j = 0; j < 4; ++j) st[j] = *(const u32x4*)(gp[j] + 128); }
    __syncthreads();
    const unsigned aoff = (unsigned)((16 * wr + fr) * 272 + g * 16), boff = (unsigned)(17408 + (32 * wc + fr) * 272 + g * 16);
#pragma unroll 1
    for (int ch = 0; ch < nchunk; ++ch) {
        const unsigned cur = (unsigned)(ch & 1) * 34816u, nxt = 34816u - cur;
        if (ch + 2 < nchunk) {
#pragma unroll
            for (int j = 0; j < 4; ++j) st2[j] = *(const u32x4*)(gp[j] + (size_t)(ch + 2) * 128); }
        bf16x8 fa[4], f0[4], f1[4];
#pragma unroll
        for (int kk = 0; kk < 4; ++kk) { fa[kk] = *(const bf16x8*)(lds + cur + aoff + kk * 64); f0[kk] = *(const bf16x8*)(lds + cur + boff + kk * 64); f1[kk] = *(const bf16x8*)(lds + cur + boff + 16 * 272 + kk * 64); }
        if (ch < nseg0) {
#pragma unroll
            for (int kk = 0; kk < 4; ++kk) { acc[0][0] = mfma16(f0[kk], fa[kk], acc[0][0]); acc[0][1] = mfma16(f1[kk], fa[kk], acc[0][1]); } }
        else {
#pragma unroll
            for (int kk = 0; kk < 4; ++kk) { acc[1][0] = mfma16(f0[kk], fa[kk], acc[1][0]); acc[1][1] = mfma16(f1[kk], fa[kk], acc[1][1]); } }
        if (ch + 1 < nchunk) {
#pragma unroll
            for (int j = 0; j < 4; ++j) *(u32x4*)(lds + nxt + lo_[j]) = st[j]; }
        __syncthreads();
#pragma unroll
        for (int j = 0; j < 4; ++j) st[j] = st2[j];
    }
}
__device__ __forceinline__ void tail_mix(const Params& P, unsigned char* lds, int tb, int tid) {
    const int w = tid >> 6, lane = tid & 63, fr = lane & 15, g = lane >> 4, tok = MP + (tb >> 4) * 64 + 16 * (w & 3) + fr, col0 = (tb & 15) * 64 + 32 * (w >> 2);
    const bf16_t* hcat = (const bf16_t*)(P.ws + WS_HCAT); const bf16_t* wab = (const bf16_t*)(P.ws + WS_WAB); const bf16_t* gates = (const bf16_t*)(P.ws + WS_GATES); bf16_t* mix = (bf16_t*)(P.ws + WS_MIXIN);
    f32x4 ab[2][2]; ab[0][0] = ab[0][1] = ab[1][0] = ab[1][1] = (f32x4){0.f, 0.f, 0.f, 0.f};
    tail_mma(lds, hcat, wab, 1024, MP + (tb >> 4) * 64, (tb & 15) * 64, 8, 4, tid, ab);
    const f32x4 (&a)[2] = ab[0]; const f32x4 (&b)[2] = ab[1];
#pragma unroll
    for (int mt = 0; mt < 2; ++mt) { const int c = col0 + mt * 16 + g * 4; const u32x2 sa = *(const u32x2*)(gates + (size_t)tok * 2048 + c), sb = *(const u32x2*)(gates + (size_t)tok * 2048 + 1024 + c);
        const float v0 = bflo(sa.x) * a[mt][0] + bflo(sb.x) * b[mt][0], v1 = bfhi(sa.x) * a[mt][1] + bfhi(sb.x) * b[mt][1], v2 = bflo(sa.y) * a[mt][2] + bflo(sb.y) * b[mt][2], v3 = bfhi(sa.y) * a[mt][3] + bfhi(sb.y) * b[mt][3];
        u32x2 pk; pk.x = cvt_pk_bf16(v0, v1); pk.y = cvt_pk_bf16(v2, v3); *(u32x2*)(mix + (size_t)tok * 1024 + c) = pk; }
}
__device__ __forceinline__ void tail_out(const Params& P, unsigned char* lds, int tb, int tid) {
    const int w = tid >> 6, lane = tid & 63, fr = lane & 15, g = lane >> 4, tok = MP + (tb >> 4) * 64 + 16 * (w & 3) + fr, col0 = (tb & 15) * 64 + 32 * (w >> 2);
    f32x4 ab[2][2]; ab[0][0] = ab[0][1] = ab[1][0] = ab[1][1] = (f32x4){0.f, 0.f, 0.f, 0.f};
    tail_mma(lds, (const bf16_t*)(P.ws + WS_MIXIN), (const bf16_t*)(P.ws + WS_WOUT), 1024, MP + (tb >> 4) * 64, (tb & 15) * 64, 8, 8, tid, ab);
    const f32x4 (&acc)[2] = ab[0];
    const float* xrow = P.in[1] + (size_t)(tok - MP) * 1024; bf16_t* x1b = (bf16_t*)(P.ws + WS_HN); float ss = 0.f;
#pragma unroll
    for (int mt = 0; mt < 2; ++mt) { const int c = col0 + mt * 16 + g * 4; const f32x4 y = *(const f32x4*)(xrow + c) + acc[mt];
        ss += (y[0] * y[0] + y[1] * y[1]) + (y[2] * y[2] + y[3] * y[3]);
        u32x2 pk; pk.x = cvt_pk_bf16(y[0], y[1]); pk.y = cvt_pk_bf16(y[2], y[3]); *(u32x2*)(x1b + (size_t)tok * 1024 + c) = pk; }
    ss += __shfl_xor(ss, 16); ss += __shfl_xor(ss, 32);
    if (g == 0) unsafeAtomicAdd((float*)(P.ws + WS_ROWSS) + tok, ss);
}
__device__ __forceinline__ void tail_down(const Params& P, unsigned char* lds, int tb, int tid) {
    const int w = tid >> 6, lane = tid & 63, fr = lane & 15, g = lane >> 4, tok = MP + (tb >> 4) * 64 + 16 * (w & 3) + fr, col0 = (tb & 15) * 64 + 32 * (w >> 2);
    f32x4 ab[2][2]; ab[0][0] = ab[0][1] = ab[1][0] = ab[1][1] = (f32x4){0.f, 0.f, 0.f, 0.f};
    tail_mma(lds, (const bf16_t*)(P.ws + WS_MIXIN), (const bf16_t*)(P.ws + WS_WD), DFF, MP + (tb >> 4) * 64, (tb & 15) * 64, 22, 22, tid, ab);
    const f32x4 (&acc)[2] = ab[0];
#pragma unroll
    for (int mt = 0; mt < 2; ++mt) { const size_t o = (size_t)tok * 1024 + col0 + mt * 16 + g * 4; const u32x2 r = *(const u32x2*)((const bf16_t*)(P.ws + WS_HN) + o);
        *(f32x4*)(P.out + o) = (f32x4){bflo(r.x), bfhi(r.x), bflo(r.y), bfhi(r.y)} + acc[mt]; }
}
#define GSYNC_F(grid) xcd_barrier(xbar)
__global__ void __launch_bounds__(512, 2) fwd_kernel(Params P) {
    extern __shared__ __attribute__((aligned(16))) unsigned char lds[];
    cg::grid_group grid = cg::this_grid();
    const int tid = threadIdx.x, G = gridDim.x;
    const int lo = P.ph_lo, hi = P.ph_hi;
    volatile LAS unsigned* xst = (volatile LAS unsigned*)((LAS unsigned char*)lds + 131072);
    if (tid < 4) xst[tid] = 0u;
    __syncthreads();
    XcdBarrier xbar = xcd_barrier_post((unsigned*)(P.ws + WS_BAR), xst);
#ifndef PHASE_MASK
#define PHASE_MASK 0x1ff
#endif
#define IN(k) (((PHASE_MASK >> (k)) & 1) && lo <= (k) && (k) < hi)
#define GSYNC() xcd_barrier(xbar)
#define SEAM(k) do { if (IN(k) && IN((k) + 1)) GSYNC(); } while (0)
#ifndef DUP_MASK
#define DUP_MASK 0
#endif
#ifndef EXTRA_SYNCS
#define EXTRA_SYNCS 0
#endif
#define REP(k) for (int rep_ = 0; rep_ <= ((DUP_MASK >> (k)) & 1); ++rep_) if (rep_ == 0 || (GSYNC_F(grid), true))
    bf16_t* HN = (bf16_t*)(P.ws + WS_HN); bf16_t* MIXIN = (bf16_t*)(P.ws + WS_MIXIN); bf16_t* GATES = (bf16_t*)(P.ws + WS_GATES); bf16_t* HCAT = (bf16_t*)(P.ws + WS_HCAT);
    PG8_LAS unsigned char* ldsa = (PG8_LAS unsigned char*)lds;
    if (IN(0)) REP(0) p0_prep(P, lds, tid, G);
    if (lo < 0) grid.sync();
    SEAM(0);
    for (int xs_ = 0; xs_ < EXTRA_SYNCS; ++xs_) GSYNC();
    if (IN(1)) REP(1) { pg8::Gemm g{HN, (const bf16_t*)(P.ws + WS_WIN), MT, NPROJ, 1024}; pg8::StaticOrder S; S.init(MT, NPROJ, G, (int)blockIdx.x);
        pg8::EpiProj E{MIXIN, GATES}; pg8::gemm_phase<pg8::EpiProj, pg8::StaticOrder, true, true>(ldsa, g, S, E);
        { const int nfull = (MT / 256) * (NPROJ / 256) / G, nlast = (MT / 256) * (NPROJ / 256) - nfull * G;
            if (nlast > 0 && nlast < G && (int)blockIdx.x >= nlast) for (int it = NT_IN + (int)blockIdx.x - nlast; it < NT_ALL; it += G - nlast) wtile_by_index(P, it, lds, tid);
            else if (nlast == 0 || nlast >= G) for (int it = NT_IN + (int)blockIdx.x; it < NT_ALL; it += G) wtile_by_index(P, it, lds, tid); } }
    SEAM(1);
    if (IN(2)) REP(2) {
        for (int it = blockIdx.x; it < 256 + 256 + 1024; it += G) {
            if (it < 256) attn_prompt_item(P, it, lds, tid);
            else if (it < 512) attn_sample_item(P, it - 256, lds, tid);
            else mlstm_b_item(P, it - 512, lds, tid);
        } }
    SEAM(2);
    if (IN(3)) REP(3) {
        const int nscan = (G > 64) ? 64 : 0;
#ifndef P3_VARIANT
#define P3_VARIANT 3
#endif
        if (nscan) { if ((int)blockIdx.x < 64) { if (P3_VARIANT & 1) mlstm_scan(P, lds, tid); } else if (P3_VARIANT & 2) { for (int it = blockIdx.x - 64; it < 512; it += G - 64) mlstm_sample_item(P, it, lds, tid); } }
        else { for (int it = blockIdx.x; it < 512; it += G) mlstm_sample_item(P, it, lds, tid); }
    }
    SEAM(3);
    if (IN(4)) REP(4) { for (int it = blockIdx.x; it < 1024; it += G) mlstm_d_item(P, it, lds, tid); }
    SEAM(4);
    if (IN(5)) REP(5) { pg8::Gemm g{HCAT, (const bf16_t*)(P.ws + WS_WAB), MP, 1024, 1024}; pg8::StaticOrder S; S.init(MP, 1024, G, (int)blockIdx.x);
        pg8::EpiMix E{GATES, MIXIN}; pg8::gemm_phase<pg8::EpiMix, pg8::StaticOrder, true, true>(ldsa, g, S, E);
        for (int tb = blockIdx.x; tb < 256; tb += G) tail_mix(P, lds, tb, tid); }
#ifdef DUPC5
    GSYNC();
    { pg8::Gemm g{HCAT, (const bf16_t*)(P.ws + WS_WAB), MP, 1024, 1024}; pg8::StaticOrder S; S.init(MP, 1024, G, (int)blockIdx.x);
        pg8::EpiMix E{GATES, MIXIN}; pg8::gemm_phase<pg8::EpiMix, pg8::StaticOrder, true, true>(ldsa, g, S, E);
        for (int tb = blockIdx.x; tb < 256; tb += G) tail_mix(P, lds, tb, tid); }
#endif
    SEAM(5);
    if (IN(6)) REP(6) { pg8::Gemm g{MIXIN, (const bf16_t*)(P.ws + WS_WOUT), MP, 1024, 1024}; pg8::StaticOrder S; S.init(MP, 1024, G, (int)blockIdx.x);
        pg8::EpiOut E{P.in[0], P.in[1], HN, (float*)(P.ws + WS_ROWSS)}; pg8::gemm_phase<pg8::EpiOut, pg8::StaticOrder, true, true>(ldsa, g, S, E);
        for (int tb = blockIdx.x; tb < 256; tb += G) tail_out(P, lds, tb, tid); }
    SEAM(6);
    if (IN(7)) REP(7) { pg8::Gemm g{HN, (const bf16_t*)(P.ws + WS_WGU), MT, 2 * DFF, 1024}; pg8::StaticOrder S; S.init(MT, 2 * DFF, G, (int)blockIdx.x);
        pg8::EpiGU E{MIXIN, (const float*)(P.ws + WS_ROWSS)}; pg8::gemm_phase<pg8::EpiGU, pg8::StaticOrder, true, true>(ldsa, g, S, E); }
#ifdef DUPC7
    GSYNC();
    { pg8::Gemm g{HN, (const bf16_t*)(P.ws + WS_WGU), MT, 2 * DFF, 1024}; pg8::StaticOrder S; S.init(MT, 2 * DFF, G, (int)blockIdx.x);
        pg8::EpiGU E{MIXIN, (const float*)(P.ws + WS_ROWSS)}; pg8::gemm_phase<pg8::EpiGU, pg8::StaticOrder, true, true>(ldsa, g, S, E); }
#endif
    SEAM(7);
    if (IN(8)) REP(8) { pg8::Gemm g{MIXIN, (const bf16_t*)(P.ws + WS_WD), MP, 1024, DFF}; pg8::StaticOrder S; S.init(MP, 1024, G, (int)blockIdx.x);
        pg8::EpiDown E{HN, P.out}; pg8::gemm_phase<pg8::EpiDown, pg8::StaticOrder, true, true>(ldsa, g, S, E);
        for (int tb = blockIdx.x; tb < 256; tb += G) tail_down(P, lds, tb, tid); }
#ifdef DBG_DUMP
    GSYNC();
    if (DBG_DUMP == 1) { for (size_t i = (size_t)blockIdx.x * 512 + tid; i < (size_t)MT * 1024; i += (size_t)G * 512) { const size_t r = i >> 10, c = i & 1023; P.out[i] = bf2f(MIXIN[r * NMIX + c]); } }
    if (DBG_DUMP == 2) { const bf16_t* d = (const bf16_t*)((unsigned char*)P.out + OB_DCT); for (size_t i = (size_t)blockIdx.x * 512 + tid; i < (size_t)1024 * 8192; i += (size_t)G * 512) P.out[i] = bf2f(d[i]); }
    if (DBG_DUMP == 4) { unsigned* d = (unsigned*)((unsigned char*)P.out + OB_DCT); for (size_t i = (size_t)blockIdx.x * 512 + tid; i < (size_t)1024 * 4096; i += (size_t)G * 512) { const unsigned w = __hip_atomic_load(d + i, __ATOMIC_RELAXED, __HIP_MEMORY_SCOPE_AGENT); P.out[2 * i] = bflo(w); P.out[2 * i + 1] = bfhi(w); } }
    if (DBG_DUMP == 5) { const float* a = (const float*)(P.ws + WS_GI); const float* bq = (const float*)(P.ws + WS_GB); for (int i = blockIdx.x * 512 + tid; i < MT * 4; i += G * 512) { P.out[i] = a[i]; P.out[MT * 4 + i] = bq[i]; } }
    if (DBG_DUMP == 6) { const float* a = (const float*)(P.ws + WS_DN); for (int i = blockIdx.x * 512 + tid; i < 65536; i += G * 512) P.out[i] = a[i]; }
    if (DBG_DUMP == 3) { for (size_t i = (size_t)blockIdx.x * 512 + tid; i < (size_t)MT * 1024; i += (size_t)G * 512) P.out[i] = bf2f(HN[i]); }
#endif
#undef IN
#undef SEAM
}

extern "C" void kernel_launch(void* const* d_in, const int* in_sizes, int n_in, void* d_out, int out_size, void* d_ws, size_t ws_size, hipStream_t stream) {
    static int grid = 0;
    if (grid == 0) {
        if (n_in != 22 || (size_t)out_size != O_END || ws_size < WS_END) { fprintf(stderr, "kernel_launch: unexpected shapes (n_in %d, out %d, ws %zu)\n", n_in, out_size, ws_size); grid = -1; return; }
        int dev = 0, cus = 0, per_cu = 0;
        (void)hipGetDevice(&dev); (void)hipDeviceGetAttribute(&cus, hipDeviceAttributeMultiprocessorCount, dev);
        if (hipFuncSetAttribute((const void*)fwd_kernel, hipFuncAttributeMaxDynamicSharedMemorySize, LDS_BYTES) != hipSuccess) { fprintf(stderr, "kernel_launch: hipFuncSetAttribute failed\n"); grid = -1; return; }
        if (hipOccupancyMaxActiveBlocksPerMultiprocessor(&per_cu, (const void*)fwd_kernel, 512, LDS_BYTES) != hipSuccess || per_cu < 1) { fprintf(stderr, "kernel_launch: occupancy query failed (%d)\n", per_cu); (void)hipGetLastError(); per_cu = 1; }
        grid = cus * 1;
        if (grid < 65) { fprintf(stderr, "kernel_launch: needs more than 64 CUs\n"); grid = -1; return; }
    }
    if (grid < 0) return;
    if (hipMemsetAsync((char*)d_ws + WS_BAR, 0, XCD_BAR_WORDS * 4, stream) != hipSuccess) { fprintf(stderr, "kernel_launch: memset failed\n"); return; }
    Params p{};
    for (int i = 0; i < 22; ++i) p.in[i] = (const float*)d_in[i];
    p.out = (float*)d_out; p.ws = (unsigned char*)d_ws;
    constexpr int NPH = 9;
    for (int li = 0; li < N_LAUNCHES; ++li) {
        p.ph_lo = (N_LAUNCHES == 1) ? 0 : li; p.ph_hi = (N_LAUNCHES == 1) ? NPH : li + 1;
        void* args[] = {&p};
        const hipError_t e = hipLaunchCooperativeKernel((const void*)fwd_kernel, dim3(grid), dim3(512), args, LDS_BYTES, stream);
        if (e != hipSuccess) { fprintf(stderr, "kernel_launch: cooperative launch %d failed: %s (grid %d)\n", li, hipGetErrorString(e), grid); break; }
    }
}
```

```cpp
#include <hip/hip_runtime.h>
#include <hip/hip_cooperative_groups.h>
#include <cstdio>
#include <cstdint>
namespace cg = cooperative_groups;

#ifndef N_LAUNCHES
#define N_LAUNCHES 1
#endif

namespace pg8 {
#define PG8_LAS __attribute__((address_space(3)))
typedef unsigned short bf16_t;
typedef short bf16x8 __attribute__((ext_vector_type(8)));
typedef float f32x4 __attribute__((ext_vector_type(4)));
typedef unsigned u32x4 __attribute__((ext_vector_type(4)));
constexpr int BM = 256, BK = 64, HALF = 128, HTB = HALF * BK * 2  , STAGE_BYTES = 8 * HTB, NXCD = 8, WGM = 8;

__host__ __device__ __forceinline__ int lds_byte(int r, int c) { const int st = (r >> 4) * 2 + (c >> 5), rr = r & 15, cc = c & 31, ob = rr * 64 + cc * 2; return st * 1024 + (ob ^ (((ob >> 9) & 1) << 5)); }
__host__ __device__ __forceinline__ void stage_rc(int b, int& R, int& C) { const int st = b / 1024, sb = b % 1024, swz = sb ^ (((sb >> 9) & 1) << 5); R = (st >> 1) * 16 + swz / 64; C = (st & 1) * 32 + (swz % 64) / 2; }
__host__ __device__ __forceinline__ int perm32(int rho) { const int n = rho >> 4, i = rho & 15; return 8 * (i >> 2) + 4 * n + (i & 3); }

struct Unit { int pm, pn; };
struct Gemm { const bf16_t* A; const bf16_t* Bt; int M, N, K; };

struct StaticOrder {
    int nM, nN, nwg, G, c;
    __host__ __device__ void init(int M, int N, int G_, int c_) { nM = M / BM; nN = N / BM; nwg = nM * nN; G = G_; c = c_; }
    __host__ __device__ bool next(int i, Unit& u) const {
        const long L = (long)i * G + c; if (L >= nwg) return false;
        int wgid = (int)L; { const int q = nwg / NXCD, r = nwg % NXCD, xcd = wgid % NXCD, off = wgid / NXCD; wgid = (xcd < r ? xcd * (q + 1) : r * (q + 1) + (xcd - r) * q) + off; }
        const int nig = WGM * nN, gid = wgid / nig, fm = gid * WGM, gsz = (nM - fm) < WGM ? (nM - fm) : WGM;
        u.pm = fm + ((wgid % nig) % gsz); u.pn = (wgid % nig) / gsz; return true;
    }
    __device__ __forceinline__ void a_ready(const Unit&) const {}
    __device__ __forceinline__ void done(const Unit&) const {}
};

typedef float f32x2_t __attribute__((ext_vector_type(2)));
typedef __bf16 bf16x2_t __attribute__((ext_vector_type(2)));
__device__ __forceinline__ unsigned cvt_pk_bf16(float lo, float hi) { const f32x2_t v = {lo, hi}; const bf16x2_t b = __builtin_convertvector(v, bf16x2_t); return __builtin_bit_cast(unsigned, b); }
__device__ __forceinline__ float bflo(unsigned w) { return __builtin_bit_cast(float, w << 16); }
__device__ __forceinline__ float bfhi(unsigned w) { return __builtin_bit_cast(float, w & 0xffff0000u); }
__device__ __forceinline__ float sigm(float x) { return __builtin_amdgcn_rcpf(1.0f + __expf(-x)); }

struct EpiProj {
    static constexpr bool PERM = true, AFTER_DRAIN = false, HAS_MID = false;
    bf16_t* mixin; bf16_t* gates;
    __device__ __forceinline__ void operator()(const f32x4 (&acc)[2][2][4][2], const Unit& u, int wr, int wc, int fr, int fq) const {
        const bool isg = u.pn >= 9; const bool sg = isg || u.pn == 4 || u.pn == 5;
        bf16_t* base = isg ? gates : mixin; const int ldc = isg ? 2048 : 2304;
        const int col0 = (isg ? (u.pn - 9) : u.pn) * 256 + wc * 32 + 8 * fq, row0 = u.pm * BM + wr * 64 + fr;
#pragma unroll
        for (int ai = 0; ai < 2; ++ai)
#pragma unroll
            for (int m = 0; m < 4; ++m) { bf16_t* rowp = base + (size_t)(row0 + ai * HALF + m * 16) * ldc + col0;
#pragma unroll
                for (int bj = 0; bj < 2; ++bj) { f32x4 v0 = acc[ai][bj][m][0], v1 = acc[ai][bj][m][1];
                    if (sg) {
#pragma unroll
                        for (int i = 0; i < 4; ++i) { v0[i] = sigm(v0[i]); v1[i] = sigm(v1[i]); } }
                    u32x4 w; w.x = cvt_pk_bf16(v0[0], v0[1]); w.y = cvt_pk_bf16(v0[2], v0[3]); w.z = cvt_pk_bf16(v1[0], v1[1]); w.w = cvt_pk_bf16(v1[2], v1[3]);
                    *(u32x4*)(rowp + bj * HALF) = w; } }
    }
};

struct EpiMix {
    static constexpr bool PERM = true, AFTER_DRAIN = false, HAS_MID = true;
    const bf16_t* gates; bf16_t* mix;
    __device__ __forceinline__ void mid(f32x4 (&acc)[2][2][4][2], const Unit& u, int wr, int wc, int fr, int fq) const {
        unsigned rb = (unsigned)(u.pm * BM + wr * 64 + fr) * 2048u + (unsigned)(u.pn * BM + wc * 32 + 8 * fq);
        asm volatile("" : "+v"(rb));
#pragma unroll
        for (int ai = 0; ai < 2; ++ai)
#pragma unroll
            for (int m = 0; m < 4; ++m) { const bf16_t* rowp = gates + (rb + (unsigned)((ai * HALF + m * 16) * 2048));
#pragma unroll
                for (int bj = 0; bj < 2; ++bj) { const u32x4 a = *(const u32x4*)(rowp + bj * HALF), b = *(const u32x4*)(rowp + 1024 + bj * HALF);
                    const float tiny = 8.673617379884035e-19f;
                    f32x4 r0, r1;
                    r0[0] = bflo(a.x) * __builtin_amdgcn_rcpf(fmaxf(bflo(b.x), tiny)); r0[1] = bfhi(a.x) * __builtin_amdgcn_rcpf(fmaxf(bfhi(b.x), tiny)); r0[2] = bflo(a.y) * __builtin_amdgcn_rcpf(fmaxf(bflo(b.y), tiny)); r0[3] = bfhi(a.y) * __builtin_amdgcn_rcpf(fmaxf(bfhi(b.y), tiny));
                    r1[0] = bflo(a.z) * __builtin_amdgcn_rcpf(fmaxf(bflo(b.z), tiny)); r1[1] = bfhi(a.z) * __builtin_amdgcn_rcpf(fmaxf(bfhi(b.z), tiny)); r1[2] = bflo(a.w) * __builtin_amdgcn_rcpf(fmaxf(bflo(b.w), tiny)); r1[3] = bfhi(a.w) * __builtin_amdgcn_rcpf(fmaxf(bfhi(b.w), tiny));
                    acc[ai][bj][m][0] = acc[ai][bj][m][0] * r0; acc[ai][bj][m][1] = acc[ai][bj][m][1] * r1; }
                if (m == 3) __builtin_amdgcn_sched_barrier(0); }
    }
    __device__ __forceinline__ void operator()(const f32x4 (&acc)[2][2][4][2], const Unit& u, int wr, int wc, int fr, int fq) const {
        const int col0 = u.pn * BM + wc * 32 + 8 * fq, row0 = u.pm * BM + wr * 64 + fr;
#pragma unroll
        for (int ai = 0; ai < 2; ++ai)
#pragma unroll
            for (int m = 0; m < 4; ++m) { const size_t row = (size_t)(row0 + ai * HALF + m * 16);
#pragma unroll
                for (int bj = 0; bj < 2; ++bj) { const u32x4 b = *(const u32x4*)(gates + row * 2048 + 1024 + col0 + bj * HALF);
                    const float tiny = 8.673617379884035e-19f;
                    f32x4 s0, s1;
                    s0[0] = fmaxf(bflo(b.x), tiny); s0[1] = fmaxf(bfhi(b.x), tiny); s0[2] = fmaxf(bflo(b.y), tiny); s0[3] = fmaxf(bfhi(b.y), tiny);
                    s1[0] = fmaxf(bflo(b.z), tiny); s1[1] = fmaxf(bfhi(b.z), tiny); s1[2] = fmaxf(bflo(b.w), tiny); s1[3] = fmaxf(bfhi(b.w), tiny);
                    const f32x4 v0 = acc[ai][bj][m][0] * s0, v1 = acc[ai][bj][m][1] * s1;
                    u32x4 w; w.x = cvt_pk_bf16(v0[0], v0[1]); w.y = cvt_pk_bf16(v0[2], v0[3]); w.z = cvt_pk_bf16(v1[0], v1[1]); w.w = cvt_pk_bf16(v1[2], v1[3]);
                    *(u32x4*)(mix + row * 1024 + col0 + bj * HALF) = w; } }
    }
};

struct EpiOut {
    static constexpr bool PERM = true, AFTER_DRAIN = false, HAS_MID = false;
    const float* xp; const float* xs; bf16_t* x1b; float* rowss;
    __device__ __forceinline__ void operator()(const f32x4 (&acc)[2][2][4][2], const Unit& u, int wr, int wc, int fr, int fq) const {
        const int col0 = u.pn * BM + wc * 32 + 8 * fq, row0 = u.pm * BM + wr * 64 + fr;
#pragma unroll
        for (int ai = 0; ai < 2; ++ai)
#pragma unroll
            for (int m = 0; m < 4; ++m) { const int row = row0 + ai * HALF + m * 16;
                const float* xrow = row < 16384 ? xp + (size_t)row * 1024 : xs + (size_t)(row - 16384) * 1024;
                float ss = 0.f;
#pragma unroll
                for (int bj = 0; bj < 2; ++bj) { const int c = col0 + bj * HALF;
                    const f32x4 y0 = *(const f32x4*)(xrow + c) + acc[ai][bj][m][0], y1 = *(const f32x4*)(xrow + c + 4) + acc[ai][bj][m][1];
                    ss += (y0[0] * y0[0] + y0[1] * y0[1]) + (y0[2] * y0[2] + y0[3] * y0[3]) + (y1[0] * y1[0] + y1[1] * y1[1]) + (y1[2] * y1[2] + y1[3] * y1[3]);
                    u32x4 w; w.x = cvt_pk_bf16(y0[0], y0[1]); w.y = cvt_pk_bf16(y0[2], y0[3]); w.z = cvt_pk_bf16(y1[0], y1[1]); w.w = cvt_pk_bf16(y1[2], y1[3]);
                    *(u32x4*)(x1b + (size_t)row * 1024 + c) = w; }
                ss += __shfl_xor(ss, 16); ss += __shfl_xor(ss, 32);
                if (fq == 0) unsafeAtomicAdd(rowss + row, ss); }
    }
};

struct EpiGU {
    static constexpr bool PERM = true, AFTER_DRAIN = false, HAS_MID = false;
    bf16_t* act; const float* rowss;
    __device__ __forceinline__ void operator()(const f32x4 (&acc)[2][2][4][2], const Unit& u, int wr, int wc, int fr, int fq) const {
        const int col0 = u.pn * HALF + wc * 32 + 8 * fq, row0 = u.pm * BM + wr * 64 + fr;
#pragma unroll
        for (int ai = 0; ai < 2; ++ai)
#pragma unroll
            for (int m = 0; m < 4; ++m) { const int row = row0 + ai * HALF + m * 16;
                const float rstd = __builtin_amdgcn_rsqf(rowss[row] * (1.0f / 1024.0f) + 1e-6f);
                float o[8];
#pragma unroll
                for (int n = 0; n < 2; ++n)
#pragma unroll
                    for (int j = 0; j < 4; ++j) { const float g = acc[ai][0][m][n][j] * rstd, up = acc[ai][1][m][n][j] * rstd; o[n * 4 + j] = g * sigm(g) * up; }
                u32x4 w; w.x = cvt_pk_bf16(o[0], o[1]); w.y = cvt_pk_bf16(o[2], o[3]); w.z = cvt_pk_bf16(o[4], o[5]); w.w = cvt_pk_bf16(o[6], o[7]);
                *(u32x4*)(act + (size_t)row * 2816 + col0) = w; }
    }
};

struct EpiDown {
    static constexpr bool PERM = true, AFTER_DRAIN = false, HAS_MID = false;
    const bf16_t* x1b; float* out;
    __device__ __forceinline__ void operator()(const f32x4 (&acc)[2][2][4][2], const Unit& u, int wr, int wc, int fr, int fq) const {
        const int col0 = u.pn * BM + wc * 32 + 8 * fq, row0 = u.pm * BM + wr * 64 + fr;
#pragma unroll
        for (int ai = 0; ai < 2; ++ai)
#pragma unroll
            for (int m = 0; m < 4; ++m) { const size_t ro = (size_t)(row0 + ai * HALF + m * 16) * 1024 + col0;
#pragma unroll
                for (int bj = 0; bj < 2; ++bj) { const u32x4 r = *(const u32x4*)(x1b + ro + bj * HALF);
                    const f32x4 y0 = (f32x4){bflo(r.x), bfhi(r.x), bflo(r.y), bfhi(r.y)} + acc[ai][bj][m][0], y1 = (f32x4){bflo(r.z), bfhi(r.z), bflo(r.w), bfhi(r.w)} + acc[ai][bj][m][1];
                    *(f32x4*)(out + ro + bj * HALF) = y0; *(f32x4*)(out + ro + bj * HALF + 4) = y1; } }
    }
};

template <class Epi, class Sched, bool ALIGN_EPI = false, bool SP2 = false>
__device__ __forceinline__ void gemm_phase(PG8_LAS unsigned char* lds, const Gemm g, const Sched& S, const Epi& E) {
    const int tid = threadIdx.x, wid = __builtin_amdgcn_readfirstlane(tid >> 6), lane = tid & 63, wr = wid >> 2, wc = wid & 3, fr = lane & 15, fq = lane >> 4;
    const int K = g.K, nt = K / BK;
    unsigned voffA[2], voffB[2];
#pragma unroll
    for (int i = 0; i < 2; ++i) { int R, C; stage_rc(tid * 16 + i * 8192, R, C); const int Rb = Epi::PERM ? ((R & ~31) + perm32(R & 31)) : R;
        voffA[i] = (unsigned)(R * K + C) * 2u; voffB[i] = (unsigned)(Rb * K + C) * 2u; }
    const size_t kstep = (size_t)(BK * 2);
    const size_t hstep = (size_t)HALF * K * 2;
    const size_t tstep = 2 * hstep;
    const unsigned ldsw = (unsigned)wid * 1024u;
    const int aoff = lds_byte(wr * 64 + fr, fq * 8), boff = lds_byte(wc * 32 + fr, fq * 8);
#define PG8_SA(b, h) (((b) * 2 + (h)) * HTB)
#define PG8_SB(b, h) ((4 + (b) * 2 + (h)) * HTB)
#define PG8_STAGE(bufoff, gbase, voff) do { _Pragma("unroll") for (int _i = 0; _i < 2; ++_i) \
        __builtin_amdgcn_global_load_lds((const unsigned*)((const char*)(gbase) + (voff)[_i]), (PG8_LAS unsigned*)(lds + (bufoff) + ldsw + _i * 8192), 16, 0, 0); } while (0)
#define PG8_LDA(dst, b, h) do { _Pragma("unroll") for (int m = 0; m < 4; ++m) _Pragma("unroll") for (int k = 0; k < 2; ++k) dst[m][k] = *(const PG8_LAS bf16x8*)(lds + PG8_SA(b, h) + aoff + m * 2048 + k * 1024); } while (0)
#define PG8_LDB(dst, b, h) do { _Pragma("unroll") for (int n = 0; n < 2; ++n) _Pragma("unroll") for (int k = 0; k < 2; ++k) dst[n][k] = *(const PG8_LAS bf16x8*)(lds + PG8_SB(b, h) + boff + n * 2048 + k * 1024); } while (0)
#define PG8_MMA(ai, bj, At, Bt) do { __builtin_amdgcn_s_setprio(1); _Pragma("unroll") for (int m = 0; m < 4; ++m) _Pragma("unroll") for (int n = 0; n < 2; ++n) _Pragma("unroll") for (int k = 0; k < 2; ++k) \
        acc[ai][bj][m][n] = __builtin_amdgcn_mfma_f32_16x16x32_bf16(Bt[n][k], At[m][k], acc[ai][bj][m][n], 0, 0, 0); __builtin_amdgcn_s_setprio(0); } while (0)
#define PG8_WAIT_V(n) asm volatile("s_waitcnt vmcnt(" #n ")" ::: "memory")
#define PG8_WAIT_L(n) asm volatile("s_waitcnt lgkmcnt(" #n ")" ::: "memory")
#define PG8_BAR __builtin_amdgcn_s_barrier()
#define PG8_SCHED __builtin_amdgcn_sched_barrier(0)
    Unit cur, nxt; int ui = 0;
    if (!S.next(0, cur)) return;
    f32x4 acc[2][2][4][2];
#pragma unroll
    for (int a = 0; a < 2; ++a)
#pragma unroll
        for (int b = 0; b < 2; ++b)
#pragma unroll
            for (int m = 0; m < 4; ++m)
#pragma unroll
                for (int n = 0; n < 2; ++n) acc[a][b][m][n] = (f32x4){0.f, 0.f, 0.f, 0.f};
    bf16x8 At[4][2], B0[2][2], B1[2][2];
    const char* cA = (const char*)g.A + (size_t)cur.pm * tstep; const char* cB = (const char*)g.Bt + (size_t)cur.pn * tstep;
    S.a_ready(cur);
    if constexpr (SP2) {
        PG8_STAGE(PG8_SB(0, 0), cB, voffB); PG8_STAGE(PG8_SB(0, 1), cB + hstep, voffB); PG8_STAGE(PG8_SA(0, 0), cA, voffA); PG8_STAGE(PG8_SA(0, 1), cA + hstep, voffA);
        if (wr == 1) PG8_BAR;
        PG8_WAIT_V(2); PG8_BAR;
        PG8_STAGE(PG8_SB(1, 0), cB + kstep, voffB); PG8_STAGE(PG8_SA(1, 0), cA + kstep, voffA); PG8_STAGE(PG8_SB(1, 1), cB + hstep + kstep, voffB);
        PG8_WAIT_V(6); PG8_BAR;
    } else {
        PG8_STAGE(PG8_SB(0, 0), cB, voffB); PG8_STAGE(PG8_SA(0, 0), cA, voffA); PG8_STAGE(PG8_SB(0, 1), cB + hstep, voffB); PG8_STAGE(PG8_SA(0, 1), cA + hstep, voffA);
        if (wr == 1) PG8_BAR;
        PG8_WAIT_V(4); PG8_BAR;
        PG8_STAGE(PG8_SB(1, 0), cB + kstep, voffB); PG8_STAGE(PG8_SA(1, 0), cA + kstep, voffA); PG8_STAGE(PG8_SB(1, 1), cB + hstep + kstep, voffB);
        PG8_WAIT_V(6); PG8_BAR;
    }
    for (;;) {
        const bool has_next = S.next(ui + 1, nxt);
        const char* nA = has_next ? (const char*)g.A + (size_t)nxt.pm * tstep : cA; const char* nB = has_next ? (const char*)g.Bt + (size_t)nxt.pn * tstep : cB;
        for (int t = 0; t < nt; t += 2) {
            if constexpr (Epi::HAS_MID) { if (t == (nt >> 1)) E.mid(acc, cur, wr, wc, fr, fq); }
            const bool last = (t == nt - 2);
            const char* a1 = cA + (size_t)(t + 1) * kstep;
            const char* a2 = last ? nA : cA + (size_t)(t + 2) * kstep; const char* b2 = last ? nB : cB + (size_t)(t + 2) * kstep;
            const char* a3 = a2 + kstep; const char* b3 = b2 + kstep;
            if (last && has_next) S.a_ready(nxt);
            if constexpr (SP2) {
            PG8_LDB(B0, 0, 0); PG8_LDB(B1, 0, 1); PG8_SCHED; PG8_LDA(At, 0, 0); PG8_STAGE(PG8_SA(1, 1), a1 + hstep, voffA);
            PG8_WAIT_V(8); PG8_WAIT_L(0); PG8_BAR; PG8_MMA(0, 0, At, B0); PG8_MMA(0, 1, At, B1); PG8_BAR; PG8_SCHED;
            PG8_LDA(At, 0, 1); PG8_STAGE(PG8_SB(0, 0), b2, voffB); PG8_STAGE(PG8_SB(0, 1), b2 + hstep, voffB); PG8_STAGE(PG8_SA(0, 0), a2, voffA);
            PG8_WAIT_V(8); PG8_WAIT_L(0); PG8_BAR; PG8_MMA(1, 0, At, B0); PG8_MMA(1, 1, At, B1); PG8_BAR; PG8_SCHED;
            PG8_LDB(B0, 1, 0); PG8_LDB(B1, 1, 1); PG8_SCHED; PG8_LDA(At, 1, 0); PG8_STAGE(PG8_SA(0, 1), a2 + hstep, voffA);
            PG8_WAIT_V(8); PG8_WAIT_L(0); PG8_BAR; PG8_MMA(0, 0, At, B0); PG8_MMA(0, 1, At, B1); PG8_BAR; PG8_SCHED;
            PG8_LDA(At, 1, 1); PG8_STAGE(PG8_SB(1, 0), b3, voffB); PG8_STAGE(PG8_SB(1, 1), b3 + hstep, voffB); PG8_STAGE(PG8_SA(1, 0), a3, voffA);
            PG8_WAIT_V(8); PG8_WAIT_L(0); PG8_BAR; PG8_MMA(1, 0, At, B0); PG8_MMA(1, 1, At, B1); PG8_BAR; PG8_SCHED;
            } else {
            PG8_LDB(B0, 0, 0); PG8_SCHED; PG8_LDA(At, 0, 0); PG8_STAGE(PG8_SA(1, 1), a1 + hstep, voffA);
            PG8_WAIT_L(8); PG8_BAR; PG8_WAIT_L(0); PG8_MMA(0, 0, At, B0); PG8_BAR; PG8_SCHED;
            PG8_LDB(B1, 0, 1); PG8_STAGE(PG8_SB(0, 0), b2, voffB);
            PG8_BAR; PG8_WAIT_L(0); PG8_MMA(0, 1, At, B1); PG8_BAR;
            PG8_LDA(At, 0, 1); PG8_STAGE(PG8_SA(0, 0), a2, voffA);
            PG8_BAR; PG8_WAIT_L(0); PG8_MMA(1, 0, At, B0); PG8_BAR; PG8_SCHED;
            PG8_STAGE(PG8_SB(0, 1), b2 + hstep, voffB);
            PG8_WAIT_V(6); PG8_BAR; PG8_MMA(1, 1, At, B1); PG8_BAR;
            PG8_LDB(B0, 1, 0); PG8_SCHED; PG8_LDA(At, 1, 0); PG8_STAGE(PG8_SA(0, 1), a2 + hstep, voffA);
            PG8_WAIT_L(8); PG8_BAR; PG8_WAIT_L(0); PG8_MMA(0, 0, At, B0); PG8_BAR; PG8_SCHED;
            PG8_LDB(B1, 1, 1); PG8_STAGE(PG8_SB(1, 0), b3, voffB);
            PG8_BAR; PG8_WAIT_L(0); PG8_MMA(0, 1, At, B1); PG8_BAR;
            PG8_LDA(At, 1, 1); PG8_STAGE(PG8_SA(1, 0), a3, voffA);
            PG8_BAR; PG8_WAIT_L(0); PG8_MMA(1, 0, At, B0); PG8_BAR; PG8_SCHED;
            PG8_STAGE(PG8_SB(1, 1), b3 + hstep, voffB);
            PG8_WAIT_V(6); PG8_BAR; PG8_MMA(1, 1, At, B1); PG8_BAR;
            }
        }
        if constexpr (ALIGN_EPI) { if (wr == 0) PG8_BAR; }
        if constexpr (!Epi::AFTER_DRAIN) { E(acc, cur, wr, wc, fr, fq); S.done(cur); }
        if (!has_next) break;
#pragma unroll
        for (int a = 0; a < 2; ++a)
#pragma unroll
            for (int b = 0; b < 2; ++b)
#pragma unroll
                for (int m = 0; m < 4; ++m)
#pragma unroll
                    for (int n = 0; n < 2; ++n) acc[a][b][m][n] = (f32x4){0.f, 0.f, 0.f, 0.f};
        cur = nxt; cA = nA; cB = nB; ++ui;
        if constexpr (ALIGN_EPI) { if (wr == 1) PG8_BAR; }
    }
    PG8_WAIT_V(0);
    if constexpr (!ALIGN_EPI) { if (wr == 0) PG8_BAR; }
    PG8_BAR;
    if constexpr (Epi::AFTER_DRAIN) { E.fused(acc, cur, wr, wc, fr, fq, lds, wid, lane); S.done(cur); }
#undef PG8_SA
#undef PG8_SB
#undef PG8_STAGE
#undef PG8_LDA
#undef PG8_LDB
#undef PG8_MMA
#undef PG8_WAIT_V
#undef PG8_WAIT_L
#undef PG8_BAR
#undef PG8_SCHED
}
}
using pg8::bf16_t; using pg8::bf16x8; using pg8::f32x4; using pg8::u32x4; using pg8::cvt_pk_bf16; using pg8::bflo; using pg8::bfhi; using pg8::sigm;
typedef unsigned u32x2 __attribute__((ext_vector_type(2)));
constexpr int MP = 16384, MS = 1024, MT = MP + MS;
constexpr int DIN = 4360, NPROJ = 4352, NMIX = 2304, NGATE = 2048, DFF = 2816;
constexpr float EPS = 1e-6f, LOG2E = 1.4426950408889634f;
constexpr size_t MiB = 1u << 20;
constexpr size_t WS_ROWSS = 0;
constexpr size_t WS_SUMA = 128 * 1024, WS_SUMM = WS_SUMA + 4096, WS_MCH = WS_SUMM + 4096;
constexpr size_t WS_GI = 256 * 1024, WS_GB = WS_GI + 320 * 1024;
constexpr size_t WS_DN = 1 * MiB, WS_NPREV = WS_DN + 256 * 1024;
constexpr size_t WS_WIN = 2 * MiB;
constexpr size_t WS_WAB = WS_WIN + 17 * MiB / 2;
constexpr size_t WS_WOUT = WS_WAB + 2 * MiB;
constexpr size_t WS_WGU = WS_WOUT + 2 * MiB;
constexpr size_t WS_WD = WS_WGU + 11 * MiB;
constexpr size_t WS_HN = WS_WD + 11 * MiB / 2;
constexpr size_t OB_DCT = 34 * MiB, OB_CPT = 50 * MiB;
constexpr size_t WS_MIXIN = WS_HN + 34 * MiB;
constexpr size_t WS_GATES = WS_MIXIN + 153 * MiB / 2;
constexpr size_t WS_HCAT = WS_GATES + 68 * MiB;
constexpr size_t WS_END = WS_HCAT + 34 * MiB;
static_assert(WS_END <= 256 * MiB, "workspace map");
constexpr size_t O_Y = 0, O_CP = (size_t)MT * 1024, O_NP = O_CP + 65536, O_MP = O_NP + 512, O_KWP = O_MP + 8, O_VWP = O_KWP + 32768,
                 O_CS = O_VWP + 32768, O_NS = O_CS + 4194304, O_MS = O_NS + 32768, O_KWS = O_MS + 512, O_VWS = O_KWS + 2097152, O_END = O_VWS + 2097152;
constexpr size_t WS_BAR = 1536 * 1024;
constexpr int LDS_BYTES = 131072 + 256;

struct Params { const float* in[22]; float* out; unsigned char* ws; int ph_lo, ph_hi; };

__device__ __forceinline__ float bf2f(bf16_t h) { return __builtin_bit_cast(float, (unsigned)h << 16); }
__device__ __forceinline__ bf16_t f2bf(float f) { return (bf16_t)(cvt_pk_bf16(f, 0.f) & 0xffffu); }
__device__ __forceinline__ float wave_sum(float v) {
#pragma unroll
    for (int o = 1; o < 64; o <<= 1) v += __shfl_xor(v, o);
    return v; }
__device__ __forceinline__ float wave_max(float v) {
#pragma unroll
    for (int o = 1; o < 64; o <<= 1) v = fmaxf(v, __shfl_xor(v, o));
    return v; }
__device__ __forceinline__ f32x4 mfma16(bf16x8 a, bf16x8 b, f32x4 c) { return __builtin_amdgcn_mfma_f32_16x16x32_bf16(a, b, c, 0, 0, 0); }
__device__ __forceinline__ bf16x8 pack8(const f32x4& a, const f32x4& b) { u32x4 t; t.x = cvt_pk_bf16(a[0], a[1]); t.y = cvt_pk_bf16(a[2], a[3]); t.z = cvt_pk_bf16(b[0], b[1]); t.w = cvt_pk_bf16(b[2], b[3]); return __builtin_bit_cast(bf16x8, t); }
__device__ __forceinline__ void unpack8(const u32x4& r, float* f) { f[0] = bflo(r.x); f[1] = bfhi(r.x); f[2] = bflo(r.y); f[3] = bfhi(r.y); f[4] = bflo(r.z); f[5] = bfhi(r.z); f[6] = bflo(r.w); f[7] = bfhi(r.w); }

__device__ __forceinline__ void p0_tokens(const Params& P, unsigned char* lds, int tid, int G) {
    const float* wg = (const float*)lds; const float* nw = P.in[7];
    bf16_t* HN = (bf16_t*)(P.ws + WS_HN); float* gi = (float*)(P.ws + WS_GI); float* gb = (float*)(P.ws + WS_GB);
    const int lane = tid & 63, w = tid >> 6;
    f32x4 xn[4], xm[4];
    { const int r = blockIdx.x * 8 + w; const float* xrow = r < MP ? P.in[0] + (size_t)r * 1024 : P.in[1] + (size_t)(r - MP) * 1024;
#pragma unroll
        for (int j = 0; j < 4; ++j) xn[j] = ((const f32x4*)xrow)[lane + 64 * j];
        const int r2 = (r + G * 8 < MT) ? r + G * 8 : r; const float* xrow2 = r2 < MP ? P.in[0] + (size_t)r2 * 1024 : P.in[1] + (size_t)(r2 - MP) * 1024;
#pragma unroll
        for (int j = 0; j < 4; ++j) xm[j] = ((const f32x4*)xrow2)[lane + 64 * j]; }
#pragma unroll 1
    for (int r = blockIdx.x * 8 + w; r < MT; r += G * 8) {
        f32x4 xv[4]; float ss = 0.f;
#pragma unroll
        for (int j = 0; j < 4; ++j) { xv[j] = xn[j]; xn[j] = xm[j]; }
        { const int rn = (r + 2 * G * 8 < MT) ? r + 2 * G * 8 : r; const float* xrow = rn < MP ? P.in[0] + (size_t)rn * 1024 : P.in[1] + (size_t)(rn - MP) * 1024;
#pragma unroll
            for (int j = 0; j < 4; ++j) xm[j] = ((const f32x4*)xrow)[lane + 64 * j]; }
#pragma unroll
        for (int j = 0; j < 4; ++j) ss += (xv[j][0] * xv[j][0] + xv[j][1] * xv[j][1]) + (xv[j][2] * xv[j][2] + xv[j][3] * xv[j][3]);
        ss = wave_sum(ss);
        const float rstd = 1.0f / sqrtf(ss * (1.0f / 1024.0f) + EPS);
        float g[8];
#pragma unroll
        for (int q = 0; q < 8; ++q) g[q] = 0.f;
#pragma unroll
        for (int j = 0; j < 4; ++j) { const int k0 = 4 * (lane + 64 * j);
            const f32x4 nv = *(const f32x4*)(nw + k0); const f32x4 hv = xv[j] * rstd * nv;
            u32x2 pk; pk.x = cvt_pk_bf16(hv[0], hv[1]); pk.y = cvt_pk_bf16(hv[2], hv[3]);
            *(u32x2*)(HN + (size_t)r * 1024 + k0) = pk;
#pragma unroll
            for (int q = 0; q < 8; ++q) { const f32x4 wv = *(const f32x4*)(wg + q * 1024 + k0); g[q] += (xv[j][0] * wv[0] + xv[j][1] * wv[1]) + (xv[j][2] * wv[2] + xv[j][3] * wv[3]); } }
#pragma unroll
        for (int q = 0; q < 8; ++q) g[q] = wave_sum(g[q]);
        if (lane < 4) { const float iv = (lane == 0 ? g[0] : lane == 1 ? g[1] : lane == 2 ? g[2] : g[3]) * rstd + P.in[9][lane];
            const float fv = (lane == 0 ? g[4] : lane == 1 ? g[5] : lane == 2 ? g[6] : g[7]) * rstd + P.in[10][lane];
            gi[r * 4 + lane] = iv; gb[r * 4 + lane] = fminf(fv, 0.f) - log1pf(expf(-fabsf(fv))); }
    }
}
template <bool GU>
__device__ __forceinline__ void p0_wunit(const float* src, int ldsrc, int k0, int c0, bf16_t* dst, int lddst, int n0, int k0d, unsigned char* lds, int tid, const float* kscale = nullptr) {
    float* tile = (float*)(lds + 40960);
    f32x4 v[8];
#pragma unroll
    for (int p = 0; p < 8; ++p) v[p] = *(const f32x4*)(src + (size_t)(k0 + (tid >> 6) + 8 * p) * ldsrc + c0 + (tid & 63) * 4);
    if (kscale) {
#pragma unroll
        for (int p = 0; p < 8; ++p) v[p] = v[p] * kscale[k0 + (tid >> 6) + 8 * p]; }
#pragma unroll
    for (int p = 0; p < 8; ++p) *(f32x4*)(tile + ((tid >> 6) + 8 * p) * 260 + (tid & 63) * 4) = v[p];
    __syncthreads();
    { const int n = tid >> 1, kc = (tid & 1) * 32; const float* s = tile + kc * 260 + n;
        const int nd = GU ? (256 * ((c0 + n) >> 7) + ((c0 + n) & 127) + n0) : (n0 + n);
        bf16_t* dp = dst + (size_t)nd * lddst + k0d + kc;
#pragma unroll
        for (int q = 0; q < 4; ++q) { u32x4 o; o.x = cvt_pk_bf16(s[(8 * q) * 260], s[(8 * q + 1) * 260]); o.y = cvt_pk_bf16(s[(8 * q + 2) * 260], s[(8 * q + 3) * 260]);
            o.z = cvt_pk_bf16(s[(8 * q + 4) * 260], s[(8 * q + 5) * 260]); o.w = cvt_pk_bf16(s[(8 * q + 6) * 260], s[(8 * q + 7) * 260]); *(u32x4*)(dp + 8 * q) = o; } }
    __syncthreads();
}
constexpr int NT_IN = 17 * 16, NT_AB = 64, NT_OUT = 64, NT_GU = 352, NT_D = 176, NT_ALL = NT_IN + NT_AB + NT_OUT + NT_GU + NT_D;
__device__ __forceinline__ void wtile_by_index(const Params& P, int r, unsigned char* lds, int tid) {
    if (r < NT_IN) { const int nt = r >> 4, kt = r & 15, c0 = nt * 256; p0_wunit<false>(P.in[8], DIN, kt * 64, c0 < 1536 ? c0 : c0 + 8, (bf16_t*)(P.ws + WS_WIN), 1024, c0, kt * 64, lds, tid); return; } r -= NT_IN;
    if (r < NT_AB) { const int which = r >> 5, rr = r & 31, nt = rr >> 3, kt = rr & 7; p0_wunit<false>(which ? P.in[16] : P.in[15], 1024, kt * 64, nt * 256, (bf16_t*)(P.ws + WS_WAB), 1024, nt * 256, which * 512 + kt * 64, lds, tid); return; } r -= NT_AB;
    if (r < NT_OUT) { const int nt = r >> 4, kt = r & 15; p0_wunit<false>(P.in[17], 1024, kt * 64, nt * 256, (bf16_t*)(P.ws + WS_WOUT), 1024, nt * 256, kt * 64, lds, tid); return; } r -= NT_OUT;
    if (r < NT_GU) { const int which = r / 176, rr = r % 176, jt = rr >> 4, kt = rr & 15; p0_wunit<true>(which ? P.in[20] : P.in[19], DFF, kt * 64, jt * 256, (bf16_t*)(P.ws + WS_WGU), 1024, which * 128, kt * 64, lds, tid, P.in[18]); return; } r -= NT_GU;
    { const int nt = r / 44, kt = r % 44; p0_wunit<false>(P.in[21], 1024, kt * 64, nt * 256, (bf16_t*)(P.ws + WS_WD), DFF, nt * 256, kt * 64, lds, tid); }
}
__device__ __forceinline__ void p0_prep(const Params& P, unsigned char* lds, int tid, int G) {
    float* rowss = (float*)(P.ws + WS_ROWSS);
    for (int i = blockIdx.x * 512 + tid; i < MT; i += G * 512) rowss[i] = 0.f;
    { float* wg = (float*)lds; const float* w_in = P.in[8]; const float* nw = P.in[7];
        for (int idx = tid; idx < 8192; idx += 512) { const int k = idx >> 3, q = idx & 7; wg[q * 1024 + k] = w_in[(size_t)k * DIN + 1536 + q] * nw[k]; } }
    __syncthreads();
    p0_tokens(P, lds, tid, G);
    __syncthreads();
    for (int it = blockIdx.x; it < NT_IN; it += G) wtile_by_index(P, it, lds, tid);
}

template <int NQT>
__device__ __forceinline__ void attn_core(const unsigned char* lds, const bf16x8 (&qf)[NQT][2], int kt_lo, int kt_hi, int qbase, int jmin, float sink2, f32x4 (&o)[4][NQT], float (&l)[NQT]) {
    const bf16_t* Ks = (const bf16_t*)lds; const bf16_t* Vt = (const bf16_t*)(lds + 36864);
    const int lane = threadIdx.x & 63, fr = lane & 15, g = lane >> 4;
    float mrun[NQT];
#pragma unroll
    for (int qt = 0; qt < NQT; ++qt) { mrun[qt] = sink2; l[qt] = (g == 0) ? 1.f : 0.f;
#pragma unroll
        for (int dt = 0; dt < 4; ++dt) o[dt][qt] = (f32x4){0.f, 0.f, 0.f, 0.f}; }
#pragma unroll 1
    for (int kt = kt_lo; kt <= kt_hi; ++kt) {
        f32x4 s[4][NQT];
#pragma unroll
        for (int ks = 0; ks < 4; ++ks)
#pragma unroll
            for (int qt = 0; qt < NQT; ++qt) s[ks][qt] = (f32x4){0.f, 0.f, 0.f, 0.f};
        { bf16x8 kfr[4][2];
#pragma unroll
        for (int ks = 0; ks < 4; ++ks)
#pragma unroll
            for (int kk = 0; kk < 2; ++kk) kfr[ks][kk] = *(const bf16x8*)(Ks + (kt * 64 + ks * 16 + fr) * 72 + g * 8 + kk * 32);
#pragma unroll
        for (int ks = 0; ks < 4; ++ks)
#pragma unroll
            for (int kk = 0; kk < 2; ++kk)
#pragma unroll
                for (int qt = 0; qt < NQT; ++qt) s[ks][qt] = mfma16(kfr[ks][kk], qf[qt][kk], s[ks][qt]); }
#pragma unroll
        for (int qt = 0; qt < NQT; ++qt) { const int qi = qbase + 16 * qt + fr; float mx = -1e30f;
#pragma unroll
            for (int ks = 0; ks < 4; ++ks)
#pragma unroll
                for (int r = 0; r < 4; ++r) { const int j = kt * 64 + ks * 16 + g * 4 + r; const bool ok = (j > qi) && (j <= qi + 128) && (j >= jmin);
                    const float v = ok ? s[ks][qt][r] : -1e30f; s[ks][qt][r] = v; mx = fmaxf(mx, v); }
            mx = fmaxf(mx, __shfl_xor(mx, 16)); mx = fmaxf(mx, __shfl_xor(mx, 32));
            const float mnew = fmaxf(mrun[qt], mx), alpha = __builtin_amdgcn_exp2f(mrun[qt] - mnew); mrun[qt] = mnew;
            float ps = 0.f;
#pragma unroll
            for (int ks = 0; ks < 4; ++ks)
#pragma unroll
                for (int r = 0; r < 4; ++r) { const float p = __builtin_amdgcn_exp2f(s[ks][qt][r] - mnew); s[ks][qt][r] = p; ps += p; }
            l[qt] = l[qt] * alpha + ps;
#pragma unroll
            for (int dt = 0; dt < 4; ++dt) o[dt][qt] = o[dt][qt] * alpha; }
        { bf16x8 vfr[2][4], pf[2][NQT];
#pragma unroll
        for (int c = 0; c < 2; ++c) {
#pragma unroll
            for (int dt = 0; dt < 4; ++dt) { const bf16_t* vp = Vt + (dt * 16 + fr) * 264 + kt * 64 + c * 32 + g * 4;
                const u32x2 v0 = *(const u32x2*)vp, v1 = *(const u32x2*)(vp + 16);
                vfr[c][dt] = __builtin_bit_cast(bf16x8, (u32x4){v0.x, v0.y, v1.x, v1.y}); }
#pragma unroll
            for (int qt = 0; qt < NQT; ++qt) pf[c][qt] = pack8(s[2 * c][qt], s[2 * c + 1][qt]); }
#pragma unroll
        for (int c = 0; c < 2; ++c)
#pragma unroll
            for (int dt = 0; dt < 4; ++dt)
#pragma unroll
                for (int qt = 0; qt < NQT; ++qt) o[dt][qt] = mfma16(vfr[c][dt], pf[c][qt], o[dt][qt]); }
    }
}
__device__ __forceinline__ void attn_put(unsigned char* lds, int slot, int hh, const float* kf, const float* vf) {
    bf16_t* Ks = (bf16_t*)lds; bf16_t* Vt = (bf16_t*)(lds + 36864);
#pragma unroll
    for (int i = 0; i < 4; ++i) { u32x4 w; w.x = cvt_pk_bf16(kf[8 * i], kf[8 * i + 1]); w.y = cvt_pk_bf16(kf[8 * i + 2], kf[8 * i + 3]); w.z = cvt_pk_bf16(kf[8 * i + 4], kf[8 * i + 5]); w.w = cvt_pk_bf16(kf[8 * i + 6], kf[8 * i + 7]);
        *(u32x4*)(Ks + slot * 72 + hh * 32 + 8 * i) = w; }
#pragma unroll
    for (int i = 0; i < 32; ++i) Vt[(hh * 32 + i) * 264 + slot] = f2bf(vf[i]);
}
__device__ __forceinline__ void attn_prompt_item(const Params& P, int item, unsigned char* lds, int tid) {
    const int kvh = item & 1, n = (item >> 1) & 63, b = item >> 7;
    const bf16_t* mixin = (const bf16_t*)(P.ws + WS_MIXIN);
    { const int slot = tid >> 1, hh = tid & 1, tokb = n * 128 - 128 + slot;
        float kf[32], vf[32];
        if (tokb >= 0) { const bf16_t* rowp = mixin + (size_t)(b * 8192 + tokb) * NMIX + 2048 + kvh * 64 + hh * 32;
#pragma unroll
            for (int i = 0; i < 4; ++i) { const u32x4 kr = *(const u32x4*)(rowp + 8 * i), vr = *(const u32x4*)(rowp + 128 + 8 * i); unpack8(kr, kf + 8 * i); unpack8(vr, vf + 8 * i); } }
        else {
#pragma unroll
            for (int i = 0; i < 32; ++i) { kf[i] = 0.f; vf[i] = 0.f; } }
        float ss = 0.f;
#pragma unroll
        for (int i = 0; i < 32; ++i) ss += kf[i] * kf[i];
        ss += __shfl_xor(ss, 1);
        const float rstd = 1.0f / sqrtf(ss * (1.0f / 64.0f) + EPS);
#pragma unroll
        for (int i = 0; i < 32; ++i) kf[i] = kf[i] * rstd * P.in[13][hh * 32 + i];
        attn_put(lds, slot, hh, kf, vf);
        if (n == 63 && slot >= 128) { float* kw = P.out + O_KWP + ((size_t)(b * 128 + slot - 128) * 2 + kvh) * 64 + hh * 32; float* vw = P.out + O_VWP + ((size_t)(b * 128 + slot - 128) * 2 + kvh) * 64 + hh * 32;
#pragma unroll
            for (int i = 0; i < 8; ++i) { *(f32x4*)(kw + 4 * i) = (f32x4){kf[4 * i], kf[4 * i + 1], kf[4 * i + 2], kf[4 * i + 3]}; *(f32x4*)(vw + 4 * i) = (f32x4){vf[4 * i], vf[4 * i + 1], vf[4 * i + 2], vf[4 * i + 3]}; } }
    }
    __syncthreads();
    const int w = tid >> 6, lane = tid & 63, fr = lane & 15, g = lane >> 4, gq = w >> 1, half = w & 1, head = kvh * 4 + gq;
    bf16_t* hcat = (bf16_t*)(P.ws + WS_HCAT);
#pragma unroll 1
    for (int qh = 0; qh < 2; ++qh) {
    bf16x8 qf[2][2];
#pragma unroll
    for (int qt = 0; qt < 2; ++qt) { const int tok = b * 8192 + n * 128 + half * 64 + qh * 32 + qt * 16 + fr; const bf16_t* qp = mixin + (size_t)tok * NMIX + 1536 + head * 64 + g * 8;
        float f0[8], f1[8]; unpack8(*(const u32x4*)qp, f0); unpack8(*(const u32x4*)(qp + 32), f1);
        float ss = 0.f;
#pragma unroll
        for (int i = 0; i < 8; ++i) ss += f0[i] * f0[i] + f1[i] * f1[i];
        ss += __shfl_xor(ss, 16); ss += __shfl_xor(ss, 32);
        const float sc = (0.125f * LOG2E) / sqrtf(ss * (1.0f / 64.0f) + EPS);
#pragma unroll
        for (int i = 0; i < 8; ++i) { f0[i] = f0[i] * sc * P.in[12][g * 8 + i]; f1[i] = f1[i] * sc * P.in[12][32 + g * 8 + i]; }
        qf[qt][0] = pack8((f32x4){f0[0], f0[1], f0[2], f0[3]}, (f32x4){f0[4], f0[5], f0[6], f0[7]}); qf[qt][1] = pack8((f32x4){f1[0], f1[1], f1[2], f1[3]}, (f32x4){f1[4], f1[5], f1[6], f1[7]}); }
    f32x4 o[4][2]; float l[2];
    attn_core<2>(lds, qf, half, half + 2, half * 64 + qh * 32, n == 0 ? 128 : 0, P.in[14][head] * LOG2E, o, l);
#pragma unroll
    for (int qt = 0; qt < 2; ++qt) { float lt = l[qt]; lt += __shfl_xor(lt, 16); lt += __shfl_xor(lt, 32); const float inv = 1.0f / lt;
        const int tok = b * 8192 + n * 128 + half * 64 + qh * 32 + qt * 16 + fr;
#pragma unroll
        for (int dt = 0; dt < 4; ++dt) { const f32x4 v = o[dt][qt] * inv; u32x2 pk; pk.x = cvt_pk_bf16(v[0], v[1]); pk.y = cvt_pk_bf16(v[2], v[3]);
            *(u32x2*)(hcat + (size_t)tok * 1024 + 512 + head * 64 + dt * 16 + g * 4) = pk; } }
    }
    __syncthreads();
}
__device__ __forceinline__ void attn_sample_item(const Params& P, int item, unsigned char* lds, int tid) {
    const int kvh = item & 1, b = item >> 1;
    const bf16_t* mixin = (const bf16_t*)(P.ws + WS_MIXIN);
    { const int slot = tid >> 1, hh = tid & 1;
        if (slot < 192) { float kf[32], vf[32];
            if (slot < 128) { const size_t off = ((size_t)(b * 128 + slot) * 2 + kvh) * 64 + hh * 32; const float* kp = P.in[5] + off; const float* vp = P.in[6] + off;
#pragma unroll
                for (int i = 0; i < 8; ++i) { const f32x4 a = *(const f32x4*)(kp + 4 * i), c = *(const f32x4*)(vp + 4 * i);
                    kf[4 * i] = a[0]; kf[4 * i + 1] = a[1]; kf[4 * i + 2] = a[2]; kf[4 * i + 3] = a[3]; vf[4 * i] = c[0]; vf[4 * i + 1] = c[1]; vf[4 * i + 2] = c[2]; vf[4 * i + 3] = c[3]; } }
            else if (slot < 136) { const bf16_t* rowp = mixin + (size_t)(MP + b * 8 + slot - 128) * NMIX + 2048 + kvh * 64 + hh * 32;
#pragma unroll
                for (int i = 0; i < 4; ++i) { const u32x4 kr = *(const u32x4*)(rowp + 8 * i), vr = *(const u32x4*)(rowp + 128 + 8 * i); unpack8(kr, kf + 8 * i); unpack8(vr, vf + 8 * i); }
                float ss = 0.f;
#pragma unroll
                for (int i = 0; i < 32; ++i) ss += kf[i] * kf[i];
                ss += __shfl_xor(ss, 1);
                const float rstd = 1.0f / sqrtf(ss * (1.0f / 64.0f) + EPS);
#pragma unroll
                for (int i = 0; i < 32; ++i) kf[i] = kf[i] * rstd * P.in[13][hh * 32 + i]; }
            else {
#pragma unroll
                for (int i = 0; i < 32; ++i) { kf[i] = 0.f; vf[i] = 0.f; } }
            attn_put(lds, slot, hh, kf, vf);
            if (slot >= 8 && slot < 136) { const size_t off = ((size_t)(b * 128 + slot - 8) * 2 + kvh) * 64 + hh * 32; float* kw = P.out + O_KWS + off; float* vw = P.out + O_VWS + off;
#pragma unroll
                for (int i = 0; i < 8; ++i) { *(f32x4*)(kw + 4 * i) = (f32x4){kf[4 * i], kf[4 * i + 1], kf[4 * i + 2], kf[4 * i + 3]}; *(f32x4*)(vw + 4 * i) = (f32x4){vf[4 * i], vf[4 * i + 1], vf[4 * i + 2], vf[4 * i + 3]}; } }
        }
    }
    __syncthreads();
    const int w = tid >> 6, lane = tid & 63, fr = lane & 15, g = lane >> 4;
    if (w < 4) { const int head = kvh * 4 + w; const int tok = MP + b * 8 + (fr & 7);
        bf16x8 qf[1][2];
        { const bf16_t* qp = mixin + (size_t)tok * NMIX + 1536 + head * 64 + g * 8;
            float f0[8], f1[8]; unpack8(*(const u32x4*)qp, f0); unpack8(*(const u32x4*)(qp + 32), f1);
            float ss = 0.f;
#pragma unroll
            for (int i = 0; i < 8; ++i) ss += f0[i] * f0[i] + f1[i] * f1[i];
            ss += __shfl_xor(ss, 16); ss += __shfl_xor(ss, 32);
            const float sc = (0.125f * LOG2E) / sqrtf(ss * (1.0f / 64.0f) + EPS);
#pragma unroll
            for (int i = 0; i < 8; ++i) { f0[i] = f0[i] * sc * P.in[12][g * 8 + i]; f1[i] = f1[i] * sc * P.in[12][32 + g * 8 + i]; }
            qf[0][0] = pack8((f32x4){f0[0], f0[1], f0[2], f0[3]}, (f32x4){f0[4], f0[5], f0[6], f0[7]}); qf[0][1] = pack8((f32x4){f1[0], f1[1], f1[2], f1[3]}, (f32x4){f1[4], f1[5], f1[6], f1[7]}); }
        f32x4 o[4][1]; float l[1];
        attn_core<1>(lds, qf, 0, 2, 0, 0, P.in[14][head] * LOG2E, o, l);
        float lt = l[0]; lt += __shfl_xor(lt, 16); lt += __shfl_xor(lt, 32); const float inv = 1.0f / lt;
        bf16_t* hcat = (bf16_t*)(P.ws + WS_HCAT);
        if (fr < 8) {
#pragma unroll
            for (int dt = 0; dt < 4; ++dt) { const f32x4 v = o[dt][0] * inv; u32x2 pk; pk.x = cvt_pk_bf16(v[0], v[1]); pk.y = cvt_pk_bf16(v[2], v[3]);
                *(u32x2*)(hcat + (size_t)tok * 1024 + 512 + head * 64 + dt * 16 + g * 4) = pk; } }
    }
    __syncthreads();
}
#define LAS __attribute__((address_space(3)))
#define XB_TMO      128
#define XB_XCNT(j)  (256  + 64 * (j))
#define XB_XSUB(j)  (1280 + 64 * (j))
#define XB_XGEN(j)  (2304 + 64 * (j))
#define XB_TOP      3328
#define XB_TOPGEN   3392
#define XCD_BAR_WORDS 3456
#define XB_SPIN_CAP (1u << 18)

__device__ __forceinline__ unsigned xb_ld(unsigned* p)              { return __hip_atomic_load(p, __ATOMIC_RELAXED, __HIP_MEMORY_SCOPE_AGENT); }
__device__ __forceinline__ unsigned xb_add(unsigned* p, unsigned v) { return __hip_atomic_fetch_add(p, v, __ATOMIC_RELAXED, __HIP_MEMORY_SCOPE_AGENT); }
__device__ __forceinline__ unsigned xb_xcc_id() { return (unsigned)__builtin_amdgcn_s_getreg((3 << 11) | 20) & 0xFu; }
#define XB_SPIN(cond, bar) do { unsigned _sp = 0; while (cond) { __builtin_amdgcn_s_sleep(1); \
    if ((++_sp & 255u) == 0u) { if (xb_ld(&(bar)[XB_TMO])) break; if (_sp > XB_SPIN_CAP) { atomicAdd(&(bar)[XB_TMO], 1u); break; } } } } while (0)

struct XcdBarrier {
    unsigned* bar; unsigned x;
    volatile LAS unsigned* st;
};

__device__ __forceinline__ XcdBarrier xcd_barrier_post(unsigned* bar, volatile LAS unsigned* st) {
    XcdBarrier b; b.bar = bar; b.x = xb_xcc_id(); b.st = st;
    if (threadIdx.x == 0) (void)xb_add(&bar[XB_XCNT(b.x)], 1u);
    return b;
}
__device__ __forceinline__ void xcd_barrier_complete(unsigned* bar, unsigned x, unsigned& nloc, unsigned& nx) {
    const unsigned G = gridDim.x * gridDim.y * gridDim.z;
    unsigned sum, cnt, mine, sp = 0u;
    for (;;) {
        sum = 0u; cnt = 0u; mine = 0u;
#pragma unroll
        for (unsigned j = 0; j < 16; ++j) { const unsigned c = xb_ld(&bar[XB_XCNT(j)]); sum += c; cnt += (c > 0u) ? 1u : 0u; mine = (j == x) ? c : mine; }
        if (sum == G) break;
        __builtin_amdgcn_s_sleep(1);
        if ((++sp & 255u) == 0u) { if (xb_ld(&bar[XB_TMO])) break; if (sp > XB_SPIN_CAP) { atomicAdd(&bar[XB_TMO], 1u); break; } }
    }
    nloc = mine > 0u ? mine : 1u; nx = cnt > 0u ? cnt : 1u;
}

__device__ __forceinline__ void xcd_barrier(const XcdBarrier& b) {
    asm volatile("s_waitcnt vmcnt(0)" ::: "memory");
    __syncthreads();
    if (threadIdx.x == 0) {
        unsigned* bar = b.bar;
        __builtin_amdgcn_s_waitcnt(0);
        unsigned nloc = b.st[0], nx = b.st[1];
        if (nloc == 0u) { xcd_barrier_complete(bar, b.x, nloc, nx); b.st[0] = nloc; b.st[1] = nx; }
        const unsigned old = xb_add(&bar[XB_XSUB(b.x)], 1u);
        const unsigned gen = old / nloc;
        if (old + 1u == (gen + 1u) * nloc) {
            __builtin_amdgcn_fence(__ATOMIC_RELEASE, "agent");
            asm volatile("s_waitcnt vmcnt(0)" ::: "memory");
            const unsigned og = xb_add(&bar[XB_TOP], 1u);
            const unsigned tg = og / nx;
            if (og + 1u == (tg + 1u) * nx) xb_add(&bar[XB_TOPGEN], 1u);
            else XB_SPIN(xb_ld(&bar[XB_TOPGEN]) == tg, bar);
            __builtin_amdgcn_fence(__ATOMIC_ACQUIRE, "agent");
            xb_add(&bar[XB_XGEN(b.x)], 1u);
            asm volatile("s_waitcnt vmcnt(0)" ::: "memory");
        } else {
            XB_SPIN(xb_ld(&bar[XB_XGEN(b.x)]) == gen, bar);
            __builtin_amdgcn_fence(__ATOMIC_ACQUIRE, "agent");
            asm volatile("s_waitcnt vmcnt(0)" ::: "memory");
        }
    }
    __syncthreads();
}
__device__ __forceinline__ void mlstm_b_item(const Params& P, int item, unsigned char* lds, int tid) {
    const int c = item & 127, h = (item >> 7) & 3, b = item >> 9, r0 = b * 8192 + c * 64;
    float* wl = (float*)lds; bf16_t* Kt = (bf16_t*)(lds + 256); bf16_t* Vt = (bf16_t*)(lds + 256 + 9216);
    const bf16_t* mixin = (const bf16_t*)(P.ws + WS_MIXIN);
    const int s_ = tid >> 3, ch_ = tid & 7; const bf16_t* rowp_ = mixin + (size_t)(r0 + s_) * NMIX;
    const u32x4 kr_ = *(const u32x4*)(rowp_ + 256 + h * 64 + ch_ * 8), v0_ = *(const u32x4*)(rowp_ + 512 + h * 128 + ch_ * 16), v1_ = *(const u32x4*)(rowp_ + 512 + h * 128 + ch_ * 16 + 8);
    if (tid < 64) { const float iv = ((const float*)(P.ws + WS_GI))[(r0 + tid) * 4 + h]; float bb = ((const float*)(P.ws + WS_GB))[(r0 + tid) * 4 + h];
#pragma unroll
        for (int o = 1; o < 64; o <<= 1) { const float nb = __shfl_up(bb, o); if (tid >= o) bb += nb; }
        const float A = __shfl(bb, 63), v = A - bb + iv, M = wave_max(v); wl[tid] = __expf(v - M) * 0.125f;
        if (tid == 0) { ((float*)(P.ws + WS_SUMA))[item] = A; ((float*)(P.ws + WS_SUMM))[item] = M; } }
    __syncthreads();
    { const int s = s_, ch = ch_; const float ws_ = wl[s];
        float kf[8]; unpack8(kr_, kf);
#pragma unroll
        for (int i = 0; i < 8; ++i) Kt[(ch * 8 + i) * 72 + s] = f2bf(kf[i] * ws_);
        const unsigned vv[8] = {v0_.x, v0_.y, v0_.z, v0_.w, v1_.x, v1_.y, v1_.z, v1_.w};
#pragma unroll
        for (int i = 0; i < 8; ++i) { Vt[(ch * 16 + 2 * i) * 72 + s] = (bf16_t)(vv[i] & 0xffffu); Vt[(ch * 16 + 2 * i + 1) * 72 + s] = (bf16_t)(vv[i] >> 16); } }
    __syncthreads();
    { const int w = tid >> 6, lane = tid & 63, fr = lane & 15, g = lane >> 4, e0 = 16 * w;
        f32x4 acc[4];
#pragma unroll
        for (int dt = 0; dt < 4; ++dt) acc[dt] = (f32x4){0.f, 0.f, 0.f, 0.f};
        bf16x8 vfr[2], kfr[2][4];
#pragma unroll
        for (int kk = 0; kk < 2; ++kk) { vfr[kk] = *(const bf16x8*)(Vt + (e0 + fr) * 72 + g * 8 + kk * 32);
#pragma unroll
            for (int dt = 0; dt < 4; ++dt) kfr[kk][dt] = *(const bf16x8*)(Kt + (dt * 16 + fr) * 72 + g * 8 + kk * 32); }
#pragma unroll
        for (int kk = 0; kk < 2; ++kk)
#pragma unroll
            for (int dt = 0; dt < 4; ++dt) acc[dt] = mfma16(kfr[kk][dt], vfr[kk], acc[dt]);
        bf16_t* dct = (bf16_t*)((unsigned char*)P.out + OB_DCT) + ((size_t)item * 128 + e0 + fr) * 64;
#pragma unroll
        for (int dt = 0; dt < 4; ++dt) { u32x2 pk; pk.x = cvt_pk_bf16(acc[dt][0], acc[dt][1]); pk.y = cvt_pk_bf16(acc[dt][2], acc[dt][3]); *(u32x2*)(dct + dt * 16 + g * 4) = pk; } }
    if (tid < 64) { float sum = 0.f;
#pragma unroll 8
        for (int s = 0; s < 64; ++s) sum += bf2f(Kt[tid * 72 + s]);
        ((float*)(P.ws + WS_DN))[item * 64 + tid] = sum; }
    __syncthreads();
}
__device__ __forceinline__ void mlstm_scan(const Params& P, unsigned char* lds, int tid) {
    const int pair = blockIdx.x >> 3, sub = blockIdx.x & 7;
    float* ga = (float*)lds; float* ea = ga + 128; float* marr = ea + 128;
    if (tid < 128) { ga[tid] = ((const float*)(P.ws + WS_SUMA))[pair * 128 + tid]; ea[tid] = ((const float*)(P.ws + WS_SUMM))[pair * 128 + tid]; }
    __syncthreads();
    if (tid == 0) { float m = 0.f; const float* sA = ga; const float* sM = ea;
        for (int c = 0; c < 128; ++c) { const float A = sA[c], Mv = sM[c], mn = fmaxf(A + m, Mv); ga[c] = __expf(A + m - mn); ea[c] = __expf(Mv - mn); m = mn; marr[c] = mn; } }
    __syncthreads();
    if (sub == 0) { if (tid < 128) ((float*)(P.ws + WS_MCH))[pair * 128 + tid] = marr[tid]; if (tid == 0) P.out[O_MP + pair] = marr[127]; }
#ifndef P3_SCANMASK
#define P3_SCANMASK 3
#endif
    if (P3_SCANMASK & 1) { const int idx2 = sub * 512 + tid; float C0 = 0.f, C1 = 0.f;
        const unsigned* src = (const unsigned*)((unsigned char*)P.out + OB_DCT) + (size_t)pair * 128 * 4096 + idx2; unsigned* dst = (unsigned*)((unsigned char*)P.out + OB_CPT) + (size_t)pair * 128 * 4096 + idx2;
#pragma unroll 1
        for (int c = 0; c < 128; c += 32) { unsigned v[32];
#pragma unroll
            for (int j = 0; j < 32; ++j) v[j] = src[(size_t)(c + j) * 4096];
#pragma unroll
            for (int j = 0; j < 32; ++j) { dst[(size_t)(c + j) * 4096] = cvt_pk_bf16(C0, C1); const float gg = ga[c + j], ee = ea[c + j]; C0 = gg * C0 + ee * bflo(v[j]); C1 = gg * C1 + ee * bfhi(v[j]); } }
        const int i0 = 2 * idx2, e = i0 >> 6, d = i0 & 63;
        P.out[O_CP + ((size_t)pair * 64 + d) * 128 + e] = C0; P.out[O_CP + ((size_t)pair * 64 + d + 1) * 128 + e] = C1; }
    if ((P3_SCANMASK & 2) && sub == 0 && tid < 64) { float nn = 0.f; const float* dn = (const float*)(P.ws + WS_DN) + (size_t)pair * 128 * 64 + tid; float* np = (float*)(P.ws + WS_NPREV) + (size_t)pair * 128 * 64 + tid;
#pragma unroll 1
        for (int c = 0; c < 128; c += 32) { float dv[32];
#pragma unroll
            for (int j = 0; j < 32; ++j) dv[j] = dn[(c + j) * 64];
#pragma unroll
            for (int j = 0; j < 32; ++j) { np[(c + j) * 64] = nn; nn = ga[c + j] * nn + ea[c + j] * dv[j]; } }
        P.out[O_NP + pair * 64 + tid] = nn; }
    __syncthreads();
}
__device__ __forceinline__ void mlstm_sample_item(const Params& P, int item, unsigned char* lds, int tid) {
    const int h = item & 3, b = item >> 2, r0 = MP + b * 8;
    float* q = (float*)lds; float* k = q + 512; float* v = k + 512; float* sw = v + 1024; float* sc = sw + 64; float* n0s = sc + 64; float* part = n0s + 64; float* red = part + 4096;
    const bf16_t* mixin = (const bf16_t*)(P.ws + WS_MIXIN);
    if (tid < 256) {
        const int sel = tid >> 6, i = tid & 63;
        if (sel < 2) { const int t = i >> 3, p = i & 7; float f[8]; unpack8(*(const u32x4*)(mixin + (size_t)(r0 + t) * NMIX + sel * 256 + h * 64 + p * 8), f);
            float* dst = (sel ? k : q) + (p * 8) * 8 + t; const float sc_ = sel ? 0.125f : 1.0f;
#pragma unroll
            for (int j = 0; j < 8; ++j) dst[j * 8] = f[j] * sc_; }
        else { const int i2 = tid - 128, t = i2 >> 4, p = i2 & 15; float f[8]; unpack8(*(const u32x4*)(mixin + (size_t)(r0 + t) * NMIX + 512 + h * 128 + p * 8), f);
#pragma unroll
            for (int j = 0; j < 8; ++j) v[t * 128 + p * 8 + j] = f[j]; } }
    if (tid < 64) n0s[tid] = P.in[3][(b * 4 + h) * 64 + tid];
    if (tid < 8) { float lf[8];
#pragma unroll
        for (int s = 0; s < 8; ++s) lf[s] = ((const float*)(P.ws + WS_GB))[(r0 + s) * 4 + h];
        float bb = 0.f;
#pragma unroll
        for (int s = 0; s < 8; ++s) bb += (s <= tid) ? lf[s] : 0.f;
        sc[tid] = bb; sc[8 + tid] = ((const float*)(P.ws + WS_GI))[(r0 + tid) * 4 + h] - bb; }
    __syncthreads();
    const float mprev = P.in[4][b * 4 + h];
    if (tid < 8) { float cm = mprev; for (int s = 0; s <= tid; ++s) cm = fmaxf(cm, sc[8 + s]); const float mt = sc[tid] + cm; sc[16 + tid] = mt; sc[24 + tid] = __expf(sc[tid] + mprev - mt); }
    __syncthreads();
    if (tid < 8) { const float b7 = sc[7], m7 = sc[23]; sc[32 + tid] = __expf(b7 + sc[8 + tid] - m7); if (tid == 0) { sc[48] = __expf(b7 + mprev - m7); P.out[O_MS + b * 4 + h] = m7; } }
    if (tid >= 64 && tid < 128) { const int i = tid - 64, t = i >> 3, s = i & 7; float dot = 0.f;
        for (int d = 0; d < 64; ++d) dot += q[d * 8 + t] * k[d * 8 + s];
        sw[i] = (s <= t) ? dot * __expf(sc[t] + sc[8 + s] - sc[16 + t]) : 0.f; }
    if (tid >= 128 && tid < 136) { const int t = tid - 128; float qn = 0.f; for (int d = 0; d < 64; ++d) qn += q[d * 8 + t] * n0s[d]; sc[40 + t] = qn; }
    __syncthreads();
    { const int e = tid & 127, dq = tid >> 7; const float gd = sc[48]; float num[8], wv[8];
#pragma unroll
        for (int t = 0; t < 8; ++t) { num[t] = 0.f; wv[t] = sc[32 + t] * v[t * 128 + e]; }
        float c0v[16];
#pragma unroll
        for (int dd = 0; dd < 16; ++dd) c0v[dd] = P.in[2][((size_t)(b * 4 + h) * 64 + dq * 16 + dd) * 128 + e];
#pragma unroll
        for (int dd = 0; dd < 16; ++dd) { const int d = dq * 16 + dd; const size_t ic = ((size_t)(b * 4 + h) * 64 + d) * 128 + e; const float c0 = c0v[dd];
            const f32x4 k0 = *(const f32x4*)(k + d * 8), k1 = *(const f32x4*)(k + d * 8 + 4), q0 = *(const f32x4*)(q + d * 8), q1 = *(const f32x4*)(q + d * 8 + 4);
            const float upd = (k0[0] * wv[0] + k0[1] * wv[1]) + (k0[2] * wv[2] + k0[3] * wv[3]) + (k1[0] * wv[4] + k1[1] * wv[5]) + (k1[2] * wv[6] + k1[3] * wv[7]);
            P.out[O_CS + ic] = gd * c0 + upd;
            num[0] += q0[0] * c0; num[1] += q0[1] * c0; num[2] += q0[2] * c0; num[3] += q0[3] * c0; num[4] += q1[0] * c0; num[5] += q1[1] * c0; num[6] += q1[2] * c0; num[7] += q1[3] * c0; }
#pragma unroll
        for (int t = 0; t < 8; ++t) part[(dq * 8 + t) * 128 + e] = num[t]; }
    if (tid < 64) { float nn = sc[48] * n0s[tid];
#pragma unroll
        for (int s = 0; s < 8; ++s) nn += sc[32 + s] * k[tid * 8 + s];
        P.out[O_NS + (b * 4 + h) * 64 + tid] = nn; }
    __syncthreads();
    { const int e = tid & 127, tq = tid >> 7, w = tid >> 6, lane = tid & 63; float hv[2];
#pragma unroll
        for (int u = 0; u < 2; ++u) { const int t = tq * 2 + u; float inter = 0.f, intra = 0.f, rs = 0.f;
#pragma unroll
            for (int dq = 0; dq < 4; ++dq) inter += part[(dq * 8 + t) * 128 + e];
#pragma unroll
            for (int s = 0; s < 8; ++s) { intra += sw[t * 8 + s] * v[s * 128 + e]; rs += sw[t * 8 + s]; }
            const float wi = sc[24 + t], den = wi * sc[40 + t] + rs; hv[u] = (wi * inter + intra) / fmaxf(fabsf(den), __expf(-sc[16 + t])); }
        const float s0 = wave_sum(hv[0] * hv[0]), s1 = wave_sum(hv[1] * hv[1]);
        if (lane == 0) { red[w * 2] = s0; red[w * 2 + 1] = s1; }
        __syncthreads();
        bf16_t* hcat = (bf16_t*)(P.ws + WS_HCAT);
#pragma unroll
        for (int u = 0; u < 2; ++u) { const int t = tq * 2 + u; const float tot = red[(w & ~1) * 2 + u] + red[(w | 1) * 2 + u]; const float rstd = 1.0f / sqrtf(tot * (1.0f / 128.0f) + EPS);
            const float so = bf2f(mixin[(size_t)(r0 + t) * NMIX + 1024 + h * 128 + e]);
            hcat[(size_t)(r0 + t) * 1024 + h * 128 + e] = f2bf(hv[u] * rstd * P.in[11][h * 128 + e] * so); } }
    __syncthreads();
}
__device__ __forceinline__ void mlstm_d_item(const Params& P, int item, unsigned char* lds, int tid) {
    const int c = item & 127, h = (item >> 7) & 3, b = item >> 9, r0 = b * 8192 + c * 64, pair = item >> 7;
    float* lb = (float*)lds; float* lu = lb + 64; float* lm = lb + 128; float* misc = lb + 192; float* npv = lb + 256; float* red = lb + 320;
    bf16_t* Kn = (bf16_t*)(lds + 2048); bf16_t* Vt = (bf16_t*)(lds + 11264); bf16_t* Cs = (bf16_t*)(lds + 29696);
    const bf16_t* mixin = (const bf16_t*)(P.ws + WS_MIXIN);
    { const int s = tid >> 3, ch = tid & 7; const bf16_t* rowp = mixin + (size_t)(r0 + s) * NMIX;
        *(u32x4*)(Kn + s * 72 + ch * 8) = *(const u32x4*)(rowp + 256 + h * 64 + ch * 8);
        const u32x4 v0 = *(const u32x4*)(rowp + 512 + h * 128 + ch * 16), v1 = *(const u32x4*)(rowp + 512 + h * 128 + ch * 16 + 8);
        const unsigned vv[8] = {v0.x, v0.y, v0.z, v0.w, v1.x, v1.y, v1.z, v1.w};
#pragma unroll
        for (int i = 0; i < 8; ++i) { Vt[(ch * 16 + 2 * i) * 72 + s] = (bf16_t)(vv[i] & 0xffffu); Vt[(ch * 16 + 2 * i + 1) * 72 + s] = (bf16_t)(vv[i] >> 16); }
        const bf16_t* cp = (const bf16_t*)((unsigned char*)P.out + OB_CPT) + (size_t)item * 8192;
#pragma unroll
        for (int j = 0; j < 2; ++j) { const int idx = tid + 512 * j, e = idx >> 3, dch = idx & 7; *(u32x4*)(Cs + e * 72 + dch * 8) = *(const u32x4*)(cp + e * 64 + dch * 8); } }
    if (tid < 64) { const float iv = ((const float*)(P.ws + WS_GI))[(r0 + tid) * 4 + h]; float bb = ((const float*)(P.ws + WS_GB))[(r0 + tid) * 4 + h];
#pragma unroll
        for (int o = 1; o < 64; o <<= 1) { const float nb = __shfl_up(bb, o); if (tid >= o) bb += nb; }
        const float mprev = c ? ((const float*)(P.ws + WS_MCH))[pair * 128 + c - 1] : 0.f;
        const float u = iv - bb; float cm = u;
#pragma unroll
        for (int o = 1; o < 64; o <<= 1) { const float nb = __shfl_up(cm, o); if (tid >= o) cm = fmaxf(cm, nb); }
        lb[tid] = bb; lu[tid] = u; lm[tid] = bb + fmaxf(mprev, cm); if (tid == 0) misc[0] = mprev;
        npv[tid] = ((const float*)(P.ws + WS_NPREV))[(size_t)item * 64 + tid]; }
    const int w = tid >> 6, lane = tid & 63, fr = lane & 15, g = lane >> 4, tt = w & 3, eh = w >> 2, t = tt * 16 + fr, tok = r0 + t;
    bf16x8 qf[2]; float qv0[8], qv1[8]; u32x2 so_[4]; f32x4 mw_[4];
    { const bf16_t* qp = mixin + (size_t)tok * NMIX + h * 64 + g * 8; const u32x4 a = *(const u32x4*)qp, bq = *(const u32x4*)(qp + 32);
        qf[0] = __builtin_bit_cast(bf16x8, a); qf[1] = __builtin_bit_cast(bf16x8, bq); unpack8(a, qv0); unpack8(bq, qv1);
#pragma unroll
        for (int et = 0; et < 4; ++et) { const int e0 = eh * 64 + et * 16 + g * 4; so_[et] = *(const u32x2*)(mixin + (size_t)tok * NMIX + 1024 + h * 128 + e0); mw_[et] = *(const f32x4*)(P.in[11] + h * 128 + e0); } }
    __syncthreads();
    f32x4 s[4];
    { bf16x8 kfr[4][2];
#pragma unroll
    for (int st = 0; st < 4; ++st)
#pragma unroll
        for (int kk = 0; kk < 2; ++kk) kfr[st][kk] = *(const bf16x8*)(Kn + (st * 16 + fr) * 72 + g * 8 + kk * 32);
#pragma unroll
    for (int st = 0; st < 4; ++st) { s[st] = (f32x4){0.f, 0.f, 0.f, 0.f};
#pragma unroll
        for (int kk = 0; kk < 2; ++kk) s[st] = mfma16(kfr[st][kk], qf[kk], s[st]); } }
    const float bt = lb[t], mt = lm[t], mprev = misc[0];
    float rs = 0.f;
#pragma unroll
    for (int st = 0; st < 4; ++st)
#pragma unroll
        for (int r = 0; r < 4; ++r) { const int si = st * 16 + g * 4 + r; const float wv = (si <= t) ? __expf(bt + lu[si] - mt) : 0.f; const float val = s[st][r] * 0.125f * wv; s[st][r] = val; rs += val; }
    rs += __shfl_xor(rs, 16); rs += __shfl_xor(rs, 32);
    float qn = 0.f;
#pragma unroll
    for (int i = 0; i < 8; ++i) qn += qv0[i] * npv[g * 8 + i] + qv1[i] * npv[32 + g * 8 + i];
    qn += __shfl_xor(qn, 16); qn += __shfl_xor(qn, 32);
    const float wi = __expf(bt + mprev - mt), den = wi * qn + rs, inv = 1.0f / fmaxf(fabsf(den), __expf(-mt));
    bf16x8 pf[2]; pf[0] = pack8(s[0], s[1]); pf[1] = pack8(s[2], s[3]);
    f32x4 h1[4], h2[4];
    { bf16x8 vfr[4][2], cfr[4][2];
#pragma unroll
    for (int et = 0; et < 4; ++et) { const int e = eh * 64 + et * 16 + fr;
#pragma unroll
        for (int cc = 0; cc < 2; ++cc) { const bf16_t* vp = Vt + e * 72 + cc * 32 + g * 4; const u32x2 v0 = *(const u32x2*)vp, v1 = *(const u32x2*)(vp + 16);
            vfr[et][cc] = __builtin_bit_cast(bf16x8, (u32x4){v0.x, v0.y, v1.x, v1.y}); cfr[et][cc] = *(const bf16x8*)(Cs + e * 72 + g * 8 + cc * 32); } }
#pragma unroll
    for (int et = 0; et < 4; ++et) { h1[et] = (f32x4){0.f, 0.f, 0.f, 0.f}; h2[et] = (f32x4){0.f, 0.f, 0.f, 0.f};
#pragma unroll
        for (int cc = 0; cc < 2; ++cc) { h2[et] = mfma16(vfr[et][cc], pf[cc], h2[et]); h1[et] = mfma16(cfr[et][cc], qf[cc], h1[et]); } } }
    float ss = 0.f;
#pragma unroll
    for (int et = 0; et < 4; ++et)
#pragma unroll
        for (int r = 0; r < 4; ++r) { const float hv = (wi * h1[et][r] + h2[et][r]) * inv; h2[et][r] = hv; ss += hv * hv; }
    ss += __shfl_xor(ss, 16); ss += __shfl_xor(ss, 32);
    if (g == 0) red[w * 16 + fr] = ss;
    __syncthreads();
    { const float tot = red[w * 16 + fr] + red[(w ^ 4) * 16 + fr]; const float rstd = 1.0f / sqrtf(tot * (1.0f / 128.0f) + EPS);
        bf16_t* hcat = (bf16_t*)(P.ws + WS_HCAT);
#pragma unroll
        for (int et = 0; et < 4; ++et) { const int e0 = eh * 64 + et * 16 + g * 4; const u32x2 so = so_[et]; const f32x4 mw = mw_[et];
            const float o0 = h2[et][0] * rstd * mw[0] * bflo(so.x), o1 = h2[et][1] * rstd * mw[1] * bfhi(so.x), o2 = h2[et][2] * rstd * mw[2] * bflo(so.y), o3 = h2[et][3] * rstd * mw[3] * bfhi(so.y);
            u32x2 pk; pk.x = cvt_pk_bf16(o0, o1); pk.y = cvt_pk_bf16(o2, o3); *(u32x2*)(hcat + (size_t)tok * 1024 + h * 128 + e0) = pk; } }
    __syncthreads();
}


__device__ __forceinline__ void tail_mma(unsigned char* lds, const bf16_t* A, const bf16_t* Bt, int K, int r0, int c0, int nchunk, int nseg0, int tid, f32x4 (&acc)[2][2]) {
    const int w = tid >> 6, lane = tid & 63, fr = lane & 15, g = lane >> 4, wr = w & 3, wc = w >> 2;
    const bf16_t* gp[4]; unsigned lo_[4];
#pragma unroll
    for (int j = 0; j < 4; ++j) { const int idx = tid + 512 * j, mat = idx >> 10, rem = idx & 1023, row = rem >> 4, seg = rem & 15;
        gp[j] = (mat ? Bt + (size_t)(c0 + row) * K : A + (size_t)(r0 + row) * K) + seg * 8; lo_[j] = (unsigned)(mat * 17408 + row * 272 + seg * 16); }
    u32x4 st[4], st2[4];
#pragma unroll
    for (int j = 0; j < 4; ++j) st[j] = *(const u32x4*)gp[j];
#pragma unroll
    for (int j = 0; j < 4; ++j) *(u32x4*)(lds + lo_[j]) = st[j];
    if (nchunk > 1) {
#pragma unroll
        for (int j = 0; j < 4; ++j) st[j] = *(const u32x4*)(gp[j] + 128); }
    __syncthreads();
    const unsigned aoff = (unsigned)((16 * wr + fr) * 272 + g * 16), boff = (unsigned)(17408 + (32 * wc + fr) * 272 + g * 16);
#pragma unroll 1
    for (int ch = 0; ch < nchunk; ++ch) {
        const unsigned cur = (unsigned)(ch & 1) * 34816u, nxt = 34816u - cur;
        if (ch + 2 < nchunk) {
#pragma unroll
            for (int j = 0; j < 4; ++j) st2[j] = *(const u32x4*)(gp[j] + (size_t)(ch + 2) * 128); }
        bf16x8 fa[4], f0[4], f1[4];
#pragma unroll
        for (int kk = 0; kk < 4; ++kk) { fa[kk] = *(const bf16x8*)(lds + cur + aoff + kk * 64); f0[kk] = *(const bf16x8*)(lds + cur + boff + kk * 64); f1[kk] = *(const bf16x8*)(lds + cur + boff + 16 * 272 + kk * 64); }
        if (ch < nseg0) {
#pragma unroll
            for (int kk = 0; kk < 4; ++kk) { acc[0][0] = mfma16(f0[kk], fa[kk], acc[0][0]); acc[0][1] = mfma16(f1[kk], fa[kk], acc[0][1]); } }
        else {
#pragma unroll
            for (int kk = 0; kk < 4; ++kk) { acc[1][0] = mfma16(f0[kk], fa[kk], acc[1][0]); acc[1][1] = mfma16(f1[kk], fa[kk], acc[1][1]); } }
        if (ch + 1 < nchunk) {
#pragma unroll
            for (int j = 0; j < 4; ++j) *(u32x4*)(lds + nxt + lo_[j]) = st[j]; }
        __syncthreads();
#pragma unroll
        for (int j = 0; j < 4; ++j) st[j] = st2[j];
    }
}
__device__ __forceinline__ void tail_mix(const Params& P, unsigned char* lds, int tb, int tid) {
    const int w = tid >> 6, lane = tid & 63, fr = lane & 15, g = lane >> 4, tok = MP + (tb >> 4) * 64 + 16 * (w & 3) + fr, col0 = (tb & 15) * 64 + 32 * (w >> 2);
    const bf16_t* hcat = (const bf16_t*)(P.ws + WS_HCAT); const bf16_t* wab = (const bf16_t*)(P.ws + WS_WAB); const bf16_t* gates = (const bf16_t*)(P.ws + WS_GATES); bf16_t* mix = (bf16_t*)(P.ws + WS_MIXIN);
    f32x4 ab[2][2]; ab[0][0] = ab[0][1] = ab[1][0] = ab[1][1] = (f32x4){0.f, 0.f, 0.f, 0.f};
    tail_mma(lds, hcat, wab, 1024, MP + (tb >> 4) * 64, (tb & 15) * 64, 8, 4, tid, ab);
    const f32x4 (&a)[2] = ab[0]; const f32x4 (&b)[2] = ab[1];
#pragma unroll
    for (int mt = 0; mt < 2; ++mt) { const int c = col0 + mt * 16 + g * 4; const u32x2 sa = *(const u32x2*)(gates + (size_t)tok * 2048 + c), sb = *(const u32x2*)(gates + (size_t)tok * 2048 + 1024 + c);
        const float v0 = bflo(sa.x) * a[mt][0] + bflo(sb.x) * b[mt][0], v1 = bfhi(sa.x) * a[mt][1] + bfhi(sb.x) * b[mt][1], v2 = bflo(sa.y) * a[mt][2] + bflo(sb.y) * b[mt][2], v3 = bfhi(sa.y) * a[mt][3] + bfhi(sb.y) * b[mt][3];
        u32x2 pk; pk.x = cvt_pk_bf16(v0, v1); pk.y = cvt_pk_bf16(v2, v3); *(u32x2*)(mix + (size_t)tok * 1024 + c) = pk; }
}
__device__ __forceinline__ void tail_out(const Params& P, unsigned char* lds, int tb, int tid) {
    const int w = tid >> 6, lane = tid & 63, fr = lane & 15, g = lane >> 4, tok = MP + (tb >> 4) * 64 + 16 * (w & 3) + fr, col0 = (tb & 15) * 64 + 32 * (w >> 2);
    f32x4 ab[2][2]; ab[0][0] = ab[0][1] = ab[1][0] = ab[1][1] = (f32x4){0.f, 0.f, 0.f, 0.f};
    tail_mma(lds, (const bf16_t*)(P.ws + WS_MIXIN), (const bf16_t*)(P.ws + WS_WOUT), 1024, MP + (tb >> 4) * 64, (tb & 15) * 64, 8, 8, tid, ab);
    const f32x4 (&acc)[2] = ab[0];
    const float* xrow = P.in[1] + (size_t)(tok - MP) * 1024; bf16_t* x1b = (bf16_t*)(P.ws + WS_HN); float ss = 0.f;
#pragma unroll
    for (int mt = 0; mt < 2; ++mt) { const int c = col0 + mt * 16 + g * 4; const f32x4 y = *(const f32x4*)(xrow + c) + acc[mt];
        ss += (y[0] * y[0] + y[1] * y[1]) + (y[2] * y[2] + y[3] * y[3]);
        u32x2 pk; pk.x = cvt_pk_bf16(y[0], y[1]); pk.y = cvt_pk_bf16(y[2], y[3]); *(u32x2*)(x1b + (size_t)tok * 1024 + c) = pk; }
    ss += __shfl_xor(ss, 16); ss += __shfl_xor(ss, 32);
    if (g == 0) unsafeAtomicAdd((float*)(P.ws + WS_ROWSS) + tok, ss);
}
__device__ __forceinline__ void tail_down(const Params& P, unsigned char* lds, int tb, int tid) {
    const int w = tid >> 6, lane = tid & 63, fr = lane & 15, g = lane >> 4, tok = MP + (tb >> 4) * 64 + 16 * (w & 3) + fr, col0 = (tb & 15) * 64 + 32 * (w >> 2);
    f32x4 ab[2][2]; ab[0][0] = ab[0][1] = ab[1][0] = ab[1][1] = (f32x4){0.f, 0.f, 0.f, 0.f};
    tail_mma(lds, (const bf16_t*)(P.ws + WS_MIXIN), (const bf16_t*)(P.ws + WS_WD), DFF, MP + (tb >> 4) * 64, (tb & 15) * 64, 22, 22, tid, ab);
    const f32x4 (&acc)[2] = ab[0];
#pragma unroll
    for (int mt = 0; mt < 2; ++mt) { const size_t o = (size_t)tok * 1024 + col0 + mt * 16 + g * 4; const u32x2 r = *(const u32x2*)((const bf16_t*)(P.ws + WS_HN) + o);
        *(f32x4*)(P.out + o) = (f32x4){bflo(r.x), bfhi(r.x), bflo(r.y), bfhi(r.y)} + acc[mt]; }
}
#define GSYNC_F(grid) xcd_barrier(xbar)
__global__ void __launch_bounds__(512, 2) fwd_kernel(Params P) {
    extern __shared__ __attribute__((aligned(16))) unsigned char lds[];
    cg::grid_group grid = cg::this_grid();
    const int tid = threadIdx.x, G = gridDim.x;
    const int lo = P.ph_lo, hi = P.ph_hi;
    volatile LAS unsigned* xst = (volatile LAS unsigned*)((LAS unsigned char*)lds + 131072);
    if (tid < 4) xst[tid] = 0u;
    __syncthreads();
    XcdBarrier xbar = xcd_barrier_post((unsigned*)(P.ws + WS_BAR), xst);
#ifndef PHASE_MASK
#define PHASE_MASK 0x1ff
#endif
#define IN(k) (((PHASE_MASK >> (k)) & 1) && lo <= (k) && (k) < hi)
#define GSYNC() xcd_barrier(xbar)
#define SEAM(k) do { if (IN(k) && IN((k) + 1)) GSYNC(); } while (0)
#ifndef DUP_MASK
#define DUP_MASK 0
#endif
#ifndef EXTRA_SYNCS
#define EXTRA_SYNCS 0
#endif
#define REP(k) for (int rep_ = 0; rep_ <= ((DUP_MASK >> (k)) & 1); ++rep_) if (rep_ == 0 || (GSYNC_F(grid), true))
    bf16_t* HN = (bf16_t*)(P.ws + WS_HN); bf16_t* MIXIN = (bf16_t*)(P.ws + WS_MIXIN); bf16_t* GATES = (bf16_t*)(P.ws + WS_GATES); bf16_t* HCAT = (bf16_t*)(P.ws + WS_HCAT);
    PG8_LAS unsigned char* ldsa = (PG8_LAS unsigned char*)lds;
    if (IN(0)) REP(0) p0_prep(P, lds, tid, G);
    if (lo < 0) grid.sync();
    SEAM(0);
    for (int xs_ = 0; xs_ < EXTRA_SYNCS; ++xs_) GSYNC();
    if (IN(1)) REP(1) { pg8::Gemm g{HN, (const bf16_t*)(P.ws + WS_WIN), MT, NPROJ, 1024}; pg8::StaticOrder S; S.init(MT, NPROJ, G, (int)blockIdx.x);
        pg8::EpiProj E{MIXIN, GATES}; pg8::gemm_phase<pg8::EpiProj, pg8::StaticOrder, true, true>(ldsa, g, S, E);
        { const int nfull = (MT / 256) * (NPROJ / 256) / G, nlast = (MT / 256) * (NPROJ / 256) - nfull * G;
            if (nlast > 0 && nlast < G && (int)blockIdx.x >= nlast) for (int it = NT_IN + (int)blockIdx.x - nlast; it < NT_ALL; it += G - nlast) wtile_by_index(P, it, lds, tid);
            else if (nlast == 0 || nlast >= G) for (int it = NT_IN + (int)blockIdx.x; it < NT_ALL; it += G) wtile_by_index(P, it, lds, tid); } }
    SEAM(1);
    if (IN(2)) REP(2) {
        for (int it = blockIdx.x; it < 256 + 256 + 1024; it += G) {
            if (it < 256) attn_prompt_item(P, it, lds, tid);
            else if (it < 512) attn_sample_item(P, it - 256, lds, tid);
            else mlstm_b_item(P, it - 512, lds, tid);
        } }
    SEAM(2);
    if (IN(3)) REP(3) {
        const int nscan = (G > 64) ? 64 : 0;
#ifndef P3_VARIANT
#define P3_VARIANT 3
#endif
        if (nscan) { if ((int)blockIdx.x < 64) { if (P3_VARIANT & 1) mlstm_scan(P, lds, tid); } else if (P3_VARIANT & 2) { for (int it = blockIdx.x - 64; it < 512; it += G - 64) mlstm_sample_item(P, it, lds, tid); } }
        else { for (int it = blockIdx.x; it < 512; it += G) mlstm_sample_item(P, it, lds, tid); }
    }
    SEAM(3);
    if (IN(4)) REP(4) { for (int it = blockIdx.x; it < 1024; it += G) mlstm_d_item(P, it, lds, tid); }
    SEAM(4);
    if (IN(5)) REP(5) { pg8::Gemm g{HCAT, (const bf16_t*)(P.ws + WS_WAB), MP, 1024, 1024}; pg8::StaticOrder S; S.init(MP, 1024, G, (int)blockIdx.x);
        pg8::EpiMix E{GATES, MIXIN}; pg8::gemm_phase<pg8::EpiMix, pg8::StaticOrder, true, true>(ldsa, g, S, E);
        for (int tb = blockIdx.x; tb < 256; tb += G) tail_mix(P, lds, tb, tid); }
#ifdef DUPC5
    GSYNC();
    { pg8::Gemm g{HCAT, (const bf16_t*)(P.ws + WS_WAB), MP, 1024, 1024}; pg8::StaticOrder S; S.init(MP, 1024, G, (int)blockIdx.x);
        pg8::EpiMix E{GATES, MIXIN}; pg8::gemm_phase<pg8::EpiMix, pg8::StaticOrder, true, true>(ldsa, g, S, E);
        for (int tb = blockIdx.x; tb < 256; tb += G) tail_mix(P, lds, tb, tid); }
#endif
    SEAM(5);
    if (IN(6)) REP(6) { pg8::Gemm g{MIXIN, (const bf16_t*)(P.ws + WS_WOUT), MP, 1024, 1024}; pg8::StaticOrder S; S.init(MP, 1024, G, (int)blockIdx.x);
        pg8::EpiOut E{P.in[0], P.in[1], HN, (float*)(P.ws + WS_ROWSS)}; pg8::gemm_phase<pg8::EpiOut, pg8::StaticOrder, true, true>(ldsa, g, S, E);
        for (int tb = blockIdx.x; tb < 256; tb += G) tail_out(P, lds, tb, tid); }
    SEAM(6);
    if (IN(7)) REP(7) { pg8::Gemm g{HN, (const bf16_t*)(P.ws + WS_WGU), MT, 2 * DFF, 1024}; pg8::StaticOrder S; S.init(MT, 2 * DFF, G, (int)blockIdx.x);
        pg8::EpiGU E{MIXIN, (const float*)(P.ws + WS_ROWSS)}; pg8::gemm_phase<pg8::EpiGU, pg8::StaticOrder, true, true>(ldsa, g, S, E); }
#ifdef DUPC7
    GSYNC();
    { pg8::Gemm g{HN, (const bf16_t*)(P.ws + WS_WGU), MT, 2 * DFF, 1024}; pg8::StaticOrder S; S.init(MT, 2 * DFF, G, (int)blockIdx.x);
        pg8::EpiGU E{MIXIN, (const float*)(P.ws + WS_ROWSS)}; pg8::gemm_phase<pg8::EpiGU, pg8::StaticOrder, true, true>(ldsa, g, S, E); }
#endif
    SEAM(7);
    if (IN(8)) REP(8) { pg8::Gemm g{MIXIN, (const bf16_t*)(P.ws + WS_WD), MP, 1024, DFF}; pg8::StaticOrder S; S.init(MP, 1024, G, (int)blockIdx.x);
        pg8::EpiDown E{HN, P.out}; pg8::gemm_phase<pg8::EpiDown, pg8::StaticOrder, true, true>(ldsa, g, S, E);
        for (int tb = blockIdx.x; tb < 256; tb += G) tail_down(P, lds, tb, tid); }
#ifdef DBG_DUMP
    GSYNC();
    if (DBG_DUMP == 1) { for (size_t i = (size_t)blockIdx.x * 512 + tid; i < (size_t)MT * 1024; i += (size_t)G * 512) { const size_t r = i >> 10, c = i & 1023; P.out[i] = bf2f(MIXIN[r * NMIX + c]); } }
    if (DBG_DUMP == 2) { const bf16_t* d = (const bf16_t*)((unsigned char*)P.out + OB_DCT); for (size_t i = (size_t)blockIdx.x * 512 + tid; i < (size_t)1024 * 8192; i += (size_t)G * 512) P.out[i] = bf2f(d[i]); }
    if (DBG_DUMP == 4) { unsigned* d = (unsigned*)((unsigned char*)P.out + OB_DCT); for (size_t i = (size_t)blockIdx.x * 512 + tid; i < (size_t)1024 * 4096; i += (size_t)G * 512) { const unsigned w = __hip_atomic_load(d + i, __ATOMIC_RELAXED, __HIP_MEMORY_SCOPE_AGENT); P.out[2 * i] = bflo(w); P.out[2 * i + 1] = bfhi(w); } }
    if (DBG_DUMP == 5) { const float* a = (const float*)(P.ws + WS_GI); const float* bq = (const float*)(P.ws + WS_GB); for (int i = blockIdx.x * 512 + tid; i < MT * 4; i += G * 512) { P.out[i] = a[i]; P.out[MT * 4 + i] = bq[i]; } }
    if (DBG_DUMP == 6) { const float* a = (const float*)(P.ws + WS_DN); for (int i = blockIdx.x * 512 + tid; i < 65536; i += G * 512) P.out[i] = a[i]; }
    if (DBG_DUMP == 3) { for (size_t i = (size_t)blockIdx.x * 512 + tid; i < (size_t)MT * 1024; i += (size_t)G * 512) P.out[i] = bf2f(HN[i]); }
#endif
#undef IN
#undef SEAM
}

extern "C" void kernel_launch(void* const* d_in, const int* in_sizes, int n_in, void* d_out, int out_size, void* d_ws, size_t ws_size, hipStream_t stream) {
    static int grid = 0;
    if (grid == 0) {
        if (n_in != 22 || (size_t)out_size != O_END || ws_size < WS_END) { fprintf(stderr, "kernel_launch: unexpected shapes (n_in %d, out %d, ws %zu)\n", n_in, out_size, ws_size); grid = -1; return; }
        int dev = 0, cus = 0, per_cu = 0;
        (void)hipGetDevice(&dev); (void)hipDeviceGetAttribute(&cus, hipDeviceAttributeMultiprocessorCount, dev);
        if (hipFuncSetAttribute((const void*)fwd_kernel, hipFuncAttributeMaxDynamicSharedMemorySize, LDS_BYTES) != hipSuccess) { fprintf(stderr, "kernel_launch: hipFuncSetAttribute failed\n"); grid = -1; return; }
        if (hipOccupancyMaxActiveBlocksPerMultiprocessor(&per_cu, (const void*)fwd_kernel, 512, LDS_BYTES) != hipSuccess || per_cu < 1) { fprintf(stderr, "kernel_launch: occupancy query failed (%d)\n", per_cu); (void)hipGetLastError(); per_cu = 1; }
        grid = cus * 1;
        if (grid < 65) { fprintf(stderr, "kernel_launch: needs more than 64 CUs\n"); grid = -1; return; }
    }
    if (grid < 0) return;
    if (hipMemsetAsync((char*)d_ws + WS_BAR, 0, XCD_BAR_WORDS * 4, stream) != hipSuccess) { fprintf(stderr, "kernel_launch: memset failed\n"); return; }
    Params p{};
    for (int i = 0; i < 22; ++i) p.in[i] = (const float*)d_in[i];
    p.out = (float*)d_out; p.ws = (unsigned char*)d_ws;
    constexpr int NPH = 9;
    for (int li = 0; li < N_LAUNCHES; ++li) {
        p.ph_lo = (N_LAUNCHES == 1) ? 0 : li; p.ph_hi = (N_LAUNCHES == 1) ? NPH : li + 1;
        void* args[] = {&p};
        const hipError_t e = hipLaunchCooperativeKernel((const void*)fwd_kernel, dim3(grid), dim3(512), args, LDS_BYTES, stream);
        if (e != hipSuccess) { fprintf(stderr, "kernel_launch: cooperative launch %d failed: %s (grid %d)\n", li, hipGetErrorString(e), grid); break; }
    }
}
```

```cpp
#include <hip/hip_runtime.h>
#include <hip/hip_cooperative_groups.h>
#include <cstdio>
#include <cstdint>
namespace cg = cooperative_groups;

#ifndef N_LAUNCHES
#define N_LAUNCHES 1
#endif

namespace pg8 {
#define PG8_LAS __attribute__((address_space(3)))
typedef unsigned short bf16_t;
typedef short bf16x8 __attribute__((ext_vector_type(8)));
typedef float f32x4 __attribute__((ext_vector_type(4)));
typedef unsigned u32x4 __attribute__((ext_vector_type(4)));
constexpr int BM = 256, BK = 64, HALF = 128, HTB = HALF * BK * 2  , STAGE_BYTES = 8 * HTB, NXCD = 8, WGM = 8;

__host__ __device__ __forceinline__ int lds_byte(int r, int c) { const int st = (r >> 4) * 2 + (c >> 5), rr = r & 15, cc = c & 31, ob = rr * 64 + cc * 2; return st * 1024 + (ob ^ (((ob >> 9) & 1) << 5)); }
__host__ __device__ __forceinline__ void stage_rc(int b, int& R, int& C) { const int st = b / 1024, sb = b % 1024, swz = sb ^ (((sb >> 9) & 1) << 5); R = (st >> 1) * 16 + swz / 64; C = (st & 1) * 32 + (swz % 64) / 2; }
__host__ __device__ __forceinline__ int perm32(int rho) { const int n = rho >> 4, i = rho & 15; return 8 * (i >> 2) + 4 * n + (i & 3); }

struct Unit { int pm, pn; };
struct Gemm { const bf16_t* A; const bf16_t* Bt; int M, N, K; };

struct StaticOrder {
    int nM, nN, nwg, G, c;
    __host__ __device__ void init(int M, int N, int G_, int c_) { nM = M / BM; nN = N / BM; nwg = nM * nN; G = G_; c = c_; }
    __host__ __device__ bool next(int i, Unit& u) const {
        const long L = (long)i * G + c; if (L >= nwg) return false;
        int wgid = (int)L; { const int q = nwg / NXCD, r = nwg % NXCD, xcd = wgid % NXCD, off = wgid / NXCD; wgid = (xcd < r ? xcd * (q + 1) : r * (q + 1) + (xcd - r) * q) + off; }
        const int nig = WGM * nN, gid = wgid / nig, fm = gid * WGM, gsz = (nM - fm) < WGM ? (nM - fm) : WGM;
        u.pm = fm + ((wgid % nig) % gsz); u.pn = (wgid % nig) / gsz; return true;
    }
    __device__ __forceinline__ void a_ready(const Unit&) const {}
    __device__ __forceinline__ void done(const Unit&) const {}
};

typedef float f32x2_t __attribute__((ext_vector_type(2)));
typedef __bf16 bf16x2_t __attribute__((ext_vector_type(2)));
__device__ __forceinline__ unsigned cvt_pk_bf16(float lo, float hi) { const f32x2_t v = {lo, hi}; const bf16x2_t b = __builtin_convertvector(v, bf16x2_t); return __builtin_bit_cast(unsigned, b); }
constexpr size_t MXROWS = 17408;
__host__ __device__ __forceinline__ size_t mxo(size_t seg, int width, int head, int row) { return seg * MXROWS + ((size_t)head * MXROWS + (size_t)row) * (size_t)width; }
__device__ __forceinline__ float bflo(unsigned w) { return __builtin_bit_cast(float, w << 16); }
__device__ __forceinline__ float bfhi(unsigned w) { return __builtin_bit_cast(float, w & 0xffff0000u); }
__device__ __forceinline__ float sigm(float x) { return __builtin_amdgcn_rcpf(1.0f + __expf(-x)); }

struct EpiProj {
    static constexpr bool PERM = true, AFTER_DRAIN = false, HAS_MID = false;
    bf16_t* mixin; bf16_t* gates;
    __device__ __forceinline__ void operator()(const f32x4 (&acc)[2][2][4][2], const Unit& u, int wr, int wc, int fr, int fq) const {
        const bool isg = u.pn >= 9; const bool sg = isg || u.pn == 4 || u.pn == 5;
        const int row0 = u.pm * BM + wr * 64 + fr;
        size_t cb[2]; int wd[2];
#pragma unroll
        for (int bj = 0; bj < 2; ++bj) {
            if (isg) { cb[bj] = (size_t)((u.pn - 9) * 256 + bj * HALF + wc * 32 + 8 * fq); wd[bj] = 2048; }
            else { const int blk = u.pn * 2 + bj, col = blk * 128 + wc * 32 + 8 * fq;
                const int seg = blk < 2 ? 0 : blk < 4 ? 256 : blk < 8 ? 512 : blk < 12 ? 1024 : blk < 16 ? 1536 : blk == 16 ? 2048 : 2176;
                const int w = (blk >= 4 && blk < 12) ? 128 : 64, cin = col - seg, head = cin / w, c = cin - head * w;
                cb[bj] = mxo((size_t)seg, w, head, 0) + (size_t)c; wd[bj] = w; } }
        bf16_t* base = isg ? gates : mixin;
#pragma unroll
        for (int ai = 0; ai < 2; ++ai)
#pragma unroll
            for (int m = 0; m < 4; ++m) { const size_t row = (size_t)(row0 + ai * HALF + m * 16);
#pragma unroll
                for (int bj = 0; bj < 2; ++bj) { f32x4 v0 = acc[ai][bj][m][0], v1 = acc[ai][bj][m][1];
                    if (sg) {
#pragma unroll
                        for (int i = 0; i < 4; ++i) { v0[i] = sigm(v0[i]); v1[i] = sigm(v1[i]); } }
                    u32x4 w; w.x = cvt_pk_bf16(v0[0], v0[1]); w.y = cvt_pk_bf16(v0[2], v0[3]); w.z = cvt_pk_bf16(v1[0], v1[1]); w.w = cvt_pk_bf16(v1[2], v1[3]);
                    *(u32x4*)(base + cb[bj] + row * (size_t)wd[bj]) = w; } }
    }
};

struct EpiMix {
    static constexpr bool PERM = true, AFTER_DRAIN = false, HAS_MID = true;
    const bf16_t* gates; bf16_t* mix;
    __device__ __forceinline__ void mid(f32x4 (&acc)[2][2][4][2], const Unit& u, int wr, int wc, int fr, int fq) const {
        unsigned rb = (unsigned)(u.pm * BM + wr * 64 + fr) * 2048u + (unsigned)(u.pn * BM + wc * 32 + 8 * fq);
        asm volatile("" : "+v"(rb));
#pragma unroll
        for (int ai = 0; ai < 2; ++ai)
#pragma unroll
            for (int m = 0; m < 4; ++m) { const bf16_t* rowp = gates + (rb + (unsigned)((ai * HALF + m * 16) * 2048));
#pragma unroll
                for (int bj = 0; bj < 2; ++bj) { const u32x4 a = *(const u32x4*)(rowp + bj * HALF), b = *(const u32x4*)(rowp + 1024 + bj * HALF);
                    const float tiny = 8.673617379884035e-19f;
                    f32x4 r0, r1;
                    r0[0] = bflo(a.x) * __builtin_amdgcn_rcpf(fmaxf(bflo(b.x), tiny)); r0[1] = bfhi(a.x) * __builtin_amdgcn_rcpf(fmaxf(bfhi(b.x), tiny)); r0[2] = bflo(a.y) * __builtin_amdgcn_rcpf(fmaxf(bflo(b.y), tiny)); r0[3] = bfhi(a.y) * __builtin_amdgcn_rcpf(fmaxf(bfhi(b.y), tiny));
                    r1[0] = bflo(a.z) * __builtin_amdgcn_rcpf(fmaxf(bflo(b.z), tiny)); r1[1] = bfhi(a.z) * __builtin_amdgcn_rcpf(fmaxf(bfhi(b.z), tiny)); r1[2] = bflo(a.w) * __builtin_amdgcn_rcpf(fmaxf(bflo(b.w), tiny)); r1[3] = bfhi(a.w) * __builtin_amdgcn_rcpf(fmaxf(bfhi(b.w), tiny));
                    acc[ai][bj][m][0] = acc[ai][bj][m][0] * r0; acc[ai][bj][m][1] = acc[ai][bj][m][1] * r1; }
                if (m == 3) __builtin_amdgcn_sched_barrier(0); }
    }
    __device__ __forceinline__ void operator()(const f32x4 (&acc)[2][2][4][2], const Unit& u, int wr, int wc, int fr, int fq) const {
        const int col0 = u.pn * BM + wc * 32 + 8 * fq, row0 = u.pm * BM + wr * 64 + fr;
#pragma unroll
        for (int ai = 0; ai < 2; ++ai)
#pragma unroll
            for (int m = 0; m < 4; ++m) { const size_t row = (size_t)(row0 + ai * HALF + m * 16);
#pragma unroll
                for (int bj = 0; bj < 2; ++bj) { const u32x4 b = *(const u32x4*)(gates + row * 2048 + 1024 + col0 + bj * HALF);
                    const float tiny = 8.673617379884035e-19f;
                    f32x4 s0, s1;
                    s0[0] = fmaxf(bflo(b.x), tiny); s0[1] = fmaxf(bfhi(b.x), tiny); s0[2] = fmaxf(bflo(b.y), tiny); s0[3] = fmaxf(bfhi(b.y), tiny);
                    s1[0] = fmaxf(bflo(b.z), tiny); s1[1] = fmaxf(bfhi(b.z), tiny); s1[2] = fmaxf(bflo(b.w), tiny); s1[3] = fmaxf(bfhi(b.w), tiny);
                    const f32x4 v0 = acc[ai][bj][m][0] * s0, v1 = acc[ai][bj][m][1] * s1;
                    u32x4 w; w.x = cvt_pk_bf16(v0[0], v0[1]); w.y = cvt_pk_bf16(v0[2], v0[3]); w.z = cvt_pk_bf16(v1[0], v1[1]); w.w = cvt_pk_bf16(v1[2], v1[3]);
                    *(u32x4*)(mix + row * 1024 + col0 + bj * HALF) = w; } }
    }
};

struct EpiOut {
    static constexpr bool PERM = true, AFTER_DRAIN = false, HAS_MID = false;
    const float* xp; const float* xs; bf16_t* x1b; float* rowss;
    __device__ __forceinline__ void operator()(const f32x4 (&acc)[2][2][4][2], const Unit& u, int wr, int wc, int fr, int fq) const {
        const int col0 = u.pn * BM + wc * 32 + 8 * fq, row0 = u.pm * BM + wr * 64 + fr;
#pragma unroll
        for (int ai = 0; ai < 2; ++ai)
#pragma unroll
            for (int m = 0; m < 4; ++m) { const int row = row0 + ai * HALF + m * 16;
                const float* xrow = row < 16384 ? xp + (size_t)row * 1024 : xs + (size_t)(row - 16384) * 1024;
                float ss = 0.f;
#pragma unroll
                for (int bj = 0; bj < 2; ++bj) { const int c = col0 + bj * HALF;
                    const f32x4 y0 = *(const f32x4*)(xrow + c) + acc[ai][bj][m][0], y1 = *(const f32x4*)(xrow + c + 4) + acc[ai][bj][m][1];
                    ss += (y0[0] * y0[0] + y0[1] * y0[1]) + (y0[2] * y0[2] + y0[3] * y0[3]) + (y1[0] * y1[0] + y1[1] * y1[1]) + (y1[2] * y1[2] + y1[3] * y1[3]);
                    u32x4 w; w.x = cvt_pk_bf16(y0[0], y0[1]); w.y = cvt_pk_bf16(y0[2], y0[3]); w.z = cvt_pk_bf16(y1[0], y1[1]); w.w = cvt_pk_bf16(y1[2], y1[3]);
                    *(u32x4*)(x1b + (size_t)row * 1024 + c) = w; }
                ss += __shfl_xor(ss, 16); ss += __shfl_xor(ss, 32);
                if (fq == 0) unsafeAtomicAdd(rowss + row, ss); }
    }
};

struct EpiGU {
    static constexpr bool PERM = true, AFTER_DRAIN = false, HAS_MID = false;
    bf16_t* act; const float* rowss;
    __device__ __forceinline__ void operator()(const f32x4 (&acc)[2][2][4][2], const Unit& u, int wr, int wc, int fr, int fq) const {
        const int col0 = u.pn * HALF + wc * 32 + 8 * fq, row0 = u.pm * BM + wr * 64 + fr;
#pragma unroll
        for (int ai = 0; ai < 2; ++ai)
#pragma unroll
            for (int m = 0; m < 4; ++m) { const int row = row0 + ai * HALF + m * 16;
                const float rstd = __builtin_amdgcn_rsqf(rowss[row] * (1.0f / 1024.0f) + 1e-6f);
                float o[8];
#pragma unroll
                for (int n = 0; n < 2; ++n)
#pragma unroll
                    for (int j = 0; j < 4; ++j) { const float g = acc[ai][0][m][n][j] * rstd, up = acc[ai][1][m][n][j] * rstd; o[n * 4 + j] = g * sigm(g) * up; }
                u32x4 w; w.x = cvt_pk_bf16(o[0], o[1]); w.y = cvt_pk_bf16(o[2], o[3]); w.z = cvt_pk_bf16(o[4], o[5]); w.w = cvt_pk_bf16(o[6], o[7]);
                *(u32x4*)(act + (size_t)row * 2816 + col0) = w; }
    }
};

struct EpiDown {
    static constexpr bool PERM = true, AFTER_DRAIN = false, HAS_MID = false;
    const bf16_t* x1b; float* out;
    __device__ __forceinline__ void operator()(const f32x4 (&acc)[2][2][4][2], const Unit& u, int wr, int wc, int fr, int fq) const {
        const int col0 = u.pn * BM + wc * 32 + 8 * fq, row0 = u.pm * BM + wr * 64 + fr;
#pragma unroll
        for (int ai = 0; ai < 2; ++ai)
#pragma unroll
            for (int m = 0; m < 4; ++m) { const size_t ro = (size_t)(row0 + ai * HALF + m * 16) * 1024 + col0;
#pragma unroll
                for (int bj = 0; bj < 2; ++bj) { const u32x4 r = *(const u32x4*)(x1b + ro + bj * HALF);
                    const f32x4 y0 = (f32x4){bflo(r.x), bfhi(r.x), bflo(r.y), bfhi(r.y)} + acc[ai][bj][m][0], y1 = (f32x4){bflo(r.z), bfhi(r.z), bflo(r.w), bfhi(r.w)} + acc[ai][bj][m][1];
                    *(f32x4*)(out + ro + bj * HALF) = y0; *(f32x4*)(out + ro + bj * HALF + 4) = y1; } }
    }
};

template <class Epi, class Sched, bool ALIGN_EPI = false, bool SP2 = false>
__device__ __forceinline__ void gemm_phase(PG8_LAS unsigned char* lds, const Gemm g, const Sched& S, const Epi& E) {
    const int tid = threadIdx.x, wid = __builtin_amdgcn_readfirstlane(tid >> 6), lane = tid & 63, wr = wid >> 2, wc = wid & 3, fr = lane & 15, fq = lane >> 4;
    const int K = g.K, nt = K / BK;
    unsigned voffA[2], voffB[2];
#pragma unroll
    for (int i = 0; i < 2; ++i) { int R, C; stage_rc(tid * 16 + i * 8192, R, C); const int Rb = Epi::PERM ? ((R & ~31) + perm32(R & 31)) : R;
        voffA[i] = (unsigned)(R * K + C) * 2u; voffB[i] = (unsigned)(Rb * K + C) * 2u; }
    const size_t kstep = (size_t)(BK * 2);
    const size_t hstep = (size_t)HALF * K * 2;
    const size_t tstep = 2 * hstep;
    const unsigned ldsw = (unsigned)wid * 1024u;
    const int aoff = lds_byte(wr * 64 + fr, fq * 8), boff = lds_byte(wc * 32 + fr, fq * 8);
#define PG8_SA(b, h) (((b) * 2 + (h)) * HTB)
#define PG8_SB(b, h) ((4 + (b) * 2 + (h)) * HTB)
#define PG8_STAGE(bufoff, gbase, voff) do { _Pragma("unroll") for (int _i = 0; _i < 2; ++_i) \
        __builtin_amdgcn_global_load_lds((const unsigned*)((const char*)(gbase) + (voff)[_i]), (PG8_LAS unsigned*)(lds + (bufoff) + ldsw + _i * 8192), 16, 0, 0); } while (0)
#define PG8_LDA(dst, b, h) do { _Pragma("unroll") for (int m = 0; m < 4; ++m) _Pragma("unroll") for (int k = 0; k < 2; ++k) dst[m][k] = *(const PG8_LAS bf16x8*)(lds + PG8_SA(b, h) + aoff + m * 2048 + k * 1024); } while (0)
#define PG8_LDB(dst, b, h) do { _Pragma("unroll") for (int n = 0; n < 2; ++n) _Pragma("unroll") for (int k = 0; k < 2; ++k) dst[n][k] = *(const PG8_LAS bf16x8*)(lds + PG8_SB(b, h) + boff + n * 2048 + k * 1024); } while (0)
#define PG8_MMA(ai, bj, At, Bt) do { __builtin_amdgcn_s_setprio(1); _Pragma("unroll") for (int m = 0; m < 4; ++m) _Pragma("unroll") for (int n = 0; n < 2; ++n) _Pragma("unroll") for (int k = 0; k < 2; ++k) \
        acc[ai][bj][m][n] = __builtin_amdgcn_mfma_f32_16x16x32_bf16(Bt[n][k], At[m][k], acc[ai][bj][m][n], 0, 0, 0); __builtin_amdgcn_s_setprio(0); } while (0)
#define PG8_WAIT_V(n) asm volatile("s_waitcnt vmcnt(" #n ")" ::: "memory")
#define PG8_WAIT_L(n) asm volatile("s_waitcnt lgkmcnt(" #n ")" ::: "memory")
#define PG8_BAR __builtin_amdgcn_s_barrier()
#define PG8_SCHED __builtin_amdgcn_sched_barrier(0)
    Unit cur, nxt; int ui = 0;
    if (!S.next(0, cur)) return;
    f32x4 acc[2][2][4][2];
#pragma unroll
    for (int a = 0; a < 2; ++a)
#pragma unroll
        for (int b = 0; b < 2; ++b)
#pragma unroll
            for (int m = 0; m < 4; ++m)
#pragma unroll
                for (int n = 0; n < 2; ++n) acc[a][b][m][n] = (f32x4){0.f, 0.f, 0.f, 0.f};
    bf16x8 At[4][2], B0[2][2], B1[2][2];
    const char* cA = (const char*)g.A + (size_t)cur.pm * tstep; const char* cB = (const char*)g.Bt + (size_t)cur.pn * tstep;
    S.a_ready(cur);
    if constexpr (SP2) {
        PG8_STAGE(PG8_SB(0, 0), cB, voffB); PG8_STAGE(PG8_SB(0, 1), cB + hstep, voffB); PG8_STAGE(PG8_SA(0, 0), cA, voffA); PG8_STAGE(PG8_SA(0, 1), cA + hstep, voffA);
        if (wr == 1) PG8_BAR;
        PG8_WAIT_V(2); PG8_BAR;
        PG8_STAGE(PG8_SB(1, 0), cB + kstep, voffB); PG8_STAGE(PG8_SA(1, 0), cA + kstep, voffA); PG8_STAGE(PG8_SB(1, 1), cB + hstep + kstep, voffB);
        PG8_WAIT_V(6); PG8_BAR;
    } else {
        PG8_STAGE(PG8_SB(0, 0), cB, voffB); PG8_STAGE(PG8_SA(0, 0), cA, voffA); PG8_STAGE(PG8_SB(0, 1), cB + hstep, voffB); PG8_STAGE(PG8_SA(0, 1), cA + hstep, voffA);
        if (wr == 1) PG8_BAR;
        PG8_WAIT_V(4); PG8_BAR;
        PG8_STAGE(PG8_SB(1, 0), cB + kstep, voffB); PG8_STAGE(PG8_SA(1, 0), cA + kstep, voffA); PG8_STAGE(PG8_SB(1, 1), cB + hstep + kstep, voffB);
        PG8_WAIT_V(6); PG8_BAR;
    }
    for (;;) {
        const bool has_next = S.next(ui + 1, nxt);
        const char* nA = has_next ? (const char*)g.A + (size_t)nxt.pm * tstep : cA; const char* nB = has_next ? (const char*)g.Bt + (size_t)nxt.pn * tstep : cB;
        for (int t = 0; t < nt; t += 2) {
            if constexpr (Epi::HAS_MID) { if (t == (nt >> 1)) E.mid(acc, cur, wr, wc, fr, fq); }
            const bool last = (t == nt - 2);
            const char* a1 = cA + (size_t)(t + 1) * kstep;
            const char* a2 = last ? nA : cA + (size_t)(t + 2) * kstep; const char* b2 = last ? nB : cB + (size_t)(t + 2) * kstep;
            const char* a3 = a2 + kstep; const char* b3 = b2 + kstep;
            if (last && has_next) S.a_ready(nxt);
            if constexpr (SP2) {
            PG8_LDB(B0, 0, 0); PG8_LDB(B1, 0, 1); PG8_SCHED; PG8_LDA(At, 0, 0); PG8_STAGE(PG8_SA(1, 1), a1 + hstep, voffA);
            PG8_WAIT_V(8); PG8_WAIT_L(0); PG8_BAR; PG8_MMA(0, 0, At, B0); PG8_MMA(0, 1, At, B1); PG8_BAR; PG8_SCHED;
            PG8_LDA(At, 0, 1); PG8_STAGE(PG8_SB(0, 0), b2, voffB); PG8_STAGE(PG8_SB(0, 1), b2 + hstep, voffB); PG8_STAGE(PG8_SA(0, 0), a2, voffA);
            PG8_WAIT_V(8); PG8_WAIT_L(0); PG8_BAR; PG8_MMA(1, 0, At, B0); PG8_MMA(1, 1, At, B1); PG8_BAR; PG8_SCHED;
            PG8_LDB(B0, 1, 0); PG8_LDB(B1, 1, 1); PG8_SCHED; PG8_LDA(At, 1, 0); PG8_STAGE(PG8_SA(0, 1), a2 + hstep, voffA);
            PG8_WAIT_V(8); PG8_WAIT_L(0); PG8_BAR; PG8_MMA(0, 0, At, B0); PG8_MMA(0, 1, At, B1); PG8_BAR; PG8_SCHED;
            PG8_LDA(At, 1, 1); PG8_STAGE(PG8_SB(1, 0), b3, voffB); PG8_STAGE(PG8_SB(1, 1), b3 + hstep, voffB); PG8_STAGE(PG8_SA(1, 0), a3, voffA);
            PG8_WAIT_V(8); PG8_WAIT_L(0); PG8_BAR; PG8_MMA(1, 0, At, B0); PG8_MMA(1, 1, At, B1); PG8_BAR; PG8_SCHED;
            } else {
            PG8_LDB(B0, 0, 0); PG8_SCHED; PG8_LDA(At, 0, 0); PG8_STAGE(PG8_SA(1, 1), a1 + hstep, voffA);
            PG8_WAIT_L(8); PG8_BAR; PG8_WAIT_L(0); PG8_MMA(0, 0, At, B0); PG8_BAR; PG8_SCHED;
            PG8_LDB(B1, 0, 1); PG8_STAGE(PG8_SB(0, 0), b2, voffB);
            PG8_BAR; PG8_WAIT_L(0); PG8_MMA(0, 1, At, B1); PG8_BAR;
            PG8_LDA(At, 0, 1); PG8_STAGE(PG8_SA(0, 0), a2, voffA);
            PG8_BAR; PG8_WAIT_L(0); PG8_MMA(1, 0, At, B0); PG8_BAR; PG8_SCHED;
            PG8_STAGE(PG8_SB(0, 1), b2 + hstep, voffB);
            PG8_WAIT_V(6); PG8_BAR; PG8_MMA(1, 1, At, B1); PG8_BAR;
            PG8_LDB(B0, 1, 0); PG8_SCHED; PG8_LDA(At, 1, 0); PG8_STAGE(PG8_SA(0, 1), a2 + hstep, voffA);
            PG8_WAIT_L(8); PG8_BAR; PG8_WAIT_L(0); PG8_MMA(0, 0, At, B0); PG8_BAR; PG8_SCHED;
            PG8_LDB(B1, 1, 1); PG8_STAGE(PG8_SB(1, 0), b3, voffB);
            PG8_BAR; PG8_WAIT_L(0); PG8_MMA(0, 1, At, B1); PG8_BAR;
            PG8_LDA(At, 1, 1); PG8_STAGE(PG8_SA(1, 0), a3, voffA);
            PG8_BAR; PG8_WAIT_L(0); PG8_MMA(1, 0, At, B0); PG8_BAR; PG8_SCHED;
            PG8_STAGE(PG8_SB(1, 1), b3 + hstep, voffB);
            PG8_WAIT_V(6); PG8_BAR; PG8_MMA(1, 1, At, B1); PG8_BAR;
            }
        }
        if constexpr (ALIGN_EPI) { if (wr == 0) PG8_BAR; }
        if constexpr (!Epi::AFTER_DRAIN) { E(acc, cur, wr, wc, fr, fq); S.done(cur); }
        if (!has_next) break;
#pragma unroll
        for (int a = 0; a < 2; ++a)
#pragma unroll
            for (int b = 0; b < 2; ++b)
#pragma unroll
                for (int m = 0; m < 4; ++m)
#pragma unroll
                    for (int n = 0; n < 2; ++n) acc[a][b][m][n] = (f32x4){0.f, 0.f, 0.f, 0.f};
        cur = nxt; cA = nA; cB = nB; ++ui;
        if constexpr (ALIGN_EPI) { if (wr == 1) PG8_BAR; }
    }
    PG8_WAIT_V(0);
    if constexpr (!ALIGN_EPI) { if (wr == 0) PG8_BAR; }
    PG8_BAR;
    if constexpr (Epi::AFTER_DRAIN) { E.fused(acc, cur, wr, wc, fr, fq, lds, wid, lane); S.done(cur); }
#undef PG8_SA
#undef PG8_SB
#undef PG8_STAGE
#undef PG8_LDA
#undef PG8_LDB
#undef PG8_MMA
#undef PG8_WAIT_V
#undef PG8_WAIT_L
#undef PG8_BAR
#undef PG8_SCHED
}
}
using pg8::mxo; using pg8::bf16_t; using pg8::bf16x8; using pg8::f32x4; using pg8::u32x4; using pg8::cvt_pk_bf16; using pg8::bflo; using pg8::bfhi; using pg8::sigm;
typedef unsigned u32x2 __attribute__((ext_vector_type(2)));
constexpr int MP = 16384, MS = 1024, MT = MP + MS;
constexpr int DIN = 4360, NPROJ = 4352, NMIX = 2304, NGATE = 2048, DFF = 2816;
constexpr float EPS = 1e-6f, LOG2E = 1.4426950408889634f;
constexpr size_t MiB = 1u << 20;
constexpr size_t WS_ROWSS = 0;
constexpr size_t WS_SUMA = 128 * 1024, WS_SUMM = WS_SUMA + 4096, WS_MCH = WS_SUMM + 4096;
constexpr size_t WS_GI = 256 * 1024, WS_GB = WS_GI + 320 * 1024;
constexpr size_t WS_DN = 1 * MiB, WS_NPREV = WS_DN + 256 * 1024;
constexpr size_t WS_WIN = 2 * MiB;
constexpr size_t WS_WAB = WS_WIN + 17 * MiB / 2;
constexpr size_t WS_WOUT = WS_WAB + 2 * MiB;
constexpr size_t WS_WGU = WS_WOUT + 2 * MiB;
constexpr size_t WS_WD = WS_WGU + 11 * MiB;
constexpr size_t WS_HN = WS_WD + 11 * MiB / 2;
constexpr size_t OB_DCT = 34 * MiB, OB_CPT = 50 * MiB;
constexpr size_t WS_MIXIN = WS_HN + 34 * MiB;
constexpr size_t WS_GATES = WS_MIXIN + 153 * MiB / 2;
constexpr size_t WS_HCAT = WS_GATES + 68 * MiB;
constexpr size_t WS_END = WS_HCAT + 34 * MiB;
static_assert(WS_END <= 256 * MiB, "workspace map");
constexpr size_t O_Y = 0, O_CP = (size_t)MT * 1024, O_NP = O_CP + 65536, O_MP = O_NP + 512, O_KWP = O_MP + 8, O_VWP = O_KWP + 32768,
                 O_CS = O_VWP + 32768, O_NS = O_CS + 4194304, O_MS = O_NS + 32768, O_KWS = O_MS + 512, O_VWS = O_KWS + 2097152, O_END = O_VWS + 2097152;
constexpr size_t WS_BAR = 1536 * 1024;
constexpr int LDS_BYTES = 131072 + 256;

struct Params { const float* in[22]; float* out; unsigned char* ws; int ph_lo, ph_hi; };

__device__ __forceinline__ float bf2f(bf16_t h) { return __builtin_bit_cast(float, (unsigned)h << 16); }
__device__ __forceinline__ bf16_t f2bf(float f) { return (bf16_t)(cvt_pk_bf16(f, 0.f) & 0xffffu); }
__device__ __forceinline__ float wave_sum(float v) {
#pragma unroll
    for (int o = 1; o < 64; o <<= 1) v += __shfl_xor(v, o);
    return v; }
__device__ __forceinline__ float wave_max(float v) {
#pragma unroll
    for (int o = 1; o < 64; o <<= 1) v = fmaxf(v, __shfl_xor(v, o));
    return v; }
__device__ __forceinline__ f32x4 mfma16(bf16x8 a, bf16x8 b, f32x4 c) { return __builtin_amdgcn_mfma_f32_16x16x32_bf16(a, b, c, 0, 0, 0); }
__device__ __forceinline__ bf16x8 pack8(const f32x4& a, const f32x4& b) { u32x4 t; t.x = cvt_pk_bf16(a[0], a[1]); t.y = cvt_pk_bf16(a[2], a[3]); t.z = cvt_pk_bf16(b[0], b[1]); t.w = cvt_pk_bf16(b[2], b[3]); return __builtin_bit_cast(bf16x8, t); }
__device__ __forceinline__ void unpack8(const u32x4& r, float* f) { f[0] = bflo(r.x); f[1] = bfhi(r.x); f[2] = bflo(r.y); f[3] = bfhi(r.y); f[4] = bflo(r.z); f[5] = bfhi(r.z); f[6] = bflo(r.w); f[7] = bfhi(r.w); }

__device__ __forceinline__ void p0_tokens(const Params& P, unsigned char* lds, int tid, int G) {
    const float* wg = (const float*)lds; const float* nw = P.in[7];
    bf16_t* HN = (bf16_t*)(P.ws + WS_HN); float* gi = (float*)(P.ws + WS_GI); float* gb = (float*)(P.ws + WS_GB);
    const int lane = tid & 63, w = tid >> 6;
    f32x4 xn[4], xm[4];
    { const int r = blockIdx.x * 8 + w; const float* xrow = r < MP ? P.in[0] + (size_t)r * 1024 : P.in[1] + (size_t)(r - MP) * 1024;
#pragma unroll
        for (int j = 0; j < 4; ++j) xn[j] = ((const f32x4*)xrow)[lane + 64 * j];
        const int r2 = (r + G * 8 < MT) ? r + G * 8 : r; const float* xrow2 = r2 < MP ? P.in[0] + (size_t)r2 * 1024 : P.in[1] + (size_t)(r2 - MP) * 1024;
#pragma unroll
        for (int j = 0; j < 4; ++j) xm[j] = ((const f32x4*)xrow2)[lane + 64 * j]; }
#pragma unroll 1
    for (int r = blockIdx.x * 8 + w; r < MT; r += G * 8) {
        f32x4 xv[4]; float ss = 0.f;
#pragma unroll
        for (int j = 0; j < 4; ++j) { xv[j] = xn[j]; xn[j] = xm[j]; }
        { const int rn = (r + 2 * G * 8 < MT) ? r + 2 * G * 8 : r; const float* xrow = rn < MP ? P.in[0] + (size_t)rn * 1024 : P.in[1] + (size_t)(rn - MP) * 1024;
#pragma unroll
            for (int j = 0; j < 4; ++j) xm[j] = ((const f32x4*)xrow)[lane + 64 * j]; }
#pragma unroll
        for (int j = 0; j < 4; ++j) ss += (xv[j][0] * xv[j][0] + xv[j][1] * xv[j][1]) + (xv[j][2] * xv[j][2] + xv[j][3] * xv[j][3]);
        ss = wave_sum(ss);
        const float rstd = 1.0f / sqrtf(ss * (1.0f / 1024.0f) + EPS);
        float g[8];
#pragma unroll
        for (int q = 0; q < 8; ++q) g[q] = 0.f;
#pragma unroll
        for (int j = 0; j < 4; ++j) { const int k0 = 4 * (lane + 64 * j);
            const f32x4 nv = *(const f32x4*)(nw + k0); const f32x4 hv = xv[j] * rstd * nv;
            u32x2 pk; pk.x = cvt_pk_bf16(hv[0], hv[1]); pk.y = cvt_pk_bf16(hv[2], hv[3]);
            *(u32x2*)(HN + (size_t)r * 1024 + k0) = pk;
#pragma unroll
            for (int q = 0; q < 8; ++q) { const f32x4 wv = *(const f32x4*)(wg + q * 1024 + k0); g[q] += (xv[j][0] * wv[0] + xv[j][1] * wv[1]) + (xv[j][2] * wv[2] + xv[j][3] * wv[3]); } }
#pragma unroll
        for (int q = 0; q < 8; ++q) g[q] = wave_sum(g[q]);
        if (lane < 4) { const float iv = (lane == 0 ? g[0] : lane == 1 ? g[1] : lane == 2 ? g[2] : g[3]) * rstd + P.in[9][lane];
            const float fv = (lane == 0 ? g[4] : lane == 1 ? g[5] : lane == 2 ? g[6] : g[7]) * rstd + P.in[10][lane];
            gi[r * 4 + lane] = iv; gb[r * 4 + lane] = fminf(fv, 0.f) - log1pf(expf(-fabsf(fv))); }
    }
}
template <bool GU>
__device__ __forceinline__ void p0_wunit(const float* src, int ldsrc, int k0, int c0, bf16_t* dst, int lddst, int n0, int k0d, unsigned char* lds, int tid, const float* kscale = nullptr) {
    float* tile = (float*)(lds + 40960);
    f32x4 v[8];
#pragma unroll
    for (int p = 0; p < 8; ++p) v[p] = *(const f32x4*)(src + (size_t)(k0 + (tid >> 6) + 8 * p) * ldsrc + c0 + (tid & 63) * 4);
    if (kscale) {
#pragma unroll
        for (int p = 0; p < 8; ++p) v[p] = v[p] * kscale[k0 + (tid >> 6) + 8 * p]; }
#pragma unroll
    for (int p = 0; p < 8; ++p) *(f32x4*)(tile + ((tid >> 6) + 8 * p) * 260 + (tid & 63) * 4) = v[p];
    __syncthreads();
    { const int n = tid >> 1, kc = (tid & 1) * 32; const float* s = tile + kc * 260 + n;
        const int nd = GU ? (256 * ((c0 + n) >> 7) + ((c0 + n) & 127) + n0) : (n0 + n);
        bf16_t* dp = dst + (size_t)nd * lddst + k0d + kc;
#pragma unroll
        for (int q = 0; q < 4; ++q) { u32x4 o; o.x = cvt_pk_bf16(s[(8 * q) * 260], s[(8 * q + 1) * 260]); o.y = cvt_pk_bf16(s[(8 * q + 2) * 260], s[(8 * q + 3) * 260]);
            o.z = cvt_pk_bf16(s[(8 * q + 4) * 260], s[(8 * q + 5) * 260]); o.w = cvt_pk_bf16(s[(8 * q + 6) * 260], s[(8 * q + 7) * 260]); *(u32x4*)(dp + 8 * q) = o; } }
    __syncthreads();
}
constexpr int NT_IN = 17 * 16, NT_AB = 64, NT_OUT = 64, NT_GU = 352, NT_D = 176, NT_ALL = NT_IN + NT_AB + NT_OUT + NT_GU + NT_D;
__device__ __forceinline__ void wtile_by_index(const Params& P, int r, unsigned char* lds, int tid) {
    if (r < NT_IN) { const int nt = r >> 4, kt = r & 15, c0 = nt * 256; p0_wunit<false>(P.in[8], DIN, kt * 64, c0 < 1536 ? c0 : c0 + 8, (bf16_t*)(P.ws + WS_WIN), 1024, c0, kt * 64, lds, tid); return; } r -= NT_IN;
    if (r < NT_AB) { const int which = r >> 5, rr = r & 31, nt = rr >> 3, kt = rr & 7; p0_wunit<false>(which ? P.in[16] : P.in[15], 1024, kt * 64, nt * 256, (bf16_t*)(P.ws + WS_WAB), 1024, nt * 256, which * 512 + kt * 64, lds, tid); return; } r -= NT_AB;
    if (r < NT_OUT) { const int nt = r >> 4, kt = r & 15; p0_wunit<false>(P.in[17], 1024, kt * 64, nt * 256, (bf16_t*)(P.ws + WS_WOUT), 1024, nt * 256, kt * 64, lds, tid); return; } r -= NT_OUT;
    if (r < NT_GU) { const int which = r / 176, rr = r % 176, jt = rr >> 4, kt = rr & 15; p0_wunit<true>(which ? P.in[20] : P.in[19], DFF, kt * 64, jt * 256, (bf16_t*)(P.ws + WS_WGU), 1024, which * 128, kt * 64, lds, tid, P.in[18]); return; } r -= NT_GU;
    { const int nt = r / 44, kt = r % 44; p0_wunit<false>(P.in[21], 1024, kt * 64, nt * 256, (bf16_t*)(P.ws + WS_WD), DFF, nt * 256, kt * 64, lds, tid); }
}
__device__ __forceinline__ void p0_prep(const Params& P, unsigned char* lds, int tid, int G) {
    float* rowss = (float*)(P.ws + WS_ROWSS);
    for (int i = blockIdx.x * 512 + tid; i < MT; i += G * 512) rowss[i] = 0.f;
    { float* wg = (float*)lds; const float* w_in = P.in[8]; const float* nw = P.in[7];
        for (int idx = tid; idx < 8192; idx += 512) { const int k = idx >> 3, q = idx & 7; wg[q * 1024 + k] = w_in[(size_t)k * DIN + 1536 + q] * nw[k]; } }
    __syncthreads();
    p0_tokens(P, lds, tid, G);
    __syncthreads();
    for (int it = blockIdx.x; it < NT_IN; it += G) wtile_by_index(P, it, lds, tid);
}

template <int NQT>
__device__ __forceinline__ void attn_core(const unsigned char* lds, const bf16x8 (&qf)[NQT][2], int kt_lo, int kt_hi, int qbase, int jmin, float sink2, f32x4 (&o)[4][NQT], float (&l)[NQT]) {
    const bf16_t* Ks = (const bf16_t*)lds; const bf16_t* Vt = (const bf16_t*)(lds + 36864);
    const int lane = threadIdx.x & 63, fr = lane & 15, g = lane >> 4;
    float mrun[NQT];
#pragma unroll
    for (int qt = 0; qt < NQT; ++qt) { mrun[qt] = sink2; l[qt] = (g == 0) ? 1.f : 0.f;
#pragma unroll
        for (int dt = 0; dt < 4; ++dt) o[dt][qt] = (f32x4){0.f, 0.f, 0.f, 0.f}; }
#pragma unroll 1
    for (int kt = kt_lo; kt <= kt_hi; ++kt) {
        f32x4 s[4][NQT];
#pragma unroll
        for (int ks = 0; ks < 4; ++ks)
#pragma unroll
            for (int qt = 0; qt < NQT; ++qt) s[ks][qt] = (f32x4){0.f, 0.f, 0.f, 0.f};
        { bf16x8 kfr[4][2];
#pragma unroll
        for (int ks = 0; ks < 4; ++ks)
#pragma unroll
            for (int kk = 0; kk < 2; ++kk) kfr[ks][kk] = *(const bf16x8*)(Ks + (kt * 64 + ks * 16 + fr) * 72 + g * 8 + kk * 32);
#pragma unroll
        for (int ks = 0; ks < 4; ++ks)
#pragma unroll
            for (int kk = 0; kk < 2; ++kk)
#pragma unroll
                for (int qt = 0; qt < NQT; ++qt) s[ks][qt] = mfma16(kfr[ks][kk], qf[qt][kk], s[ks][qt]); }
#pragma unroll
        for (int qt = 0; qt < NQT; ++qt) { const int qi = qbase + 16 * qt + fr; float mx = -1e30f;
#pragma unroll
            for (int ks = 0; ks < 4; ++ks)
#pragma unroll
                for (int r = 0; r < 4; ++r) { const int j = kt * 64 + ks * 16 + g * 4 + r; const bool ok = (j > qi) && (j <= qi + 128) && (j >= jmin);
                    const float v = ok ? s[ks][qt][r] : -1e30f; s[ks][qt][r] = v; mx = fmaxf(mx, v); }
            mx = fmaxf(mx, __shfl_xor(mx, 16)); mx = fmaxf(mx, __shfl_xor(mx, 32));
            const float mnew = fmaxf(mrun[qt], mx), alpha = __builtin_amdgcn_exp2f(mrun[qt] - mnew); mrun[qt] = mnew;
            float ps = 0.f;
#pragma unroll
            for (int ks = 0; ks < 4; ++ks)
#pragma unroll
                for (int r = 0; r < 4; ++r) { const float p = __builtin_amdgcn_exp2f(s[ks][qt][r] - mnew); s[ks][qt][r] = p; ps += p; }
            l[qt] = l[qt] * alpha + ps;
#pragma unroll
            for (int dt = 0; dt < 4; ++dt) o[dt][qt] = o[dt][qt] * alpha; }
        { bf16x8 vfr[2][4], pf[2][NQT];
#pragma unroll
        for (int c = 0; c < 2; ++c) {
#pragma unroll
            for (int dt = 0; dt < 4; ++dt) { const bf16_t* vp = Vt + (dt * 16 + fr) * 264 + kt * 64 + c * 32 + g * 4;
                const u32x2 v0 = *(const u32x2*)vp, v1 = *(const u32x2*)(vp + 16);
                vfr[c][dt] = __builtin_bit_cast(bf16x8, (u32x4){v0.x, v0.y, v1.x, v1.y}); }
#pragma unroll
            for (int qt = 0; qt < NQT; ++qt) pf[c][qt] = pack8(s[2 * c][qt], s[2 * c + 1][qt]); }
#pragma unroll
        for (int c = 0; c < 2; ++c)
#pragma unroll
            for (int dt = 0; dt < 4; ++dt)
#pragma unroll
                for (int qt = 0; qt < NQT; ++qt) o[dt][qt] = mfma16(vfr[c][dt], pf[c][qt], o[dt][qt]); }
    }
}
__device__ __forceinline__ void attn_put(unsigned char* lds, int slot, int hh, const float* kf, const float* vf) {
    bf16_t* Ks = (bf16_t*)lds; bf16_t* Vt = (bf16_t*)(lds + 36864);
#pragma unroll
    for (int i = 0; i < 4; ++i) { u32x4 w; w.x = cvt_pk_bf16(kf[8 * i], kf[8 * i + 1]); w.y = cvt_pk_bf16(kf[8 * i + 2], kf[8 * i + 3]); w.z = cvt_pk_bf16(kf[8 * i + 4], kf[8 * i + 5]); w.w = cvt_pk_bf16(kf[8 * i + 6], kf[8 * i + 7]);
        *(u32x4*)(Ks + slot * 72 + hh * 32 + 8 * i) = w; }
#pragma unroll
    for (int i = 0; i < 32; ++i) Vt[(hh * 32 + i) * 264 + slot] = f2bf(vf[i]);
}
__device__ __forceinline__ void attn_prompt_item(const Params& P, int item, unsigned char* lds, int tid) {
    const int kvh = item & 1, n = (item >> 1) & 63, b = item >> 7;
    const bf16_t* mixin = (const bf16_t*)(P.ws + WS_MIXIN);
    { const int slot = tid >> 1, hh = tid & 1, tokb = n * 128 - 128 + slot;
        float kf[32], vf[32];
        if (tokb >= 0) { const bf16_t* kp_ = mixin + mxo(2048, 64, kvh, b * 8192 + tokb) + hh * 32; const bf16_t* vp_ = mixin + mxo(2176, 64, kvh, b * 8192 + tokb) + hh * 32;
#pragma unroll
            for (int i = 0; i < 4; ++i) { const u32x4 kr = *(const u32x4*)(kp_ + 8 * i), vr = *(const u32x4*)(vp_ + 8 * i); unpack8(kr, kf + 8 * i); unpack8(vr, vf + 8 * i); } }
        else {
#pragma unroll
            for (int i = 0; i < 32; ++i) { kf[i] = 0.f; vf[i] = 0.f; } }
        float ss = 0.f;
#pragma unroll
        for (int i = 0; i < 32; ++i) ss += kf[i] * kf[i];
        ss += __shfl_xor(ss, 1);
        const float rstd = 1.0f / sqrtf(ss * (1.0f / 64.0f) + EPS);
#pragma unroll
        for (int i = 0; i < 32; ++i) kf[i] = kf[i] * rstd * P.in[13][hh * 32 + i];
        attn_put(lds, slot, hh, kf, vf);
        if (n == 63 && slot >= 128) { float* kw = P.out + O_KWP + ((size_t)(b * 128 + slot - 128) * 2 + kvh) * 64 + hh * 32; float* vw = P.out + O_VWP + ((size_t)(b * 128 + slot - 128) * 2 + kvh) * 64 + hh * 32;
#pragma unroll
            for (int i = 0; i < 8; ++i) { *(f32x4*)(kw + 4 * i) = (f32x4){kf[4 * i], kf[4 * i + 1], kf[4 * i + 2], kf[4 * i + 3]}; *(f32x4*)(vw + 4 * i) = (f32x4){vf[4 * i], vf[4 * i + 1], vf[4 * i + 2], vf[4 * i + 3]}; } }
    }
    __syncthreads();
    const int w = tid >> 6, lane = tid & 63, fr = lane & 15, g = lane >> 4, gq = w >> 1, half = w & 1, head = kvh * 4 + gq;
    bf16_t* hcat = (bf16_t*)(P.ws + WS_HCAT);
#pragma unroll 1
    for (int qh = 0; qh < 2; ++qh) {
    bf16x8 qf[2][2];
#pragma unroll
    for (int qt = 0; qt < 2; ++qt) { const int tok = b * 8192 + n * 128 + half * 64 + qh * 32 + qt * 16 + fr; const bf16_t* qp = mixin + mxo(1536, 64, head, tok) + g * 8;
        float f0[8], f1[8]; unpack8(*(const u32x4*)qp, f0); unpack8(*(const u32x4*)(qp + 32), f1);
        float ss = 0.f;
#pragma unroll
        for (int i = 0; i < 8; ++i) ss += f0[i] * f0[i] + f1[i] * f1[i];
        ss += __shfl_xor(ss, 16); ss += __shfl_xor(ss, 32);
        const float sc = (0.125f * LOG2E) / sqrtf(ss * (1.0f / 64.0f) + EPS);
#pragma unroll
        for (int i = 0; i < 8; ++i) { f0[i] = f0[i] * sc * P.in[12][g * 8 + i]; f1[i] = f1[i] * sc * P.in[12][32 + g * 8 + i]; }
        qf[qt][0] = pack8((f32x4){f0[0], f0[1], f0[2], f0[3]}, (f32x4){f0[4], f0[5], f0[6], f0[7]}); qf[qt][1] = pack8((f32x4){f1[0], f1[1], f1[2], f1[3]}, (f32x4){f1[4], f1[5], f1[6], f1[7]}); }
    f32x4 o[4][2]; float l[2];
    attn_core<2>(lds, qf, half, half + 2, half * 64 + qh * 32, n == 0 ? 128 : 0, P.in[14][head] * LOG2E, o, l);
#pragma unroll
    for (int qt = 0; qt < 2; ++qt) { float lt = l[qt]; lt += __shfl_xor(lt, 16); lt += __shfl_xor(lt, 32); const float inv = 1.0f / lt;
        const int tok = b * 8192 + n * 128 + half * 64 + qh * 32 + qt * 16 + fr;
#pragma unroll
        for (int dt = 0; dt < 4; ++dt) { const f32x4 v = o[dt][qt] * inv; u32x2 pk; pk.x = cvt_pk_bf16(v[0], v[1]); pk.y = cvt_pk_bf16(v[2], v[3]);
            *(u32x2*)(hcat + (size_t)tok * 1024 + 512 + head * 64 + dt * 16 + g * 4) = pk; } }
    }
    __syncthreads();
}
__device__ __forceinline__ void attn_sample_item(const Params& P, int item, unsigned char* lds, int tid) {
    const int kvh = item & 1, b = item >> 1;
    const bf16_t* mixin = (const bf16_t*)(P.ws + WS_MIXIN);
    { const int slot = tid >> 1, hh = tid & 1;
        if (slot < 192) { float kf[32], vf[32];
            if (slot < 128) { const size_t off = ((size_t)(b * 128 + slot) * 2 + kvh) * 64 + hh * 32; const float* kp = P.in[5] + off; const float* vp = P.in[6] + off;
#pragma unroll
                for (int i = 0; i < 8; ++i) { const f32x4 a = *(const f32x4*)(kp + 4 * i), c = *(const f32x4*)(vp + 4 * i);
                    kf[4 * i] = a[0]; kf[4 * i + 1] = a[1]; kf[4 * i + 2] = a[2]; kf[4 * i + 3] = a[3]; vf[4 * i] = c[0]; vf[4 * i + 1] = c[1]; vf[4 * i + 2] = c[2]; vf[4 * i + 3] = c[3]; } }
            else if (slot < 136) { const bf16_t* kp_ = mixin + mxo(2048, 64, kvh, MP + b * 8 + slot - 128) + hh * 32; const bf16_t* vp_ = mixin + mxo(2176, 64, kvh, MP + b * 8 + slot - 128) + hh * 32;
#pragma unroll
                for (int i = 0; i < 4; ++i) { const u32x4 kr = *(const u32x4*)(kp_ + 8 * i), vr = *(const u32x4*)(vp_ + 8 * i); unpack8(kr, kf + 8 * i); unpack8(vr, vf + 8 * i); }
                float ss = 0.f;
#pragma unroll
                for (int i = 0; i < 32; ++i) ss += kf[i] * kf[i];
                ss += __shfl_xor(ss, 1);
                const float rstd = 1.0f / sqrtf(ss * (1.0f / 64.0f) + EPS);
#pragma unroll
                for (int i = 0; i < 32; ++i) kf[i] = kf[i] * rstd * P.in[13][hh * 32 + i]; }
            else {
#pragma unroll
                for (int i = 0; i < 32; ++i) { kf[i] = 0.f; vf[i] = 0.f; } }
            attn_put(lds, slot, hh, kf, vf);
            if (slot >= 8 && slot < 136) { const size_t off = ((size_t)(b * 128 + slot - 8) * 2 + kvh) * 64 + hh * 32; float* kw = P.out + O_KWS + off; float* vw = P.out + O_VWS + off;
#pragma unroll
                for (int i = 0; i < 8; ++i) { *(f32x4*)(kw + 4 * i) = (f32x4){kf[4 * i], kf[4 * i + 1], kf[4 * i + 2], kf[4 * i + 3]}; *(f32x4*)(vw + 4 * i) = (f32x4){vf[4 * i], vf[4 * i + 1], vf[4 * i + 2], vf[4 * i + 3]}; } }
        }
    }
    __syncthreads();
    const int w = tid >> 6, lane = tid & 63, fr = lane & 15, g = lane >> 4;
    if (w < 4) { const int head = kvh * 4 + w; const int tok = MP + b * 8 + (fr & 7);
        bf16x8 qf[1][2];
        { const bf16_t* qp = mixin + mxo(1536, 64, head, tok) + g * 8;
            float f0[8], f1[8]; unpack8(*(const u32x4*)qp, f0); unpack8(*(const u32x4*)(qp + 32), f1);
            float ss = 0.f;
#pragma unroll
            for (int i = 0; i < 8; ++i) ss += f0[i] * f0[i] + f1[i] * f1[i];
            ss += __shfl_xor(ss, 16); ss += __shfl_xor(ss, 32);
            const float sc = (0.125f * LOG2E) / sqrtf(ss * (1.0f / 64.0f) + EPS);
#pragma unroll
            for (int i = 0; i < 8; ++i) { f0[i] = f0[i] * sc * P.in[12][g * 8 + i]; f1[i] = f1[i] * sc * P.in[12][32 + g * 8 + i]; }
            qf[0][0] = pack8((f32x4){f0[0], f0[1], f0[2], f0[3]}, (f32x4){f0[4], f0[5], f0[6], f0[7]}); qf[0][1] = pack8((f32x4){f1[0], f1[1], f1[2], f1[3]}, (f32x4){f1[4], f1[5], f1[6], f1[7]}); }
        f32x4 o[4][1]; float l[1];
        attn_core<1>(lds, qf, 0, 2, 0, 0, P.in[14][head] * LOG2E, o, l);
        float lt = l[0]; lt += __shfl_xor(lt, 16); lt += __shfl_xor(lt, 32); const float inv = 1.0f / lt;
        bf16_t* hcat = (bf16_t*)(P.ws + WS_HCAT);
        if (fr < 8) {
#pragma unroll
            for (int dt = 0; dt < 4; ++dt) { const f32x4 v = o[dt][0] * inv; u32x2 pk; pk.x = cvt_pk_bf16(v[0], v[1]); pk.y = cvt_pk_bf16(v[2], v[3]);
                *(u32x2*)(hcat + (size_t)tok * 1024 + 512 + head * 64 + dt * 16 + g * 4) = pk; } }
    }
    __syncthreads();
}
#define LAS __attribute__((address_space(3)))
#define XB_TMO      128
#define XB_XCNT(j)  (256  + 64 * (j))
#define XB_XSUB(j)  (1280 + 64 * (j))
#define XB_XGEN(j)  (2304 + 64 * (j))
#define XB_TOP      3328
#define XB_TOPGEN   3392
#define XCD_BAR_WORDS 3456
#define XB_SPIN_CAP (1u << 18)

__device__ __forceinline__ unsigned xb_ld(unsigned* p)              { return __hip_atomic_load(p, __ATOMIC_RELAXED, __HIP_MEMORY_SCOPE_AGENT); }
__device__ __forceinline__ unsigned xb_add(unsigned* p, unsigned v) { return __hip_atomic_fetch_add(p, v, __ATOMIC_RELAXED, __HIP_MEMORY_SCOPE_AGENT); }
__device__ __forceinline__ unsigned xb_xcc_id() { return (unsigned)__builtin_amdgcn_s_getreg((3 << 11) | 20) & 0xFu; }
#define XB_SPIN(cond, bar) do { unsigned _sp = 0; while (cond) { __builtin_amdgcn_s_sleep(1); \
    if ((++_sp & 255u) == 0u) { if (xb_ld(&(bar)[XB_TMO])) break; if (_sp > XB_SPIN_CAP) { atomicAdd(&(bar)[XB_TMO], 1u); break; } } } } while (0)

struct XcdBarrier {
    unsigned* bar; unsigned x;
    volatile LAS unsigned* st;
};

__device__ __forceinline__ XcdBarrier xcd_barrier_post(unsigned* bar, volatile LAS unsigned* st) {
    XcdBarrier b; b.bar = bar; b.x = xb_xcc_id(); b.st = st;
    if (threadIdx.x == 0) (void)xb_add(&bar[XB_XCNT(b.x)], 1u);
    return b;
}
__device__ __forceinline__ void xcd_barrier_complete(unsigned* bar, unsigned x, unsigned& nloc, unsigned& nx) {
    const unsigned G = gridDim.x * gridDim.y * gridDim.z;
    unsigned sum, cnt, mine, sp = 0u;
    for (;;) {
        sum = 0u; cnt = 0u; mine = 0u;
#pragma unroll
        for (unsigned j = 0; j < 16; ++j) { const unsigned c = xb_ld(&bar[XB_XCNT(j)]); sum += c; cnt += (c > 0u) ? 1u : 0u; mine = (j == x) ? c : mine; }
        if (sum == G) break;
        __builtin_amdgcn_s_sleep(1);
        if ((++sp & 255u) == 0u) { if (xb_ld(&bar[XB_TMO])) break; if (sp > XB_SPIN_CAP) { atomicAdd(&bar[XB_TMO], 1u); break; } }
    }
    nloc = mine > 0u ? mine : 1u; nx = cnt > 0u ? cnt : 1u;
}

__device__ __forceinline__ void xcd_barrier(const XcdBarrier& b) {
    asm volatile("s_waitcnt vmcnt(0)" ::: "memory");
    __syncthreads();
    if (threadIdx.x == 0) {
        unsigned* bar = b.bar;
        __builtin_amdgcn_s_waitcnt(0);
        unsigned nloc = b.st[0], nx = b.st[1];
        if (nloc == 0u) { xcd_barrier_complete(bar, b.x, nloc, nx); b.st[0] = nloc; b.st[1] = nx; }
        const unsigned old = xb_add(&bar[XB_XSUB(b.x)], 1u);
        const unsigned gen = old / nloc;
        if (old + 1u == (gen + 1u) * nloc) {
            __builtin_amdgcn_fence(__ATOMIC_RELEASE, "agent");
            asm volatile("s_waitcnt vmcnt(0)" ::: "memory");
            const unsigned og = xb_add(&bar[XB_TOP], 1u);
            const unsigned tg = og / nx;
            if (og + 1u == (tg + 1u) * nx) xb_add(&bar[XB_TOPGEN], 1u);
            else XB_SPIN(xb_ld(&bar[XB_TOPGEN]) == tg, bar);
            __builtin_amdgcn_fence(__ATOMIC_ACQUIRE, "agent");
            xb_add(&bar[XB_XGEN(b.x)], 1u);
            asm volatile("s_waitcnt vmcnt(0)" ::: "memory");
        } else {
            XB_SPIN(xb_ld(&bar[XB_XGEN(b.x)]) == gen, bar);
            __builtin_amdgcn_fence(__ATOMIC_ACQUIRE, "agent");
            asm volatile("s_waitcnt vmcnt(0)" ::: "memory");
        }
    }
    __syncthreads();
}
__device__ __forceinline__ void mlstm_b_item(const Params& P, int item, unsigned char* lds, int tid) {
    const int c = item & 127, h = (item >> 7) & 3, b = item >> 9, r0 = b * 8192 + c * 64;
    float* wl = (float*)lds; bf16_t* Kt = (bf16_t*)(lds + 256); bf16_t* Vt = (bf16_t*)(lds + 256 + 9216);
    const bf16_t* mixin = (const bf16_t*)(P.ws + WS_MIXIN);
    const int s_ = tid >> 3, ch_ = tid & 7; const bf16_t* kp_ = mixin + mxo(256, 64, h, r0 + s_) + ch_ * 8; const bf16_t* vp_ = mixin + mxo(512, 128, h, r0 + s_) + ch_ * 16;
    const u32x4 kr_ = *(const u32x4*)kp_, v0_ = *(const u32x4*)vp_, v1_ = *(const u32x4*)(vp_ + 8);
    if (tid < 64) { const float iv = ((const float*)(P.ws + WS_GI))[(r0 + tid) * 4 + h]; float bb = ((const float*)(P.ws + WS_GB))[(r0 + tid) * 4 + h];
#pragma unroll
        for (int o = 1; o < 64; o <<= 1) { const float nb = __shfl_up(bb, o); if (tid >= o) bb += nb; }
        const float A = __shfl(bb, 63), v = A - bb + iv, M = wave_max(v); wl[tid] = __expf(v - M) * 0.125f;
        if (tid == 0) { ((float*)(P.ws + WS_SUMA))[item] = A; ((float*)(P.ws + WS_SUMM))[item] = M; } }
    __syncthreads();
    { const int s = s_, ch = ch_; const float ws_ = wl[s];
        float kf[8]; unpack8(kr_, kf);
#pragma unroll
        for (int i = 0; i < 8; ++i) Kt[(ch * 8 + i) * 72 + s] = f2bf(kf[i] * ws_);
        const unsigned vv[8] = {v0_.x, v0_.y, v0_.z, v0_.w, v1_.x, v1_.y, v1_.z, v1_.w};
#pragma unroll
        for (int i = 0; i < 8; ++i) { Vt[(ch * 16 + 2 * i) * 72 + s] = (bf16_t)(vv[i] & 0xffffu); Vt[(ch * 16 + 2 * i + 1) * 72 + s] = (bf16_t)(vv[i] >> 16); } }
    __syncthreads();
    { const int w = tid >> 6, lane = tid & 63, fr = lane & 15, g = lane >> 4, e0 = 16 * w;
        f32x4 acc[4];
#pragma unroll
        for (int dt = 0; dt < 4; ++dt) acc[dt] = (f32x4){0.f, 0.f, 0.f, 0.f};
        bf16x8 vfr[2], kfr[2][4];
#pragma unroll
        for (int kk = 0; kk < 2; ++kk) { vfr[kk] = *(const bf16x8*)(Vt + (e0 + fr) * 72 + g * 8 + kk * 32);
#pragma unroll
            for (int dt = 0; dt < 4; ++dt) kfr[kk][dt] = *(const bf16x8*)(Kt + (dt * 16 + fr) * 72 + g * 8 + kk * 32); }
#pragma unroll
        for (int kk = 0; kk < 2; ++kk)
#pragma unroll
            for (int dt = 0; dt < 4; ++dt) acc[dt] = mfma16(kfr[kk][dt], vfr[kk], acc[dt]);
        bf16_t* dct = (bf16_t*)((unsigned char*)P.out + OB_DCT) + ((size_t)item * 128 + e0 + fr) * 64;
#pragma unroll
        for (int dt = 0; dt < 4; ++dt) { u32x2 pk; pk.x = cvt_pk_bf16(acc[dt][0], acc[dt][1]); pk.y = cvt_pk_bf16(acc[dt][2], acc[dt][3]); *(u32x2*)(dct + dt * 16 + g * 4) = pk; } }
    if (tid < 64) { float sum = 0.f;
#pragma unroll 8
        for (int s = 0; s < 64; ++s) sum += bf2f(Kt[tid * 72 + s]);
        ((float*)(P.ws + WS_DN))[item * 64 + tid] = sum; }
    __syncthreads();
}
__device__ __forceinline__ void mlstm_scan(const Params& P, unsigned char* lds, int tid) {
    const int pair = blockIdx.x >> 3, sub = blockIdx.x & 7;
    float* ga = (float*)lds; float* ea = ga + 128; float* marr = ea + 128;
    if (tid < 128) { ga[tid] = ((const float*)(P.ws + WS_SUMA))[pair * 128 + tid]; ea[tid] = ((const float*)(P.ws + WS_SUMM))[pair * 128 + tid]; }
    __syncthreads();
    if (tid == 0) { float m = 0.f; const float* sA = ga; const float* sM = ea;
        for (int c = 0; c < 128; ++c) { const float A = sA[c], Mv = sM[c], mn = fmaxf(A + m, Mv); ga[c] = __expf(A + m - mn); ea[c] = __expf(Mv - mn); m = mn; marr[c] = mn; } }
    __syncthreads();
    if (sub == 0) { if (tid < 128) ((float*)(P.ws + WS_MCH))[pair * 128 + tid] = marr[tid]; if (tid == 0) P.out[O_MP + pair] = marr[127]; }
#ifndef P3_SCANMASK
#define P3_SCANMASK 3
#endif
    if (P3_SCANMASK & 1) { const int idx2 = sub * 512 + tid; float C0 = 0.f, C1 = 0.f;
        const unsigned* src = (const unsigned*)((unsigned char*)P.out + OB_DCT) + (size_t)pair * 128 * 4096 + idx2; unsigned* dst = (unsigned*)((unsigned char*)P.out + OB_CPT) + (size_t)pair * 128 * 4096 + idx2;
#pragma unroll 1
        for (int c = 0; c < 128; c += 32) { unsigned v[32];
#pragma unroll
            for (int j = 0; j < 32; ++j) v[j] = src[(size_t)(c + j) * 4096];
#pragma unroll
            for (int j = 0; j < 32; ++j) { dst[(size_t)(c + j) * 4096] = cvt_pk_bf16(C0, C1); const float gg = ga[c + j], ee = ea[c + j]; C0 = gg * C0 + ee * bflo(v[j]); C1 = gg * C1 + ee * bfhi(v[j]); } }
        const int i0 = 2 * idx2, e = i0 >> 6, d = i0 & 63;
        P.out[O_CP + ((size_t)pair * 64 + d) * 128 + e] = C0; P.out[O_CP + ((size_t)pair * 64 + d + 1) * 128 + e] = C1; }
    if ((P3_SCANMASK & 2) && sub == 0 && tid < 64) { float nn = 0.f; const float* dn = (const float*)(P.ws + WS_DN) + (size_t)pair * 128 * 64 + tid; float* np = (float*)(P.ws + WS_NPREV) + (size_t)pair * 128 * 64 + tid;
#pragma unroll 1
        for (int c = 0; c < 128; c += 32) { float dv[32];
#pragma unroll
            for (int j = 0; j < 32; ++j) dv[j] = dn[(c + j) * 64];
#pragma unroll
            for (int j = 0; j < 32; ++j) { np[(c + j) * 64] = nn; nn = ga[c + j] * nn + ea[c + j] * dv[j]; } }
        P.out[O_NP + pair * 64 + tid] = nn; }
    __syncthreads();
}
__device__ __forceinline__ void mlstm_sample_item(const Params& P, int item, unsigned char* lds, int tid) {
    const int h = item & 3, b = item >> 2, r0 = MP + b * 8;
    float* q = (float*)lds; float* k = q + 512; float* v = k + 512; float* sw = v + 1024; float* sc = sw + 64; float* n0s = sc + 64; float* part = n0s + 64; float* red = part + 4096;
    const bf16_t* mixin = (const bf16_t*)(P.ws + WS_MIXIN);
    if (tid < 256) {
        const int sel = tid >> 6, i = tid & 63;
        if (sel < 2) { const int t = i >> 3, p = i & 7; float f[8]; unpack8(*(const u32x4*)(mixin + mxo(sel * 256, 64, h, r0 + t) + p * 8), f);
            float* dst = (sel ? k : q) + (p * 8) * 8 + t; const float sc_ = sel ? 0.125f : 1.0f;
#pragma unroll
            for (int j = 0; j < 8; ++j) dst[j * 8] = f[j] * sc_; }
        else { const int i2 = tid - 128, t = i2 >> 4, p = i2 & 15; float f[8]; unpack8(*(const u32x4*)(mixin + mxo(512, 128, h, r0 + t) + p * 8), f);
#pragma unroll
            for (int j = 0; j < 8; ++j) v[t * 128 + p * 8 + j] = f[j]; } }
    if (tid < 64) n0s[tid] = P.in[3][(b * 4 + h) * 64 + tid];
    if (tid < 8) { float lf[8];
#pragma unroll
        for (int s = 0; s < 8; ++s) lf[s] = ((const float*)(P.ws + WS_GB))[(r0 + s) * 4 + h];
        float bb = 0.f;
#pragma unroll
        for (int s = 0; s < 8; ++s) bb += (s <= tid) ? lf[s] : 0.f;
        sc[tid] = bb; sc[8 + tid] = ((const float*)(P.ws + WS_GI))[(r0 + tid) * 4 + h] - bb; }
    __syncthreads();
    const float mprev = P.in[4][b * 4 + h];
    if (tid < 8) { float cm = mprev; for (int s = 0; s <= tid; ++s) cm = fmaxf(cm, sc[8 + s]); const float mt = sc[tid] + cm; sc[16 + tid] = mt; sc[24 + tid] = __expf(sc[tid] + mprev - mt); }
    __syncthreads();
    if (tid < 8) { const float b7 = sc[7], m7 = sc[23]; sc[32 + tid] = __expf(b7 + sc[8 + tid] - m7); if (tid == 0) { sc[48] = __expf(b7 + mprev - m7); P.out[O_MS + b * 4 + h] = m7; } }
    if (tid >= 64 && tid < 128) { const int i = tid - 64, t = i >> 3, s = i & 7; float dot = 0.f;
        for (int d = 0; d < 64; ++d) dot += q[d * 8 + t] * k[d * 8 + s];
        sw[i] = (s <= t) ? dot * __expf(sc[t] + sc[8 + s] - sc[16 + t]) : 0.f; }
    if (tid >= 128 && tid < 136) { const int t = tid - 128; float qn = 0.f; for (int d = 0; d < 64; ++d) qn += q[d * 8 + t] * n0s[d]; sc[40 + t] = qn; }
    __syncthreads();
    { const int e = tid & 127, dq = tid >> 7; const float gd = sc[48]; float num[8], wv[8];
#pragma unroll
        for (int t = 0; t < 8; ++t) { num[t] = 0.f; wv[t] = sc[32 + t] * v[t * 128 + e]; }
        float c0v[16];
#pragma unroll
        for (int dd = 0; dd < 16; ++dd) c0v[dd] = P.in[2][((size_t)(b * 4 + h) * 64 + dq * 16 + dd) * 128 + e];
#pragma unroll
        for (int dd = 0; dd < 16; ++dd) { const int d = dq * 16 + dd; const size_t ic = ((size_t)(b * 4 + h) * 64 + d) * 128 + e; const float c0 = c0v[dd];
            const f32x4 k0 = *(const f32x4*)(k + d * 8), k1 = *(const f32x4*)(k + d * 8 + 4), q0 = *(const f32x4*)(q + d * 8), q1 = *(const f32x4*)(q + d * 8 + 4);
            const float upd = (k0[0] * wv[0] + k0[1] * wv[1]) + (k0[2] * wv[2] + k0[3] * wv[3]) + (k1[0] * wv[4] + k1[1] * wv[5]) + (k1[2] * wv[6] + k1[3] * wv[7]);
            P.out[O_CS + ic] = gd * c0 + upd;
            num[0] += q0[0] * c0; num[1] += q0[1] * c0; num[2] += q0[2] * c0; num[3] += q0[3] * c0; num[4] += q1[0] * c0; num[5] += q1[1] * c0; num[6] += q1[2] * c0; num[7] += q1[3] * c0; }
#pragma unroll
        for (int t = 0; t < 8; ++t) part[(dq * 8 + t) * 128 + e] = num[t]; }
    if (tid < 64) { float nn = sc[48] * n0s[tid];
#pragma unroll
        for (int s = 0; s < 8; ++s) nn += sc[32 + s] * k[tid * 8 + s];
        P.out[O_NS + (b * 4 + h) * 64 + tid] = nn; }
    __syncthreads();
    { const int e = tid & 127, tq = tid >> 7, w = tid >> 6, lane = tid & 63; float hv[2];
#pragma unroll
        for (int u = 0; u < 2; ++u) { const int t = tq * 2 + u; float inter = 0.f, intra = 0.f, rs = 0.f;
#pragma unroll
            for (int dq = 0; dq < 4; ++dq) inter += part[(dq * 8 + t) * 128 + e];
#pragma unroll
            for (int s = 0; s < 8; ++s) { intra += sw[t * 8 + s] * v[s * 128 + e]; rs += sw[t * 8 + s]; }
            const float wi = sc[24 + t], den = wi * sc[40 + t] + rs; hv[u] = (wi * inter + intra) / fmaxf(fabsf(den), __expf(-sc[16 + t])); }
        const float s0 = wave_sum(hv[0] * hv[0]), s1 = wave_sum(hv[1] * hv[1]);
        if (lane == 0) { red[w * 2] = s0; red[w * 2 + 1] = s1; }
        __syncthreads();
        bf16_t* hcat = (bf16_t*)(P.ws + WS_HCAT);
#pragma unroll
        for (int u = 0; u < 2; ++u) { const int t = tq * 2 + u; const float tot = red[(w & ~1) * 2 + u] + red[(w | 1) * 2 + u]; const float rstd = 1.0f / sqrtf(tot * (1.0f / 128.0f) + EPS);
            const float so = bf2f(mixin[mxo(1024, 128, h, r0 + t) + e]);
            hcat[(size_t)(r0 + t) * 1024 + h * 128 + e] = f2bf(hv[u] * rstd * P.in[11][h * 128 + e] * so); } }
    __syncthreads();
}
struct DRegs { u32x4 k, v0, v1, c0, c1, qa, qb; u32x2 so[4]; float iv, bb, mprev, npv; };
__device__ __forceinline__ DRegs mlstm_d_load(const Params& P, int item, int tid) {
    DRegs R; const int c = item & 127, h = (item >> 7) & 3, b = item >> 9, r0 = b * 8192 + c * 64, pair = item >> 7;
    const bf16_t* mixin = (const bf16_t*)(P.ws + WS_MIXIN);
    const int s = tid >> 3, ch = tid & 7; const bf16_t* kp_ = mixin + mxo(256, 64, h, r0 + s) + ch * 8; const bf16_t* vp_ = mixin + mxo(512, 128, h, r0 + s) + ch * 16;
    R.k = *(const u32x4*)kp_; R.v0 = *(const u32x4*)vp_; R.v1 = *(const u32x4*)(vp_ + 8);
    const bf16_t* cp = (const bf16_t*)((unsigned char*)P.out + OB_CPT) + (size_t)item * 8192;
    R.c0 = *(const u32x4*)(cp + (tid >> 3) * 64 + (tid & 7) * 8); R.c1 = *(const u32x4*)(cp + ((tid + 512) >> 3) * 64 + (tid & 7) * 8);
    R.iv = 0.f; R.bb = 0.f; R.mprev = 0.f; R.npv = 0.f;
    if (tid < 64) { R.iv = ((const float*)(P.ws + WS_GI))[(r0 + tid) * 4 + h]; R.bb = ((const float*)(P.ws + WS_GB))[(r0 + tid) * 4 + h];
        R.mprev = c ? ((const float*)(P.ws + WS_MCH))[pair * 128 + c - 1] : 0.f; R.npv = ((const float*)(P.ws + WS_NPREV))[(size_t)item * 64 + tid]; }
    const int w = tid >> 6, lane = tid & 63, fr = lane & 15, g = lane >> 4, tt = w & 3, eh = w >> 2, tok = r0 + tt * 16 + fr;
    const bf16_t* qp = mixin + mxo(0, 64, h, tok) + g * 8; R.qa = *(const u32x4*)qp; R.qb = *(const u32x4*)(qp + 32);
#pragma unroll
    for (int et = 0; et < 4; ++et) R.so[et] = *(const u32x2*)(mixin + mxo(1024, 128, h, tok) + eh * 64 + et * 16 + g * 4);
    return R;
}
__device__ __forceinline__ void mlstm_d_item(const Params& P, int item, int next_item, DRegs& R, unsigned char* lds, int tid, int lite = 0) {
    const int c = item & 127, h = (item >> 7) & 3, b = item >> 9, r0 = b * 8192 + c * 64, pair = item >> 7;
    float* lb = (float*)lds; float* lu = lb + 64; float* lm = lb + 128; float* misc = lb + 192; float* npv = lb + 256; float* red = lb + 320;
    bf16_t* Kn = (bf16_t*)(lds + 2048); bf16_t* Vt = (bf16_t*)(lds + 11264); bf16_t* Cs = (bf16_t*)(lds + 29696);
    const bf16_t* mixin = (const bf16_t*)(P.ws + WS_MIXIN);
    const float iv_ = R.iv, bb_ = R.bb, mprev_ = R.mprev, npv_ = R.npv;
    { const int s = tid >> 3, ch = tid & 7;
        *(u32x4*)(Kn + s * 72 + ch * 8) = R.k;
        const unsigned vv[8] = {R.v0.x, R.v0.y, R.v0.z, R.v0.w, R.v1.x, R.v1.y, R.v1.z, R.v1.w};
#pragma unroll
        for (int i = 0; i < 8; ++i) { Vt[(ch * 16 + 2 * i) * 72 + s] = (bf16_t)(vv[i] & 0xffffu); Vt[(ch * 16 + 2 * i + 1) * 72 + s] = (bf16_t)(vv[i] >> 16); }
        *(u32x4*)(Cs + (tid >> 3) * 72 + (tid & 7) * 8) = R.c0; *(u32x4*)(Cs + ((tid + 512) >> 3) * 72 + (tid & 7) * 8) = R.c1; }
    if (tid < 64) { const float iv = iv_; float bb = bb_;
#pragma unroll
        for (int o = 1; o < 64; o <<= 1) { const float nb = __shfl_up(bb, o); if (tid >= o) bb += nb; }
        const float mprev = mprev_;
        const float u = iv - bb; float cm = u;
#pragma unroll
        for (int o = 1; o < 64; o <<= 1) { const float nb = __shfl_up(cm, o); if (tid >= o) cm = fmaxf(cm, nb); }
        lb[tid] = bb; lu[tid] = u; lm[tid] = bb + fmaxf(mprev, cm); if (tid == 0) misc[0] = mprev;
        npv[tid] = npv_; }
    const int w = tid >> 6, lane = tid & 63, fr = lane & 15, g = lane >> 4, tt = w & 3, eh = w >> 2, t = tt * 16 + fr, tok = r0 + t;
    bf16x8 qf[2]; float qv0[8], qv1[8]; u32x2 so_[4]; f32x4 mw_[4];
    { qf[0] = __builtin_bit_cast(bf16x8, R.qa); qf[1] = __builtin_bit_cast(bf16x8, R.qb); unpack8(R.qa, qv0); unpack8(R.qb, qv1);
#pragma unroll
        for (int et = 0; et < 4; ++et) { const int e0 = eh * 64 + et * 16 + g * 4; so_[et] = R.so[et]; mw_[et] = *(const f32x4*)(P.in[11] + h * 128 + e0); } }
    if (next_item < 1024) R = mlstm_d_load(P, next_item, tid);
    __syncthreads();
    if (lite == 1) { __syncthreads(); return; }
    f32x4 s[4];
    { bf16x8 kfr[4][2];
#pragma unroll
    for (int st = 0; st < 4; ++st)
#pragma unroll
        for (int kk = 0; kk < 2; ++kk) kfr[st][kk] = *(const bf16x8*)(Kn + (st * 16 + fr) * 72 + g * 8 + kk * 32);
#pragma unroll
    for (int st = 0; st < 4; ++st) { s[st] = (f32x4){0.f, 0.f, 0.f, 0.f};
#pragma unroll
        for (int kk = 0; kk < 2; ++kk) s[st] = mfma16(kfr[st][kk], qf[kk], s[st]); } }
    const float bt = lb[t], mt = lm[t], mprev = misc[0];
    float rs = 0.f;
#pragma unroll
    for (int st = 0; st < 4; ++st)
#pragma unroll
        for (int r = 0; r < 4; ++r) { const int si = st * 16 + g * 4 + r; const float wv = (si <= t) ? __expf(bt + lu[si] - mt) : 0.f; const float val = s[st][r] * 0.125f * wv; s[st][r] = val; rs += val; }
    rs += __shfl_xor(rs, 16); rs += __shfl_xor(rs, 32);
    float qn = 0.f;
#pragma unroll
    for (int i = 0; i < 8; ++i) qn += qv0[i] * npv[g * 8 + i] + qv1[i] * npv[32 + g * 8 + i];
    qn += __shfl_xor(qn, 16); qn += __shfl_xor(qn, 32);
    const float wi = __expf(bt + mprev - mt), den = wi * qn + rs, inv = 1.0f / fmaxf(fabsf(den), __expf(-mt));
    bf16x8 pf[2]; pf[0] = pack8(s[0], s[1]); pf[1] = pack8(s[2], s[3]);
    f32x4 h1[4], h2[4];
    { bf16x8 vfr[4][2], cfr[4][2];
#pragma unroll
    for (int et = 0; et < 4; ++et) { const int e = eh * 64 + et * 16 + fr;
#pragma unroll
        for (int cc = 0; cc < 2; ++cc) { const bf16_t* vp = Vt + e * 72 + cc * 32 + g * 4; const u32x2 v0 = *(const u32x2*)vp, v1 = *(const u32x2*)(vp + 16);
            vfr[et][cc] = __builtin_bit_cast(bf16x8, (u32x4){v0.x, v0.y, v1.x, v1.y}); cfr[et][cc] = *(const bf16x8*)(Cs + e * 72 + g * 8 + cc * 32); } }
#pragma unroll
    for (int et = 0; et < 4; ++et) { h1[et] = (f32x4){0.f, 0.f, 0.f, 0.f}; h2[et] = (f32x4){0.f, 0.f, 0.f, 0.f};
#pragma unroll
        for (int cc = 0; cc < 2; ++cc) { h2[et] = mfma16(vfr[et][cc], pf[cc], h2[et]); h1[et] = mfma16(cfr[et][cc], qf[cc], h1[et]); } } }
    float ss = 0.f;
#pragma unroll
    for (int et = 0; et < 4; ++et)
#pragma unroll
        for (int r = 0; r < 4; ++r) { const float hv = (wi * h1[et][r] + h2[et][r]) * inv; h2[et][r] = hv; ss += hv * hv; }
    ss += __shfl_xor(ss, 16); ss += __shfl_xor(ss, 32);
    if (g == 0) red[w * 16 + fr] = ss;
    __syncthreads();
    { const float tot = red[w * 16 + fr] + red[(w ^ 4) * 16 + fr]; const float rstd = 1.0f / sqrtf(tot * (1.0f / 128.0f) + EPS);
        bf16_t* hcat = (bf16_t*)(P.ws + WS_HCAT);
#pragma unroll
        for (int et = 0; et < 4; ++et) { const int e0 = eh * 64 + et * 16 + g * 4; const u32x2 so = so_[et]; const f32x4 mw = mw_[et];
            const float o0 = h2[et][0] * rstd * mw[0] * bflo(so.x), o1 = h2[et][1] * rstd * mw[1] * bfhi(so.x), o2 = h2[et][2] * rstd * mw[2] * bflo(so.y), o3 = h2[et][3] * rstd * mw[3] * bfhi(so.y);
            u32x2 pk; pk.x = cvt_pk_bf16(o0, o1); pk.y = cvt_pk_bf16(o2, o3); *(u32x2*)(hcat + (size_t)tok * 1024 + h * 128 + e0) = pk; } }
    __syncthreads();
}


__device__ __forceinline__ void tail_mma(unsigned char* lds, const bf16_t* A, const bf16_t* Bt, int K, int r0, int c0, int nchunk, int nseg0, int tid, f32x4 (&acc)[2][2]) {
    const int w = tid >> 6, lane = tid & 63, fr = lane & 15, g = lane >> 4, wr = w & 3, wc = w >> 2;
    const bf16_t* gp[4]; unsigned lo_[4];
#pragma unroll
    for (int j = 0; j < 4; ++j) { const int idx = tid + 512 * j, mat = idx >> 10, rem = idx & 1023, row = rem >> 4, seg = rem & 15;
        gp[j] = (mat ? Bt + (size_t)(c0 + row) * K : A + (size_t)(r0 + row) * K) + seg * 8; lo_[j] = (unsigned)(mat * 17408 + row * 272 + seg * 16); }
    u32x4 st[4], st2[4];
#pragma unroll
    for (int j = 0; j < 4; ++j) st[j] = *(const u32x4*)gp[j];
#pragma unroll
    for (int j = 0; j < 4; ++j) *(u32x4*)(lds + lo_[j]) = st[j];
    if (nchunk > 1) {
#pragma unroll
        for (int j = 0; j < 4; ++j) st[j] = *(const u32x4*)(gp[j] + 128); }
    __syncthreads();
    const unsigned aoff = (unsigned)((16 * wr + fr) * 272 + g * 16), boff = (unsigned)(17408 + (32 * wc + fr) * 272 + g * 16);
#pragma unroll 1
    for (int ch = 0; ch < nchunk; ++ch) {
        const unsigned cur = (unsigned)(ch & 1) * 34816u, nxt = 34816u - cur;
        if (ch + 2 < nchunk) {
#pragma unroll
            for (int j = 0; j < 4; ++j) st2[j] = *(const u32x4*)(gp[j] + (size_t)(ch + 2) * 128); }
        bf16x8 fa[4], f0[4], f1[4];
#pragma unroll
        for (int kk = 0; kk < 4; ++kk) { fa[kk] = *(const bf16x8*)(lds + cur + aoff + kk * 64); f0[kk] = *(const bf16x8*)(lds + cur + boff + kk * 64); f1[kk] = *(const bf16x8*)(lds + cur + boff + 16 * 272 + kk * 64); }
        if (ch < nseg0) {
#pragma unroll
            for (int kk = 0; kk < 4; ++kk) { acc[0][0] = mfma16(f0[kk], fa[kk], acc[0][0]); acc[0][1] = mfma16(f1[kk], fa[kk], acc[0][1]); } }
        else {
#pragma unroll
            for (int kk = 0; kk < 4; ++kk) { acc[1][0] = mfma16(f0[kk], fa[kk], acc[1][0]); acc[1][1] = mfma16(f1[kk], fa[kk], acc[1][1]); } }
        if (ch + 1 < nchunk) {
#pragma unroll
            for (int j = 0; j < 4; ++j) *(u32x4*)(lds + nxt + lo_[j]) = st[j]; }
        __syncthreads();
#pragma unroll
        for (int j = 0; j < 4; ++j) st[j] = st2[j];
    }
}
__device__ __forceinline__ void tail_mix(const Params& P, unsigned char* lds, int tb, int tid) {
    const int w = tid >> 6, lane = tid & 63, fr = lane & 15, g = lane >> 4, tok = MP + (tb >> 4) * 64 + 16 * (w & 3) + fr, col0 = (tb & 15) * 64 + 32 * (w >> 2);
    const bf16_t* hcat = (const bf16_t*)(P.ws + WS_HCAT); const bf16_t* wab = (const bf16_t*)(P.ws + WS_WAB); const bf16_t* gates = (const bf16_t*)(P.ws + WS_GATES); bf16_t* mix = (bf16_t*)(P.ws + WS_MIXIN);
    f32x4 ab[2][2]; ab[0][0] = ab[0][1] = ab[1][0] = ab[1][1] = (f32x4){0.f, 0.f, 0.f, 0.f};
    tail_mma(lds, hcat, wab, 1024, MP + (tb >> 4) * 64, (tb & 15) * 64, 8, 4, tid, ab);
    const f32x4 (&a)[2] = ab[0]; const f32x4 (&b)[2] = ab[1];
#pragma unroll
    for (int mt = 0; mt < 2; ++mt) { const int c = col0 + mt * 16 + g * 4; const u32x2 sa = *(const u32x2*)(gates + (size_t)tok * 2048 + c), sb = *(const u32x2*)(gates + (size_t)tok * 2048 + 1024 + c);
        const float v0 = bflo(sa.x) * a[mt][0] + bflo(sb.x) * b[mt][0], v1 = bfhi(sa.x) * a[mt][1] + bfhi(sb.x) * b[mt][1], v2 = bflo(sa.y) * a[mt][2] + bflo(sb.y) * b[mt][2], v3 = bfhi(sa.y) * a[mt][3] + bfhi(sb.y) * b[mt][3];
        u32x2 pk; pk.x = cvt_pk_bf16(v0, v1); pk.y = cvt_pk_bf16(v2, v3); *(u32x2*)(mix + (size_t)tok * 1024 + c) = pk; }
}
__device__ __forceinline__ void tail_out(const Params& P, unsigned char* lds, int tb, int tid) {
    const int w = tid >> 6, lane = tid & 63, fr = lane & 15, g = lane >> 4, tok = MP + (tb >> 4) * 64 + 16 * (w & 3) + fr, col0 = (tb & 15) * 64 + 32 * (w >> 2);
    f32x4 ab[2][2]; ab[0][0] = ab[0][1] = ab[1][0] = ab[1][1] = (f32x4){0.f, 0.f, 0.f, 0.f};
    tail_mma(lds, (const bf16_t*)(P.ws + WS_MIXIN), (const bf16_t*)(P.ws + WS_WOUT), 1024, MP + (tb >> 4) * 64, (tb & 15) * 64, 8, 8, tid, ab);
    const f32x4 (&acc)[2] = ab[0];
    const float* xrow = P.in[1] + (size_t)(tok - MP) * 1024; bf16_t* x1b = (bf16_t*)(P.ws + WS_HN); float ss = 0.f;
#pragma unroll
    for (int mt = 0; mt < 2; ++mt) { const int c = col0 + mt * 16 + g * 4; const f32x4 y = *(const f32x4*)(xrow + c) + acc[mt];
        ss += (y[0] * y[0] + y[1] * y[1]) + (y[2] * y[2] + y[3] * y[3]);
        u32x2 pk; pk.x = cvt_pk_bf16(y[0], y[1]); pk.y = cvt_pk_bf16(y[2], y[3]); *(u32x2*)(x1b + (size_t)tok * 1024 + c) = pk; }
    ss += __shfl_xor(ss, 16); ss += __shfl_xor(ss, 32);
    if (g == 0) unsafeAtomicAdd((float*)(P.ws + WS_ROWSS) + tok, ss);
}
__device__ __forceinline__ void tail_down(const Params& P, unsigned char* lds, int tb, int tid) {
    const int w = tid >> 6, lane = tid & 63, fr = lane & 15, g = lane >> 4, tok = MP + (tb >> 4) * 64 + 16 * (w & 3) + fr, col0 = (tb & 15) * 64 + 32 * (w >> 2);
    f32x4 ab[2][2]; ab[0][0] = ab[0][1] = ab[1][0] = ab[1][1] = (f32x4){0.f, 0.f, 0.f, 0.f};
    tail_mma(lds, (const bf16_t*)(P.ws + WS_MIXIN), (const bf16_t*)(P.ws + WS_WD), DFF, MP + (tb >> 4) * 64, (tb & 15) * 64, 22, 22, tid, ab);
    const f32x4 (&acc)[2] = ab[0];
#pragma unroll
    for (int mt = 0; mt < 2; ++mt) { const size_t o = (size_t)tok * 1024 + col0 + mt * 16 + g * 4; const u32x2 r = *(const u32x2*)((const bf16_t*)(P.ws + WS_HN) + o);
        *(f32x4*)(P.out + o) = (f32x4){bflo(r.x), bfhi(r.x), bflo(r.y), bfhi(r.y)} + acc[mt]; }
}
#define GSYNC_F(grid) xcd_barrier(xbar)
__global__ void __launch_bounds__(512, 2) fwd_kernel(Params P) {
    extern __shared__ __attribute__((aligned(16))) unsigned char lds[];
    cg::grid_group grid = cg::this_grid();
    const int tid = threadIdx.x, G = gridDim.x;
    const int lo = P.ph_lo, hi = P.ph_hi;
    volatile LAS unsigned* xst = (volatile LAS unsigned*)((LAS unsigned char*)lds + 131072);
    if (tid < 4) xst[tid] = 0u;
    __syncthreads();
    XcdBarrier xbar = xcd_barrier_post((unsigned*)(P.ws + WS_BAR), xst);
#ifndef PHASE_MASK
#define PHASE_MASK 0x1ff
#endif
#define IN(k) (((PHASE_MASK >> (k)) & 1) && lo <= (k) && (k) < hi)
#define GSYNC() xcd_barrier(xbar)
#define SEAM(k) do { if (IN(k) && IN((k) + 1)) GSYNC(); } while (0)
#ifndef DUP_MASK
#define DUP_MASK 0
#endif
#ifndef EXTRA_SYNCS
#define EXTRA_SYNCS 0
#endif
#define REP(k) for (int rep_ = 0; rep_ <= ((DUP_MASK >> (k)) & 1); ++rep_) if (rep_ == 0 || (GSYNC_F(grid), true))
    bf16_t* HN = (bf16_t*)(P.ws + WS_HN); bf16_t* MIXIN = (bf16_t*)(P.ws + WS_MIXIN); bf16_t* GATES = (bf16_t*)(P.ws + WS_GATES); bf16_t* HCAT = (bf16_t*)(P.ws + WS_HCAT);
    PG8_LAS unsigned char* ldsa = (PG8_LAS unsigned char*)lds;
    if (IN(0)) REP(0) p0_prep(P, lds, tid, G);
    if (lo < 0) grid.sync();
    SEAM(0);
    for (int xs_ = 0; xs_ < EXTRA_SYNCS; ++xs_) GSYNC();
    if (IN(1)) REP(1) { pg8::Gemm g{HN, (const bf16_t*)(P.ws + WS_WIN), MT, NPROJ, 1024}; pg8::StaticOrder S; S.init(MT, NPROJ, G, (int)blockIdx.x);
        pg8::EpiProj E{MIXIN, GATES}; pg8::gemm_phase<pg8::EpiProj, pg8::StaticOrder, true, true>(ldsa, g, S, E);
        { const int nfull = (MT / 256) * (NPROJ / 256) / G, nlast = (MT / 256) * (NPROJ / 256) - nfull * G;
            if (nlast > 0 && nlast < G && (int)blockIdx.x >= nlast) for (int it = NT_IN + (int)blockIdx.x - nlast; it < NT_ALL; it += G - nlast) wtile_by_index(P, it, lds, tid);
            else if (nlast == 0 || nlast >= G) for (int it = NT_IN + (int)blockIdx.x; it < NT_ALL; it += G) wtile_by_index(P, it, lds, tid); } }
    SEAM(1);
    if (IN(2)) REP(2) {
        for (int it = blockIdx.x; it < 256 + 256 + 1024; it += G) {
            if (it < 256) attn_prompt_item(P, it, lds, tid);
            else if (it < 512) attn_sample_item(P, it - 256, lds, tid);
            else mlstm_b_item(P, it - 512, lds, tid);
        } }
    SEAM(2);
    if (IN(3)) REP(3) {
        const int nscan = (G > 64) ? 64 : 0;
#ifndef P3_VARIANT
#define P3_VARIANT 3
#endif
        if (nscan) { if ((int)blockIdx.x < 64) { if (P3_VARIANT & 1) mlstm_scan(P, lds, tid); } else if (P3_VARIANT & 2) { for (int it = blockIdx.x - 64; it < 512; it += G - 64) mlstm_sample_item(P, it, lds, tid); } }
        else { for (int it = blockIdx.x; it < 512; it += G) mlstm_sample_item(P, it, lds, tid); }
    }
    SEAM(3);
#ifndef LITE4
#define LITE4 0
#endif
    if (IN(4)) REP(4) { if ((int)blockIdx.x < 1024) { DRegs R = mlstm_d_load(P, blockIdx.x, tid); for (int it = blockIdx.x; it < 1024; it += G) mlstm_d_item(P, it, it + G, R, lds, tid, rep_ ? LITE4 : 0); } }
    SEAM(4);
    if (IN(5)) REP(5) { pg8::Gemm g{HCAT, (const bf16_t*)(P.ws + WS_WAB), MP, 1024, 1024}; pg8::StaticOrder S; S.init(MP, 1024, G, (int)blockIdx.x);
        pg8::EpiMix E{GATES, MIXIN}; pg8::gemm_phase<pg8::EpiMix, pg8::StaticOrder, true, true>(ldsa, g, S, E);
        for (int tb = blockIdx.x; tb < 256; tb += G) tail_mix(P, lds, tb, tid); }
#ifdef DUPC5
    GSYNC();
    { pg8::Gemm g{HCAT, (const bf16_t*)(P.ws + WS_WAB), MP, 1024, 1024}; pg8::StaticOrder S; S.init(MP, 1024, G, (int)blockIdx.x);
        pg8::EpiMix E{GATES, MIXIN}; pg8::gemm_phase<pg8::EpiMix, pg8::StaticOrder, true, true>(ldsa, g, S, E);
        for (int tb = blockIdx.x; tb < 256; tb += G) tail_mix(P, lds, tb, tid); }
#endif
    SEAM(5);
    if (IN(6)) REP(6) { pg8::Gemm g{MIXIN, (const bf16_t*)(P.ws + WS_WOUT), MP, 1024, 1024}; pg8::StaticOrder S; S.init(MP, 1024, G, (int)blockIdx.x);
        pg8::EpiOut E{P.in[0], P.in[1], HN, (float*)(P.ws + WS_ROWSS)}; pg8::gemm_phase<pg8::EpiOut, pg8::StaticOrder, true, true>(ldsa, g, S, E);
        for (int tb = blockIdx.x; tb < 256; tb += G) tail_out(P, lds, tb, tid); }
    SEAM(6);
    if (IN(7)) REP(7) { pg8::Gemm g{HN, (const bf16_t*)(P.ws + WS_WGU), MT, 2 * DFF, 1024}; pg8::StaticOrder S; S.init(MT, 2 * DFF, G, (int)blockIdx.x);
        pg8::EpiGU E{MIXIN, (const float*)(P.ws + WS_ROWSS)}; pg8::gemm_phase<pg8::EpiGU, pg8::StaticOrder, true, true>(ldsa, g, S, E); }
#ifdef DUPC7
    GSYNC();
    { pg8::Gemm g{HN, (const bf16_t*)(P.ws + WS_WGU), MT, 2 * DFF, 1024}; pg8::StaticOrder S; S.init(MT, 2 * DFF, G, (int)blockIdx.x);
        pg8::EpiGU E{MIXIN, (const float*)(P.ws + WS_ROWSS)}; pg8::gemm_phase<pg8::EpiGU, pg8::StaticOrder, true, true>(ldsa, g, S, E); }
#endif
    SEAM(7);
    if (IN(8)) REP(8) { pg8::Gemm g{MIXIN, (const bf16_t*)(P.ws + WS_WD), MP, 1024, DFF}; pg8::StaticOrder S; S.init(MP, 1024, G, (int)blockIdx.x);
        pg8::EpiDown E{HN, P.out}; pg8::gemm_phase<pg8::EpiDown, pg8::StaticOrder, true, true>(ldsa, g, S, E);
        for (int tb = blockIdx.x; tb < 256; tb += G) tail_down(P, lds, tb, tid); }
#ifdef DBG_DUMP
    GSYNC();
    if (DBG_DUMP == 1) { for (size_t i = (size_t)blockIdx.x * 512 + tid; i < (size_t)MT * 1024; i += (size_t)G * 512) { const size_t r = i >> 10, c = i & 1023; P.out[i] = bf2f(MIXIN[r * NMIX + c]); } }
    if (DBG_DUMP == 2) { const bf16_t* d = (const bf16_t*)((unsigned char*)P.out + OB_DCT); for (size_t i = (size_t)blockIdx.x * 512 + tid; i < (size_t)1024 * 8192; i += (size_t)G * 512) P.out[i] = bf2f(d[i]); }
    if (DBG_DUMP == 4) { unsigned* d = (unsigned*)((unsigned char*)P.out + OB_DCT); for (size_t i = (size_t)blockIdx.x * 512 + tid; i < (size_t)1024 * 4096; i += (size_t)G * 512) { const unsigned w = __hip_atomic_load(d + i, __ATOMIC_RELAXED, __HIP_MEMORY_SCOPE_AGENT); P.out[2 * i] = bflo(w); P.out[2 * i + 1] = bfhi(w); } }
    if (DBG_DUMP == 5) { const float* a = (const float*)(P.ws + WS_GI); const float* bq = (const float*)(P.ws + WS_GB); for (int i = blockIdx.x * 512 + tid; i < MT * 4; i += G * 512) { P.out[i] = a[i]; P.out[MT * 4 + i] = bq[i]; } }
    if (DBG_DUMP == 6) { const float* a = (const float*)(P.ws + WS_DN); for (int i = blockIdx.x * 512 + tid; i < 65536; i += G * 512) P.out[i] = a[i]; }
    if (DBG_DUMP == 3) { for (size_t i = (size_t)blockIdx.x * 512 + tid; i < (size_t)MT * 1024; i += (size_t)G * 512) P.out[i] = bf2f(HN[i]); }
#endif
#undef IN
#undef SEAM
}

extern "C" void kernel_launch(void* const* d_in, const int* in_sizes, int n_in, void* d_out, int out_size, void* d_ws, size_t ws_size, hipStream_t stream) {
    static int grid = 0;
    if (grid == 0) {
        if (n_in != 22 || (size_t)out_size != O_END || ws_size < WS_END) { fprintf(stderr, "kernel_launch: unexpected shapes (n_in %d, out %d, ws %zu)\n", n_in, out_size, ws_size); grid = -1; return; }
        int dev = 0, cus = 0, per_cu = 0;
        (void)hipGetDevice(&dev); (void)hipDeviceGetAttribute(&cus, hipDeviceAttributeMultiprocessorCount, dev);
        if (hipFuncSetAttribute((const void*)fwd_kernel, hipFuncAttributeMaxDynamicSharedMemorySize, LDS_BYTES) != hipSuccess) { fprintf(stderr, "kernel_launch: hipFuncSetAttribute failed\n"); grid = -1; return; }
        if (hipOccupancyMaxActiveBlocksPerMultiprocessor(&per_cu, (const void*)fwd_kernel, 512, LDS_BYTES) != hipSuccess || per_cu < 1) { fprintf(stderr, "kernel_launch: occupancy query failed (%d)\n", per_cu); (void)hipGetLastError(); per_cu = 1; }
        grid = cus * 1;
        if (grid < 65) { fprintf(stderr, "kernel_launch: needs more than 64 CUs\n"); grid = -1; return; }
    }
    if (grid < 0) return;
    if (hipMemsetAsync((char*)d_ws + WS_BAR, 0, XCD_BAR_WORDS * 4, stream) != hipSuccess) { fprintf(stderr, "kernel_launch: memset failed\n"); return; }
    Params p{};
    for (int i = 0; i < 22; ++i) p.in[i] = (const float*)d_in[i];
    p.out = (float*)d_out; p.ws = (unsigned char*)d_ws;
    constexpr int NPH = 9;
    for (int li = 0; li < N_LAUNCHES; ++li) {
        p.ph_lo = (N_LAUNCHES == 1) ? 0 : li; p.ph_hi = (N_LAUNCHES == 1) ? NPH : li + 1;
        void* args[] = {&p};
        const hipError_t e = hipLaunchCooperativeKernel((const void*)fwd_kernel, dim3(grid), dim3(512), args, LDS_BYTES, stream);
        if (e != hipSuccess) { fprintf(stderr, "kernel_launch: cooperative launch %d failed: %s (grid %d)\n", li, hipGetErrorString(e), grid); break; }
    }
}
```
